# Optimizing an MI355X kernel written in HIP

```python
import jax, jax.numpy as jnp
from jax import lax
import numpy as np

D_MODEL = 1024
BATCH = 16
SEQ = 2048
DEPTH = 1

CHUNK = 64
D_MIX = D_MODEL
SSD_HEADS = 8
SSD_HEAD_DIM = 64
SSD_INNER = SSD_HEADS * SSD_HEAD_DIM
SSD_GROUPS = 2
SSD_STATE = 128
CONV_WIDTH = 4
SSD_CONV_DIM = SSD_INNER + 2 * SSD_GROUPS * SSD_STATE
ATT_HEADS = 8
ATT_HEAD_DIM = 64
ATT_INNER = ATT_HEADS * ATT_HEAD_DIM
Q_BLOCK = 128
N_EXPERT_GROUPS = 4
EXPERTS_PER_GROUP = 4
N_EXPERTS = N_EXPERT_GROUPS * EXPERTS_PER_GROUP
TOP_K = 2
D_FF_EXPERT = 512
DEEPNORM_ALPHA = (2.0 * DEPTH) ** 0.25
DEEPNORM_BETA = (8.0 * DEPTH) ** -0.25
LN_EPS = 1e-5
RMS_EPS = 1e-5
IN_SIZES = (SSD_INNER, SSD_CONV_DIM, SSD_HEADS, ATT_INNER, ATT_INNER, ATT_INNER, ATT_HEADS)
D_IN_PROJ = SSD_INNER + SSD_CONV_DIM + SSD_HEADS + 3 * ATT_INNER + ATT_HEADS

kernel_name = "hybrid_ssd_fox_hiermoe_deepnorm"


def _split_cols(u, sizes):
    idx = np.cumsum(np.array(sizes))[:-1].tolist()
    return jnp.split(u, idx, axis=-1)


def _layer_norm(u, g, b):
    uf = u.astype(jnp.float32)
    mu = jnp.mean(uf, axis=-1, keepdims=True)
    var = jnp.mean(jnp.square(uf - mu), axis=-1, keepdims=True)
    return ((uf - mu) * lax.rsqrt(var + LN_EPS) * g + b).astype(u.dtype)


def _causal_dwconv(u, w, b):
    s = u.shape[1]
    up = jnp.pad(u, ((0, 0), (CONV_WIDTH - 1, 0), (0, 0)))
    out = b
    for k in range(CONV_WIDTH):
        out = out + up[:, k:k + s, :] * w[k]
    return out


def _ssd_scan(xs, dt, a, bm, cm, d_skip):
    f32 = jnp.float32
    xs, dt, bm, cm = xs.astype(f32), dt.astype(f32), bm.astype(f32), cm.astype(f32)
    b, s, h, p = xs.shape
    nc = s // CHUNK
    r = h // SSD_GROUPS
    xdt = (xs * dt[..., None]).reshape(b, nc, CHUNK, SSD_GROUPS, r, p)
    da = (dt * a.astype(f32)).reshape(b, nc, CHUNK, SSD_GROUPS, r)
    bc = bm.reshape(b, nc, CHUNK, SSD_GROUPS, SSD_STATE)
    cc = cm.reshape(b, nc, CHUNK, SSD_GROUPS, SSD_STATE)
    a_cum = jnp.cumsum(da, axis=2)
    seg = a_cum[:, :, :, None] - a_cum[:, :, None, :]
    tri = jnp.tril(jnp.ones((CHUNK, CHUNK), dtype=bool))[None, None, :, :, None, None]
    lmat = jnp.exp(jnp.where(tri, seg, -jnp.inf))
    cb = jnp.einsum('bclgn,bcsgn->bclsg', cc, bc)
    y_diag = jnp.einsum('bclsg,bclsgr,bcsgrp->bclgrp', cb, lmat, xdt)
    decay_to_end = jnp.exp(a_cum[:, :, -1:] - a_cum)
    chunk_states = jnp.einsum('bclgn,bclgr,bclgrp->bcgrpn', bc, decay_to_end, xdt)
    chunk_decay = jnp.exp(a_cum[:, :, -1])

    def step(state, inp):
        st, dec = inp
        return state * dec[..., None, None] + st, state

    init = jnp.zeros((b, SSD_GROUPS, r, p, SSD_STATE), f32)
    _, states_in = lax.scan(step, init, (jnp.moveaxis(chunk_states, 1, 0),
                                         jnp.moveaxis(chunk_decay, 1, 0)))
    states_in = jnp.moveaxis(states_in, 0, 1)
    y_off = jnp.einsum('bclgn,bcgrpn,bclgr->bclgrp', cc, states_in, jnp.exp(a_cum))
    y = (y_diag + y_off).reshape(b, s, h, p)
    return y + xs * d_skip.astype(f32)[:, None]


def _forgetting_attention(q, k, v, log_f):
    b, s, h, d = q.shape
    fcum = jnp.transpose(jnp.cumsum(log_f, axis=1), (0, 2, 1))
    scale = d ** -0.5
    outs = []
    for blk in range(s // Q_BLOCK):
        q0, q1 = blk * Q_BLOCK, (blk + 1) * Q_BLOCK
        logits = jnp.einsum('bqhd,bkhd->bhqk', q[:, q0:q1], k[:, :q1]).astype(jnp.float32) * scale
        logits = logits + fcum[:, :, q0:q1, None] - fcum[:, :, None, :q1]
        qpos = jnp.arange(q0, q1)[:, None]
        kpos = jnp.arange(q1)[None, :]
        logits = jnp.where(qpos >= kpos, logits, -jnp.inf)
        probs = jax.nn.softmax(logits, axis=-1)
        outs.append(jnp.einsum('bhqk,bkhd->bqhd', probs.astype(v.dtype), v[:, :q1]))
    return jnp.concatenate(outs, axis=1)


def _hybrid_mixer(h, w_in, b_in, conv_w, conv_b, a_log, d_skip, ssd_norm_g, w_out):
    bsz, s, _ = h.shape
    proj = jnp.einsum('bsd,de->bse', h, w_in) + b_in
    z, xbc, dt_raw, q, k, v, f_raw = _split_cols(proj, IN_SIZES)
    xbc = jax.nn.silu(_causal_dwconv(xbc, conv_w, conv_b))
    xs, bm, cm = _split_cols(xbc, (SSD_INNER, SSD_GROUPS * SSD_STATE, SSD_GROUPS * SSD_STATE))
    xs = xs.reshape(bsz, s, SSD_HEADS, SSD_HEAD_DIM)
    bm = bm.reshape(bsz, s, SSD_GROUPS, SSD_STATE)
    cm = cm.reshape(bsz, s, SSD_GROUPS, SSD_STATE)
    dt = jax.nn.softplus(dt_raw.astype(jnp.float32))
    a = -jnp.exp(a_log.astype(jnp.float32))
    y = _ssd_scan(xs, dt, a, bm, cm, d_skip).reshape(bsz, s, SSD_INNER)
    y = (y * jax.nn.silu(z.astype(jnp.float32))).reshape(bsz, s, SSD_GROUPS, SSD_INNER // SSD_GROUPS)
    y = y * lax.rsqrt(jnp.mean(jnp.square(y), axis=-1, keepdims=True) + RMS_EPS)
    y_ssd = (y.reshape(bsz, s, SSD_INNER) * ssd_norm_g).astype(h.dtype)
    q = q.reshape(bsz, s, ATT_HEADS, ATT_HEAD_DIM)
    k = k.reshape(bsz, s, ATT_HEADS, ATT_HEAD_DIM)
    v = v.reshape(bsz, s, ATT_HEADS, ATT_HEAD_DIM)
    log_f = jax.nn.log_sigmoid(f_raw.astype(jnp.float32))
    y_att = _forgetting_attention(q, k, v, log_f).reshape(bsz, s, ATT_INNER)
    merged = jnp.concatenate([y_ssd, y_att.astype(h.dtype)], axis=-1)
    return jnp.einsum('bse,ed->bsd', merged, w_out)


def _hier_moe(h, rg_w, rg_b, re_w, re_b, w_gate, w_up, w_down):
    bsz, s, d = h.shape
    hf = h.reshape(bsz * s, d)
    g_logits = (hf @ rg_w + rg_b).astype(jnp.float32)
    g_val, g_idx = lax.top_k(jax.nn.softmax(g_logits, axis=-1), 1)
    g_val, g_idx = g_val[:, 0], g_idx[:, 0]
    e_all = (jnp.einsum('td,gde->tge', hf, re_w) + re_b).astype(jnp.float32)
    e_logits = jnp.take_along_axis(e_all, g_idx[:, None, None], axis=1)[:, 0]
    e_val, e_idx = lax.top_k(jax.nn.softmax(e_logits, axis=-1), TOP_K)
    e_val = e_val / jnp.sum(e_val, axis=-1, keepdims=True)
    weights = g_val[:, None] * e_val
    expert_id = g_idx[:, None] * EXPERTS_PER_GROUP + e_idx
    combine = jnp.sum(jax.nn.one_hot(expert_id, N_EXPERTS, dtype=jnp.float32) * weights[..., None], axis=1)
    out = jnp.zeros((bsz * s, d), jnp.float32)
    for e in range(N_EXPERTS):
        act = jax.nn.silu(hf @ w_gate[e]) * (hf @ w_up[e])
        out = out + combine[:, e:e + 1] * (act @ w_down[e]).astype(jnp.float32)
    return out.astype(h.dtype).reshape(bsz, s, d)


def setup_inputs(seed: int = 0) -> dict:
    key = jax.random.key(seed)
    ks = jax.random.split(key, 20)
    f32 = jnp.float32
    x = jax.random.normal(ks[0], (BATCH, SEQ, D_MODEL), f32)
    col_scale = np.concatenate([
        np.ones(SSD_INNER + SSD_CONV_DIM), np.full(SSD_HEADS, 0.1),
        np.ones(2 * ATT_INNER), np.full(ATT_INNER, DEEPNORM_BETA), np.full(ATT_HEADS, 0.1)]).astype(np.float32)
    w_in = jax.random.normal(ks[1], (DEPTH, D_MODEL, D_IN_PROJ), f32) * (D_MODEL ** -0.5) * jnp.asarray(col_scale)
    b_in = 0.01 * jax.random.normal(ks[2], (DEPTH, D_IN_PROJ), f32)
    dt0 = jnp.exp(jax.random.uniform(ks[3], (DEPTH, SSD_HEADS), f32, np.log(1e-3), np.log(1e-1)))
    dt_bias = dt0 + jnp.log(-jnp.expm1(-dt0))
    off_dt = SSD_INNER + SSD_CONV_DIM
    b_in = b_in.at[:, off_dt:off_dt + SSD_HEADS].set(dt_bias)
    f_bias = jax.random.uniform(ks[4], (DEPTH, ATT_HEADS), f32, 1.0, 5.0)
    b_in = b_in.at[:, D_IN_PROJ - ATT_HEADS:].set(f_bias)
    conv_w = jax.random.normal(ks[5], (DEPTH, CONV_WIDTH, SSD_CONV_DIM), f32) * (CONV_WIDTH ** -0.5)
    conv_b = 0.01 * jax.random.normal(ks[6], (DEPTH, SSD_CONV_DIM), f32)
    a_log = jnp.log(jax.random.uniform(ks[7], (DEPTH, SSD_HEADS), f32, 1.0, 16.0))
    d_skip = 1.0 + 0.1 * jax.random.normal(ks[8], (DEPTH, SSD_HEADS), f32)
    ssd_norm_g = 1.0 + 0.05 * jax.random.normal(ks[9], (DEPTH, SSD_INNER), f32)
    w_out = jax.random.normal(ks[10], (DEPTH, D_MIX, D_MODEL), f32) * (D_MIX ** -0.5) * DEEPNORM_BETA
    ln1_g = 1.0 + 0.05 * jax.random.normal(ks[11], (DEPTH, D_MODEL), f32)
    ln1_b = 0.02 * jax.random.normal(ks[12], (DEPTH, D_MODEL), f32)
    router_group_w = jax.random.normal(ks[13], (DEPTH, D_MODEL, N_EXPERT_GROUPS), f32) * (D_MODEL ** -0.5)
    router_group_b = 0.01 * jax.random.normal(ks[14], (DEPTH, N_EXPERT_GROUPS), f32)
    router_expert_w = jax.random.normal(ks[15], (DEPTH, N_EXPERT_GROUPS, D_MODEL, EXPERTS_PER_GROUP), f32) * (D_MODEL ** -0.5)
    router_expert_b = 0.01 * jax.random.normal(ks[16], (DEPTH, N_EXPERT_GROUPS, EXPERTS_PER_GROUP), f32)
    kw = jax.random.split(ks[17], 3)
    w_gate = jax.random.normal(kw[0], (DEPTH, N_EXPERTS, D_MODEL, D_FF_EXPERT), f32) * (D_MODEL ** -0.5)
    w_up = jax.random.normal(kw[1], (DEPTH, N_EXPERTS, D_MODEL, D_FF_EXPERT), f32) * (D_MODEL ** -0.5)
    w_down = jax.random.normal(kw[2], (DEPTH, N_EXPERTS, D_FF_EXPERT, D_MODEL), f32) * (D_FF_EXPERT ** -0.5) * DEEPNORM_BETA
    ln2_g = 1.0 + 0.05 * jax.random.normal(ks[18], (DEPTH, D_MODEL), f32)
    ln2_b = 0.02 * jax.random.normal(ks[19], (DEPTH, D_MODEL), f32)
    return {"x": x, "w_in": w_in, "b_in": b_in, "conv_w": conv_w, "conv_b": conv_b,
            "a_log": a_log, "d_skip": d_skip, "ssd_norm_g": ssd_norm_g, "w_out": w_out,
            "ln1_g": ln1_g, "ln1_b": ln1_b, "router_group_w": router_group_w,
            "router_group_b": router_group_b, "router_expert_w": router_expert_w,
            "router_expert_b": router_expert_b, "w_gate": w_gate, "w_up": w_up,
            "w_down": w_down, "ln2_g": ln2_g, "ln2_b": ln2_b}


def reference(x, w_in, b_in, conv_w, conv_b, a_log, d_skip, ssd_norm_g, w_out,
              ln1_g, ln1_b, router_group_w, router_group_b, router_expert_w,
              router_expert_b, w_gate, w_up, w_down, ln2_g, ln2_b):
    h = x
    for l in range(DEPTH):
        mix = _hybrid_mixer(h, w_in[l], b_in[l], conv_w[l], conv_b[l], a_log[l],
                            d_skip[l], ssd_norm_g[l], w_out[l])
        h = _layer_norm(DEEPNORM_ALPHA * h + mix, ln1_g[l], ln1_b[l])
        ffn = _hier_moe(h, router_group_w[l], router_group_b[l], router_expert_w[l],
                        router_expert_b[l], w_gate[l], w_up[l], w_down[l])
        h = _layer_norm(DEEPNORM_ALPHA * h + ffn, ln2_g[l], ln2_b[l])
    return h
```

```cpp
#include <hip/hip_runtime.h>
#include <stdint.h>

typedef unsigned short bf16_t;
__device__ __forceinline__ float bf2f(bf16_t v) { return __uint_as_float(((unsigned)v) << 16); }
__device__ __forceinline__ bf16_t f2bf(float f) { unsigned u = __float_as_uint(f); return (bf16_t)((u + 0x7fffu + ((u >> 16) & 1u)) >> 16); }

constexpr int BATCH = 16, SEQ = 2048, T = BATCH * SEQ, D = 1024;
constexpr int NPROJ = 3088;
constexpr int NH = 8, HD = 64, NG = 2, NS = 128;
constexpr int NCLS = 24;
constexpr float ALPHA = 1.189207115002721f;
constexpr float LN_EPS = 1e-5f, RMS_EPS = 1e-5f;
constexpr float LOG2E = 1.4426950408889634f;
constexpr float C2 = 0.125f * LOG2E;

constexpr size_t MiB = 1u << 20;
constexpr size_t WS_CTL = 0;
constexpr size_t WS_DT = 58 * MiB;
constexpr size_t WS_LOGF = 59 * MiB;
constexpr size_t WS_F = 60 * MiB;
constexpr size_t WS_PERM = 61 * MiB;
constexpr size_t WS_TOK = 64 * MiB;
constexpr size_t WS_YRAW = 72 * MiB;
constexpr size_t WS_Z = 136 * MiB;
constexpr size_t WS_XBC = 168 * MiB;
constexpr size_t WS_MERGED = 168 * MiB;
constexpr size_t WS_Q = 232 * MiB, WS_K = 264 * MiB, WS_V = 296 * MiB;
constexpr size_t WS_ACT = 232 * MiB;
constexpr size_t WS_XCONV = 328 * MiB;
constexpr size_t WS_HB = 328 * MiB;

struct P {
    const float *x, *w_in, *b_in, *conv_w, *conv_b, *a_log, *d_skip, *ssd_norm_g, *w_out, *ln1_g, *ln1_b,
        *rg_w, *rg_b, *re_w, *re_b, *w_gate, *w_up, *w_down, *ln2_g, *ln2_b;
    float* out; unsigned char* ws;
};

__device__ __forceinline__ float softplus_f(float x) { return fmaxf(x, 0.f) + log1pf(expf(-fabsf(x))); }
__device__ __forceinline__ float silu_f(float x) { return x / (1.f + expf(-x)); }

template <int NB, class AL, class BL, class EP>
__global__ __launch_bounds__(256) void ngemm(AL al, BL bl, EP ep, int K) {
    __shared__ float As[16][68];
    __shared__ float Bs[NB][16][68];
    const int tm = blockIdx.y * 64, tn = blockIdx.x * 64;
    if (!al.tile_ok(tm)) return;
    const int tx = threadIdx.x & 15, ty = threadIdx.x >> 4;
    float acc[NB][4][4];
#pragma unroll
    for (int b = 0; b < NB; ++b)
#pragma unroll
        for (int i = 0; i < 4; ++i)
#pragma unroll
            for (int j = 0; j < 4; ++j) acc[b][i][j] = 0.f;
    for (int k0 = 0; k0 < K; k0 += 16) {
#pragma unroll
        for (int i = 0; i < 4; ++i) { const int idx = threadIdx.x + i * 256; const int r = idx >> 4, kk = idx & 15; As[kk][r] = al(tm + r, k0 + kk); }
#pragma unroll
        for (int b = 0; b < NB; ++b)
#pragma unroll
            for (int i = 0; i < 4; ++i) { const int idx = threadIdx.x + i * 256; const int kk = idx >> 6, n = idx & 63; Bs[b][kk][n] = bl(b, tm, k0 + kk, tn + n); }
        __syncthreads();
#pragma unroll
        for (int kk = 0; kk < 16; ++kk) {
            float a[4];
#pragma unroll
            for (int i = 0; i < 4; ++i) a[i] = As[kk][ty * 4 + i];
#pragma unroll
            for (int b = 0; b < NB; ++b) {
                float bb[4];
#pragma unroll
                for (int j = 0; j < 4; ++j) bb[j] = Bs[b][kk][tx * 4 + j];
#pragma unroll
                for (int i = 0; i < 4; ++i)
#pragma unroll
                    for (int j = 0; j < 4; ++j) acc[b][i][j] += a[i] * bb[j];
            }
        }
        __syncthreads();
    }
#pragma unroll
    for (int i = 0; i < 4; ++i)
#pragma unroll
        for (int j = 0; j < 4; ++j) {
            if (NB == 1) ep(tm + ty * 4 + i, tn + tx * 4 + j, acc[0][i][j], 0.f);
            else ep(tm + ty * 4 + i, tn + tx * 4 + j, acc[0][i][j], acc[NB - 1][i][j]);
        }
}

struct AL_x { const float* x; __device__ bool tile_ok(int) const { return true; } __device__ float operator()(int r, int k) const { return x[(size_t)r * D + k]; } };
struct BL_win { const float* w; __device__ float operator()(int, int, int k, int n) const { return n < NPROJ ? w[(size_t)k * NPROJ + n] : 0.f; } };
struct EP_inproj {
    const float* b_in; bf16_t *z, *xbc, *q, *k, *v; float *dt, *logf;
    __device__ void operator()(int r, int c, float v0, float) const {
        if (c >= NPROJ) return;
        const float val = v0 + b_in[c];
        if (c < 512) z[(size_t)r * 512 + c] = f2bf(val);
        else if (c < 1536) xbc[(size_t)r * 1024 + (c - 512)] = f2bf(val);
        else if (c < 1544) dt[(size_t)r * 8 + (c - 1536)] = softplus_f(val);
        else if (c < 2056) q[(size_t)r * 512 + (c - 1544)] = f2bf(val * C2);
        else if (c < 2568) k[(size_t)r * 512 + (c - 2056)] = f2bf(val);
        else if (c < 3080) v[(size_t)r * 512 + (c - 2568)] = f2bf(val);
        else logf[(size_t)r * 8 + (c - 3080)] = -softplus_f(-val);
    }
};

__global__ void k_conv(const bf16_t* xbc, const float* conv_w, const float* conv_b, float* xconv) {
    const size_t idx = (size_t)blockIdx.x * 256 + threadIdx.x;
    const int c = (int)(idx & 1023); const int t = (int)(idx >> 10); const int s = t & (SEQ - 1);
    float acc = conv_b[c];
#pragma unroll
    for (int k = 0; k < 4; ++k) { const int ss = s - 3 + k; if (ss >= 0) acc += conv_w[k * 1024 + c] * bf2f(xbc[(size_t)(t - 3 + k) * 1024 + c]); }
    xconv[idx] = silu_f(acc);
}

__global__ __launch_bounds__(64) void k_ssd(const float* xconv, const float* dt, const float* a_log, const float* d_skip, float* yraw) {
    __shared__ float Bs[16][128], Cs[16][128];
    const int b = blockIdx.x >> 3, h = blockIdx.x & 7, g = h >> 2, p = threadIdx.x;
    const float a = -expf(a_log[h]), dsk = d_skip[h];
    float st[128];
#pragma unroll
    for (int n = 0; n < 128; ++n) st[n] = 0.f;
    for (int t0 = 0; t0 < SEQ; t0 += 16) {
        __syncthreads();
        for (int i = p; i < 16 * 128; i += 64) { const int tt = i >> 7, n = i & 127; const size_t row = (size_t)(b * SEQ + t0 + tt) * 1024;
            Bs[tt][n] = xconv[row + 512 + g * 128 + n]; Cs[tt][n] = xconv[row + 768 + g * 128 + n]; }
        __syncthreads();
        for (int tt = 0; tt < 16; ++tt) {
            const size_t tok = (size_t)(b * SEQ + t0 + tt);
            const float xs = xconv[tok * 1024 + h * 64 + p], dtv = dt[tok * 8 + h];
            const float dA = expf(dtv * a), xdt = xs * dtv;
            float y = 0.f;
#pragma unroll
            for (int n = 0; n < 128; ++n) { st[n] = st[n] * dA + xdt * Bs[tt][n]; y += Cs[tt][n] * st[n]; }
            yraw[tok * 512 + h * 64 + p] = y + dsk * xs;
        }
    }
}

__global__ __launch_bounds__(256) void k_gatenorm(const float* yraw, const bf16_t* z, const float* norm_g, bf16_t* merged) {
    const int w = blockIdx.x * 4 + (threadIdx.x >> 6), lane = threadIdx.x & 63;
    const int t = w >> 1, g = w & 1;
    float v[4]; float ss = 0.f;
#pragma unroll
    for (int j = 0; j < 4; ++j) { const int c = g * 256 + lane * 4 + j; const float y = yraw[(size_t)t * 512 + c] * silu_f(bf2f(z[(size_t)t * 512 + c])); v[j] = y; ss += y * y; }
#pragma unroll
    for (int o = 1; o < 64; o <<= 1) ss += __shfl_xor(ss, o);
    const float r = rsqrtf(ss * (1.f / 256.f) + RMS_EPS);
#pragma unroll
    for (int j = 0; j < 4; ++j) { const int c = g * 256 + lane * 4 + j; merged[(size_t)t * 1024 + c] = f2bf(v[j] * r * norm_g[c]); }
}

__global__ void k_scanF(const float* logf, float* F) {
    const int i = blockIdx.x * 64 + threadIdx.x; if (i >= BATCH * NH) return;
    const int b = i >> 3, h = i & 7; float s = 0.f;
    for (int t = 0; t < SEQ; ++t) { const size_t o = (size_t)(b * SEQ + t) * 8 + h; s += logf[o]; F[o] = s; }
}

__global__ __launch_bounds__(64) void k_attn(const bf16_t* Q, const bf16_t* K, const bf16_t* V, const float* F, bf16_t* merged) {
    const int bh = blockIdx.y, b = bh >> 3, h = bh & 7; const int t = blockIdx.x * 64 + threadIdx.x;
    const size_t row = (size_t)(b * SEQ + t);
    float q[64], o[64];
#pragma unroll
    for (int d = 0; d < 64; ++d) { q[d] = bf2f(Q[row * 512 + h * 64 + d]); o[d] = 0.f; }
    const float Ft = F[row * 8 + h];
    float m = -INFINITY, l = 0.f;
    const int smax = blockIdx.x * 64 + 63;
    for (int s = 0; s <= smax; ++s) {
        const size_t kr = (size_t)(b * SEQ + s);
        const bf16_t* kp = K + kr * 512 + h * 64; const bf16_t* vp = V + kr * 512 + h * 64;
        float dot = 0.f;
#pragma unroll
        for (int d = 0; d < 64; ++d) dot += q[d] * bf2f(kp[d]);
        const float logit = dot + (Ft - F[kr * 8 + h]) * LOG2E;
        if (s <= t) {
            const float mn = fmaxf(m, logit), corr = exp2f(m - mn), pp = exp2f(logit - mn);
            l = l * corr + pp;
#pragma unroll
            for (int d = 0; d < 64; ++d) o[d] = o[d] * corr + pp * bf2f(vp[d]);
            m = mn;
        }
    }
    const float rl = 1.f / l;
#pragma unroll
    for (int d = 0; d < 64; ++d) merged[row * 1024 + 512 + h * 64 + d] = f2bf(o[d] * rl);
}

struct AL_bf { const bf16_t* a; int lda; int pad; __device__ bool tile_ok(int) const { return true; } __device__ float operator()(int r, int k) const { return bf2f(a[(size_t)r * lda + k]); } };
struct BL_plain { const float* w; int ldb; int pad; __device__ float operator()(int, int, int k, int n) const { return w[(size_t)k * ldb + n]; } };
struct EP_outproj { const float* x; float* out; __device__ void operator()(int r, int c, float v, float) const { out[(size_t)r * D + c] = ALPHA * x[(size_t)r * D + c] + v; } };

__device__ __forceinline__ float wsum(float v) {
#pragma unroll
    for (int o = 1; o < 64; o <<= 1) v += __shfl_xor(v, o);
    return v;
}
__global__ __launch_bounds__(256) void k_ln1_router(float* hio, const float* g1, const float* b1, const float* rg_w, const float* rg_b, const float* re_w, const float* re_b,
                                                    bf16_t* hb, unsigned* cnt, int* perm, float* tokinfo) {
    const int t = blockIdx.x * 4 + (threadIdx.x >> 6), lane = threadIdx.x & 63;
    float v[16]; float s = 0.f;
#pragma unroll
    for (int j = 0; j < 4; ++j) { const float4 u = *(const float4*)(hio + (size_t)t * D + j * 256 + lane * 4); v[4 * j] = u.x; v[4 * j + 1] = u.y; v[4 * j + 2] = u.z; v[4 * j + 3] = u.w; s += (u.x + u.y) + (u.z + u.w); }
    const float mu = wsum(s) * (1.f / D); float s2 = 0.f;
#pragma unroll
    for (int i = 0; i < 16; ++i) { v[i] -= mu; s2 += v[i] * v[i]; }
    const float rstd = rsqrtf(wsum(s2) * (1.f / D) + LN_EPS);
    float gl[4] = {0.f, 0.f, 0.f, 0.f};
#pragma unroll
    for (int j = 0; j < 4; ++j)
#pragma unroll
        for (int i = 0; i < 4; ++i) { const int c = j * 256 + lane * 4 + i; const float hv = v[4 * j + i] * rstd * g1[c] + b1[c]; v[4 * j + i] = hv;
            hio[(size_t)t * D + c] = hv; hb[(size_t)t * D + c] = f2bf(hv);
#pragma unroll
            for (int e = 0; e < 4; ++e) gl[e] += hv * rg_w[c * 4 + e]; }
#pragma unroll
    for (int e = 0; e < 4; ++e) gl[e] = wsum(gl[e]) + rg_b[e];
    int gi = 0; float gm = gl[0];
#pragma unroll
    for (int e = 1; e < 4; ++e) if (gl[e] > gm) { gm = gl[e]; gi = e; }
    float gden = 0.f;
#pragma unroll
    for (int e = 0; e < 4; ++e) gden += expf(gl[e] - gm);
    const float gval = 1.f / gden;
    float el[4] = {0.f, 0.f, 0.f, 0.f};
#pragma unroll
    for (int j = 0; j < 4; ++j)
#pragma unroll
        for (int i = 0; i < 4; ++i) { const int c = j * 256 + lane * 4 + i;
#pragma unroll
            for (int e = 0; e < 4; ++e) el[e] += v[4 * j + i] * re_w[((size_t)gi * D + c) * 4 + e]; }
#pragma unroll
    for (int e = 0; e < 4; ++e) el[e] = wsum(el[e]) + re_b[gi * 4 + e];
    int i1 = 0;
#pragma unroll
    for (int e = 1; e < 4; ++e) if (el[e] > el[i1]) i1 = e;
    int i2 = -1;
#pragma unroll
    for (int e = 0; e < 4; ++e) if (e != i1 && (i2 < 0 || el[e] > el[i2])) i2 = e;
    const float mx = el[i1]; const float p2 = expf(el[i2] - mx); const float w1 = gval / (1.f + p2), w2 = gval * p2 / (1.f + p2);
    const int lo = i1 < i2 ? i1 : i2, hi = i1 < i2 ? i2 : i1; const float wlo = i1 < i2 ? w1 : w2, whi = i1 < i2 ? w2 : w1;
    const int pairidx = lo == 0 ? (hi - 1) : (lo == 1 ? (hi + 1) : 5);
    const int cls = gi * 6 + pairidx;
    if (lane == 0) {
        const unsigned pos = atomicAdd(&cnt[cls], 1u);
        perm[(size_t)cls * T + pos] = t;
        tokinfo[(size_t)t * 4 + 0] = __int_as_float(cls); tokinfo[(size_t)t * 4 + 1] = __int_as_float((int)pos); tokinfo[(size_t)t * 4 + 2] = wlo; tokinfo[(size_t)t * 4 + 3] = whi;
    }
}

struct ClsGeo { const unsigned* cnt;
    __device__ bool find(int row, int& cls, int& pos, int& n) const {
        int off = 0;
        for (int c = 0; c < NCLS; ++c) { const int nc = (int)cnt[c], pc = (nc + 255) & ~255; if (row < off + pc) { cls = c; pos = row - off; n = nc; return true; } off += pc; }
        return false;
    }
};
__device__ __forceinline__ void cls_experts(int cls, int& ea, int& eb) { const int g = cls / 6, pi = cls % 6; const int lo = pi < 3 ? 0 : (pi < 5 ? 1 : 2); const int hi = pi < 3 ? pi + 1 : (pi < 5 ? pi - 1 : 3); ea = g * 4 + lo; eb = g * 4 + hi; }

struct AL_moe1 { const bf16_t* hb; const int* perm; ClsGeo geo;
    __device__ bool tile_ok(int tm) const { int c, p, n; if (!geo.find(tm, c, p, n)) return false; return p < n; }
    __device__ float operator()(int r, int k) const { int c, p, n; if (!geo.find(r, c, p, n) || p >= n) return 0.f; const int tok = perm[(size_t)c * T + p]; return bf2f(hb[(size_t)tok * D + k]); } };
struct BL_moe1 { const float *wg, *wu; ClsGeo geo;
    __device__ float operator()(int b, int tm, int k, int n) const { int c, p, nn; geo.find(tm, c, p, nn); int ea, eb; cls_experts(c, ea, eb); const int e = n < 512 ? ea : eb; const int col = n & 511;
        const float* w = b == 0 ? wg : wu; return w[((size_t)e * D + k) * 512 + col]; } };
struct EP_moe1 { bf16_t* act; const int* perm; const float* tokinfo; ClsGeo geo;
    __device__ void operator()(int r, int c, float g, float u) const { int cl, p, n; float w = 0.f; if (geo.find(r, cl, p, n) && p < n) { const int tok = perm[(size_t)cl * T + p]; w = tokinfo[(size_t)tok * 4 + (c < 512 ? 2 : 3)]; }
        act[(size_t)r * 1024 + c] = f2bf(silu_f(g) * u * w); } };
struct AL_moe2 { const bf16_t* act; ClsGeo geo;
    __device__ bool tile_ok(int tm) const { int c, p, n; if (!geo.find(tm, c, p, n)) return false; return p < n; }
    __device__ float operator()(int r, int k) const { return bf2f(act[(size_t)r * 1024 + k]); } };
struct BL_moe2 { const float* wd; ClsGeo geo;
    __device__ float operator()(int, int tm, int k, int n) const { int c, p, nn; geo.find(tm, c, p, nn); int ea, eb; cls_experts(c, ea, eb); const int e = k < 512 ? ea : eb; return wd[((size_t)e * 512 + (k & 511)) * D + n]; } };
struct EP_moe2 { float* out; const int* perm; ClsGeo geo;
    __device__ void operator()(int r, int c, float v, float) const { int cl, p, n; if (!geo.find(r, cl, p, n) || p >= n) return; const int tok = perm[(size_t)cl * T + p]; float* o = out + (size_t)tok * D + c; *o = ALPHA * (*o) + v; } };

__global__ __launch_bounds__(256) void k_ln2(float* io, const float* g2, const float* b2) {
    const int t = blockIdx.x * 4 + (threadIdx.x >> 6), lane = threadIdx.x & 63;
    float v[16]; float s = 0.f;
#pragma unroll
    for (int j = 0; j < 4; ++j) { const float4 u = *(const float4*)(io + (size_t)t * D + j * 256 + lane * 4); v[4 * j] = u.x; v[4 * j + 1] = u.y; v[4 * j + 2] = u.z; v[4 * j + 3] = u.w; s += (u.x + u.y) + (u.z + u.w); }
    const float mu = wsum(s) * (1.f / D); float s2 = 0.f;
#pragma unroll
    for (int i = 0; i < 16; ++i) { v[i] -= mu; s2 += v[i] * v[i]; }
    const float rstd = rsqrtf(wsum(s2) * (1.f / D) + LN_EPS);
#pragma unroll
    for (int j = 0; j < 4; ++j) { float4 o; const int c = j * 256 + lane * 4;
        o.x = v[4 * j] * rstd * g2[c] + b2[c]; o.y = v[4 * j + 1] * rstd * g2[c + 1] + b2[c + 1]; o.z = v[4 * j + 2] * rstd * g2[c + 2] + b2[c + 2]; o.w = v[4 * j + 3] * rstd * g2[c + 3] + b2[c + 3];
        *(float4*)(io + (size_t)t * D + c) = o; }
}

extern "C" void kernel_launch(void* const* d_in, const int* in_sizes, int n_in, void* d_out, int out_size, void* d_ws, size_t ws_size, hipStream_t stream) {
    P p{};
    const float** ins = (const float**)&p;
    for (int i = 0; i < 20; ++i) ins[i] = (const float*)d_in[i];
    p.out = (float*)d_out; p.ws = (unsigned char*)d_ws;
    unsigned char* ws = p.ws;
    (void)hipMemsetAsync(ws + WS_CTL, 0, 4096, stream);
    unsigned* cnt = (unsigned*)(ws + WS_CTL);
    float* dt = (float*)(ws + WS_DT); float* logf = (float*)(ws + WS_LOGF); float* F = (float*)(ws + WS_F);
    int* perm = (int*)(ws + WS_PERM); float* tokinfo = (float*)(ws + WS_TOK);
    float* yraw = (float*)(ws + WS_YRAW); bf16_t* z = (bf16_t*)(ws + WS_Z); bf16_t* xbc = (bf16_t*)(ws + WS_XBC); bf16_t* merged = (bf16_t*)(ws + WS_MERGED);
    bf16_t *q = (bf16_t*)(ws + WS_Q), *k = (bf16_t*)(ws + WS_K), *v = (bf16_t*)(ws + WS_V), *act = (bf16_t*)(ws + WS_ACT);
    float* xconv = (float*)(ws + WS_XCONV); bf16_t* hb = (bf16_t*)(ws + WS_HB);

    { AL_x al{p.x}; BL_win bl{p.w_in}; EP_inproj ep{p.b_in, z, xbc, q, k, v, dt, logf};
      hipLaunchKernelGGL((ngemm<1, AL_x, BL_win, EP_inproj>), dim3((NPROJ + 63) / 64, T / 64), dim3(256), 0, stream, al, bl, ep, D); }
    hipLaunchKernelGGL(k_conv, dim3(T * 1024 / 256), dim3(256), 0, stream, xbc, p.conv_w, p.conv_b, xconv);
    hipLaunchKernelGGL(k_ssd, dim3(BATCH * NH), dim3(64), 0, stream, xconv, dt, p.a_log, p.d_skip, yraw);
    hipLaunchKernelGGL(k_gatenorm, dim3(T * 2 / 4), dim3(256), 0, stream, yraw, z, p.ssd_norm_g, merged);
    hipLaunchKernelGGL(k_scanF, dim3(2), dim3(64), 0, stream, logf, F);
    hipLaunchKernelGGL(k_attn, dim3(SEQ / 64, BATCH * NH), dim3(64), 0, stream, q, k, v, F, merged);
    { AL_bf al{merged, 1024, 0}; BL_plain bl{p.w_out, D, 0}; EP_outproj ep{p.x, p.out};
      hipLaunchKernelGGL((ngemm<1, AL_bf, BL_plain, EP_outproj>), dim3(D / 64, T / 64), dim3(256), 0, stream, al, bl, ep, D); }
    hipLaunchKernelGGL(k_ln1_router, dim3(T / 4), dim3(256), 0, stream, p.out, p.ln1_g, p.ln1_b, p.rg_w, p.rg_b, p.re_w, p.re_b, hb, cnt, perm, tokinfo);
    const int maxrows = T + NCLS * 256;
    { ClsGeo geo{cnt}; AL_moe1 al{hb, perm, geo}; BL_moe1 bl{p.w_gate, p.w_up, geo}; EP_moe1 ep{act, perm, tokinfo, geo};
      hipLaunchKernelGGL((ngemm<2, AL_moe1, BL_moe1, EP_moe1>), dim3(1024 / 64, maxrows / 64), dim3(256), 0, stream, al, bl, ep, D); }
    { ClsGeo geo{cnt}; AL_moe2 al{act, geo}; BL_moe2 bl{p.w_down, geo}; EP_moe2 ep{p.out, perm, geo};
      hipLaunchKernelGGL((ngemm<1, AL_moe2, BL_moe2, EP_moe2>), dim3(D / 64, maxrows / 64), dim3(256), 0, stream, al, bl, ep, 1024); }
    hipLaunchKernelGGL(k_ln2, dim3(T / 4), dim3(256), 0, stream, p.out, p.ln2_g, p.ln2_b);
}
```

```cpp
#include <hip/hip_runtime.h>
#include <hip/hip_bf16.h>
#include <stdint.h>
#include <cstdio>

typedef unsigned short bf16_t;
__device__ __forceinline__ float bf2f(bf16_t v) { return __uint_as_float(((unsigned)v) << 16); }
__device__ __forceinline__ bf16_t f2bf(float f) { unsigned u = __float_as_uint(f); return (bf16_t)((u + 0x7fffu + ((u >> 16) & 1u)) >> 16); }

constexpr int BATCH = 16, SEQ = 2048, T = BATCH * SEQ, D = 1024;
constexpr int NPROJ = 3088;
constexpr int NH = 8, HD = 64, NG = 2, NS = 128;
constexpr int NCLS = 24;
constexpr float ALPHA = 1.189207115002721f;
constexpr float LN_EPS = 1e-5f, RMS_EPS = 1e-5f;
constexpr float LOG2E = 1.4426950408889634f;
constexpr float C2 = 0.125f * LOG2E;

constexpr size_t MiB = 1u << 20;
constexpr size_t WS_CTL = 0, CTL_ZERO_BYTES = 1 * MiB;
constexpr size_t WS_WIN = 1 * MiB;
constexpr size_t WS_WOUT = 7 * MiB;
constexpr size_t WS_WGU = 9 * MiB;
constexpr size_t WS_WD = 41 * MiB;
constexpr size_t WS_DT = 58 * MiB;
constexpr size_t WS_LOGF = 59 * MiB;
constexpr size_t WS_F = 60 * MiB;
constexpr size_t WS_PERM = 61 * MiB;
constexpr size_t WS_TOK = 64 * MiB;
constexpr size_t WS_KX = 65 * MiB;
constexpr size_t WS_XB = 72 * MiB;
constexpr size_t WS_S = 72 * MiB;
constexpr size_t WS_CDEC = 69 * MiB;
constexpr size_t WS_XCB = 328 * MiB;
constexpr size_t WS_YRAW = 72 * MiB;
constexpr size_t WS_Z = 136 * MiB;
constexpr size_t WS_XBC = 168 * MiB;
constexpr size_t WS_HB = 136 * MiB;
constexpr size_t WS_Q = 232 * MiB, WS_K = 264 * MiB, WS_V = 296 * MiB;
constexpr size_t WS_ACT = 232 * MiB;
constexpr size_t WS_XCONV = 328 * MiB;
constexpr size_t WS_MERGED = 408 * MiB;
constexpr int CW_CNT = 0;
constexpr int CW_TMO = 64, CW_CODE = 65;
constexpr int CW_BAR = 4096;

struct P {
    const float *x, *w_in, *b_in, *conv_w, *conv_b, *a_log, *d_skip, *ssd_norm_g, *w_out, *ln1_g, *ln1_b,
        *rg_w, *rg_b, *re_w, *re_b, *w_gate, *w_up, *w_down, *ln2_g, *ln2_b;
    float* out; unsigned char* ws;
};

__device__ __forceinline__ float softplus_f(float x) { return fmaxf(x, 0.f) + log1pf(expf(-fabsf(x))); }
__device__ __forceinline__ float silu_f(float x) { return x / (1.f + expf(-x)); }

template <int NB, class AL, class BL, class EP>
__global__ __launch_bounds__(256) void ngemm(AL al, BL bl, EP ep, int K) {
    __shared__ float As[16][68];
    __shared__ float Bs[NB][16][68];
    const int tm = blockIdx.y * 64, tn = blockIdx.x * 64;
    if (!al.tile_ok(tm)) return;
    const int tx = threadIdx.x & 15, ty = threadIdx.x >> 4;
    float acc[NB][4][4];
#pragma unroll
    for (int b = 0; b < NB; ++b)
#pragma unroll
        for (int i = 0; i < 4; ++i)
#pragma unroll
            for (int j = 0; j < 4; ++j) acc[b][i][j] = 0.f;
    for (int k0 = 0; k0 < K; k0 += 16) {
#pragma unroll
        for (int i = 0; i < 4; ++i) { const int idx = threadIdx.x + i * 256; const int r = idx >> 4, kk = idx & 15; As[kk][r] = al(tm + r, k0 + kk); }
#pragma unroll
        for (int b = 0; b < NB; ++b)
#pragma unroll
            for (int i = 0; i < 4; ++i) { const int idx = threadIdx.x + i * 256; const int kk = idx >> 6, n = idx & 63; Bs[b][kk][n] = bl(b, tm, k0 + kk, tn + n); }
        __syncthreads();
#pragma unroll
        for (int kk = 0; kk < 16; ++kk) {
            float a[4];
#pragma unroll
            for (int i = 0; i < 4; ++i) a[i] = As[kk][ty * 4 + i];
#pragma unroll
            for (int b = 0; b < NB; ++b) {
                float bb[4];
#pragma unroll
                for (int j = 0; j < 4; ++j) bb[j] = Bs[b][kk][tx * 4 + j];
#pragma unroll
                for (int i = 0; i < 4; ++i)
#pragma unroll
                    for (int j = 0; j < 4; ++j) acc[b][i][j] += a[i] * bb[j];
            }
        }
        __syncthreads();
    }
#pragma unroll
    for (int i = 0; i < 4; ++i)
#pragma unroll
        for (int j = 0; j < 4; ++j) {
            if (NB == 1) ep(tm + ty * 4 + i, tn + tx * 4 + j, acc[0][i][j], 0.f);
            else ep(tm + ty * 4 + i, tn + tx * 4 + j, acc[0][i][j], acc[NB - 1][i][j]);
        }
}

struct AL_x { const float* x; __device__ bool tile_ok(int) const { return true; } __device__ float operator()(int r, int k) const { return x[(size_t)r * D + k]; } };
struct BL_win { const float* w; __device__ float operator()(int, int, int k, int n) const { return n < NPROJ ? w[(size_t)k * NPROJ + n] : 0.f; } };
struct EP_inproj {
    const float* b_in; bf16_t *z, *xbc, *q, *k, *v; float *dt, *logf;
    __device__ void operator()(int r, int c, float v0, float) const {
        if (c >= NPROJ) return;
        const float val = v0 + b_in[c];
        if (c < 512) z[(size_t)r * 512 + c] = f2bf(val);
        else if (c < 1536) xbc[(size_t)r * 1024 + (c - 512)] = f2bf(val);
        else if (c < 1544) dt[(size_t)r * 8 + (c - 1536)] = softplus_f(val);
        else if (c < 2056) q[(size_t)r * 512 + (c - 1544)] = f2bf(val * C2);
        else if (c < 2568) k[(size_t)r * 512 + (c - 2056)] = f2bf(val);
        else if (c < 3080) v[(size_t)r * 512 + (c - 2568)] = f2bf(val);
        else logf[(size_t)r * 8 + (c - 3080)] = -softplus_f(-val);
    }
};

__global__ void k_conv(const bf16_t* xbc, const float* conv_w, const float* conv_b, float* xconv) {
    const size_t idx = (size_t)blockIdx.x * 256 + threadIdx.x;
    const int c = (int)(idx & 1023); const int t = (int)(idx >> 10); const int s = t & (SEQ - 1);
    float acc = conv_b[c];
#pragma unroll
    for (int k = 0; k < 4; ++k) { const int ss = s - 3 + k; if (ss >= 0) acc += conv_w[k * 1024 + c] * bf2f(xbc[(size_t)(t - 3 + k) * 1024 + c]); }
    xconv[idx] = silu_f(acc);
}

__global__ __launch_bounds__(64) void k_ssd(const float* xconv, const float* dt, const float* a_log, const float* d_skip, float* yraw) {
    __shared__ float Bs[16][128], Cs[16][128];
    const int b = blockIdx.x >> 3, h = blockIdx.x & 7, g = h >> 2, p = threadIdx.x;
    const float a = -expf(a_log[h]), dsk = d_skip[h];
    float st[128];
#pragma unroll
    for (int n = 0; n < 128; ++n) st[n] = 0.f;
    for (int t0 = 0; t0 < SEQ; t0 += 16) {
        __syncthreads();
        for (int i = p; i < 16 * 128; i += 64) { const int tt = i >> 7, n = i & 127; const size_t row = (size_t)(b * SEQ + t0 + tt) * 1024;
            Bs[tt][n] = xconv[row + 512 + g * 128 + n]; Cs[tt][n] = xconv[row + 768 + g * 128 + n]; }
        __syncthreads();
        for (int tt = 0; tt < 16; ++tt) {
            const size_t tok = (size_t)(b * SEQ + t0 + tt);
            const float xs = xconv[tok * 1024 + h * 64 + p], dtv = dt[tok * 8 + h];
            const float dA = expf(dtv * a), xdt = xs * dtv;
            float y = 0.f;
#pragma unroll
            for (int n = 0; n < 128; ++n) { st[n] = st[n] * dA + xdt * Bs[tt][n]; y += Cs[tt][n] * st[n]; }
            yraw[tok * 512 + h * 64 + p] = y + dsk * xs;
        }
    }
}

__global__ __launch_bounds__(256) void k_gatenorm(const float* yraw, const bf16_t* z, const float* norm_g, bf16_t* merged) {
    const int w = blockIdx.x * 4 + (threadIdx.x >> 6), lane = threadIdx.x & 63;
    const int t = w >> 1, g = w & 1;
    float v[4]; float ss = 0.f;
#pragma unroll
    for (int j = 0; j < 4; ++j) { const int c = g * 256 + lane * 4 + j; const float y = yraw[(size_t)t * 512 + c] * silu_f(bf2f(z[(size_t)t * 512 + c])); v[j] = y; ss += y * y; }
#pragma unroll
    for (int o = 1; o < 64; o <<= 1) ss += __shfl_xor(ss, o);
    const float r = rsqrtf(ss * (1.f / 256.f) + RMS_EPS);
#pragma unroll
    for (int j = 0; j < 4; ++j) { const int c = g * 256 + lane * 4 + j; merged[(size_t)t * 1024 + c] = f2bf(v[j] * r * norm_g[c]); }
}

__global__ void k_scanF(const float* logf, float* F) {
    const int i = blockIdx.x * 64 + threadIdx.x; if (i >= BATCH * NH) return;
    const int b = i >> 3, h = i & 7; float s = 0.f;
    for (int t = 0; t < SEQ; ++t) { const size_t o = (size_t)(b * SEQ + t) * 8 + h; s += logf[o]; F[o] = s; }
}

__global__ __launch_bounds__(64) void k_attn(const bf16_t* Q, const bf16_t* K, const bf16_t* V, const float* F, bf16_t* merged) {
    const int bh = blockIdx.y, b = bh >> 3, h = bh & 7; const int t = blockIdx.x * 64 + threadIdx.x;
    const size_t row = (size_t)(b * SEQ + t);
    float q[64], o[64];
#pragma unroll
    for (int d = 0; d < 64; ++d) { q[d] = bf2f(Q[row * 512 + h * 64 + d]); o[d] = 0.f; }
    const float Ft = F[row * 8 + h];
    float m = -INFINITY, l = 0.f;
    const int smax = blockIdx.x * 64 + 63;
    for (int s = 0; s <= smax; ++s) {
        const size_t kr = (size_t)(b * SEQ + s);
        const bf16_t* kp = K + kr * 512 + h * 64; const bf16_t* vp = V + kr * 512 + h * 64;
        float dot = 0.f;
#pragma unroll
        for (int d = 0; d < 64; ++d) dot += q[d] * bf2f(kp[d]);
        const float logit = dot + (Ft - F[kr * 8 + h]) * LOG2E;
        if (s <= t) {
            const float mn = fmaxf(m, logit), corr = exp2f(m - mn), pp = exp2f(logit - mn);
            l = l * corr + pp;
#pragma unroll
            for (int d = 0; d < 64; ++d) o[d] = o[d] * corr + pp * bf2f(vp[d]);
            m = mn;
        }
    }
    const float rl = 1.f / l;
#pragma unroll
    for (int d = 0; d < 64; ++d) merged[row * 1024 + 512 + h * 64 + d] = f2bf(o[d] * rl);
}

struct AL_bf { const bf16_t* a; int lda; int pad; __device__ bool tile_ok(int) const { return true; } __device__ float operator()(int r, int k) const { return bf2f(a[(size_t)r * lda + k]); } };
struct BL_plain { const float* w; int ldb; int pad; __device__ float operator()(int, int, int k, int n) const { return w[(size_t)k * ldb + n]; } };
struct EP_outproj { const float* x; float* out; __device__ void operator()(int r, int c, float v, float) const { out[(size_t)r * D + c] = ALPHA * x[(size_t)r * D + c] + v; } };

__device__ __forceinline__ float wsum(float v) {
#pragma unroll
    for (int o = 1; o < 64; o <<= 1) v += __shfl_xor(v, o);
    return v;
}
__global__ __launch_bounds__(256) void k_ln1_router(float* hio, const float* g1, const float* b1, const float* rg_w, const float* rg_b, const float* re_w, const float* re_b,
                                                    bf16_t* hb, unsigned* cnt, int* perm, float* tokinfo) {
    const int t = blockIdx.x * 4 + (threadIdx.x >> 6), lane = threadIdx.x & 63;
    float v[16]; float s = 0.f;
#pragma unroll
    for (int j = 0; j < 4; ++j) { const float4 u = *(const float4*)(hio + (size_t)t * D + j * 256 + lane * 4); v[4 * j] = u.x; v[4 * j + 1] = u.y; v[4 * j + 2] = u.z; v[4 * j + 3] = u.w; s += (u.x + u.y) + (u.z + u.w); }
    const float mu = wsum(s) * (1.f / D); float s2 = 0.f;
#pragma unroll
    for (int i = 0; i < 16; ++i) { v[i] -= mu; s2 += v[i] * v[i]; }
    const float rstd = rsqrtf(wsum(s2) * (1.f / D) + LN_EPS);
    float gl[4] = {0.f, 0.f, 0.f, 0.f};
#pragma unroll
    for (int j = 0; j < 4; ++j)
#pragma unroll
        for (int i = 0; i < 4; ++i) { const int c = j * 256 + lane * 4 + i; const float hv = v[4 * j + i] * rstd * g1[c] + b1[c]; v[4 * j + i] = hv;
            hio[(size_t)t * D + c] = hv; hb[(size_t)t * D + c] = f2bf(hv);
#pragma unroll
            for (int e = 0; e < 4; ++e) gl[e] += hv * rg_w[c * 4 + e]; }
#pragma unroll
    for (int e = 0; e < 4; ++e) gl[e] = wsum(gl[e]) + rg_b[e];
    int gi = 0; float gm = gl[0];
#pragma unroll
    for (int e = 1; e < 4; ++e) if (gl[e] > gm) { gm = gl[e]; gi = e; }
    float gden = 0.f;
#pragma unroll
    for (int e = 0; e < 4; ++e) gden += expf(gl[e] - gm);
    const float gval = 1.f / gden;
    float el[4] = {0.f, 0.f, 0.f, 0.f};
#pragma unroll
    for (int j = 0; j < 4; ++j)
#pragma unroll
        for (int i = 0; i < 4; ++i) { const int c = j * 256 + lane * 4 + i;
#pragma unroll
            for (int e = 0; e < 4; ++e) el[e] += v[4 * j + i] * re_w[((size_t)gi * D + c) * 4 + e]; }
#pragma unroll
    for (int e = 0; e < 4; ++e) el[e] = wsum(el[e]) + re_b[gi * 4 + e];
    int i1 = 0;
#pragma unroll
    for (int e = 1; e < 4; ++e) if (el[e] > el[i1]) i1 = e;
    int i2 = -1;
#pragma unroll
    for (int e = 0; e < 4; ++e) if (e != i1 && (i2 < 0 || el[e] > el[i2])) i2 = e;
    const float mx = el[i1]; const float p2 = expf(el[i2] - mx); const float w1 = gval / (1.f + p2), w2 = gval * p2 / (1.f + p2);
    const int lo = i1 < i2 ? i1 : i2, hi = i1 < i2 ? i2 : i1; const float wlo = i1 < i2 ? w1 : w2, whi = i1 < i2 ? w2 : w1;
    const int pairidx = lo == 0 ? (hi - 1) : (lo == 1 ? (hi + 1) : 5);
    const int cls = gi * 6 + pairidx;
    if (lane == 0) {
        const unsigned pos = atomicAdd(&cnt[cls], 1u);
        perm[(size_t)cls * T + pos] = t;
        tokinfo[(size_t)t * 4 + 0] = __int_as_float(cls); tokinfo[(size_t)t * 4 + 1] = __int_as_float((int)pos); tokinfo[(size_t)t * 4 + 2] = wlo; tokinfo[(size_t)t * 4 + 3] = whi;
    }
}

struct ClsGeo { const unsigned* cnt;
    __device__ bool find(int row, int& cls, int& pos, int& n) const {
        int off = 0;
        for (int c = 0; c < NCLS; ++c) { const int nc = (int)cnt[c], pc = (nc + 255) & ~255; if (row < off + pc) { cls = c; pos = row - off; n = nc; return true; } off += pc; }
        return false;
    }
};
__device__ __forceinline__ void cls_experts(int cls, int& ea, int& eb) { const int g = cls / 6, pi = cls % 6; const int lo = pi < 3 ? 0 : (pi < 5 ? 1 : 2); const int hi = pi < 3 ? pi + 1 : (pi < 5 ? pi - 1 : 3); ea = g * 4 + lo; eb = g * 4 + hi; }

struct AL_moe1 { const bf16_t* hb; const int* perm; ClsGeo geo;
    __device__ bool tile_ok(int tm) const { int c, p, n; if (!geo.find(tm, c, p, n)) return false; return p < n; }
    __device__ float operator()(int r, int k) const { int c, p, n; if (!geo.find(r, c, p, n) || p >= n) return 0.f; const int tok = perm[(size_t)c * T + p]; return bf2f(hb[(size_t)tok * D + k]); } };
struct BL_moe1 { const float *wg, *wu; ClsGeo geo;
    __device__ float operator()(int b, int tm, int k, int n) const { int c, p, nn; geo.find(tm, c, p, nn); int ea, eb; cls_experts(c, ea, eb); const int e = n < 512 ? ea : eb; const int col = n & 511;
        const float* w = b == 0 ? wg : wu; return w[((size_t)e * D + k) * 512 + col]; } };
struct EP_moe1 { bf16_t* act; const int* perm; const float* tokinfo; ClsGeo geo;
    __device__ void operator()(int r, int c, float g, float u) const { int cl, p, n; float w = 0.f; if (geo.find(r, cl, p, n) && p < n) { const int tok = perm[(size_t)cl * T + p]; w = tokinfo[(size_t)tok * 4 + (c < 512 ? 2 : 3)]; }
        act[(size_t)r * 1024 + c] = f2bf(silu_f(g) * u * w); } };
struct AL_moe2 { const bf16_t* act; ClsGeo geo;
    __device__ bool tile_ok(int tm) const { int c, p, n; if (!geo.find(tm, c, p, n)) return false; return p < n; }
    __device__ float operator()(int r, int k) const { return bf2f(act[(size_t)r * 1024 + k]); } };
struct BL_moe2 { const float* wd; ClsGeo geo;
    __device__ float operator()(int, int tm, int k, int n) const { int c, p, nn; geo.find(tm, c, p, nn); int ea, eb; cls_experts(c, ea, eb); const int e = k < 512 ? ea : eb; return wd[((size_t)e * 512 + (k & 511)) * D + n]; } };
struct EP_moe2 { float* out; const int* perm; ClsGeo geo;
    __device__ void operator()(int r, int c, float v, float) const { int cl, p, n; if (!geo.find(r, cl, p, n) || p >= n) return; const int tok = perm[(size_t)cl * T + p]; float* o = out + (size_t)tok * D + c; *o = ALPHA * (*o) + v; } };

__global__ __launch_bounds__(256) void k_ln2(float* io, const float* g2, const float* b2) {
    const int t = blockIdx.x * 4 + (threadIdx.x >> 6), lane = threadIdx.x & 63;
    float v[16]; float s = 0.f;
#pragma unroll
    for (int j = 0; j < 4; ++j) { const float4 u = *(const float4*)(io + (size_t)t * D + j * 256 + lane * 4); v[4 * j] = u.x; v[4 * j + 1] = u.y; v[4 * j + 2] = u.z; v[4 * j + 3] = u.w; s += (u.x + u.y) + (u.z + u.w); }
    const float mu = wsum(s) * (1.f / D); float s2 = 0.f;
#pragma unroll
    for (int i = 0; i < 16; ++i) { v[i] -= mu; s2 += v[i] * v[i]; }
    const float rstd = rsqrtf(wsum(s2) * (1.f / D) + LN_EPS);
#pragma unroll
    for (int j = 0; j < 4; ++j) { float4 o; const int c = j * 256 + lane * 4;
        o.x = v[4 * j] * rstd * g2[c] + b2[c]; o.y = v[4 * j + 1] * rstd * g2[c + 1] + b2[c + 1]; o.z = v[4 * j + 2] * rstd * g2[c + 2] + b2[c + 2]; o.w = v[4 * j + 3] * rstd * g2[c + 3] + b2[c + 3];
        *(float4*)(io + (size_t)t * D + c) = o; }
}

namespace pg8 {
#define PG8_LAS __attribute__((address_space(3)))
typedef short bf16x8 __attribute__((ext_vector_type(8)));
typedef float f32x4 __attribute__((ext_vector_type(4)));
typedef float f32x2 __attribute__((ext_vector_type(2)));
typedef unsigned u32x4 __attribute__((ext_vector_type(4)));
typedef unsigned u32x2 __attribute__((ext_vector_type(2)));
constexpr int BM = 256, BK = 64, HALF = 128, HTB = HALF * BK * 2, STAGE_BYTES = 8 * HTB, NXCD = 8, WGM = 8;
__host__ __device__ __forceinline__ int lds_byte(int r, int c) { const int st = (r >> 4) * 2 + (c >> 5), rr = r & 15, cc = c & 31, ob = rr * 64 + cc * 2; return st * 1024 + (ob ^ (((ob >> 9) & 1) << 5)); }
__host__ __device__ __forceinline__ void stage_rc(int b, int& R, int& C) { const int st = b / 1024, sb = b % 1024, swz = sb ^ (((sb >> 9) & 1) << 5); R = (st >> 1) * 16 + swz / 64; C = (st & 1) * 32 + (swz % 64) / 2; }
__host__ __device__ __forceinline__ int perm32(int rho) { const int n = rho >> 4, i = rho & 15; return 8 * (i >> 2) + 4 * n + (i & 3); }
__device__ __forceinline__ unsigned cvt_pk_bf16(float lo, float hi) { unsigned r; asm volatile("v_cvt_pk_bf16_f32 %0, %1, %2" : "=v"(r) : "v"(lo), "v"(hi)); return r; }

struct Unit { int pm, pn; };
struct StaticOrder {
    int nM, nN, nwg, G, c;
    __device__ void init(int M, int N, int G_, int c_) { nM = M / BM; nN = N / BM; nwg = nM * nN; G = G_; c = c_; }
    __device__ bool next(int i, Unit& u) const {
        const long L = (long)i * G + c; if (L >= nwg) return false;
        int wgid = (int)L; { const int q = nwg / NXCD, r = nwg % NXCD, xcd = wgid % NXCD, off = wgid / NXCD; wgid = (xcd < r ? xcd * (q + 1) : r * (q + 1) + (xcd - r) * q) + off; }
        const int nig = WGM * nN, gid = wgid / nig, fm = gid * WGM, gsz = (nM - fm) < WGM ? (nM - fm) : WGM;
        u.pm = fm + ((wgid % nig) % gsz); u.pn = (wgid % nig) / gsz; return true;
    }
};
struct PlainProb {
    static constexpr bool GATHER = false;
    const bf16_t* A; const bf16_t* Bt; int lda, ldb, nt;
    __device__ __forceinline__ const char* a_base(const Unit& u) const { return (const char*)(A + (size_t)u.pm * BM * lda); }
    __device__ __forceinline__ void b_base(const Unit& u, const char*& b0, const char*& b1) const { b0 = (const char*)(Bt + (size_t)u.pn * BM * ldb); b1 = b0; }
    __device__ __forceinline__ int ksplit() const { return nt; }
    __device__ __forceinline__ unsigned rowoff(int, int) const { return 0u; }
};

template <class PR, class Sched, class Epi, bool ALIGN_EPI>
__device__ __forceinline__ void gemm_phase(PG8_LAS unsigned char* lds, const PR& pr, const Sched& S, const Epi& E) {
    const int tid = threadIdx.x, wid = __builtin_amdgcn_readfirstlane(tid >> 6), lane = tid & 63, wr = wid >> 2, wc = wid & 3, fr = lane & 15, fq = lane >> 4;
    const int nt = pr.nt, ksp = pr.ksplit();
    unsigned voffA[2][2], nvA[2][2], voffB[2]; int RA[2], CA[2];
#pragma unroll
    for (int i = 0; i < 2; ++i) { int R, C; stage_rc(tid * 16 + i * 8192, R, C); const int Rb = Epi::PERM ? ((R & ~31) + perm32(R & 31)) : R;
        RA[i] = R; CA[i] = C; voffB[i] = (unsigned)(Rb * pr.ldb + C) * 2u; }
    const size_t kstep = (size_t)(BK * 2);
    const size_t hstepB = (size_t)HALF * pr.ldb * 2;
    const unsigned ldsw = (unsigned)wid * 1024u;
    const int aoff = lds_byte(wr * 64 + fr, fq * 8), boff = lds_byte(wc * 32 + fr, fq * 8);
#define PG8_SA(b, h) (((b) * 2 + (h)) * HTB)
#define PG8_SB(b, h) ((4 + (b) * 2 + (h)) * HTB)
#define PG8_STAGE(bufoff, gbase, voff) do { _Pragma("unroll") for (int _i = 0; _i < 2; ++_i) \
        __builtin_amdgcn_global_load_lds((const unsigned*)((const char*)(gbase) + (voff)[_i]), (PG8_LAS unsigned*)(lds + (bufoff) + ldsw + _i * 8192), 16, 0, 0); } while (0)
#define PG8_LDA(dst, b, h) do { _Pragma("unroll") for (int m = 0; m < 4; ++m) _Pragma("unroll") for (int k = 0; k < 2; ++k) dst[m][k] = *(const PG8_LAS bf16x8*)(lds + PG8_SA(b, h) + aoff + m * 2048 + k * 1024); } while (0)
#define PG8_LDB(dst, b, h) do { _Pragma("unroll") for (int n = 0; n < 2; ++n) _Pragma("unroll") for (int k = 0; k < 2; ++k) dst[n][k] = *(const PG8_LAS bf16x8*)(lds + PG8_SB(b, h) + boff + n * 2048 + k * 1024); } while (0)
#define PG8_MMA(ai, bj, At, Bt) do { __builtin_amdgcn_s_setprio(1); _Pragma("unroll") for (int m = 0; m < 4; ++m) _Pragma("unroll") for (int n = 0; n < 2; ++n) _Pragma("unroll") for (int k = 0; k < 2; ++k) \
        acc[ai][bj][m][n] = __builtin_amdgcn_mfma_f32_16x16x32_bf16(Bt[n][k], At[m][k], acc[ai][bj][m][n], 0, 0, 0); __builtin_amdgcn_s_setprio(0); } while (0)
#define PG8_WAIT_V(n) asm volatile("s_waitcnt vmcnt(" #n ")" ::: "memory")
#define PG8_WAIT_L(n) asm volatile("s_waitcnt lgkmcnt(" #n ")" ::: "memory")
#define PG8_BAR __builtin_amdgcn_s_barrier()
#define PG8_SCHED __builtin_amdgcn_sched_barrier(0)
#define PG8_SETVA(dst, slot) do { _Pragma("unroll") for (int _h = 0; _h < 2; ++_h) _Pragma("unroll") for (int _i = 0; _i < 2; ++_i) \
        dst[_h][_i] = PR::GATHER ? (pr.rowoff((slot), _h * HALF + RA[_i]) + (unsigned)CA[_i] * 2u) : (unsigned)((_h * HALF + RA[_i]) * pr.lda + CA[_i]) * 2u; } while (0)
    Unit cur, nxt; int ui = 0;
    if (!S.next(0, cur)) return;
    f32x4 acc[2][2][4][2];
#pragma unroll
    for (int a = 0; a < 2; ++a)
#pragma unroll
        for (int b = 0; b < 2; ++b)
#pragma unroll
            for (int m = 0; m < 4; ++m)
#pragma unroll
                for (int n = 0; n < 2; ++n) acc[a][b][m][n] = (f32x4){0.f, 0.f, 0.f, 0.f};
    bf16x8 At[4][2], B0[2][2], B1[2][2];
    PG8_SETVA(voffA, 0);
    const char* cA = pr.a_base(cur); const char *cB0, *cB1; pr.b_base(cur, cB0, cB1);
    PG8_STAGE(PG8_SB(0, 0), cB0, voffB); PG8_STAGE(PG8_SB(0, 1), cB0 + hstepB, voffB); PG8_STAGE(PG8_SA(0, 0), cA, voffA[0]); PG8_STAGE(PG8_SA(0, 1), cA, voffA[1]);
    if (wr == 1) PG8_BAR;
    PG8_WAIT_V(2); PG8_BAR;
    PG8_STAGE(PG8_SB(1, 0), cB0 + kstep, voffB); PG8_STAGE(PG8_SA(1, 0), cA + kstep, voffA[0]); PG8_STAGE(PG8_SB(1, 1), cB0 + hstepB + kstep, voffB);
    PG8_WAIT_V(6); PG8_BAR;
    for (;;) {
        const bool has_next = S.next(ui + 1, nxt);
        const char *nA = cA, *nB0 = cB0, *nB1 = cB1;
        if (has_next) { nA = pr.a_base(nxt); pr.b_base(nxt, nB0, nB1); }
        if (PR::GATHER) { if (has_next) { PG8_SETVA(nvA, ui + 1); } else {
#pragma unroll
            for (int h = 0; h < 2; ++h)
#pragma unroll
                for (int i = 0; i < 2; ++i) nvA[h][i] = voffA[h][i]; } }
        for (int t = 0; t < nt; t += 2) {
            const bool last = (t == nt - 2);
            const char* a1 = cA + (size_t)(t + 1) * kstep;
            const char* a2 = last ? nA : cA + (size_t)(t + 2) * kstep;
            const char* b2 = last ? nB0 : ((t + 2 < ksp) ? cB0 + (size_t)(t + 2) * kstep : cB1 + (size_t)(t + 2 - ksp) * kstep);
            const char* a3 = a2 + kstep; const char* b3 = b2 + kstep;
            unsigned va2[2][2];
#pragma unroll
            for (int h = 0; h < 2; ++h)
#pragma unroll
                for (int i = 0; i < 2; ++i) va2[h][i] = (PR::GATHER && last) ? nvA[h][i] : voffA[h][i];
            PG8_LDB(B0, 0, 0); PG8_LDB(B1, 0, 1); PG8_SCHED; PG8_LDA(At, 0, 0); PG8_STAGE(PG8_SA(1, 1), a1, voffA[1]);
            PG8_WAIT_V(8); PG8_WAIT_L(0); PG8_BAR; PG8_MMA(0, 0, At, B0); PG8_MMA(0, 1, At, B1); PG8_BAR; PG8_SCHED;
            PG8_LDA(At, 0, 1); PG8_STAGE(PG8_SB(0, 0), b2, voffB); PG8_STAGE(PG8_SB(0, 1), b2 + hstepB, voffB); PG8_STAGE(PG8_SA(0, 0), a2, va2[0]);
            PG8_WAIT_V(8); PG8_WAIT_L(0); PG8_BAR; PG8_MMA(1, 0, At, B0); PG8_MMA(1, 1, At, B1); PG8_BAR; PG8_SCHED;
            PG8_LDB(B0, 1, 0); PG8_LDB(B1, 1, 1); PG8_SCHED; PG8_LDA(At, 1, 0); PG8_STAGE(PG8_SA(0, 1), a2, va2[1]);
            PG8_WAIT_V(8); PG8_WAIT_L(0); PG8_BAR; PG8_MMA(0, 0, At, B0); PG8_MMA(0, 1, At, B1); PG8_BAR; PG8_SCHED;
            PG8_LDA(At, 1, 1); PG8_STAGE(PG8_SB(1, 0), b3, voffB); PG8_STAGE(PG8_SB(1, 1), b3 + hstepB, voffB); PG8_STAGE(PG8_SA(1, 0), a3, va2[0]);
            PG8_WAIT_V(8); PG8_WAIT_L(0); PG8_BAR; PG8_MMA(1, 0, At, B0); PG8_MMA(1, 1, At, B1); PG8_BAR; PG8_SCHED;
        }
        if constexpr (ALIGN_EPI) { if (wr == 0) PG8_BAR; }
        if constexpr (!Epi::AFTER_DRAIN) { E(acc, cur, ui, wr, wc, fr, fq); }
        if (!has_next) break;
#pragma unroll
        for (int a = 0; a < 2; ++a)
#pragma unroll
            for (int b = 0; b < 2; ++b)
#pragma unroll
                for (int m = 0; m < 4; ++m)
#pragma unroll
                    for (int n = 0; n < 2; ++n) acc[a][b][m][n] = (f32x4){0.f, 0.f, 0.f, 0.f};
        cur = nxt; cA = nA; cB0 = nB0; cB1 = nB1; ++ui;
        if (PR::GATHER) {
#pragma unroll
            for (int h = 0; h < 2; ++h)
#pragma unroll
                for (int i = 0; i < 2; ++i) voffA[h][i] = nvA[h][i]; }
        if constexpr (ALIGN_EPI) { if (wr == 1) PG8_BAR; }
    }
    PG8_WAIT_V(0);
    if constexpr (!ALIGN_EPI) { if (wr == 0) PG8_BAR; }
    PG8_BAR;
    if constexpr (Epi::AFTER_DRAIN) { E.fused(acc, cur, ui, wr, wc, fr, fq, lds, wid, lane); }
#undef PG8_SA
#undef PG8_SB
#undef PG8_STAGE
#undef PG8_LDA
#undef PG8_LDB
#undef PG8_MMA
#undef PG8_WAIT_V
#undef PG8_WAIT_L
#undef PG8_BAR
#undef PG8_SCHED
#undef PG8_SETVA
}

struct EpiInproj {
    static constexpr bool PERM = true, AFTER_DRAIN = false;
    const float* b_in; bf16_t *z, *xbc, *q, *k, *v;
    __device__ __forceinline__ void operator()(const f32x4 (&acc)[2][2][4][2], const Unit& u, int, int wr, int wc, int fr, int fq) const {
        const int pn = u.pn; bf16_t* base; int ldc, colt; float sc = 1.f;
        if (pn < 2) { base = z; ldc = 512; colt = pn * 256; }
        else if (pn < 6) { base = xbc; ldc = 1024; colt = (pn - 2) * 256; }
        else if (pn < 8) { base = q; ldc = 512; colt = (pn - 6) * 256; sc = C2; }
        else if (pn < 10) { base = k; ldc = 512; colt = (pn - 8) * 256; }
        else { base = v; ldc = 512; colt = (pn - 10) * 256; }
        const int row0 = u.pm * BM + wr * 64 + fr;
        const int col0 = colt + wc * 32 + 8 * fq, bcol0 = pn * BM + (pn >= 6 ? 8 : 0) + wc * 32 + 8 * fq;
        f32x4 bv[2][2];
#pragma unroll
        for (int bj = 0; bj < 2; ++bj)
#pragma unroll
            for (int n = 0; n < 2; ++n) bv[bj][n] = *(const f32x4*)(b_in + bcol0 + bj * HALF + 4 * n);
#pragma unroll
        for (int ai = 0; ai < 2; ++ai)
#pragma unroll
            for (int m = 0; m < 4; ++m) { bf16_t* rowp = base + (size_t)(row0 + ai * HALF + m * 16) * ldc + col0;
#pragma unroll
                for (int bj = 0; bj < 2; ++bj) { f32x4 v0 = (acc[ai][bj][m][0] + bv[bj][0]) * sc, v1 = (acc[ai][bj][m][1] + bv[bj][1]) * sc;
                    u32x4 w; w.x = cvt_pk_bf16(v0[0], v0[1]); w.y = cvt_pk_bf16(v0[2], v0[3]); w.z = cvt_pk_bf16(v1[0], v1[1]); w.w = cvt_pk_bf16(v1[2], v1[3]);
                    *(u32x4*)(rowp + bj * HALF) = w; } }
    }
};

struct EpiOutproj {
    static constexpr bool PERM = false, AFTER_DRAIN = false;
    const float* x; float* out;
    __device__ __forceinline__ void operator()(const f32x4 (&acc)[2][2][4][2], const Unit& u, int, int wr, int wc, int fr, int fq) const {
        const int col0 = u.pn * BM + wc * 32 + 4 * fq;
#pragma unroll
        for (int ai = 0; ai < 2; ++ai)
#pragma unroll
            for (int m = 0; m < 4; ++m) { const size_t off = (size_t)(u.pm * BM + ai * HALF + wr * 64 + m * 16 + fr) * D + col0;
#pragma unroll
                for (int bj = 0; bj < 2; ++bj)
#pragma unroll
                    for (int n = 0; n < 2; ++n) { const f32x4 xv = *(const f32x4*)(x + off + bj * HALF + n * 16); *(f32x4*)(out + off + bj * HALF + n * 16) = xv * ALPHA + acc[ai][bj][m][n]; } }
    }
};

struct MoeGeo {
    const PG8_LAS int* tab;
    __device__ __forceinline__ int np() const { return tab[24]; }
    __device__ __forceinline__ int cls_of(int panel) const { int c = 0;
#pragma unroll 1
        for (int j = 1; j < 24; ++j) if (panel >= tab[j]) c = j;
        return c; }
};
struct MoeOrder {
    int total, npn, G, c;
    __device__ __forceinline__ bool next(int i, Unit& u) const { const int L = i * G + c; if (L >= total) return false; u.pm = L / npn; u.pn = L % npn; return true; }
};
struct Moe1Prob {
    static constexpr bool GATHER = true;
    const bf16_t* A; const bf16_t* Wgu; MoeGeo geo; const PG8_LAS unsigned* rofftab; int lda, ldb, nt;
    __device__ __forceinline__ const char* a_base(const Unit&) const { return (const char*)A; }
    __device__ __forceinline__ void b_base(const Unit& u, const char*& b0, const char*& b1) const { int ea, eb; cls_experts(geo.cls_of(u.pm), ea, eb); const int e = u.pn < 4 ? ea : eb;
        b0 = (const char*)(Wgu + (size_t)((e * 4 + (u.pn & 3)) * 256) * 1024); b1 = b0; }
    __device__ __forceinline__ int ksplit() const { return nt; }
    __device__ __forceinline__ unsigned rowoff(int slot, int r) const { return rofftab[slot * 256 + r]; }
};
__device__ __forceinline__ float silu_fast(float g) { return g * __builtin_amdgcn_rcpf(1.f + __builtin_amdgcn_exp2f(-g * LOG2E)); }
struct EpiMoe1 {
    static constexpr bool PERM = true, AFTER_DRAIN = false;
    bf16_t* act; const float* tokinfo; const PG8_LAS int* toktab;
    __device__ __forceinline__ void operator()(const f32x4 (&acc)[2][2][4][2], const Unit& u, int slot, int wr, int wc, int fr, int fq) const {
        const int ex = u.pn >> 2; const int col0 = ex * 512 + (u.pn & 3) * 128 + wc * 32 + 8 * fq;
#pragma unroll
        for (int ai = 0; ai < 2; ++ai)
#pragma unroll
            for (int m = 0; m < 4; ++m) { const int r = ai * HALF + wr * 64 + m * 16 + fr; const int tok = toktab[slot * 256 + r];
                const float w = tok >= 0 ? tokinfo[(size_t)tok * 4 + 2 + ex] : 0.f;
                const f32x4 g0 = acc[ai][0][m][0], g1 = acc[ai][0][m][1], u0 = acc[ai][1][m][0], u1 = acc[ai][1][m][1];
                float o[8];
#pragma unroll
                for (int j = 0; j < 4; ++j) { o[j] = silu_fast(g0[j]) * u0[j] * w; o[4 + j] = silu_fast(g1[j]) * u1[j] * w; }
                u32x4 wv; wv.x = cvt_pk_bf16(o[0], o[1]); wv.y = cvt_pk_bf16(o[2], o[3]); wv.z = cvt_pk_bf16(o[4], o[5]); wv.w = cvt_pk_bf16(o[6], o[7]);
                *(u32x4*)(act + (size_t)(u.pm * BM + r) * 1024 + col0) = wv; }
    }
};
struct Moe2Prob {
    static constexpr bool GATHER = false;
    const bf16_t* A; const bf16_t* Wd; MoeGeo geo; int lda, ldb, nt;
    __device__ __forceinline__ const char* a_base(const Unit& u) const { return (const char*)(A + (size_t)u.pm * BM * lda); }
    __device__ __forceinline__ void b_base(const Unit& u, const char*& b0, const char*& b1) const { int ea, eb; cls_experts(geo.cls_of(u.pm), ea, eb);
        b0 = (const char*)(Wd + ((size_t)ea * 1024 + u.pn * 256) * 512); b1 = (const char*)(Wd + ((size_t)eb * 1024 + u.pn * 256) * 512); }
    __device__ __forceinline__ int ksplit() const { return 8; }
    __device__ __forceinline__ unsigned rowoff(int, int) const { return 0u; }
};
struct EpiMoe2 {
    static constexpr bool PERM = false, AFTER_DRAIN = false;
    float* out; const PG8_LAS int* toktab;
    __device__ __forceinline__ void operator()(const f32x4 (&acc)[2][2][4][2], const Unit& u, int slot, int wr, int wc, int fr, int fq) const {
        const int col0 = u.pn * BM + wc * 32 + 4 * fq;
#pragma unroll
        for (int ai = 0; ai < 2; ++ai)
#pragma unroll
            for (int m = 0; m < 4; ++m) { const int r = ai * HALF + wr * 64 + m * 16 + fr; const int tok = toktab[slot * 256 + r];
                if (tok >= 0) { float* o = out + (size_t)tok * D + col0;
#pragma unroll
                    for (int bj = 0; bj < 2; ++bj)
#pragma unroll
                        for (int n = 0; n < 2; ++n) { const f32x4 hv = *(const f32x4*)(o + bj * HALF + n * 16); *(f32x4*)(o + bj * HALF + n * 16) = hv * ALPHA + acc[ai][bj][m][n]; } } }
    }
};
}

#include <cmath>
namespace attn_body {

using bf16=__hip_bfloat16;
#define ALAS __attribute__((address_space(3)))
using bf16x8=__attribute__((ext_vector_type(8)))short;
using s16x4=__attribute__((ext_vector_type(4)))short;
using f32x16=__attribute__((ext_vector_type(16)))float;
using u32x4=__attribute__((ext_vector_type(4)))unsigned;
constexpr int BATCH=16,NHEAD=8,SEQ=2048,D=64,DM=NHEAD*D,ODM=1024,OCOL=512;
constexpr int NW=8,QBLK=32,QB=QBLK*NW,KVBLK=64,NQB=SEQ/QB;
constexpr int ATTN_PITCH=DM, ATTN_UNIT_ROWS=QB;
__device__ __forceinline__ int crow(int r,int hi){return (r&3)+8*(r>>2)+4*hi;}
#define SBAR() __builtin_amdgcn_sched_barrier(0)
__device__ __forceinline__ void cmask(f32x16&p0,f32x16&p1,int jb,int qrel,int hi){
  const float NEG=-INFINITY; int kb=64*jb+4*hi;
  #pragma unroll
  for(int r=0;r<16;++r){int kv=kb+(r&3)+8*(r>>2); if(kv>qrel)p0[r]=NEG; if(kv+32>qrel)p1[r]=NEG;}
}

constexpr int NSLOT=3, SLOTB=9216, KXOFF=8192;
constexpr int LDS_K=0, LDS_V=NSLOT*SLOTB, LDS_WS=2*NSLOT*SLOTB, LDS_OST=LDS_WS+NW*64*4, LDS_BYTES=LDS_OST+NW*4096;
constexpr float C2=0.125f*1.4426950408889634f;
__device__ __forceinline__ void glds16(const void*gsrc,unsigned lds_dst){unsigned keep;
  asm volatile("s_mov_b32 %0, m0\n\ts_mov_b32 m0, %2\n\ts_nop 0\n\tglobal_load_lds_dwordx4 %1, off\n\ts_mov_b32 m0, %0":"=&s"(keep):"v"(gsrc),"s"(lds_dst):"memory");}
__device__ __forceinline__ float max3f(float a,float b,float c){float r;asm("v_max3_f32 %0, %1, %2, %3":"=v"(r):"v"(a),"v"(b),"v"(c));return r;}
__device__ __forceinline__ float max2f(float a,float b){float r;asm("v_max_f32_e32 %0, %1, %2":"=v"(r):"v"(a),"v"(b));return r;}
__device__ __forceinline__ float fadd_s(float a,float b){float r;asm("v_add_f32_e32 %0, %1, %2":"=v"(r):"v"(a),"v"(b));return r;}
__device__ __forceinline__ float fsub_s(float a,float b){float r;asm("v_sub_f32_e32 %0, %1, %2":"=v"(r):"v"(a),"v"(b));return r;}
typedef float f32x2_t __attribute__((ext_vector_type(2))); typedef __bf16 bf16x2_t __attribute__((ext_vector_type(2)));
__device__ __forceinline__ unsigned cvtpk_s(float lo,float hi){f32x2_t v={lo,hi};bf16x2_t b=__builtin_convertvector(v,bf16x2_t);return __builtin_bit_cast(unsigned,b);}
#define WAIT_BAR(N) asm volatile("s_waitcnt vmcnt(" #N ") lgkmcnt(0)\n\ts_barrier":::"memory")
#define WAIT_BARK(N,N0) do{ if(wid==0){WAIT_BAR(N0);} else {WAIT_BAR(N);} }while(0)

__device__ __forceinline__ void qkt(f32x16&p0,f32x16&p1,const char*Kslot,const bf16x8*qr,const bf16x8 qr4,const f32x16&negm,int r32,int hi){
  const char*kb=Kslot+hi*1024+r32*16;
  #pragma unroll
  for(int d0=0;d0<4;++d0){
    const bf16x8 b0=*reinterpret_cast<const bf16x8*>(kb+d0*2048);
    const bf16x8 b1=*reinterpret_cast<const bf16x8*>(kb+d0*2048+512);
    if(d0==0){p0=__builtin_amdgcn_mfma_f32_32x32x16_bf16(b0,qr[0],negm,0,0,0);p1=__builtin_amdgcn_mfma_f32_32x32x16_bf16(b1,qr[0],negm,0,0,0);}
    else{p0=__builtin_amdgcn_mfma_f32_32x32x16_bf16(b0,qr[d0],p0,0,0,0);p1=__builtin_amdgcn_mfma_f32_32x32x16_bf16(b1,qr[d0],p1,0,0,0);}}
  { const bf16x8 x0=*reinterpret_cast<const bf16x8*>(Kslot+KXOFF+r32*16); const bf16x8 x1=*reinterpret_cast<const bf16x8*>(Kslot+KXOFF+r32*16+512);
    p0=__builtin_amdgcn_mfma_f32_32x32x16_bf16(x0,qr4,p0,0,0,0);p1=__builtin_amdgcn_mfma_f32_32x32x16_bf16(x1,qr4,p1,0,0,0); }
}
typedef __attribute__((address_space(3))) const char* lds_cptr;
typedef short v4i16_t __attribute__((ext_vector_type(4)));
__device__ __forceinline__ void kload8(bf16x8*kf,lds_cptr kp){
  kf[0]=*(const __attribute__((address_space(3))) bf16x8*)(kp);      kf[1]=*(const __attribute__((address_space(3))) bf16x8*)(kp+512);
  kf[2]=*(const __attribute__((address_space(3))) bf16x8*)(kp+2048); kf[3]=*(const __attribute__((address_space(3))) bf16x8*)(kp+2560);
  kf[4]=*(const __attribute__((address_space(3))) bf16x8*)(kp+4096); kf[5]=*(const __attribute__((address_space(3))) bf16x8*)(kp+4608);
  kf[6]=*(const __attribute__((address_space(3))) bf16x8*)(kp+6144); kf[7]=*(const __attribute__((address_space(3))) bf16x8*)(kp+6656);
}
__device__ __forceinline__ void kload2(bf16x8*kf,lds_cptr kp,int j){ kf[2*j]=*(const __attribute__((address_space(3))) bf16x8*)(kp+j*2048); kf[2*j+1]=*(const __attribute__((address_space(3))) bf16x8*)(kp+j*2048+512); }
__device__ __forceinline__ s16x4 vtr(lds_cptr p){ return __builtin_bit_cast(s16x4,__builtin_amdgcn_ds_read_tr16_b64_v4i16((__attribute__((address_space(3))) v4i16_t*)p)); }
__device__ __forceinline__ float rowmax(const f32x16&p0,const f32x16&p1){
  float a=max3f(p0[0],p0[1],p1[0]),b=max3f(p0[2],p0[3],p1[1]);a=max3f(a,p1[2],p1[3]);
  #pragma unroll
  for(int r=4;r<16;r+=4){a=max3f(a,p0[r],p0[r+1]);b=max3f(b,p0[r+2],p0[r+3]);a=max3f(a,p1[r],p1[r+1]);b=max3f(b,p1[r+2],p1[r+3]);}
  const float m=max2f(a,b);
  auto rr=__builtin_amdgcn_permlane32_swap(__float_as_uint(m),__float_as_uint(m),false,false);
  return max2f(__uint_as_float(rr[0]),__uint_as_float(rr[1]));
}
__device__ __forceinline__ void pv(f32x16*o,int vb,bf16x8 pa0,bf16x8 pa1,bf16x8 pa2,bf16x8 pa3){
  #pragma unroll
  for(int d0=0;d0<2;++d0){s16x4 lo[4],hi[4];
    #pragma unroll
    for(int ks=0;ks<4;++ks){
      asm volatile("ds_read_b64_tr_b16 %0,%1 offset:%c2":"=&v"(lo[ks]):"v"(vb),"i"(d0*4096+ks*1024):"memory");
      asm volatile("ds_read_b64_tr_b16 %0,%1 offset:%c2":"=&v"(hi[ks]):"v"(vb),"i"(d0*4096+ks*1024+512):"memory");}
    asm volatile("s_waitcnt lgkmcnt(0)":::"memory");SBAR();
    #define PK(k) (bf16x8){lo[k][0],lo[k][1],lo[k][2],lo[k][3],hi[k][0],hi[k][1],hi[k][2],hi[k][3]}
    o[d0]=__builtin_amdgcn_mfma_f32_32x32x16_bf16(pa0,PK(0),o[d0],0,0,0);
    o[d0]=__builtin_amdgcn_mfma_f32_32x32x16_bf16(pa1,PK(1),o[d0],0,0,0);
    o[d0]=__builtin_amdgcn_mfma_f32_32x32x16_bf16(pa2,PK(2),o[d0],0,0,0);
    o[d0]=__builtin_amdgcn_mfma_f32_32x32x16_bf16(pa3,PK(3),o[d0],0,0,0);
    #undef PK
  }
}

#ifndef ATTN_STORE16
#define ATTN_STORE16(p,v) (*(u32x4*)(p)=(v))
#endif
template<int THRL> __device__ __forceinline__ void attn_unit(int b,int h,int qb,const bf16*Q,const bf16*__restrict__ K,const bf16*__restrict__ V,const bf16*__restrict__ KX,bf16*O,char*shm){
  const int tid=threadIdx.x,lane=tid&63,r32=lane&31,hi=lane>>5; const int wid=__builtin_amdgcn_readfirstlane(tid>>6);
  const long rowbase=(long)b*SEQ; const int q0=qb*QB;
  const bf16*Qw=Q+(rowbase+q0+wid*QBLK)*DM+h*D;
  const bf16*Kh=K+rowbase*DM+h*D,*Vh=V+rowbase*DM+h*D;
  const unsigned lds0=(unsigned)(uintptr_t)shm;
  float*wsf=(float*)(shm+LDS_WS)+wid*64;
  const bf16*ksrc=Kh+(long)lane*DM+wid*8;
  const bf16*vsrc=Vh+(long)(16*(wid&3)+(lane>>2))*DM+(wid>>2)*32+(lane&3)*8;
  const unsigned kdst=lds0+LDS_K+wid*1024, vdst=lds0+LDS_V+wid*1024, kxdst=lds0+LDS_K+KXOFF;
  const bf16*kxsrc=KX+((rowbase+lane)*NHEAD+h)*8;
  #define DMA_K(t,slot) do{ glds16(ksrc+(long)(t)*KVBLK*DM,(unsigned)__builtin_amdgcn_readfirstlane(kdst+(slot))); if(wid==0) glds16(kxsrc+(long)(t)*KVBLK*NHEAD*8,(unsigned)__builtin_amdgcn_readfirstlane(kxdst+(slot))); }while(0)
  #define DMA_V(t,slot) glds16(vsrc+(long)(t)*KVBLK*DM,(unsigned)__builtin_amdgcn_readfirstlane(vdst+(slot)))
  const int vb0=(int)(lds0+LDS_V)+((lane>>4)&1)*32+(lane&3)*8+(4*hi+((lane&15)>>2))*64;
  const char*Kbase=shm+LDS_K; bf16x8 kf[8]; bf16x8 kx0,kx1;
  const lds_cptr shm3=(lds_cptr)shm; const lds_cptr kxp0=shm3+LDS_K+KXOFF+r32*16; const lds_cptr kp0=shm3+LDS_K+hi*1024+r32*16; const lds_cptr vp0=shm3+LDS_V+((lane>>4)&1)*32+(lane&3)*8+(4*hi+((lane&15)>>2))*64;
  const int NT=(q0+QB)/KVBLK;
  DMA_K(0,0);DMA_V(0,0);DMA_K(1,SLOTB);
  bf16x8 qr[4]; bf16x8 qr4={0,0,0,0,0,0,0,0}; if(hi==0){qr4[0]=(short)0x3F80;qr4[1]=(short)0x3F80;qr4[2]=(short)0x3F80;}
  #pragma unroll
  for(int d0=0;d0<4;++d0)qr[d0]=*reinterpret_cast<const bf16x8*>(&Qw[(long)r32*DM+d0*16+hi*8]);
  float mhat=0.f,l_reg=0.f;f32x16 o[2];o[0]=f32x16{};o[1]=f32x16{};f32x16 negm=f32x16{};asm volatile("":"+v"(negm));
  const int qrel=wid*QBLK+r32;
  #define CMASK(P0,P1,t) do{int jb_=(t)-(NT-4); if(jb_>=0)cmask(P0,P1,jb_,qrel,hi);}while(0)
  bool resc=false;
  #define START(P0,P1) do{ const float rm=rowmax(P0,P1); resc=false; \
    { const float dl=rm; mhat=fadd_s(mhat,dl); \
      _Pragma("unroll") for(int r=0;r<16;++r){P0[r]=fsub_s(P0[r],dl);P1[r]=fsub_s(P1[r],dl);} \
      _Pragma("unroll") for(int r=0;r<16;++r)negm[r]=-mhat; asm volatile("":"+v"(negm)); } \
    _Pragma("unroll") for(int r=0;r<16;++r)P0[r]=__builtin_amdgcn_exp2f(P0[r]); }while(0)
  #define RESC() do{ if(resc){ asm volatile("s_waitcnt lgkmcnt(0)":::"memory"); \
      _Pragma("unroll") for(int d_=0;d_<2;++d_) _Pragma("unroll") for(int r=0;r<16;++r)o[d_][r]*=wsf[crow(r,hi)]; } }while(0)
  f32x16 pA0,pA1,pB0,pB1;
  int sl_prev=0,sl_cur=0,sl_next=SLOTB;
  #define ROT() do{sl_prev=sl_cur;sl_cur=sl_next;sl_next=(sl_next==(NSLOT-1)*SLOTB)?0:sl_next+SLOTB;}while(0)
  DMA_K(2,2*SLOTB);
  WAIT_BARK(3,5);
  qkt(pA0,pA1,Kbase,qr,qr4,negm,r32,hi);asm volatile("s_nop 15\n\ts_nop 7":"+v"(pA0),"+v"(pA1));CMASK(pA0,pA1,0);
  START(pA0,pA1);
  _Pragma("unroll") for(int r=0;r<16;++r)pA1[r]=__builtin_amdgcn_exp2f(pA1[r]);
  WAIT_BAR(0);
  DMA_K(3,0);DMA_V(1,SLOTB);
  ROT();
  kload8(kf,kp0+sl_cur); kx0=*(const ALAS bf16x8*)(kxp0+sl_cur); kx1=*(const ALAS bf16x8*)(kxp0+sl_cur+512);
  WAIT_BARK(2,3);
  s16x4 vlo[8],vhi[8]; u32x4 pw0,pw1,pw2,pw3;
  #define PKW(P,B) cvtpk_s(P[B],P[B+1])
  #define PAF(k) __builtin_bit_cast(bf16x8,pw##k)
  #define VFR(i) (bf16x8){vlo[i][0],vlo[i][1],vlo[i][2],vlo[i][3],vhi[i][0],vhi[i][1],vhi[i][2],vhi[i][3]}
  #define PIN(x) asm volatile("":"+v"(x))
  #define MX3(a,b,c) __builtin_fmaxf(__builtin_fmaxf((a),(b)),(c))
  #define GAPA(MF,A0,A1,A2,A3,W0,W1,PW) do{ MF; sacc+=A0; sacc+=A1; sacc+=A2; sacc+=A3; PIN(sacc); W0; W1; PIN(PW); SBAR(); }while(0)
  #define EX(v) __builtin_amdgcn_exp2f(v)
  #define GAPB(MF,X,B) do{ MF; X[B]=EX(X[B]); X[B+1]=EX(X[B+1]); X[B+2]=EX(X[B+2]); X[B+3]=EX(X[B+3]); PIN(X); SBAR(); }while(0)
  #define VRD(i) do{ vlo[i]=vtr(vp_+(((i)>>2)*4096+((i)&3)*1024)); vhi[i]=vtr(vp_+(((i)>>2)*4096+((i)&3)*1024+512)); }while(0)
  #define KRD(G,j) do{ if(G){ kload2(kf,kp0+sl_next,j); SBAR(); } }while(0)
  #define STEP(C0,C1,P0,P1,t,GK,GV,GL) do{ SBAR(); \
    const lds_cptr vp_=vp0+sl_prev; \
    VRD(0); SBAR(); float sacc=(P0[0]+P0[1]); \
    GAPA(C0=__builtin_amdgcn_mfma_f32_32x32x16_bf16(kf[0],qr[0],negm,0,0,0), P0[2],P0[3],P0[4],P0[5],     pw0[0]=PKW(P0,0), pw0[1]=PKW(P0,2), pw0); \
    VRD(4); SBAR(); GAPA(C1=__builtin_amdgcn_mfma_f32_32x32x16_bf16(kf[1],qr[0],negm,0,0,0), P0[6],P0[7],P0[8],P0[9],     pw0[2]=PKW(P0,4), pw0[3]=PKW(P0,6), pw0); \
    VRD(1); SBAR(); GAPA(C0=__builtin_amdgcn_mfma_f32_32x32x16_bf16(kf[2],qr[1],C0,0,0,0),   P0[10],P0[11],P0[12],P0[13], pw1[0]=PKW(P0,8), pw1[1]=PKW(P0,10), pw1); \
    VRD(5); SBAR(); GAPA(C1=__builtin_amdgcn_mfma_f32_32x32x16_bf16(kf[3],qr[1],C1,0,0,0),   P0[14],P0[15],P1[0],P1[1],   pw1[2]=PKW(P0,12),pw1[3]=PKW(P0,14), pw1); \
    VRD(2); SBAR(); GAPA(C0=__builtin_amdgcn_mfma_f32_32x32x16_bf16(kf[4],qr[2],C0,0,0,0),   P1[2],P1[3],P1[4],P1[5],     pw2[0]=PKW(P1,0), pw2[1]=PKW(P1,2), pw2); \
    VRD(6); SBAR(); GAPA(C1=__builtin_amdgcn_mfma_f32_32x32x16_bf16(kf[5],qr[2],C1,0,0,0),   P1[6],P1[7],P1[8],P1[9],     pw2[2]=PKW(P1,4), pw2[3]=PKW(P1,6), pw2); \
    VRD(3); SBAR(); GAPA(C0=__builtin_amdgcn_mfma_f32_32x32x16_bf16(kf[6],qr[3],C0,0,0,0),   P1[10],P1[11],P1[12],P1[13], pw3[0]=PKW(P1,8), pw3[1]=PKW(P1,10), pw3); \
    VRD(7); SBAR(); GAPA(C1=__builtin_amdgcn_mfma_f32_32x32x16_bf16(kf[7],qr[3],C1,0,0,0),   P1[14],P1[15],0.f,0.f,       pw3[2]=PKW(P1,12),pw3[3]=PKW(P1,14), pw3); \
    C0=__builtin_amdgcn_mfma_f32_32x32x16_bf16(kx0,qr4,C0,0,0,0); C1=__builtin_amdgcn_mfma_f32_32x32x16_bf16(kx1,qr4,C1,0,0,0); SBAR(); \
    l_reg+=sacc; \
    if(GK){DMA_K((t)+3,sl_cur);} if(GV){DMA_V((t)+1,sl_next);} \
    CMASK(C0,C1,t); \
    { float a=MX3(C0[0],C0[1],C1[0]),b=MX3(C0[2],C0[3],C1[1]); a=MX3(a,C1[2],C1[3]); \
      _Pragma("unroll") for(int r=4;r<16;r+=4){a=MX3(a,C0[r],C0[r+1]);b=MX3(b,C0[r+2],C0[r+3]);a=MX3(a,C1[r],C1[r+1]);b=MX3(b,C1[r+2],C1[r+3]);} \
      float rm=__builtin_fmaxf(a,b); { auto rr=__builtin_amdgcn_permlane32_swap(__float_as_uint(rm),__float_as_uint(rm),false,false); rm=__builtin_fmaxf(__uint_as_float(rr[0]),__uint_as_float(rr[1])); } \
      resc=false; \
      if(__builtin_expect(__any(rm>(float)THRL),0)){ const float dl=__builtin_fmaxf(rm,0.f); mhat+=dl; \
        _Pragma("unroll") for(int r=0;r<16;++r){C0[r]-=dl;C1[r]-=dl;} \
        _Pragma("unroll") for(int r=0;r<16;++r)negm[r]=-mhat; asm volatile("":"+v"(negm)); \
        const float f=__builtin_amdgcn_exp2f(-dl); l_reg*=f; if(hi==0)wsf[r32]=f; resc=true; } } \
    SBAR(); \
    GAPB(o[0]=__builtin_amdgcn_mfma_f32_32x32x16_bf16(PAF(0),VFR(0),o[0],0,0,0), C0,0); \
    GAPB(o[1]=__builtin_amdgcn_mfma_f32_32x32x16_bf16(PAF(0),VFR(4),o[1],0,0,0), C0,4); \
    KRD(GL,0); GAPB(o[0]=__builtin_amdgcn_mfma_f32_32x32x16_bf16(PAF(1),VFR(1),o[0],0,0,0), C0,8); \
    KRD(GL,1); GAPB(o[1]=__builtin_amdgcn_mfma_f32_32x32x16_bf16(PAF(1),VFR(5),o[1],0,0,0), C0,12); \
    KRD(GL,2); GAPB(o[0]=__builtin_amdgcn_mfma_f32_32x32x16_bf16(PAF(2),VFR(2),o[0],0,0,0), C1,0); \
    KRD(GL,3); GAPB(o[1]=__builtin_amdgcn_mfma_f32_32x32x16_bf16(PAF(2),VFR(6),o[1],0,0,0), C1,4); \
    if(GL){ kx0=*(const ALAS bf16x8*)(kxp0+sl_next); kx1=*(const ALAS bf16x8*)(kxp0+sl_next+512); SBAR(); } \
    GAPB(o[0]=__builtin_amdgcn_mfma_f32_32x32x16_bf16(PAF(3),VFR(3),o[0],0,0,0), C1,8); \
    GAPB(o[1]=__builtin_amdgcn_mfma_f32_32x32x16_bf16(PAF(3),VFR(7),o[1],0,0,0), C1,12); \
    }while(0)
  int t=1;
  #undef CMASK
  #define CMASK(P0,P1,t) do{}while(0)
  for(;t+5<NT;t+=2){
    STEP(pB0,pB1,pA0,pA1,t,true,true,true);     WAIT_BARK(2,3); RESC(); ROT();
    STEP(pA0,pA1,pB0,pB1,t+1,true,true,true);   WAIT_BARK(2,3); RESC(); ROT();
  }
  #undef CMASK
  #define CMASK(P0,P1,t) do{int jb_=(t)-(NT-4); if(jb_>=0)cmask(P0,P1,jb_,qrel,hi);}while(0)
  #define ENDW(tt) do{ if((tt)+3<NT){WAIT_BARK(2,3);} else if((tt)+2<NT){WAIT_BAR(1);} else {WAIT_BAR(0);} }while(0)
  for(;t+1<NT;t+=2){
    STEP(pB0,pB1,pA0,pA1,t,(t+3<NT),(t+1<NT),(t+1<NT));       ENDW(t);   RESC(); ROT();
    STEP(pA0,pA1,pB0,pB1,t+1,(t+4<NT),(t+2<NT),(t+2<NT));     ENDW(t+1); RESC(); ROT();
  }
  STEP(pB0,pB1,pA0,pA1,NT-1,false,false,false); RESC();
  { float sacc=pB0[0]+pB0[1]; _Pragma("unroll") for(int r=2;r<16;++r)sacc+=pB0[r]; _Pragma("unroll") for(int r=0;r<16;++r)sacc+=pB1[r]; l_reg+=sacc;
    pw0=(u32x4){PKW(pB0,0),PKW(pB0,2),PKW(pB0,4),PKW(pB0,6)};pw1=(u32x4){PKW(pB0,8),PKW(pB0,10),PKW(pB0,12),PKW(pB0,14)};pw2=(u32x4){PKW(pB1,0),PKW(pB1,2),PKW(pB1,4),PKW(pB1,6)};pw3=(u32x4){PKW(pB1,8),PKW(pB1,10),PKW(pB1,12),PKW(pB1,14)};
    SBAR(); pv(o,vb0+sl_cur,PAF(0),PAF(1),PAF(2),PAF(3)); }
  #undef PKW
  #undef PAF
  #undef VFR
  #undef PIN
  #undef MX3
  #undef GAPA
  #undef GAPB
  #undef EX
  #undef VRD
  #undef KRD
  #undef STEP
  #undef ENDW
  {auto rr=__builtin_amdgcn_permlane32_swap(__float_as_uint(l_reg),__float_as_uint(l_reg),false,false);l_reg=__uint_as_float(rr[0])+__uint_as_float(rr[1]);}
  if(hi==0)wsf[32+r32]=l_reg;asm volatile("s_waitcnt lgkmcnt(0)":::"memory");
  float rli[16];
  #pragma unroll
  for(int r=0;r<16;++r)rli[r]=__builtin_amdgcn_rcpf(wsf[32+crow(r,hi)]);
  bf16*Ow=O+(rowbase+q0+wid*QBLK)*ODM+OCOL+h*D;
  { bf16*stg=(bf16*)(shm+LDS_OST)+wid*2048;
    #pragma unroll
    for(int r=0;r<16;++r){const int orow=crow(r,hi);
      #pragma unroll
      for(int d0=0;d0<2;++d0)stg[orow*64+d0*32+r32]=__float2bfloat16(o[d0][r]*rli[r]);}
    asm volatile("s_waitcnt lgkmcnt(0)":::"memory");
    #pragma unroll
    for(int i=0;i<4;++i){const int row=i*8+(lane>>3),ch=lane&7; const u32x4 v=*(const u32x4*)(stg+row*64+ch*8); ATTN_STORE16(Ow+(long)row*ODM+ch*8,v);} }
  asm volatile("s_waitcnt lgkmcnt(0)\n\ts_barrier":::"memory");
  #undef DMA_K
  #undef DMA_V
  #undef CMASK
  #undef START
  #undef RESC
  #undef ROT
}
constexpr int ATTN_LDS_BYTES=LDS_BYTES;
struct AttnTensors { const bf16* Q; const bf16* K; const bf16* V; const bf16* KX; bf16* O; };
struct AttnUnit { int bh; int qb; };
struct StaticOrder {
  int vcu;
  __device__ __forceinline__ explicit StaticOrder(int grid,int block):vcu((block%8)*(grid/8)+block/8){}
  __device__ __forceinline__ bool next(int i,AttnUnit&u)const{ if(i>=4)return false; const int s=vcu&1; u.bh=vcu>>1; u.qb=(i==0)?(7-s):(i==1)?s:(i==2)?(5-s):(2+s); return true; }
  __device__ __forceinline__ void a_ready(const AttnUnit&)const{}
  __device__ __forceinline__ void done(const AttnUnit&)const{}
};
template<class Sched,int THRL=8> __device__ __forceinline__ void attn_phase(char*lds,const AttnTensors&T,const Sched&S){
  AttnUnit u;
  for(int i=0;S.next(i,u);++i){ S.a_ready(u); attn_unit<THRL>(u.bh/NHEAD,u.bh%NHEAD,u.qb,T.Q,T.K,T.V,T.KX,T.O,lds); S.done(u); }
}
#undef SBAR
#undef WAIT_BAR
}

namespace ssd {
typedef short bf16x8 __attribute__((ext_vector_type(8)));
typedef float f32x4 __attribute__((ext_vector_type(4)));
typedef unsigned u32x4 __attribute__((ext_vector_type(4)));
typedef unsigned u32x2 __attribute__((ext_vector_type(2)));
#define SLAS __attribute__((address_space(3)))
constexpr int LPB = 144;
constexpr int NPB = 272;
constexpr int NCH = SEQ / 64;
__device__ __forceinline__ unsigned pkbf(float lo, float hi) { return (unsigned)f2bf(lo) | ((unsigned)f2bf(hi) << 16); }

__device__ __forceinline__ float chunk_acum(const float* dt, const float* a_log, int tok0, int h, int lane, float& dtv) {
    dtv = dt[(size_t)(tok0 + lane) * 8 + h];
    float A = dtv * (-expf(a_log[h]));
#pragma unroll
    for (int o = 1; o < 64; o <<= 1) { const float y = __shfl_up(A, o); if (lane >= o) A += y; }
    return A;
}


__device__ __forceinline__ void conv_chunk(const bf16_t* xbc, const float* cw, const float* cb, bf16_t* xcb, int b, int c) {
    const int tid = threadIdx.x, cg = tid & 127, rq = tid >> 7, ch0 = cg * 8, l0 = rq * 16;
    const size_t tok0 = (size_t)b * SEQ + c * 64;
    float w[4][8], bias[8];
#pragma unroll
    for (int k = 0; k < 4; ++k) { const f32x4 a = *(const f32x4*)(cw + k * 1024 + ch0), bq = *(const f32x4*)(cw + k * 1024 + ch0 + 4);
        w[k][0] = a[0]; w[k][1] = a[1]; w[k][2] = a[2]; w[k][3] = a[3]; w[k][4] = bq[0]; w[k][5] = bq[1]; w[k][6] = bq[2]; w[k][7] = bq[3]; }
    { const f32x4 a = *(const f32x4*)(cb + ch0), bq = *(const f32x4*)(cb + ch0 + 4); bias[0] = a[0]; bias[1] = a[1]; bias[2] = a[2]; bias[3] = a[3]; bias[4] = bq[0]; bias[5] = bq[1]; bias[6] = bq[2]; bias[7] = bq[3]; }
    float win[3][8];
#pragma unroll
    for (int k = 0; k < 3; ++k) { const int l = l0 - 3 + k; u32x4 v = (u32x4){0u, 0u, 0u, 0u};
        if (c * 64 + l >= 0) v = *(const u32x4*)(xbc + (tok0 + l) * 1024 + ch0);
#pragma unroll
        for (int j = 0; j < 4; ++j) { win[k][2 * j] = __uint_as_float(v[j] << 16); win[k][2 * j + 1] = __uint_as_float(v[j] & 0xffff0000u); } }
#pragma unroll
    for (int i = 0; i < 16; ++i) {
        const u32x4 v = *(const u32x4*)(xbc + (tok0 + l0 + i) * 1024 + ch0);
        float cur[8], o[8];
#pragma unroll
        for (int j = 0; j < 4; ++j) { cur[2 * j] = __uint_as_float(v[j] << 16); cur[2 * j + 1] = __uint_as_float(v[j] & 0xffff0000u); }
#pragma unroll
        for (int j = 0; j < 8; ++j) { const float a = bias[j] + w[0][j] * win[0][j] + w[1][j] * win[1][j] + w[2][j] * win[2][j] + w[3][j] * cur[j]; o[j] = a / (1.f + expf(-a)); }
        *(u32x4*)(xcb + (tok0 + l0 + i) * 1024 + ch0) = (u32x4){pkbf(o[0], o[1]), pkbf(o[2], o[3]), pkbf(o[4], o[5]), pkbf(o[6], o[7])};
#pragma unroll
        for (int j = 0; j < 8; ++j) { win[0][j] = win[1][j]; win[1][j] = win[2][j]; win[2][j] = cur[j]; }
    }
}

__device__ __forceinline__ void states_unit(SLAS unsigned char* lds, const bf16_t* xc, const float* dt, const float* a_log, bf16_t* S, float* cdec, int b, int c) {
    const int tid = threadIdx.x, lane = tid & 63, w = __builtin_amdgcn_readfirstlane(tid >> 6), r = lane & 15, q = lane >> 4;
    const int tok0 = b * SEQ + c * 64;
    SLAS float* warr = (SLAS float*)lds;
    SLAS unsigned char* BT = lds + 2048;
    SLAS unsigned char* XW = lds + 2048 + 128 * LPB;
    { float dtv; const float A = chunk_acum(dt, a_log, tok0, w, lane, dtv); const float A63 = __shfl(A, 63);
      warr[w * 64 + lane] = dtv * expf(A63 - A);
      if (lane == 63) cdec[(size_t)(b * NCH + c) * 8 + w] = expf(A63); }
    __syncthreads();
#pragma unroll 1
    for (int g = 0; g < 2; ++g) {
        { const int n = tid & 127, lq = tid >> 7; unsigned pk[8];
#pragma unroll
          for (int i = 0; i < 8; ++i) { const unsigned lo = xc[(size_t)(tok0 + 16 * lq + 2 * i) * 1024 + 512 + g * 128 + n], hi = xc[(size_t)(tok0 + 16 * lq + 2 * i + 1) * 1024 + 512 + g * 128 + n]; pk[i] = lo | (hi << 16); }
          *(SLAS u32x4*)(BT + n * LPB + lq * 32) = (u32x4){pk[0], pk[1], pk[2], pk[3]}; *(SLAS u32x4*)(BT + n * LPB + lq * 32 + 16) = (u32x4){pk[4], pk[5], pk[6], pk[7]}; }
        { const int hp = tid & 255, lh = tid >> 8, hh = hp >> 6; unsigned pk[16];
#pragma unroll
          for (int i = 0; i < 16; ++i) { const int l0 = 32 * lh + 2 * i;
              const float x0 = bf2f(xc[(size_t)(tok0 + l0) * 1024 + g * 256 + hp]) * warr[(g * 4 + hh) * 64 + l0], x1 = bf2f(xc[(size_t)(tok0 + l0 + 1) * 1024 + g * 256 + hp]) * warr[(g * 4 + hh) * 64 + l0 + 1];
              pk[i] = pkbf(x0, x1); }
#pragma unroll
          for (int j = 0; j < 4; ++j) *(SLAS u32x4*)(XW + hp * LPB + lh * 64 + 16 * j) = (u32x4){pk[4 * j], pk[4 * j + 1], pk[4 * j + 2], pk[4 * j + 3]}; }
        __syncthreads();
        f32x4 acc[8][2];
#pragma unroll
        for (int nt = 0; nt < 8; ++nt) { acc[nt][0] = (f32x4){0.f, 0.f, 0.f, 0.f}; acc[nt][1] = (f32x4){0.f, 0.f, 0.f, 0.f}; }
#pragma unroll
        for (int k = 0; k < 2; ++k) {
            bf16x8 xf[2];
#pragma unroll
            for (int ht = 0; ht < 2; ++ht) xf[ht] = *(const SLAS bf16x8*)(XW + (32 * w + 16 * ht + r) * LPB + (32 * k + 8 * q) * 2);
#pragma unroll
            for (int nt = 0; nt < 8; ++nt) { const bf16x8 bf = *(const SLAS bf16x8*)(BT + (16 * nt + r) * LPB + (32 * k + 8 * q) * 2);
#pragma unroll
                for (int ht = 0; ht < 2; ++ht) acc[nt][ht] = __builtin_amdgcn_mfma_f32_16x16x32_bf16(bf, xf[ht], acc[nt][ht], 0, 0, 0); }
        }
        const int h = g * 4 + (w >> 1);
#pragma unroll
        for (int ht = 0; ht < 2; ++ht) { const int p = (w & 1) * 32 + 16 * ht + r; bf16_t* dst = S + ((size_t)((b * NCH + c) * 8 + h) * 64 + p) * 128 + 4 * q;
#pragma unroll
            for (int nt = 0; nt < 8; ++nt) *(u32x2*)(dst + 16 * nt) = (u32x2){pkbf(acc[nt][ht][0], acc[nt][ht][1]), pkbf(acc[nt][ht][2], acc[nt][ht][3])}; }
        __syncthreads();
    }
}

__device__ __forceinline__ void scan_unit(bf16_t* S, const float* cdec, int bh, int half) {
    const int tid = threadIdx.x, b = bh >> 3, h = bh & 7;
    const size_t e0 = (size_t)(half * 512 + tid) * 8;
    float st[8];
#pragma unroll
    for (int i = 0; i < 8; ++i) st[i] = 0.f;
#pragma unroll 1
    for (int c0 = 0; c0 < NCH; c0 += 8) {
        u32x4 v[8];
#pragma unroll
        for (int j = 0; j < 8; ++j) v[j] = *(const u32x4*)(S + (size_t)((b * NCH + c0 + j) * 8 + h) * 8192 + e0);
#pragma unroll
        for (int j = 0; j < 8; ++j) {
            *(u32x4*)(S + (size_t)((b * NCH + c0 + j) * 8 + h) * 8192 + e0) = (u32x4){pkbf(st[0], st[1]), pkbf(st[2], st[3]), pkbf(st[4], st[5]), pkbf(st[6], st[7])};
            const float d = cdec[(size_t)(b * NCH + c0 + j) * 8 + h];
#pragma unroll
            for (int i = 0; i < 4; ++i) { const unsigned wv = v[j][i]; st[2 * i] = st[2 * i] * d + __uint_as_float(wv << 16); st[2 * i + 1] = st[2 * i + 1] * d + __uint_as_float(wv & 0xffff0000u); }
        }
    }
}

__device__ __forceinline__ void out_unit(SLAS unsigned char* lds, const bf16_t* xc, const bf16_t* z, const float* dt, const float* a_log, const float* d_skip, const float* norm_g,
                                         const bf16_t* Sin, bf16_t* merged, int b, int c) {
    const int tid = threadIdx.x, lane = tid & 63, w = __builtin_amdgcn_readfirstlane(tid >> 6), r = lane & 15, q = lane >> 4;
    const int tok0 = b * SEQ + c * 64;
    SLAS float* Aarr = (SLAS float*)lds;
    SLAS float* dtarr = (SLAS float*)(lds + 2048);
    SLAS float* npart = (SLAS float*)(lds + 4096);
    SLAS unsigned char* Cg = lds + 6144;
    SLAS unsigned char* Bg = Cg + 64 * NPB;
    SLAS unsigned char* XT = Bg + 64 * NPB;
    SLAS unsigned char* Mm = XT + 256 * LPB;
    { float dtv; const float A = chunk_acum(dt, a_log, tok0, w, lane, dtv); Aarr[w * 64 + lane] = A; dtarr[w * 64 + lane] = dtv; }
    __syncthreads();
#pragma unroll 1
    for (int g = 0; g < 2; ++g) {
#pragma unroll
        for (int i = 0; i < 2; ++i) { const int id = tid + 512 * i, l = id >> 4, ch = id & 15; const bf16_t* src = xc + (size_t)(tok0 + l) * 1024 + g * 128 + ch * 8;
            *(SLAS u32x4*)(Cg + l * NPB + ch * 16) = *(const u32x4*)(src + 768); *(SLAS u32x4*)(Bg + l * NPB + ch * 16) = *(const u32x4*)(src + 512); }
        { const int hp = tid & 255, lh = tid >> 8; unsigned pk[16];
#pragma unroll
          for (int i = 0; i < 16; ++i) { const int l0 = 32 * lh + 2 * i; const unsigned lo = xc[(size_t)(tok0 + l0) * 1024 + g * 256 + hp], hi = xc[(size_t)(tok0 + l0 + 1) * 1024 + g * 256 + hp]; pk[i] = lo | (hi << 16); }
#pragma unroll
          for (int j = 0; j < 4; ++j) *(SLAS u32x4*)(XT + hp * LPB + lh * 64 + 16 * j) = (u32x4){pk[4 * j], pk[4 * j + 1], pk[4 * j + 2], pk[4 * j + 3]}; }
        __syncthreads();
        {
            const int lt = w >> 1, st0 = 2 * (w & 1);
            f32x4 accG[2]; accG[0] = (f32x4){0.f, 0.f, 0.f, 0.f}; accG[1] = (f32x4){0.f, 0.f, 0.f, 0.f};
#pragma unroll
            for (int k = 0; k < 4; ++k) { const bf16x8 cf = *(const SLAS bf16x8*)(Cg + (16 * lt + r) * NPB + (32 * k + 8 * q) * 2);
#pragma unroll
                for (int j = 0; j < 2; ++j) { const bf16x8 bf = *(const SLAS bf16x8*)(Bg + (16 * (st0 + j) + r) * NPB + (32 * k + 8 * q) * 2); accG[j] = __builtin_amdgcn_mfma_f32_16x16x32_bf16(bf, cf, accG[j], 0, 0, 0); } }
            const int l = 16 * lt + r;
#pragma unroll
            for (int hh = 0; hh < 4; ++hh) { const int h = g * 4 + hh; const float Al = Aarr[h * 64 + l];
#pragma unroll
                for (int j = 0; j < 2; ++j) { const int s0 = 16 * (st0 + j) + 4 * q; float m[4];
#pragma unroll
                    for (int e = 0; e < 4; ++e) { const int s = s0 + e; m[e] = (s <= l) ? accG[j][e] * expf(Al - Aarr[h * 64 + s]) * dtarr[h * 64 + s] : 0.f; }
                    *(SLAS u32x2*)(Mm + hh * 64 * LPB + l * LPB + s0 * 2) = (u32x2){pkbf(m[0], m[1]), pkbf(m[2], m[3])}; } }
        }
        __syncthreads();
        {
            const int hh = w >> 1, h = g * 4 + hh;
            f32x4 acc[4][2];
#pragma unroll
            for (int lt = 0; lt < 4; ++lt) { acc[lt][0] = (f32x4){0.f, 0.f, 0.f, 0.f}; acc[lt][1] = (f32x4){0.f, 0.f, 0.f, 0.f}; }
            const bf16_t* sin = Sin + ((size_t)((b * NCH + c) * 8 + h) * 64 + (w & 1) * 32 + r) * 128 + 8 * q;
#pragma unroll
            for (int k = 0; k < 4; ++k) { bf16x8 sf[2];
#pragma unroll
                for (int ht = 0; ht < 2; ++ht) sf[ht] = *(const bf16x8*)(sin + (size_t)(16 * ht) * 128 + 32 * k);
#pragma unroll
                for (int lt = 0; lt < 4; ++lt) { const bf16x8 cf = *(const SLAS bf16x8*)(Cg + (16 * lt + r) * NPB + (32 * k + 8 * q) * 2);
#pragma unroll
                    for (int ht = 0; ht < 2; ++ht) acc[lt][ht] = __builtin_amdgcn_mfma_f32_16x16x32_bf16(sf[ht], cf, acc[lt][ht], 0, 0, 0); } }
#pragma unroll
            for (int lt = 0; lt < 4; ++lt) { const float e = expf(Aarr[h * 64 + 16 * lt + r]); acc[lt][0] = acc[lt][0] * e; acc[lt][1] = acc[lt][1] * e; }
#pragma unroll
            for (int k = 0; k < 2; ++k) { bf16x8 xf[2];
#pragma unroll
                for (int ht = 0; ht < 2; ++ht) xf[ht] = *(const SLAS bf16x8*)(XT + (32 * w + 16 * ht + r) * LPB + (32 * k + 8 * q) * 2);
#pragma unroll
                for (int lt = 0; lt < 4; ++lt) { const bf16x8 mf = *(const SLAS bf16x8*)(Mm + hh * 64 * LPB + (16 * lt + r) * LPB + (32 * k + 8 * q) * 2);
#pragma unroll
                    for (int ht = 0; ht < 2; ++ht) acc[lt][ht] = __builtin_amdgcn_mfma_f32_16x16x32_bf16(xf[ht], mf, acc[lt][ht], 0, 0, 0); } }
            const float dsk = d_skip[h];
            float ss[4];
#pragma unroll
            for (int lt = 0; lt < 4; ++lt) { const int l = 16 * lt + r; float s2 = 0.f;
#pragma unroll
                for (int ht = 0; ht < 2; ++ht) { const int ch = g * 256 + 32 * w + 16 * ht + 4 * q;
                    const u32x2 xv = *(const u32x2*)(xc + (size_t)(tok0 + l) * 1024 + ch); const u32x2 zv = *(const u32x2*)(z + (size_t)(tok0 + l) * 512 + ch);
                    const float xs4[4] = {__uint_as_float(xv.x << 16), __uint_as_float(xv.x & 0xffff0000u), __uint_as_float(xv.y << 16), __uint_as_float(xv.y & 0xffff0000u)};
                    const float z4[4] = {__uint_as_float(zv.x << 16), __uint_as_float(zv.x & 0xffff0000u), __uint_as_float(zv.y << 16), __uint_as_float(zv.y & 0xffff0000u)};
#pragma unroll
                    for (int e = 0; e < 4; ++e) { const float y = acc[lt][ht][e] + dsk * xs4[e]; const float yg = y * (z4[e] / (1.f + expf(-z4[e]))); acc[lt][ht][e] = yg; s2 += yg * yg; } }
                s2 += __shfl_xor(s2, 16); s2 += __shfl_xor(s2, 32); ss[lt] = s2; }
            if (q == 0) {
#pragma unroll
                for (int lt = 0; lt < 4; ++lt) npart[w * 64 + 16 * lt + r] = ss[lt]; }
            __syncthreads();
#pragma unroll
            for (int lt = 0; lt < 4; ++lt) { const int l = 16 * lt + r; float tot = 0.f;
#pragma unroll
                for (int ww = 0; ww < 8; ++ww) tot += npart[ww * 64 + l];
                const float rs = rsqrtf(tot * (1.f / 256.f) + RMS_EPS);
#pragma unroll
                for (int ht = 0; ht < 2; ++ht) { const int ch = g * 256 + 32 * w + 16 * ht + 4 * q; const f32x4 gv = *(const f32x4*)(norm_g + ch);
                    *(u32x2*)(merged + (size_t)(tok0 + l) * 1024 + ch) = (u32x2){pkbf(acc[lt][ht][0] * rs * gv[0], acc[lt][ht][1] * rs * gv[1]), pkbf(acc[lt][ht][2] * rs * gv[2], acc[lt][ht][3] * rs * gv[3])}; } }
        }
        __syncthreads();
    }
}
#undef SLAS
}

__global__ void k_convb(const bf16_t* xbc, const float* conv_w, const float* conv_b, bf16_t* xc) {
    const size_t idx = (size_t)blockIdx.x * 256 + threadIdx.x;
    const int c = (int)(idx & 1023); const int t = (int)(idx >> 10); const int s = t & (SEQ - 1);
    float acc = conv_b[c];
#pragma unroll
    for (int k = 0; k < 4; ++k) { const int ss = s - 3 + k; if (ss >= 0) acc += conv_w[k * 1024 + c] * bf2f(xbc[(size_t)(t - 3 + k) * 1024 + c]); }
    xc[idx] = f2bf(acc / (1.f + expf(-acc)));
}


constexpr int NWAVES = 8;
constexpr int RING_OFF = 0, RING_BYTES = 131072;
constexpr int LDSCTL_OFF = RING_BYTES, MISC_OFF = LDSCTL_OFF + 320;
constexpr int TAB_OFF = RING_BYTES + 1024;
constexpr int LDS_BYTES = 147456;
#define GAS __attribute__((address_space(1)))
#define LAS __attribute__((address_space(3)))
typedef unsigned v4u __attribute__((ext_vector_type(4)));
typedef float f32x4 __attribute__((ext_vector_type(4)));
typedef GAS unsigned gu32;
#define RLX_AGENT __ATOMIC_RELAXED, __HIP_MEMORY_SCOPE_AGENT
#define LDS_WAIT() asm volatile("s_waitcnt lgkmcnt(0)" ::: "memory")
#define VM_WAIT() asm volatile("s_waitcnt vmcnt(0)" ::: "memory")
__device__ __forceinline__ unsigned pk2(float lo, float hi) { return (unsigned)f2bf(lo) | ((unsigned)f2bf(hi) << 16); }

#define XB_TMO      128
#define XB_XCNT(j)  (256  + 64 * (j))
#define XB_XSUB(j)  (1280 + 64 * (j))
#define XB_XGEN(j)  (2304 + 64 * (j))
#define XB_TOP      3328
#define XB_TOPGEN   3392
#define XCD_BAR_WORDS 3456
#define XB_SPIN_CAP (1u << 18)
__device__ __forceinline__ unsigned xb_ld(unsigned* p)              { return __hip_atomic_load(p, __ATOMIC_RELAXED, __HIP_MEMORY_SCOPE_AGENT); }
__device__ __forceinline__ unsigned xb_add(unsigned* p, unsigned v) { return __hip_atomic_fetch_add(p, v, __ATOMIC_RELAXED, __HIP_MEMORY_SCOPE_AGENT); }
__device__ __forceinline__ unsigned xb_xcc_id() { return (unsigned)__builtin_amdgcn_s_getreg((3 << 11) | 20) & 0xFu; }
#define XB_SPIN(cond, bar) do { unsigned _sp = 0; while (cond) { __builtin_amdgcn_s_sleep(1); \
    if ((++_sp & 255u) == 0u) { if (xb_ld(&(bar)[XB_TMO])) break; if (_sp > XB_SPIN_CAP) { atomicAdd(&(bar)[XB_TMO], 1u); break; } } } } while (0)
struct XcdBarrier { unsigned* bar; unsigned x; volatile LAS unsigned* st; };
__device__ __forceinline__ XcdBarrier xcd_barrier_post(unsigned* bar, volatile LAS unsigned* st) {
    XcdBarrier b; b.bar = bar; b.x = xb_xcc_id(); b.st = st;
    if (threadIdx.x == 0) (void)xb_add(&bar[XB_XCNT(b.x)], 1u);
    return b;
}
__device__ __forceinline__ void xcd_barrier_complete(unsigned* bar, unsigned x, unsigned& nloc, unsigned& nx) {
    const unsigned G = gridDim.x * gridDim.y * gridDim.z;
    unsigned sum, cnt, mine, sp = 0u;
    for (;;) {
        sum = 0u; cnt = 0u; mine = 0u;
#pragma unroll
        for (unsigned j = 0; j < 16; ++j) { const unsigned c = xb_ld(&bar[XB_XCNT(j)]); sum += c; cnt += (c > 0u) ? 1u : 0u; mine = (j == x) ? c : mine; }
        if (sum == G) break;
        __builtin_amdgcn_s_sleep(1);
        if ((++sp & 255u) == 0u) { if (xb_ld(&bar[XB_TMO])) break; if (sp > XB_SPIN_CAP) { atomicAdd(&bar[XB_TMO], 1u); break; } }
    }
    nloc = mine > 0u ? mine : 1u; nx = cnt > 0u ? cnt : 1u;
}
__device__ __forceinline__ void xcd_barrier(const XcdBarrier& b) {
    asm volatile("s_waitcnt vmcnt(0)" ::: "memory");
    __syncthreads();
    if (threadIdx.x == 0) {
        unsigned* bar = b.bar;
        __builtin_amdgcn_s_waitcnt(0);
        unsigned nloc = b.st[0], nx = b.st[1];
        if (nloc == 0u) { xcd_barrier_complete(bar, b.x, nloc, nx); b.st[0] = nloc; b.st[1] = nx; }
        const unsigned old = xb_add(&bar[XB_XSUB(b.x)], 1u);
        const unsigned gen = old / nloc;
        if (old + 1u == (gen + 1u) * nloc) {
            __builtin_amdgcn_fence(__ATOMIC_RELEASE, "agent");
            asm volatile("s_waitcnt vmcnt(0)" ::: "memory");
            const unsigned og = xb_add(&bar[XB_TOP], 1u);
            const unsigned tg = og / nx;
            if (og + 1u == (tg + 1u) * nx) xb_add(&bar[XB_TOPGEN], 1u);
            else XB_SPIN(xb_ld(&bar[XB_TOPGEN]) == tg, bar);
            __builtin_amdgcn_fence(__ATOMIC_ACQUIRE, "agent");
            xb_add(&bar[XB_XGEN(b.x)], 1u);
            asm volatile("s_waitcnt vmcnt(0)" ::: "memory");
        } else {
            XB_SPIN(xb_ld(&bar[XB_XGEN(b.x)]) == gen, bar);
            __builtin_amdgcn_fence(__ATOMIC_ACQUIRE, "agent");
            asm volatile("s_waitcnt vmcnt(0)" ::: "memory");
        }
    }
    __syncthreads();
}

struct Frame {
    LAS unsigned char* lds;
    volatile LAS unsigned* MISC;
    gu32* ctl;
    int tid, lane, wave, vcu, G;
};
__device__ __forceinline__ float wave_sum(float v) {
#pragma unroll
    for (int o = 1; o < 64; o <<= 1) v += __shfl_xor(v, o);
    return v;
}

__device__ __forceinline__ void p0_transpose_item(const float* W, int ldw, int k0, int n0, bf16_t* WT, int ldt, int drow0, LAS float* scr, int lane) {
#pragma unroll 8
    for (int i = 0; i < 32; ++i) { const int kk = 2 * i + (lane >> 5); scr[kk * 33 + (lane & 31)] = W[(size_t)(k0 + kk) * ldw + n0 + (lane & 31)]; }
    LDS_WAIT(); asm volatile("" ::: "memory");
    const int c = lane & 7;
#pragma unroll
    for (int j = 0; j < 4; ++j) { const int n = (lane >> 3) + 8 * j; const LAS float* s = scr + (8 * c) * 33 + n;
        v4u o; o.x = pk2(s[0 * 33], s[1 * 33]); o.y = pk2(s[2 * 33], s[3 * 33]); o.z = pk2(s[4 * 33], s[5 * 33]); o.w = pk2(s[6 * 33], s[7 * 33]);
        *(GAS v4u*)(WT + (size_t)(drow0 + n) * ldt + k0 + 8 * c) = o; }
    LDS_WAIT(); asm volatile("" ::: "memory");
}
__device__ __forceinline__ float softplus_d(float x) { return fmaxf(x, 0.f) + log1pf(expf(-fabsf(x))); }

__device__ __forceinline__ void p0_prologue(Frame& F, const P& p) {
    unsigned char* ws = p.ws;
    bf16_t* Win_t = (bf16_t*)(ws + WS_WIN); bf16_t* Wout_t = (bf16_t*)(ws + WS_WOUT); bf16_t* Wgu_t = (bf16_t*)(ws + WS_WGU); bf16_t* Wd_t = (bf16_t*)(ws + WS_WD);
    LAS float* scr = (LAS float*)(F.lds + RING_OFF + F.wave * 16384);
    const int gw = F.vcu * NWAVES + F.wave, NGW = F.G * NWAVES;
    constexpr int I_IN = 16 * 96, I_OUT = 16 * 32, I_GU = 16 * 2 * 256, I_D = 16 * 256, NITEMS = I_IN + I_OUT + I_GU + I_D;
    for (int it = gw; it < NITEMS; it += NGW) {
        int r = it;
        if (r < I_IN) { const int kb = r / 96, nb = r % 96, n0 = 32 * nb; p0_transpose_item(p.w_in, NPROJ, 64 * kb, n0 + (n0 >= 1536 ? 8 : 0), Win_t, 1024, n0, scr, F.lane); continue; } r -= I_IN;
        if (r < I_OUT) { const int kb = r / 32, nb = r % 32; p0_transpose_item(p.w_out, 1024, 64 * kb, 32 * nb, Wout_t, 1024, 32 * nb, scr, F.lane); continue; } r -= I_OUT;
        if (r < I_GU) { const int e = r / 512, rr = r % 512, mat = rr / 256, r2 = rr % 256, kb = r2 / 16, nb = r2 % 16, n0 = 32 * nb, q = n0 / 128;
            p0_transpose_item((mat ? p.w_up : p.w_gate) + (size_t)e * 1024 * 512, 512, 64 * kb, n0, Wgu_t, 1024, (e * 4 + q) * 256 + mat * 128 + (n0 % 128), scr, F.lane); continue; } r -= I_GU;
        { const int e = r / 256, r2 = r % 256, kb = r2 / 32, nb = r2 % 32;
            p0_transpose_item(p.w_down + (size_t)e * 512 * 1024, 1024, 64 * kb, 32 * nb, Wd_t + (size_t)e * 1024 * 512, 512, 32 * nb, scr, F.lane); }
    }
    __syncthreads();
    LAS float* w16 = (LAS float*)(F.lds + RING_OFF);
    for (int idx = F.tid; idx < 16 * 1024; idx += NWAVES * 64) { const int k = idx >> 4, c = idx & 15; w16[c * 1024 + k] = p.w_in[(size_t)k * NPROJ + (c < 8 ? 1536 + c : 3080 + c - 8)]; }
    __syncthreads();
    bf16_t* xb = (bf16_t*)(ws + WS_XB); float* dt = (float*)(ws + WS_DT); float* logf = (float*)(ws + WS_LOGF);
#pragma unroll 1
    for (int grp = gw; grp < T / 2; grp += NGW) {
        float a[32];
#pragma unroll
        for (int r = 0; r < 2; ++r) {
            const int m = grp * 2 + r;
            const GAS f32x4* xr = (const GAS f32x4*)(p.x + (size_t)m * D) + F.lane;
            f32x4 v[4];
#pragma unroll
            for (int j = 0; j < 4; ++j) v[j] = xr[64 * j];
            GAS unsigned long long* o8 = (GAS unsigned long long*)(xb + (size_t)m * D) + F.lane;
#pragma unroll
            for (int j = 0; j < 4; ++j) o8[64 * j] = (unsigned long long)pk2(v[j].x, v[j].y) | ((unsigned long long)pk2(v[j].z, v[j].w) << 32);
#pragma unroll
            for (int c = 0; c < 16; ++c) {
                float s = 0.f;
#pragma unroll
                for (int j = 0; j < 4; ++j) { const f32x4 w = *(const LAS f32x4*)(w16 + c * 1024 + 256 * j + 4 * F.lane); s += (v[j].x * w.x + v[j].y * w.y) + (v[j].z * w.z + v[j].w * w.w); }
                a[r * 16 + c] = s; asm volatile("" ::: "memory");
            }
        }
#define TRSTEP(HALFN, SB) do { const bool up = (F.lane >> (SB)) & 1; _Pragma("unroll") for (int i = 0; i < (HALFN); ++i) { const float keep = up ? a[i + (HALFN)] : a[i]; const float send = up ? a[i] : a[i + (HALFN)]; a[i] = keep + __shfl_xor(send, 1 << (SB)); } } while (0)
        TRSTEP(16, 0); TRSTEP(8, 1); TRSTEP(4, 2); TRSTEP(2, 3); TRSTEP(1, 4);
#undef TRSTEP
        const float tot = a[0] + __shfl_xor(a[0], 32);
        const int L = F.lane & 31; const int idx = ((L & 1) << 4) | ((L & 2) << 2) | (L & 4) | ((L & 8) >> 2) | ((L & 16) >> 4);
        const int r = idx >> 4, c = idx & 15, m = grp * 2 + r;
        if (F.lane < 32) {
            if (c < 8) dt[(size_t)m * 8 + c] = softplus_d(tot + p.b_in[1536 + c]);
            else logf[(size_t)m * 8 + (c - 8)] = -softplus_d(-(tot + p.b_in[3080 + c - 8]));
        }
    }
}

__device__ __forceinline__ void scanF_unit(Frame& F, const P& p, int bh) {
    const int b = bh >> 3, h = bh & 7;
    const float* logf = (const float*)(p.ws + WS_LOGF); float* Fo = (float*)(p.ws + WS_F); bf16_t* kx = (bf16_t*)(p.ws + WS_KX);
    LAS float* wsum8 = (LAS float*)(F.lds + RING_OFF);
    float v[4]; float s = 0.f;
#pragma unroll
    for (int i = 0; i < 4; ++i) { v[i] = logf[(size_t)(b * SEQ + F.tid * 4 + i) * 8 + h]; s += v[i]; v[i] = s; }
    float inc = s;
#pragma unroll
    for (int o = 1; o < 64; o <<= 1) { const float y = __shfl_up(inc, o); if (F.lane >= o) inc += y; }
    if (F.lane == 63) wsum8[F.wave] = inc;
    __syncthreads();
    float base = inc - s;
    for (int w = 0; w < F.wave; ++w) base += wsum8[w];
#pragma unroll
    for (int i = 0; i < 4; ++i) { const size_t tok = (size_t)(b * SEQ + F.tid * 4 + i); const float f = base + v[i]; Fo[tok * 8 + h] = f;
        const float g = -f * LOG2E; const bf16_t g0 = f2bf(g); const float r1 = g - bf2f(g0); const bf16_t g1 = f2bf(r1); const float r2 = r1 - bf2f(g1); const bf16_t g2 = f2bf(r2);
        v4u o; o.x = (unsigned)g0 | ((unsigned)g1 << 16); o.y = (unsigned)g2; o.z = 0u; o.w = 0u;
        *(GAS v4u*)(kx + (tok * 8 + h) * 8) = o; }
    __syncthreads();
}


__device__ __forceinline__ void ln1_router_row(const P& p, int t, int lane, bf16_t* hb, gu32* cnt, int* perm, float* tokinfo) {
    float* hio = p.out;
    float v[16]; float s = 0.f;
#pragma unroll
    for (int j = 0; j < 4; ++j) { const f32x4 u = *(const GAS f32x4*)(hio + (size_t)t * D + j * 256 + lane * 4); v[4 * j] = u.x; v[4 * j + 1] = u.y; v[4 * j + 2] = u.z; v[4 * j + 3] = u.w; s += (u.x + u.y) + (u.z + u.w); }
    const float mu = wave_sum(s) * (1.f / D); float s2 = 0.f;
#pragma unroll
    for (int i = 0; i < 16; ++i) { v[i] -= mu; s2 += v[i] * v[i]; }
    const float rstd = rsqrtf(wave_sum(s2) * (1.f / D) + LN_EPS);
    float gl[4] = {0.f, 0.f, 0.f, 0.f};
#pragma unroll
    for (int j = 0; j < 4; ++j) { const int c = j * 256 + lane * 4;
        const f32x4 g1 = *(const GAS f32x4*)(p.ln1_g + c), b1 = *(const GAS f32x4*)(p.ln1_b + c);
        f32x4 hv; hv.x = v[4 * j] * rstd * g1.x + b1.x; hv.y = v[4 * j + 1] * rstd * g1.y + b1.y; hv.z = v[4 * j + 2] * rstd * g1.z + b1.z; hv.w = v[4 * j + 3] * rstd * g1.w + b1.w;
        v[4 * j] = hv.x; v[4 * j + 1] = hv.y; v[4 * j + 2] = hv.z; v[4 * j + 3] = hv.w;
        *(GAS f32x4*)(hio + (size_t)t * D + c) = hv;
        *(GAS unsigned long long*)(hb + (size_t)t * D + c) = (unsigned long long)pk2(hv.x, hv.y) | ((unsigned long long)pk2(hv.z, hv.w) << 32);
#pragma unroll
        for (int i = 0; i < 4; ++i) { const f32x4 w = *(const GAS f32x4*)(p.rg_w + (size_t)(c + i) * 4); const float hh = v[4 * j + i]; gl[0] += hh * w.x; gl[1] += hh * w.y; gl[2] += hh * w.z; gl[3] += hh * w.w; } }
#pragma unroll
    for (int e = 0; e < 4; ++e) gl[e] = wave_sum(gl[e]) + p.rg_b[e];
    int gi = 0; float gm = gl[0];
#pragma unroll
    for (int e = 1; e < 4; ++e) if (gl[e] > gm) { gm = gl[e]; gi = e; }
    float gden = 0.f;
#pragma unroll
    for (int e = 0; e < 4; ++e) gden += expf(gl[e] - gm);
    const float gval = 1.f / gden;
    float el[4] = {0.f, 0.f, 0.f, 0.f};
#pragma unroll
    for (int j = 0; j < 4; ++j)
#pragma unroll
        for (int i = 0; i < 4; ++i) { const int c = j * 256 + lane * 4 + i; const f32x4 w = *(const GAS f32x4*)(p.re_w + ((size_t)gi * D + c) * 4); const float hh = v[4 * j + i];
            el[0] += hh * w.x; el[1] += hh * w.y; el[2] += hh * w.z; el[3] += hh * w.w; }
#pragma unroll
    for (int e = 0; e < 4; ++e) el[e] = wave_sum(el[e]) + p.re_b[gi * 4 + e];
    int i1 = 0;
#pragma unroll
    for (int e = 1; e < 4; ++e) if (el[e] > el[i1]) i1 = e;
    int i2 = -1;
#pragma unroll
    for (int e = 0; e < 4; ++e) if (e != i1 && (i2 < 0 || el[e] > el[i2])) i2 = e;
    const float e1v = i1 == 0 ? el[0] : i1 == 1 ? el[1] : i1 == 2 ? el[2] : el[3];
    const float e2v = i2 == 0 ? el[0] : i2 == 1 ? el[1] : i2 == 2 ? el[2] : el[3];
    const float p2 = expf(e2v - e1v); const float w1 = gval / (1.f + p2), w2 = gval * p2 / (1.f + p2);
    const int lo = i1 < i2 ? i1 : i2, hi = i1 < i2 ? i2 : i1; const float wlo = i1 < i2 ? w1 : w2, whi = i1 < i2 ? w2 : w1;
    const int pairidx = lo == 0 ? (hi - 1) : (lo == 1 ? (hi + 1) : 5);
    const int cls = gi * 6 + pairidx;
    if (lane == 0) {
        const unsigned pos = __hip_atomic_fetch_add(cnt + cls, 1u, RLX_AGENT);
        perm[(size_t)cls * T + pos] = t;
        *(GAS f32x4*)(tokinfo + (size_t)t * 4) = (f32x4){__int_as_float(cls), __int_as_float((int)pos), wlo, whi};
    }
}
__device__ __forceinline__ void ln2_row(const P& p, int t, int lane) {
    float* io = p.out;
    f32x4 v[4]; float s = 0.f;
#pragma unroll
    for (int j = 0; j < 4; ++j) { v[j] = *(const GAS f32x4*)(io + (size_t)t * D + j * 256 + lane * 4); s += (v[j].x + v[j].y) + (v[j].z + v[j].w); }
    const float mu = wave_sum(s) * (1.f / D); float s2 = 0.f;
#pragma unroll
    for (int j = 0; j < 4; ++j) { v[j] = v[j] - mu; s2 += (v[j].x * v[j].x + v[j].y * v[j].y) + (v[j].z * v[j].z + v[j].w * v[j].w); }
    const float rstd = rsqrtf(wave_sum(s2) * (1.f / D) + LN_EPS);
#pragma unroll
    for (int j = 0; j < 4; ++j) { const int c = j * 256 + lane * 4; const f32x4 g2 = *(const GAS f32x4*)(p.ln2_g + c), b2 = *(const GAS f32x4*)(p.ln2_b + c);
        *(GAS f32x4*)(io + (size_t)t * D + c) = v[j] * rstd * g2 + b2; }
}

struct Args { P p; int ph_lo, ph_hi, li, pad; };
constexpr int N_PHASES = 2;
__global__ void __launch_bounds__(NWAVES * 64, 2) mega_fwd(Args args) {
    extern __shared__ __attribute__((aligned(16))) unsigned char lds[];
    Frame F;
    F.lds = (LAS unsigned char*)lds;
    F.MISC = (volatile LAS unsigned*)(F.lds + MISC_OFF);
    F.tid = threadIdx.x; F.lane = F.tid & 63; F.wave = __builtin_amdgcn_readfirstlane(F.tid >> 6);
    F.G = gridDim.x; { const int bx = blockIdx.x; F.vcu = (F.G % 8 == 0) ? (bx % 8) * (F.G / 8) + bx / 8 : bx; }
    const P& p = args.p;
    unsigned char* ws = p.ws;
    F.ctl = (gu32*)(ws + WS_CTL);
    for (int u = F.tid; u < (LDS_BYTES - LDSCTL_OFF) / 4; u += NWAVES * 64) ((LAS unsigned*)(F.lds + LDSCTL_OFF))[u] = 0u;
    __syncthreads();
    XcdBarrier bar = xcd_barrier_post((unsigned*)(F.ctl + CW_BAR) + args.li * XCD_BAR_WORDS, F.MISC + 8);
    const int lo = args.ph_lo, hi = args.ph_hi;
#define IN(k) (lo <= (k) && (k) < hi)
#define BOTH(k) (IN(k) && IN((k) + 1))
#define GRID_BAR() xcd_barrier(bar)
    if (IN(0)) { p0_prologue(F, p); if (BOTH(0)) GRID_BAR(); }
    if (IN(1)) {
        if (blockIdx.x < BATCH * NH) scanF_unit(F, p, blockIdx.x);
        pg8::PlainProb pr{(const bf16_t*)(ws + WS_XB), (const bf16_t*)(ws + WS_WIN), 1024, 1024, 16};
        pg8::StaticOrder S; S.init(T, 3072, F.G, (int)blockIdx.x);
        pg8::EpiInproj E{p.b_in, (bf16_t*)(ws + WS_Z), (bf16_t*)(ws + WS_XBC), (bf16_t*)(ws + WS_Q), (bf16_t*)(ws + WS_K), (bf16_t*)(ws + WS_V)};
        pg8::gemm_phase<pg8::PlainProb, pg8::StaticOrder, pg8::EpiInproj, true>(F.lds + RING_OFF, pr, S, E);
        if (BOTH(1)) GRID_BAR();
    }

    if (IN(2)) {
#pragma unroll 1
        for (int u = F.vcu; u < BATCH * ssd::NCH; u += F.G) { ssd::conv_chunk((const bf16_t*)(ws + WS_XBC), p.conv_w, p.conv_b, (bf16_t*)(ws + WS_XCB), u / ssd::NCH, u % ssd::NCH); VM_WAIT(); __syncthreads(); ssd::states_unit(F.lds + RING_OFF, (const bf16_t*)(ws + WS_XCB), (const float*)(ws + WS_DT), p.a_log, (bf16_t*)(ws + WS_S), (float*)(ws + WS_CDEC), u / ssd::NCH, u % ssd::NCH); }
        if (BOTH(2)) GRID_BAR();
    }
    if (IN(3)) {
#pragma unroll 1
        for (int u = F.vcu; u < BATCH * NH * 2; u += F.G) ssd::scan_unit((bf16_t*)(ws + WS_S), (const float*)(ws + WS_CDEC), u >> 1, u & 1);
        __syncthreads();
        const attn_body::AttnTensors AT{(const attn_body::bf16*)(ws + WS_Q), (const attn_body::bf16*)(ws + WS_K), (const attn_body::bf16*)(ws + WS_V), (const attn_body::bf16*)(ws + WS_KX), (attn_body::bf16*)(ws + WS_MERGED)};
        const attn_body::StaticOrder S((int)F.G, (int)blockIdx.x);
        attn_body::attn_phase<attn_body::StaticOrder>((char*)lds + RING_OFF, AT, S);
        if (BOTH(3)) GRID_BAR();
    }
    if (IN(4)) {
#pragma unroll 1
        for (int u = F.vcu; u < BATCH * ssd::NCH; u += F.G) ssd::out_unit(F.lds + RING_OFF, (const bf16_t*)(ws + WS_XCB), (const bf16_t*)(ws + WS_Z), (const float*)(ws + WS_DT), p.a_log, p.d_skip, p.ssd_norm_g,
                                                                          (const bf16_t*)(ws + WS_S), (bf16_t*)(ws + WS_MERGED), u / ssd::NCH, u % ssd::NCH);
        if (BOTH(4)) GRID_BAR();
    }
    if (IN(5)) {
        pg8::PlainProb pr{(const bf16_t*)(ws + WS_MERGED), (const bf16_t*)(ws + WS_WOUT), 1024, 1024, 16};
        pg8::StaticOrder S; S.init(T, 1024, F.G, (int)blockIdx.x);
        pg8::EpiOutproj E{p.x, p.out};
        pg8::gemm_phase<pg8::PlainProb, pg8::StaticOrder, pg8::EpiOutproj, true>(F.lds + RING_OFF, pr, S, E);
        if (BOTH(5)) GRID_BAR();
    }
    if (IN(6)) {
        const int gw = F.vcu * NWAVES + F.wave, NGW = F.G * NWAVES;
#pragma unroll 1
        for (int m = gw; m < T; m += NGW) ln1_router_row(p, m, F.lane, (bf16_t*)(ws + WS_HB), F.ctl + CW_CNT, (int*)(ws + WS_PERM), (float*)(ws + WS_TOK));
        if (BOTH(6)) GRID_BAR();
    }
    if (IN(7) || IN(8)) {
        LAS int* gt = (LAS int*)(F.lds + TAB_OFF);
        if (F.tid == 0) { int acc = 0; for (int c = 0; c < NCLS; ++c) { const int n = (int)__hip_atomic_load(F.ctl + CW_CNT + c, RLX_AGENT); gt[c] = acc; gt[32 + c] = n; acc += (n + 255) >> 8; } gt[24] = acc; }
        __syncthreads();
    }
    if (IN(7)) {
        const LAS int* gt = (const LAS int*)(F.lds + TAB_OFF);
        LAS unsigned* rofft = (LAS unsigned*)(F.lds + TAB_OFF + 256); LAS int* tokt = (LAS int*)(F.lds + TAB_OFF + 256 + 6144);
        pg8::MoeGeo geo{gt}; pg8::MoeOrder S{geo.np() * 8, 8, F.G, F.vcu};
        const int* perm = (const int*)(ws + WS_PERM);
        { pg8::Unit u; for (int i = 0; S.next(i, u); ++i) if (F.tid < 256) { const int c = geo.cls_of(u.pm); const int pos = (u.pm - gt[c]) * 256 + F.tid; const int tok = pos < gt[32 + c] ? perm[(size_t)c * T + pos] : -1;
            rofft[i * 256 + F.tid] = (unsigned)(tok < 0 ? 0 : tok) * 2048u; tokt[i * 256 + F.tid] = tok; } }
        __syncthreads();
        pg8::Moe1Prob pr{(const bf16_t*)(ws + WS_HB), (const bf16_t*)(ws + WS_WGU), geo, rofft, 1024, 1024, 16};
        pg8::EpiMoe1 E{(bf16_t*)(ws + WS_ACT), (const float*)(ws + WS_TOK), tokt};
        pg8::gemm_phase<pg8::Moe1Prob, pg8::MoeOrder, pg8::EpiMoe1, true>(F.lds + RING_OFF, pr, S, E);
        if (BOTH(7)) GRID_BAR();
    }
    if (IN(8)) {
        const LAS int* gt = (const LAS int*)(F.lds + TAB_OFF);
        LAS int* tokt = (LAS int*)(F.lds + TAB_OFF + 256 + 6144);
        pg8::MoeGeo geo{gt}; pg8::MoeOrder S{geo.np() * 4, 4, F.G, F.vcu};
        const int* perm = (const int*)(ws + WS_PERM);
        __syncthreads();
        { pg8::Unit u; for (int i = 0; S.next(i, u); ++i) if (F.tid < 256) { const int c = geo.cls_of(u.pm); const int pos = (u.pm - gt[c]) * 256 + F.tid; tokt[i * 256 + F.tid] = pos < gt[32 + c] ? perm[(size_t)c * T + pos] : -1; } }
        __syncthreads();
        pg8::Moe2Prob pr{(const bf16_t*)(ws + WS_ACT), (const bf16_t*)(ws + WS_WD), geo, 1024, 512, 16};
        pg8::EpiMoe2 E{p.out, tokt};
        pg8::gemm_phase<pg8::Moe2Prob, pg8::MoeOrder, pg8::EpiMoe2, true>(F.lds + RING_OFF, pr, S, E);
        if (BOTH(8)) GRID_BAR();
    }
    if (IN(9)) {
        const int gw = F.vcu * NWAVES + F.wave, NGW = F.G * NWAVES;
#pragma unroll 1
        for (int m = gw; m < T; m += NGW) ln2_row(p, m, F.lane);
    }
#undef IN
#undef BOTH
#undef GRID_BAR
}

static void launch_mega(const P& p, int lo, int hi, int li, hipStream_t stream) {
    Args a{}; a.p = p; a.ph_lo = lo; a.ph_hi = hi; a.li = li; a.pad = 0;
    hipLaunchKernelGGL(mega_fwd, dim3(256), dim3(NWAVES * 64), LDS_BYTES, stream, a);
}

extern "C" void kernel_launch(void* const* d_in, const int* in_sizes, int n_in, void* d_out, int out_size, void* d_ws, size_t ws_size, hipStream_t stream) {
    static int inited = 0;
    if (!inited) { (void)hipFuncSetAttribute((const void*)mega_fwd, hipFuncAttributeMaxDynamicSharedMemorySize, LDS_BYTES); inited = 1; }
    P p{};
    const float** ins = (const float**)&p;
    for (int i = 0; i < 20; ++i) ins[i] = (const float*)d_in[i];
    p.out = (float*)d_out; p.ws = (unsigned char*)d_ws;
    unsigned char* ws = p.ws;
    (void)hipMemsetAsync(ws + WS_CTL, 0, CTL_ZERO_BYTES, stream);
    unsigned* cnt = (unsigned*)(ws + WS_CTL) + CW_CNT;
    float* dt = (float*)(ws + WS_DT); float* F = (float*)(ws + WS_F);
    int* perm = (int*)(ws + WS_PERM); float* tokinfo = (float*)(ws + WS_TOK);
    float* yraw = (float*)(ws + WS_YRAW); bf16_t* z = (bf16_t*)(ws + WS_Z); bf16_t* xbc = (bf16_t*)(ws + WS_XBC); bf16_t* merged = (bf16_t*)(ws + WS_MERGED);
    bf16_t *q = (bf16_t*)(ws + WS_Q), *k = (bf16_t*)(ws + WS_K), *v = (bf16_t*)(ws + WS_V), *act = (bf16_t*)(ws + WS_ACT);
    float* xconv = (float*)(ws + WS_XCONV); bf16_t* hb = (bf16_t*)(ws + WS_HB);

    launch_mega(p, 0, 10, 0, stream);
}
```

```cpp
#include <hip/hip_runtime.h>
#include <hip/hip_bf16.h>
#include <stdint.h>
#include <cstdio>

typedef unsigned short bf16_t;
__device__ __forceinline__ float bf2f(bf16_t v) { return __uint_as_float(((unsigned)v) << 16); }
__device__ __forceinline__ bf16_t f2bf(float f) { unsigned u = __float_as_uint(f); return (bf16_t)((u + 0x7fffu + ((u >> 16) & 1u)) >> 16); }

constexpr int BATCH = 16, SEQ = 2048, T = BATCH * SEQ, D = 1024;
constexpr int NPROJ = 3088;
constexpr int NH = 8, HD = 64, NG = 2, NS = 128;
constexpr int NCLS = 24;
constexpr float ALPHA = 1.189207115002721f;
constexpr float LN_EPS = 1e-5f, RMS_EPS = 1e-5f;
constexpr float LOG2E = 1.4426950408889634f;
constexpr float C2 = 0.125f * LOG2E;

constexpr size_t MiB = 1u << 20;
constexpr size_t WS_CTL = 0, CTL_ZERO_BYTES = 1 * MiB;
constexpr size_t WS_WIN = 1 * MiB;
constexpr size_t WS_WOUT = 7 * MiB;
constexpr size_t WS_WGU = 9 * MiB;
constexpr size_t WS_WD = 41 * MiB;
constexpr size_t WS_DT = 58 * MiB;
constexpr size_t WS_LOGF = 59 * MiB;
constexpr size_t WS_F = 60 * MiB;
constexpr size_t WS_PERM = 61 * MiB;
constexpr size_t WS_TOK = 64 * MiB;
constexpr size_t WS_KX = 65 * MiB;
constexpr size_t WS_XB = 72 * MiB;
constexpr size_t WS_S = 72 * MiB;
constexpr size_t WS_CDEC = 69 * MiB;
constexpr size_t WS_XCB = 328 * MiB;
constexpr size_t WS_YRAW = 72 * MiB;
constexpr size_t WS_Z = 136 * MiB;
constexpr size_t WS_XBC = 168 * MiB;
constexpr size_t WS_HB = 136 * MiB;
constexpr size_t WS_Q = 232 * MiB, WS_K = 264 * MiB, WS_V = 296 * MiB;
constexpr size_t WS_ACT = 232 * MiB;
constexpr size_t WS_XCONV = 328 * MiB;
constexpr size_t WS_MERGED = 408 * MiB;
constexpr int CW_CNT = 1024;
constexpr int CW_TMO = 64, CW_CODE = 65;
constexpr int CW_BAR = 4096;

struct P {
    const float *x, *w_in, *b_in, *conv_w, *conv_b, *a_log, *d_skip, *ssd_norm_g, *w_out, *ln1_g, *ln1_b,
        *rg_w, *rg_b, *re_w, *re_b, *w_gate, *w_up, *w_down, *ln2_g, *ln2_b;
    float* out; unsigned char* ws;
};

__device__ __forceinline__ float softplus_f(float x) { return fmaxf(x, 0.f) + log1pf(expf(-fabsf(x))); }
__device__ __forceinline__ float silu_f(float x) { return x / (1.f + expf(-x)); }

template <int NB, class AL, class BL, class EP>
__global__ __launch_bounds__(256) void ngemm(AL al, BL bl, EP ep, int K) {
    __shared__ float As[16][68];
    __shared__ float Bs[NB][16][68];
    const int tm = blockIdx.y * 64, tn = blockIdx.x * 64;
    if (!al.tile_ok(tm)) return;
    const int tx = threadIdx.x & 15, ty = threadIdx.x >> 4;
    float acc[NB][4][4];
#pragma unroll
    for (int b = 0; b < NB; ++b)
#pragma unroll
        for (int i = 0; i < 4; ++i)
#pragma unroll
            for (int j = 0; j < 4; ++j) acc[b][i][j] = 0.f;
    for (int k0 = 0; k0 < K; k0 += 16) {
#pragma unroll
        for (int i = 0; i < 4; ++i) { const int idx = threadIdx.x + i * 256; const int r = idx >> 4, kk = idx & 15; As[kk][r] = al(tm + r, k0 + kk); }
#pragma unroll
        for (int b = 0; b < NB; ++b)
#pragma unroll
            for (int i = 0; i < 4; ++i) { const int idx = threadIdx.x + i * 256; const int kk = idx >> 6, n = idx & 63; Bs[b][kk][n] = bl(b, tm, k0 + kk, tn + n); }
        __syncthreads();
#pragma unroll
        for (int kk = 0; kk < 16; ++kk) {
            float a[4];
#pragma unroll
            for (int i = 0; i < 4; ++i) a[i] = As[kk][ty * 4 + i];
#pragma unroll
            for (int b = 0; b < NB; ++b) {
                float bb[4];
#pragma unroll
                for (int j = 0; j < 4; ++j) bb[j] = Bs[b][kk][tx * 4 + j];
#pragma unroll
                for (int i = 0; i < 4; ++i)
#pragma unroll
                    for (int j = 0; j < 4; ++j) acc[b][i][j] += a[i] * bb[j];
            }
        }
        __syncthreads();
    }
#pragma unroll
    for (int i = 0; i < 4; ++i)
#pragma unroll
        for (int j = 0; j < 4; ++j) {
            if (NB == 1) ep(tm + ty * 4 + i, tn + tx * 4 + j, acc[0][i][j], 0.f);
            else ep(tm + ty * 4 + i, tn + tx * 4 + j, acc[0][i][j], acc[NB - 1][i][j]);
        }
}

struct AL_x { const float* x; __device__ bool tile_ok(int) const { return true; } __device__ float operator()(int r, int k) const { return x[(size_t)r * D + k]; } };
struct BL_win { const float* w; __device__ float operator()(int, int, int k, int n) const { return n < NPROJ ? w[(size_t)k * NPROJ + n] : 0.f; } };
struct EP_inproj {
    const float* b_in; bf16_t *z, *xbc, *q, *k, *v; float *dt, *logf;
    __device__ void operator()(int r, int c, float v0, float) const {
        if (c >= NPROJ) return;
        const float val = v0 + b_in[c];
        if (c < 512) z[(size_t)r * 512 + c] = f2bf(val);
        else if (c < 1536) xbc[(size_t)r * 1024 + (c - 512)] = f2bf(val);
        else if (c < 1544) dt[(size_t)r * 8 + (c - 1536)] = softplus_f(val);
        else if (c < 2056) q[(size_t)r * 512 + (c - 1544)] = f2bf(val * C2);
        else if (c < 2568) k[(size_t)r * 512 + (c - 2056)] = f2bf(val);
        else if (c < 3080) v[(size_t)r * 512 + (c - 2568)] = f2bf(val);
        else logf[(size_t)r * 8 + (c - 3080)] = -softplus_f(-val);
    }
};

__global__ void k_conv(const bf16_t* xbc, const float* conv_w, const float* conv_b, float* xconv) {
    const size_t idx = (size_t)blockIdx.x * 256 + threadIdx.x;
    const int c = (int)(idx & 1023); const int t = (int)(idx >> 10); const int s = t & (SEQ - 1);
    float acc = conv_b[c];
#pragma unroll
    for (int k = 0; k < 4; ++k) { const int ss = s - 3 + k; if (ss >= 0) acc += conv_w[k * 1024 + c] * bf2f(xbc[(size_t)(t - 3 + k) * 1024 + c]); }
    xconv[idx] = silu_f(acc);
}

__global__ __launch_bounds__(64) void k_ssd(const float* xconv, const float* dt, const float* a_log, const float* d_skip, float* yraw) {
    __shared__ float Bs[16][128], Cs[16][128];
    const int b = blockIdx.x >> 3, h = blockIdx.x & 7, g = h >> 2, p = threadIdx.x;
    const float a = -expf(a_log[h]), dsk = d_skip[h];
    float st[128];
#pragma unroll
    for (int n = 0; n < 128; ++n) st[n] = 0.f;
    for (int t0 = 0; t0 < SEQ; t0 += 16) {
        __syncthreads();
        for (int i = p; i < 16 * 128; i += 64) { const int tt = i >> 7, n = i & 127; const size_t row = (size_t)(b * SEQ + t0 + tt) * 1024;
            Bs[tt][n] = xconv[row + 512 + g * 128 + n]; Cs[tt][n] = xconv[row + 768 + g * 128 + n]; }
        __syncthreads();
        for (int tt = 0; tt < 16; ++tt) {
            const size_t tok = (size_t)(b * SEQ + t0 + tt);
            const float xs = xconv[tok * 1024 + h * 64 + p], dtv = dt[tok * 8 + h];
            const float dA = expf(dtv * a), xdt = xs * dtv;
            float y = 0.f;
#pragma unroll
            for (int n = 0; n < 128; ++n) { st[n] = st[n] * dA + xdt * Bs[tt][n]; y += Cs[tt][n] * st[n]; }
            yraw[tok * 512 + h * 64 + p] = y + dsk * xs;
        }
    }
}

__global__ __launch_bounds__(256) void k_gatenorm(const float* yraw, const bf16_t* z, const float* norm_g, bf16_t* merged) {
    const int w = blockIdx.x * 4 + (threadIdx.x >> 6), lane = threadIdx.x & 63;
    const int t = w >> 1, g = w & 1;
    float v[4]; float ss = 0.f;
#pragma unroll
    for (int j = 0; j < 4; ++j) { const int c = g * 256 + lane * 4 + j; const float y = yraw[(size_t)t * 512 + c] * silu_f(bf2f(z[(size_t)t * 512 + c])); v[j] = y; ss += y * y; }
#pragma unroll
    for (int o = 1; o < 64; o <<= 1) ss += __shfl_xor(ss, o);
    const float r = rsqrtf(ss * (1.f / 256.f) + RMS_EPS);
#pragma unroll
    for (int j = 0; j < 4; ++j) { const int c = g * 256 + lane * 4 + j; merged[(size_t)t * 1024 + c] = f2bf(v[j] * r * norm_g[c]); }
}

__global__ void k_scanF(const float* logf, float* F) {
    const int i = blockIdx.x * 64 + threadIdx.x; if (i >= BATCH * NH) return;
    const int b = i >> 3, h = i & 7; float s = 0.f;
    for (int t = 0; t < SEQ; ++t) { const size_t o = (size_t)(b * SEQ + t) * 8 + h; s += logf[o]; F[o] = s; }
}

__global__ __launch_bounds__(64) void k_attn(const bf16_t* Q, const bf16_t* K, const bf16_t* V, const float* F, bf16_t* merged) {
    const int bh = blockIdx.y, b = bh >> 3, h = bh & 7; const int t = blockIdx.x * 64 + threadIdx.x;
    const size_t row = (size_t)(b * SEQ + t);
    float q[64], o[64];
#pragma unroll
    for (int d = 0; d < 64; ++d) { q[d] = bf2f(Q[row * 512 + h * 64 + d]); o[d] = 0.f; }
    const float Ft = F[row * 8 + h];
    float m = -INFINITY, l = 0.f;
    const int smax = blockIdx.x * 64 + 63;
    for (int s = 0; s <= smax; ++s) {
        const size_t kr = (size_t)(b * SEQ + s);
        const bf16_t* kp = K + kr * 512 + h * 64; const bf16_t* vp = V + kr * 512 + h * 64;
        float dot = 0.f;
#pragma unroll
        for (int d = 0; d < 64; ++d) dot += q[d] * bf2f(kp[d]);
        const float logit = dot + (Ft - F[kr * 8 + h]) * LOG2E;
        if (s <= t) {
            const float mn = fmaxf(m, logit), corr = exp2f(m - mn), pp = exp2f(logit - mn);
            l = l * corr + pp;
#pragma unroll
            for (int d = 0; d < 64; ++d) o[d] = o[d] * corr + pp * bf2f(vp[d]);
            m = mn;
        }
    }
    const float rl = 1.f / l;
#pragma unroll
    for (int d = 0; d < 64; ++d) merged[row * 1024 + 512 + h * 64 + d] = f2bf(o[d] * rl);
}

struct AL_bf { const bf16_t* a; int lda; int pad; __device__ bool tile_ok(int) const { return true; } __device__ float operator()(int r, int k) const { return bf2f(a[(size_t)r * lda + k]); } };
struct BL_plain { const float* w; int ldb; int pad; __device__ float operator()(int, int, int k, int n) const { return w[(size_t)k * ldb + n]; } };
struct EP_outproj { const float* x; float* out; __device__ void operator()(int r, int c, float v, float) const { out[(size_t)r * D + c] = ALPHA * x[(size_t)r * D + c] + v; } };

__device__ __forceinline__ float wsum(float v) {
#pragma unroll
    for (int o = 1; o < 64; o <<= 1) v += __shfl_xor(v, o);
    return v;
}
__global__ __launch_bounds__(256) void k_ln1_router(float* hio, const float* g1, const float* b1, const float* rg_w, const float* rg_b, const float* re_w, const float* re_b,
                                                    bf16_t* hb, unsigned* cnt, int* perm, float* tokinfo) {
    const int t = blockIdx.x * 4 + (threadIdx.x >> 6), lane = threadIdx.x & 63;
    float v[16]; float s = 0.f;
#pragma unroll
    for (int j = 0; j < 4; ++j) { const float4 u = *(const float4*)(hio + (size_t)t * D + j * 256 + lane * 4); v[4 * j] = u.x; v[4 * j + 1] = u.y; v[4 * j + 2] = u.z; v[4 * j + 3] = u.w; s += (u.x + u.y) + (u.z + u.w); }
    const float mu = wsum(s) * (1.f / D); float s2 = 0.f;
#pragma unroll
    for (int i = 0; i < 16; ++i) { v[i] -= mu; s2 += v[i] * v[i]; }
    const float rstd = rsqrtf(wsum(s2) * (1.f / D) + LN_EPS);
    float gl[4] = {0.f, 0.f, 0.f, 0.f};
#pragma unroll
    for (int j = 0; j < 4; ++j)
#pragma unroll
        for (int i = 0; i < 4; ++i) { const int c = j * 256 + lane * 4 + i; const float hv = v[4 * j + i] * rstd * g1[c] + b1[c]; v[4 * j + i] = hv;
            hio[(size_t)t * D + c] = hv; hb[(size_t)t * D + c] = f2bf(hv);
#pragma unroll
            for (int e = 0; e < 4; ++e) gl[e] += hv * rg_w[c * 4 + e]; }
#pragma unroll
    for (int e = 0; e < 4; ++e) gl[e] = wsum(gl[e]) + rg_b[e];
    int gi = 0; float gm = gl[0];
#pragma unroll
    for (int e = 1; e < 4; ++e) if (gl[e] > gm) { gm = gl[e]; gi = e; }
    float gden = 0.f;
#pragma unroll
    for (int e = 0; e < 4; ++e) gden += expf(gl[e] - gm);
    const float gval = 1.f / gden;
    float el[4] = {0.f, 0.f, 0.f, 0.f};
#pragma unroll
    for (int j = 0; j < 4; ++j)
#pragma unroll
        for (int i = 0; i < 4; ++i) { const int c = j * 256 + lane * 4 + i;
#pragma unroll
            for (int e = 0; e < 4; ++e) el[e] += v[4 * j + i] * re_w[((size_t)gi * D + c) * 4 + e]; }
#pragma unroll
    for (int e = 0; e < 4; ++e) el[e] = wsum(el[e]) + re_b[gi * 4 + e];
    int i1 = 0;
#pragma unroll
    for (int e = 1; e < 4; ++e) if (el[e] > el[i1]) i1 = e;
    int i2 = -1;
#pragma unroll
    for (int e = 0; e < 4; ++e) if (e != i1 && (i2 < 0 || el[e] > el[i2])) i2 = e;
    const float mx = el[i1]; const float p2 = expf(el[i2] - mx); const float w1 = gval / (1.f + p2), w2 = gval * p2 / (1.f + p2);
    const int lo = i1 < i2 ? i1 : i2, hi = i1 < i2 ? i2 : i1; const float wlo = i1 < i2 ? w1 : w2, whi = i1 < i2 ? w2 : w1;
    const int pairidx = lo == 0 ? (hi - 1) : (lo == 1 ? (hi + 1) : 5);
    const int cls = gi * 6 + pairidx;
    if (lane == 0) {
        const unsigned pos = atomicAdd(&cnt[cls], 1u);
        perm[(size_t)cls * T + pos] = t;
        tokinfo[(size_t)t * 4 + 0] = __int_as_float(cls); tokinfo[(size_t)t * 4 + 1] = __int_as_float((int)pos); tokinfo[(size_t)t * 4 + 2] = wlo; tokinfo[(size_t)t * 4 + 3] = whi;
    }
}

struct ClsGeo { const unsigned* cnt;
    __device__ bool find(int row, int& cls, int& pos, int& n) const {
        int off = 0;
        for (int c = 0; c < NCLS; ++c) { const int nc = (int)cnt[c], pc = (nc + 255) & ~255; if (row < off + pc) { cls = c; pos = row - off; n = nc; return true; } off += pc; }
        return false;
    }
};
__device__ __forceinline__ void cls_experts(int cls, int& ea, int& eb) { const int g = cls / 6, pi = cls % 6; const int lo = pi < 3 ? 0 : (pi < 5 ? 1 : 2); const int hi = pi < 3 ? pi + 1 : (pi < 5 ? pi - 1 : 3); ea = g * 4 + lo; eb = g * 4 + hi; }

struct AL_moe1 { const bf16_t* hb; const int* perm; ClsGeo geo;
    __device__ bool tile_ok(int tm) const { int c, p, n; if (!geo.find(tm, c, p, n)) return false; return p < n; }
    __device__ float operator()(int r, int k) const { int c, p, n; if (!geo.find(r, c, p, n) || p >= n) return 0.f; const int tok = perm[(size_t)c * T + p]; return bf2f(hb[(size_t)tok * D + k]); } };
struct BL_moe1 { const float *wg, *wu; ClsGeo geo;
    __device__ float operator()(int b, int tm, int k, int n) const { int c, p, nn; geo.find(tm, c, p, nn); int ea, eb; cls_experts(c, ea, eb); const int e = n < 512 ? ea : eb; const int col = n & 511;
        const float* w = b == 0 ? wg : wu; return w[((size_t)e * D + k) * 512 + col]; } };
struct EP_moe1 { bf16_t* act; const int* perm; const float* tokinfo; ClsGeo geo;
    __device__ void operator()(int r, int c, float g, float u) const { int cl, p, n; float w = 0.f; if (geo.find(r, cl, p, n) && p < n) { const int tok = perm[(size_t)cl * T + p]; w = tokinfo[(size_t)tok * 4 + (c < 512 ? 2 : 3)]; }
        act[(size_t)r * 1024 + c] = f2bf(silu_f(g) * u * w); } };
struct AL_moe2 { const bf16_t* act; ClsGeo geo;
    __device__ bool tile_ok(int tm) const { int c, p, n; if (!geo.find(tm, c, p, n)) return false; return p < n; }
    __device__ float operator()(int r, int k) const { return bf2f(act[(size_t)r * 1024 + k]); } };
struct BL_moe2 { const float* wd; ClsGeo geo;
    __device__ float operator()(int, int tm, int k, int n) const { int c, p, nn; geo.find(tm, c, p, nn); int ea, eb; cls_experts(c, ea, eb); const int e = k < 512 ? ea : eb; return wd[((size_t)e * 512 + (k & 511)) * D + n]; } };
struct EP_moe2 { float* out; const int* perm; ClsGeo geo;
    __device__ void operator()(int r, int c, float v, float) const { int cl, p, n; if (!geo.find(r, cl, p, n) || p >= n) return; const int tok = perm[(size_t)cl * T + p]; float* o = out + (size_t)tok * D + c; *o = ALPHA * (*o) + v; } };

__global__ __launch_bounds__(256) void k_ln2(float* io, const float* g2, const float* b2) {
    const int t = blockIdx.x * 4 + (threadIdx.x >> 6), lane = threadIdx.x & 63;
    float v[16]; float s = 0.f;
#pragma unroll
    for (int j = 0; j < 4; ++j) { const float4 u = *(const float4*)(io + (size_t)t * D + j * 256 + lane * 4); v[4 * j] = u.x; v[4 * j + 1] = u.y; v[4 * j + 2] = u.z; v[4 * j + 3] = u.w; s += (u.x + u.y) + (u.z + u.w); }
    const float mu = wsum(s) * (1.f / D); float s2 = 0.f;
#pragma unroll
    for (int i = 0; i < 16; ++i) { v[i] -= mu; s2 += v[i] * v[i]; }
    const float rstd = rsqrtf(wsum(s2) * (1.f / D) + LN_EPS);
#pragma unroll
    for (int j = 0; j < 4; ++j) { float4 o; const int c = j * 256 + lane * 4;
        o.x = v[4 * j] * rstd * g2[c] + b2[c]; o.y = v[4 * j + 1] * rstd * g2[c + 1] + b2[c + 1]; o.z = v[4 * j + 2] * rstd * g2[c + 2] + b2[c + 2]; o.w = v[4 * j + 3] * rstd * g2[c + 3] + b2[c + 3];
        *(float4*)(io + (size_t)t * D + c) = o; }
}

namespace pg8 {
#define PG8_LAS __attribute__((address_space(3)))
typedef short bf16x8 __attribute__((ext_vector_type(8)));
typedef float f32x4 __attribute__((ext_vector_type(4)));
typedef float f32x2 __attribute__((ext_vector_type(2)));
typedef unsigned u32x4 __attribute__((ext_vector_type(4)));
typedef unsigned u32x2 __attribute__((ext_vector_type(2)));
constexpr int BM = 256, BK = 64, HALF = 128, HTB = HALF * BK * 2, STAGE_BYTES = 8 * HTB, NXCD = 8, WGM = 8;
__host__ __device__ __forceinline__ int lds_byte(int r, int c) { const int st = (r >> 4) * 2 + (c >> 5), rr = r & 15, cc = c & 31, ob = rr * 64 + cc * 2; return st * 1024 + (ob ^ (((ob >> 9) & 1) << 5)); }
__host__ __device__ __forceinline__ void stage_rc(int b, int& R, int& C) { const int st = b / 1024, sb = b % 1024, swz = sb ^ (((sb >> 9) & 1) << 5); R = (st >> 1) * 16 + swz / 64; C = (st & 1) * 32 + (swz % 64) / 2; }
__host__ __device__ __forceinline__ int perm32(int rho) { const int n = rho >> 4, i = rho & 15; return 8 * (i >> 2) + 4 * n + (i & 3); }
__device__ __forceinline__ unsigned cvt_pk_bf16(float lo, float hi) { unsigned r; asm volatile("v_cvt_pk_bf16_f32 %0, %1, %2" : "=v"(r) : "v"(lo), "v"(hi)); return r; }

struct Unit { int pm, pn; };
struct StaticOrder {
    int nM, nN, nwg, G, c;
    __device__ void init(int M, int N, int G_, int c_) { nM = M / BM; nN = N / BM; nwg = nM * nN; G = G_; c = c_; }
    __device__ bool next(int i, Unit& u) const {
        const long L = (long)i * G + c; if (L >= nwg) return false;
        int wgid = (int)L; { const int q = nwg / NXCD, r = nwg % NXCD, xcd = wgid % NXCD, off = wgid / NXCD; wgid = (xcd < r ? xcd * (q + 1) : r * (q + 1) + (xcd - r) * q) + off; }
        const int nig = WGM * nN, gid = wgid / nig, fm = gid * WGM, gsz = (nM - fm) < WGM ? (nM - fm) : WGM;
        u.pm = fm + ((wgid % nig) % gsz); u.pn = (wgid % nig) / gsz; return true;
    }
};
struct PlainProb {
    static constexpr bool GATHER = false;
    const bf16_t* A; const bf16_t* Bt; int lda, ldb, nt;
    __device__ __forceinline__ const char* a_base(const Unit& u) const { return (const char*)(A + (size_t)u.pm * BM * lda); }
    __device__ __forceinline__ void b_base(const Unit& u, const char*& b0, const char*& b1) const { b0 = (const char*)(Bt + (size_t)u.pn * BM * ldb); b1 = b0; }
    __device__ __forceinline__ int ksplit() const { return nt; }
    __device__ __forceinline__ unsigned rowoff(int, int) const { return 0u; }
};

template <class PR, class Sched, class Epi, bool ALIGN_EPI>
__device__ __forceinline__ void gemm_phase(PG8_LAS unsigned char* lds, const PR& pr, const Sched& S, const Epi& E) {
    const int tid = threadIdx.x, wid = __builtin_amdgcn_readfirstlane(tid >> 6), lane = tid & 63, wr = wid >> 2, wc = wid & 3, fr = lane & 15, fq = lane >> 4;
    const int nt = pr.nt, ksp = pr.ksplit();
    unsigned voffA[2][2], nvA[2][2], voffB[2]; int RA[2], CA[2];
#pragma unroll
    for (int i = 0; i < 2; ++i) { int R, C; stage_rc(tid * 16 + i * 8192, R, C); const int Rb = Epi::PERM ? ((R & ~31) + perm32(R & 31)) : R;
        RA[i] = R; CA[i] = C; voffB[i] = (unsigned)(Rb * pr.ldb + C) * 2u; }
    const size_t kstep = (size_t)(BK * 2);
    const size_t hstepB = (size_t)HALF * pr.ldb * 2;
    const unsigned ldsw = (unsigned)wid * 1024u;
    const int aoff = lds_byte(wr * 64 + fr, fq * 8), boff = lds_byte(wc * 32 + fr, fq * 8);
#define PG8_SA(b, h) (((b) * 2 + (h)) * HTB)
#define PG8_SB(b, h) ((4 + (b) * 2 + (h)) * HTB)
#define PG8_STAGE(bufoff, gbase, voff) do { _Pragma("unroll") for (int _i = 0; _i < 2; ++_i) \
        __builtin_amdgcn_global_load_lds((const unsigned*)((const char*)(gbase) + (voff)[_i]), (PG8_LAS unsigned*)(lds + (bufoff) + ldsw + _i * 8192), 16, 0, 0); } while (0)
#define PG8_LDA(dst, b, h) do { _Pragma("unroll") for (int m = 0; m < 4; ++m) _Pragma("unroll") for (int k = 0; k < 2; ++k) dst[m][k] = *(const PG8_LAS bf16x8*)(lds + PG8_SA(b, h) + aoff + m * 2048 + k * 1024); } while (0)
#define PG8_LDB(dst, b, h) do { _Pragma("unroll") for (int n = 0; n < 2; ++n) _Pragma("unroll") for (int k = 0; k < 2; ++k) dst[n][k] = *(const PG8_LAS bf16x8*)(lds + PG8_SB(b, h) + boff + n * 2048 + k * 1024); } while (0)
#define PG8_MMA(ai, bj, At, Bt) do { __builtin_amdgcn_s_setprio(1); _Pragma("unroll") for (int m = 0; m < 4; ++m) _Pragma("unroll") for (int n = 0; n < 2; ++n) _Pragma("unroll") for (int k = 0; k < 2; ++k) \
        acc[ai][bj][m][n] = __builtin_amdgcn_mfma_f32_16x16x32_bf16(Bt[n][k], At[m][k], acc[ai][bj][m][n], 0, 0, 0); __builtin_amdgcn_s_setprio(0); } while (0)
#define PG8_WAIT_V(n) asm volatile("s_waitcnt vmcnt(" #n ")" ::: "memory")
#define PG8_WAIT_L(n) asm volatile("s_waitcnt lgkmcnt(" #n ")" ::: "memory")
#define PG8_BAR __builtin_amdgcn_s_barrier()
#define PG8_SCHED __builtin_amdgcn_sched_barrier(0)
#define PG8_SETVA(dst, slot) do { _Pragma("unroll") for (int _h = 0; _h < 2; ++_h) _Pragma("unroll") for (int _i = 0; _i < 2; ++_i) \
        dst[_h][_i] = PR::GATHER ? (pr.rowoff((slot), _h * HALF + RA[_i]) + (unsigned)CA[_i] * 2u) : (unsigned)((_h * HALF + RA[_i]) * pr.lda + CA[_i]) * 2u; } while (0)
    Unit cur, nxt; int ui = 0;
    if (!S.next(0, cur)) return;
    f32x4 acc[2][2][4][2];
#pragma unroll
    for (int a = 0; a < 2; ++a)
#pragma unroll
        for (int b = 0; b < 2; ++b)
#pragma unroll
            for (int m = 0; m < 4; ++m)
#pragma unroll
                for (int n = 0; n < 2; ++n) acc[a][b][m][n] = (f32x4){0.f, 0.f, 0.f, 0.f};
    bf16x8 At[4][2], B0[2][2], B1[2][2];
    PG8_SETVA(voffA, 0);
    const char* cA = pr.a_base(cur); const char *cB0, *cB1; pr.b_base(cur, cB0, cB1);
    PG8_STAGE(PG8_SB(0, 0), cB0, voffB); PG8_STAGE(PG8_SB(0, 1), cB0 + hstepB, voffB); PG8_STAGE(PG8_SA(0, 0), cA, voffA[0]); PG8_STAGE(PG8_SA(0, 1), cA, voffA[1]);
    if (wr == 1) PG8_BAR;
    PG8_WAIT_V(2); PG8_BAR;
    PG8_STAGE(PG8_SB(1, 0), cB0 + kstep, voffB); PG8_STAGE(PG8_SA(1, 0), cA + kstep, voffA[0]); PG8_STAGE(PG8_SB(1, 1), cB0 + hstepB + kstep, voffB);
    PG8_WAIT_V(6); PG8_BAR;
    for (;;) {
        const bool has_next = S.next(ui + 1, nxt);
        const char *nA = cA, *nB0 = cB0, *nB1 = cB1;
        if (has_next) { nA = pr.a_base(nxt); pr.b_base(nxt, nB0, nB1); }
        if (PR::GATHER) { if (has_next) { PG8_SETVA(nvA, ui + 1); } else {
#pragma unroll
            for (int h = 0; h < 2; ++h)
#pragma unroll
                for (int i = 0; i < 2; ++i) nvA[h][i] = voffA[h][i]; } }
        for (int t = 0; t < nt; t += 2) {
            const bool last = (t == nt - 2);
            const char* a1 = cA + (size_t)(t + 1) * kstep;
            const char* a2 = last ? nA : cA + (size_t)(t + 2) * kstep;
            const char* b2 = last ? nB0 : ((t + 2 < ksp) ? cB0 + (size_t)(t + 2) * kstep : cB1 + (size_t)(t + 2 - ksp) * kstep);
            const char* a3 = a2 + kstep; const char* b3 = b2 + kstep;
            unsigned va2[2][2];
#pragma unroll
            for (int h = 0; h < 2; ++h)
#pragma unroll
                for (int i = 0; i < 2; ++i) va2[h][i] = (PR::GATHER && last) ? nvA[h][i] : voffA[h][i];
            PG8_LDB(B0, 0, 0); PG8_LDB(B1, 0, 1); PG8_SCHED; PG8_LDA(At, 0, 0); PG8_STAGE(PG8_SA(1, 1), a1, voffA[1]);
            PG8_WAIT_V(8); PG8_WAIT_L(0); PG8_BAR; PG8_MMA(0, 0, At, B0); PG8_MMA(0, 1, At, B1); PG8_BAR; PG8_SCHED;
            PG8_LDA(At, 0, 1); PG8_STAGE(PG8_SB(0, 0), b2, voffB); PG8_STAGE(PG8_SB(0, 1), b2 + hstepB, voffB); PG8_STAGE(PG8_SA(0, 0), a2, va2[0]);
            PG8_WAIT_V(8); PG8_WAIT_L(0); PG8_BAR; PG8_MMA(1, 0, At, B0); PG8_MMA(1, 1, At, B1); PG8_BAR; PG8_SCHED;
            PG8_LDB(B0, 1, 0); PG8_LDB(B1, 1, 1); PG8_SCHED; PG8_LDA(At, 1, 0); PG8_STAGE(PG8_SA(0, 1), a2, va2[1]);
            PG8_WAIT_V(8); PG8_WAIT_L(0); PG8_BAR; PG8_MMA(0, 0, At, B0); PG8_MMA(0, 1, At, B1); PG8_BAR; PG8_SCHED;
            PG8_LDA(At, 1, 1); PG8_STAGE(PG8_SB(1, 0), b3, voffB); PG8_STAGE(PG8_SB(1, 1), b3 + hstepB, voffB); PG8_STAGE(PG8_SA(1, 0), a3, va2[0]);
            PG8_WAIT_V(8); PG8_WAIT_L(0); PG8_BAR; PG8_MMA(1, 0, At, B0); PG8_MMA(1, 1, At, B1); PG8_BAR; PG8_SCHED;
        }
        if constexpr (ALIGN_EPI) { if (wr == 0) PG8_BAR; }
        if constexpr (!Epi::AFTER_DRAIN) { E(acc, cur, ui, wr, wc, fr, fq); }
        if (!has_next) break;
#pragma unroll
        for (int a = 0; a < 2; ++a)
#pragma unroll
            for (int b = 0; b < 2; ++b)
#pragma unroll
                for (int m = 0; m < 4; ++m)
#pragma unroll
                    for (int n = 0; n < 2; ++n) acc[a][b][m][n] = (f32x4){0.f, 0.f, 0.f, 0.f};
        cur = nxt; cA = nA; cB0 = nB0; cB1 = nB1; ++ui;
        if (PR::GATHER) {
#pragma unroll
            for (int h = 0; h < 2; ++h)
#pragma unroll
                for (int i = 0; i < 2; ++i) voffA[h][i] = nvA[h][i]; }
        if constexpr (ALIGN_EPI) { if (wr == 1) PG8_BAR; }
    }
    PG8_WAIT_V(0);
    if constexpr (!ALIGN_EPI) { if (wr == 0) PG8_BAR; }
    PG8_BAR;
    if constexpr (Epi::AFTER_DRAIN) { E.fused(acc, cur, ui, wr, wc, fr, fq, lds, wid, lane); }
#undef PG8_SA
#undef PG8_SB
#undef PG8_STAGE
#undef PG8_LDA
#undef PG8_LDB
#undef PG8_MMA
#undef PG8_WAIT_V
#undef PG8_WAIT_L
#undef PG8_BAR
#undef PG8_SCHED
#undef PG8_SETVA
}

struct EpiInproj {
    static constexpr bool PERM = true, AFTER_DRAIN = false;
    const float* b_in; bf16_t *z, *xbc, *q, *k, *v;
    __device__ __forceinline__ void operator()(const f32x4 (&acc)[2][2][4][2], const Unit& u, int, int wr, int wc, int fr, int fq) const {
        const int pn = u.pn; bf16_t* base; int ldc, colt; float sc = 1.f;
        if (pn < 2) { base = z; ldc = 512; colt = pn * 256; }
        else if (pn < 6) { base = xbc; ldc = 1024; colt = (pn - 2) * 256; }
        else if (pn < 8) { base = q; ldc = 512; colt = (pn - 6) * 256; sc = C2; }
        else if (pn < 10) { base = k; ldc = 512; colt = (pn - 8) * 256; }
        else { base = v; ldc = 512; colt = (pn - 10) * 256; }
        const int row0 = u.pm * BM + wr * 64 + fr;
        const int col0 = colt + wc * 32 + 8 * fq, bcol0 = pn * BM + (pn >= 6 ? 8 : 0) + wc * 32 + 8 * fq;
        f32x4 bv[2][2];
#pragma unroll
        for (int bj = 0; bj < 2; ++bj)
#pragma unroll
            for (int n = 0; n < 2; ++n) bv[bj][n] = *(const f32x4*)(b_in + bcol0 + bj * HALF + 4 * n);
#pragma unroll
        for (int ai = 0; ai < 2; ++ai)
#pragma unroll
            for (int m = 0; m < 4; ++m) { bf16_t* rowp = base + (size_t)(row0 + ai * HALF + m * 16) * ldc + col0;
#pragma unroll
                for (int bj = 0; bj < 2; ++bj) { f32x4 v0 = (acc[ai][bj][m][0] + bv[bj][0]) * sc, v1 = (acc[ai][bj][m][1] + bv[bj][1]) * sc;
                    u32x4 w; w.x = cvt_pk_bf16(v0[0], v0[1]); w.y = cvt_pk_bf16(v0[2], v0[3]); w.z = cvt_pk_bf16(v1[0], v1[1]); w.w = cvt_pk_bf16(v1[2], v1[3]);
                    *(u32x4*)(rowp + bj * HALF) = w; } }
    }
};

struct EpiOutproj {
    static constexpr bool PERM = false, AFTER_DRAIN = false;
    const float* x; float* out;
    __device__ __forceinline__ void operator()(const f32x4 (&acc)[2][2][4][2], const Unit& u, int, int wr, int wc, int fr, int fq) const {
        const int col0 = u.pn * BM + wc * 32 + 4 * fq;
#pragma unroll
        for (int ai = 0; ai < 2; ++ai)
#pragma unroll
            for (int m = 0; m < 4; ++m) { const size_t off = (size_t)(u.pm * BM + ai * HALF + wr * 64 + m * 16 + fr) * D + col0;
#pragma unroll
                for (int bj = 0; bj < 2; ++bj)
#pragma unroll
                    for (int n = 0; n < 2; ++n) { const f32x4 xv = *(const f32x4*)(x + off + bj * HALF + n * 16); *(f32x4*)(out + off + bj * HALF + n * 16) = xv * ALPHA + acc[ai][bj][m][n]; } }
    }
};

struct MoeGeo {
    const PG8_LAS int* tab;
    __device__ __forceinline__ int np() const { return tab[24]; }
    __device__ __forceinline__ int cls_of(int panel) const { int c = 0;
#pragma unroll 1
        for (int j = 1; j < 24; ++j) if (panel >= tab[j]) c = j;
        return c; }
};
struct MoeOrder {
    int total, npn, G, c;
    __device__ __forceinline__ bool next(int i, Unit& u) const { const int L = i * G + c; if (L >= total) return false; u.pm = L / npn; u.pn = L % npn; return true; }
};
struct Moe1Prob {
    static constexpr bool GATHER = true;
    const bf16_t* A; const bf16_t* Wgu; MoeGeo geo; const PG8_LAS unsigned* rofftab; int lda, ldb, nt;
    __device__ __forceinline__ const char* a_base(const Unit&) const { return (const char*)A; }
    __device__ __forceinline__ void b_base(const Unit& u, const char*& b0, const char*& b1) const { int ea, eb; cls_experts(geo.cls_of(u.pm), ea, eb); const int e = u.pn < 4 ? ea : eb;
        b0 = (const char*)(Wgu + (size_t)((e * 4 + (u.pn & 3)) * 256) * 1024); b1 = b0; }
    __device__ __forceinline__ int ksplit() const { return nt; }
    __device__ __forceinline__ unsigned rowoff(int slot, int r) const { return rofftab[slot * 256 + r]; }
};
__device__ __forceinline__ float silu_fast(float g) { return g * __builtin_amdgcn_rcpf(1.f + __builtin_amdgcn_exp2f(-g * LOG2E)); }
struct EpiMoe1 {
    static constexpr bool PERM = true, AFTER_DRAIN = false;
    bf16_t* act; const float* tokinfo; const PG8_LAS int* toktab;
    __device__ __forceinline__ void operator()(const f32x4 (&acc)[2][2][4][2], const Unit& u, int slot, int wr, int wc, int fr, int fq) const {
        const int ex = u.pn >> 2; const int col0 = ex * 512 + (u.pn & 3) * 128 + wc * 32 + 8 * fq;
#pragma unroll
        for (int ai = 0; ai < 2; ++ai)
#pragma unroll
            for (int m = 0; m < 4; ++m) { const int r = ai * HALF + wr * 64 + m * 16 + fr; const int tok = toktab[slot * 256 + r];
                const float w = tok >= 0 ? tokinfo[(size_t)tok * 4 + 2 + ex] : 0.f;
                const f32x4 g0 = acc[ai][0][m][0], g1 = acc[ai][0][m][1], u0 = acc[ai][1][m][0], u1 = acc[ai][1][m][1];
                float o[8];
#pragma unroll
                for (int j = 0; j < 4; ++j) { o[j] = silu_fast(g0[j]) * u0[j] * w; o[4 + j] = silu_fast(g1[j]) * u1[j] * w; }
                u32x4 wv; wv.x = cvt_pk_bf16(o[0], o[1]); wv.y = cvt_pk_bf16(o[2], o[3]); wv.z = cvt_pk_bf16(o[4], o[5]); wv.w = cvt_pk_bf16(o[6], o[7]);
                *(u32x4*)(act + (size_t)(u.pm * BM + r) * 1024 + col0) = wv; }
    }
};
struct Moe2Prob {
    static constexpr bool GATHER = false;
    const bf16_t* A; const bf16_t* Wd; MoeGeo geo; int lda, ldb, nt;
    __device__ __forceinline__ const char* a_base(const Unit& u) const { return (const char*)(A + (size_t)u.pm * BM * lda); }
    __device__ __forceinline__ void b_base(const Unit& u, const char*& b0, const char*& b1) const { int ea, eb; cls_experts(geo.cls_of(u.pm), ea, eb);
        b0 = (const char*)(Wd + ((size_t)ea * 1024 + u.pn * 256) * 512); b1 = (const char*)(Wd + ((size_t)eb * 1024 + u.pn * 256) * 512); }
    __device__ __forceinline__ int ksplit() const { return 8; }
    __device__ __forceinline__ unsigned rowoff(int, int) const { return 0u; }
};
struct EpiMoe2 {
    static constexpr bool PERM = false, AFTER_DRAIN = false;
    float* out; const PG8_LAS int* toktab;
    __device__ __forceinline__ void operator()(const f32x4 (&acc)[2][2][4][2], const Unit& u, int slot, int wr, int wc, int fr, int fq) const {
        const int col0 = u.pn * BM + wc * 32 + 4 * fq;
#pragma unroll
        for (int ai = 0; ai < 2; ++ai)
#pragma unroll
            for (int m = 0; m < 4; ++m) { const int r = ai * HALF + wr * 64 + m * 16 + fr; const int tok = toktab[slot * 256 + r];
                if (tok >= 0) { float* o = out + (size_t)tok * D + col0;
#pragma unroll
                    for (int bj = 0; bj < 2; ++bj)
#pragma unroll
                        for (int n = 0; n < 2; ++n) { const f32x4 hv = *(const f32x4*)(o + bj * HALF + n * 16); *(f32x4*)(o + bj * HALF + n * 16) = hv * ALPHA + acc[ai][bj][m][n]; } } }
    }
};
}

#include <cmath>
namespace attn_body {

using bf16=__hip_bfloat16;
#define ALAS __attribute__((address_space(3)))
using bf16x8=__attribute__((ext_vector_type(8)))short;
using s16x4=__attribute__((ext_vector_type(4)))short;
using f32x16=__attribute__((ext_vector_type(16)))float;
using u32x4=__attribute__((ext_vector_type(4)))unsigned;
constexpr int BATCH=16,NHEAD=8,SEQ=2048,D=64,DM=NHEAD*D,ODM=1024,OCOL=512;
constexpr int NW=8,QBLK=32,QB=QBLK*NW,KVBLK=64,NQB=SEQ/QB;
constexpr int ATTN_PITCH=DM, ATTN_UNIT_ROWS=QB;
__device__ __forceinline__ int crow(int r,int hi){return (r&3)+8*(r>>2)+4*hi;}
#define SBAR() __builtin_amdgcn_sched_barrier(0)
__device__ __forceinline__ void cmask(f32x16&p0,f32x16&p1,int jb,int qrel,int hi){
  const float NEG=-INFINITY; int kb=64*jb+4*hi;
  #pragma unroll
  for(int r=0;r<16;++r){int kv=kb+(r&3)+8*(r>>2); if(kv>qrel)p0[r]=NEG; if(kv+32>qrel)p1[r]=NEG;}
}

constexpr int NSLOT=3, SLOTB=9216, KXOFF=8192;
constexpr int LDS_K=0, LDS_V=NSLOT*SLOTB, LDS_WS=2*NSLOT*SLOTB, LDS_OST=LDS_WS+NW*64*4, LDS_BYTES=LDS_OST+NW*4096;
constexpr float C2=0.125f*1.4426950408889634f;
__device__ __forceinline__ void glds16(const void*gsrc,unsigned lds_dst){unsigned keep;
  asm volatile("s_mov_b32 %0, m0\n\ts_mov_b32 m0, %2\n\ts_nop 0\n\tglobal_load_lds_dwordx4 %1, off\n\ts_mov_b32 m0, %0":"=&s"(keep):"v"(gsrc),"s"(lds_dst):"memory");}
__device__ __forceinline__ float max3f(float a,float b,float c){float r;asm("v_max3_f32 %0, %1, %2, %3":"=v"(r):"v"(a),"v"(b),"v"(c));return r;}
__device__ __forceinline__ float max2f(float a,float b){float r;asm("v_max_f32_e32 %0, %1, %2":"=v"(r):"v"(a),"v"(b));return r;}
__device__ __forceinline__ float fadd_s(float a,float b){float r;asm("v_add_f32_e32 %0, %1, %2":"=v"(r):"v"(a),"v"(b));return r;}
__device__ __forceinline__ float fsub_s(float a,float b){float r;asm("v_sub_f32_e32 %0, %1, %2":"=v"(r):"v"(a),"v"(b));return r;}
typedef float f32x2_t __attribute__((ext_vector_type(2))); typedef __bf16 bf16x2_t __attribute__((ext_vector_type(2)));
__device__ __forceinline__ unsigned cvtpk_s(float lo,float hi){f32x2_t v={lo,hi};bf16x2_t b=__builtin_convertvector(v,bf16x2_t);return __builtin_bit_cast(unsigned,b);}
#define WAIT_BAR(N) asm volatile("s_waitcnt vmcnt(" #N ") lgkmcnt(0)\n\ts_barrier":::"memory")
#define WAIT_BARK(N,N0) do{ if(wid==0){WAIT_BAR(N0);} else {WAIT_BAR(N);} }while(0)

__device__ __forceinline__ void qkt(f32x16&p0,f32x16&p1,const char*Kslot,const bf16x8*qr,const bf16x8 qr4,const f32x16&negm,int r32,int hi){
  const char*kb=Kslot+hi*1024+r32*16;
  #pragma unroll
  for(int d0=0;d0<4;++d0){
    const bf16x8 b0=*reinterpret_cast<const bf16x8*>(kb+d0*2048);
    const bf16x8 b1=*reinterpret_cast<const bf16x8*>(kb+d0*2048+512);
    if(d0==0){p0=__builtin_amdgcn_mfma_f32_32x32x16_bf16(b0,qr[0],negm,0,0,0);p1=__builtin_amdgcn_mfma_f32_32x32x16_bf16(b1,qr[0],negm,0,0,0);}
    else{p0=__builtin_amdgcn_mfma_f32_32x32x16_bf16(b0,qr[d0],p0,0,0,0);p1=__builtin_amdgcn_mfma_f32_32x32x16_bf16(b1,qr[d0],p1,0,0,0);}}
  { const bf16x8 x0=*reinterpret_cast<const bf16x8*>(Kslot+KXOFF+r32*16); const bf16x8 x1=*reinterpret_cast<const bf16x8*>(Kslot+KXOFF+r32*16+512);
    p0=__builtin_amdgcn_mfma_f32_32x32x16_bf16(x0,qr4,p0,0,0,0);p1=__builtin_amdgcn_mfma_f32_32x32x16_bf16(x1,qr4,p1,0,0,0); }
}
typedef __attribute__((address_space(3))) const char* lds_cptr;
typedef short v4i16_t __attribute__((ext_vector_type(4)));
__device__ __forceinline__ void kload8(bf16x8*kf,lds_cptr kp){
  kf[0]=*(const __attribute__((address_space(3))) bf16x8*)(kp);      kf[1]=*(const __attribute__((address_space(3))) bf16x8*)(kp+512);
  kf[2]=*(const __attribute__((address_space(3))) bf16x8*)(kp+2048); kf[3]=*(const __attribute__((address_space(3))) bf16x8*)(kp+2560);
  kf[4]=*(const __attribute__((address_space(3))) bf16x8*)(kp+4096); kf[5]=*(const __attribute__((address_space(3))) bf16x8*)(kp+4608);
  kf[6]=*(const __attribute__((address_space(3))) bf16x8*)(kp+6144); kf[7]=*(const __attribute__((address_space(3))) bf16x8*)(kp+6656);
}
__device__ __forceinline__ void kload2(bf16x8*kf,lds_cptr kp,int j){ kf[2*j]=*(const __attribute__((address_space(3))) bf16x8*)(kp+j*2048); kf[2*j+1]=*(const __attribute__((address_space(3))) bf16x8*)(kp+j*2048+512); }
__device__ __forceinline__ s16x4 vtr(lds_cptr p){ return __builtin_bit_cast(s16x4,__builtin_amdgcn_ds_read_tr16_b64_v4i16((__attribute__((address_space(3))) v4i16_t*)p)); }
__device__ __forceinline__ float rowmax(const f32x16&p0,const f32x16&p1){
  float a=max3f(p0[0],p0[1],p1[0]),b=max3f(p0[2],p0[3],p1[1]);a=max3f(a,p1[2],p1[3]);
  #pragma unroll
  for(int r=4;r<16;r+=4){a=max3f(a,p0[r],p0[r+1]);b=max3f(b,p0[r+2],p0[r+3]);a=max3f(a,p1[r],p1[r+1]);b=max3f(b,p1[r+2],p1[r+3]);}
  const float m=max2f(a,b);
  auto rr=__builtin_amdgcn_permlane32_swap(__float_as_uint(m),__float_as_uint(m),false,false);
  return max2f(__uint_as_float(rr[0]),__uint_as_float(rr[1]));
}
__device__ __forceinline__ void pv(f32x16*o,int vb,bf16x8 pa0,bf16x8 pa1,bf16x8 pa2,bf16x8 pa3){
  #pragma unroll
  for(int d0=0;d0<2;++d0){s16x4 lo[4],hi[4];
    #pragma unroll
    for(int ks=0;ks<4;++ks){
      asm volatile("ds_read_b64_tr_b16 %0,%1 offset:%c2":"=&v"(lo[ks]):"v"(vb),"i"(d0*4096+ks*1024):"memory");
      asm volatile("ds_read_b64_tr_b16 %0,%1 offset:%c2":"=&v"(hi[ks]):"v"(vb),"i"(d0*4096+ks*1024+512):"memory");}
    asm volatile("s_waitcnt lgkmcnt(0)":::"memory");SBAR();
    #define PK(k) (bf16x8){lo[k][0],lo[k][1],lo[k][2],lo[k][3],hi[k][0],hi[k][1],hi[k][2],hi[k][3]}
    o[d0]=__builtin_amdgcn_mfma_f32_32x32x16_bf16(pa0,PK(0),o[d0],0,0,0);
    o[d0]=__builtin_amdgcn_mfma_f32_32x32x16_bf16(pa1,PK(1),o[d0],0,0,0);
    o[d0]=__builtin_amdgcn_mfma_f32_32x32x16_bf16(pa2,PK(2),o[d0],0,0,0);
    o[d0]=__builtin_amdgcn_mfma_f32_32x32x16_bf16(pa3,PK(3),o[d0],0,0,0);
    #undef PK
  }
}

#ifndef ATTN_STORE16
#define ATTN_STORE16(p,v) (*(u32x4*)(p)=(v))
#endif
template<int THRL> __device__ __forceinline__ void attn_unit(int b,int h,int qb,const bf16*Q,const bf16*__restrict__ K,const bf16*__restrict__ V,const bf16*__restrict__ KX,bf16*O,char*shm){
  const int tid=threadIdx.x,lane=tid&63,r32=lane&31,hi=lane>>5; const int wid=__builtin_amdgcn_readfirstlane(tid>>6);
  const long rowbase=(long)b*SEQ; const int q0=qb*QB;
  const bf16*Qw=Q+(rowbase+q0+wid*QBLK)*DM+h*D;
  const bf16*Kh=K+rowbase*DM+h*D,*Vh=V+rowbase*DM+h*D;
  const unsigned lds0=(unsigned)(uintptr_t)shm;
  float*wsf=(float*)(shm+LDS_WS)+wid*64;
  const bf16*ksrc=Kh+(long)lane*DM+wid*8;
  const bf16*vsrc=Vh+(long)(16*(wid&3)+(lane>>2))*DM+(wid>>2)*32+(lane&3)*8;
  const unsigned kdst=lds0+LDS_K+wid*1024, vdst=lds0+LDS_V+wid*1024, kxdst=lds0+LDS_K+KXOFF;
  const bf16*kxsrc=KX+((rowbase+lane)*NHEAD+h)*8;
  #define DMA_K(t,slot) do{ glds16(ksrc+(long)(t)*KVBLK*DM,(unsigned)__builtin_amdgcn_readfirstlane(kdst+(slot))); if(wid==0) glds16(kxsrc+(long)(t)*KVBLK*NHEAD*8,(unsigned)__builtin_amdgcn_readfirstlane(kxdst+(slot))); }while(0)
  #define DMA_V(t,slot) glds16(vsrc+(long)(t)*KVBLK*DM,(unsigned)__builtin_amdgcn_readfirstlane(vdst+(slot)))
  const int vb0=(int)(lds0+LDS_V)+((lane>>4)&1)*32+(lane&3)*8+(4*hi+((lane&15)>>2))*64;
  const char*Kbase=shm+LDS_K; bf16x8 kf[8]; bf16x8 kx0,kx1;
  const lds_cptr shm3=(lds_cptr)shm; const lds_cptr kxp0=shm3+LDS_K+KXOFF+r32*16; const lds_cptr kp0=shm3+LDS_K+hi*1024+r32*16; const lds_cptr vp0=shm3+LDS_V+((lane>>4)&1)*32+(lane&3)*8+(4*hi+((lane&15)>>2))*64;
  const int NT=(q0+QB)/KVBLK;
  DMA_K(0,0);DMA_V(0,0);DMA_K(1,SLOTB);
  bf16x8 qr[4]; bf16x8 qr4={0,0,0,0,0,0,0,0}; if(hi==0){qr4[0]=(short)0x3F80;qr4[1]=(short)0x3F80;qr4[2]=(short)0x3F80;}
  #pragma unroll
  for(int d0=0;d0<4;++d0)qr[d0]=*reinterpret_cast<const bf16x8*>(&Qw[(long)r32*DM+d0*16+hi*8]);
  float mhat=0.f,l_reg=0.f;f32x16 o[2];o[0]=f32x16{};o[1]=f32x16{};f32x16 negm=f32x16{};asm volatile("":"+v"(negm));
  const int qrel=wid*QBLK+r32;
  #define CMASK(P0,P1,t) do{int jb_=(t)-(NT-4); if(jb_>=0)cmask(P0,P1,jb_,qrel,hi);}while(0)
  bool resc=false;
  #define START(P0,P1) do{ const float rm=rowmax(P0,P1); resc=false; \
    { const float dl=rm; mhat=fadd_s(mhat,dl); \
      _Pragma("unroll") for(int r=0;r<16;++r){P0[r]=fsub_s(P0[r],dl);P1[r]=fsub_s(P1[r],dl);} \
      _Pragma("unroll") for(int r=0;r<16;++r)negm[r]=-mhat; asm volatile("":"+v"(negm)); } \
    _Pragma("unroll") for(int r=0;r<16;++r)P0[r]=__builtin_amdgcn_exp2f(P0[r]); }while(0)
  #define RESC() do{ if(resc){ asm volatile("s_waitcnt lgkmcnt(0)":::"memory"); \
      _Pragma("unroll") for(int d_=0;d_<2;++d_) _Pragma("unroll") for(int r=0;r<16;++r)o[d_][r]*=wsf[crow(r,hi)]; } }while(0)
  f32x16 pA0,pA1,pB0,pB1;
  int sl_prev=0,sl_cur=0,sl_next=SLOTB;
  #define ROT() do{sl_prev=sl_cur;sl_cur=sl_next;sl_next=(sl_next==(NSLOT-1)*SLOTB)?0:sl_next+SLOTB;}while(0)
  DMA_K(2,2*SLOTB);
  WAIT_BARK(3,5);
  qkt(pA0,pA1,Kbase,qr,qr4,negm,r32,hi);asm volatile("s_nop 15\n\ts_nop 7":"+v"(pA0),"+v"(pA1));CMASK(pA0,pA1,0);
  START(pA0,pA1);
  _Pragma("unroll") for(int r=0;r<16;++r)pA1[r]=__builtin_amdgcn_exp2f(pA1[r]);
  WAIT_BAR(0);
  DMA_K(3,0);DMA_V(1,SLOTB);
  ROT();
  kload8(kf,kp0+sl_cur); kx0=*(const ALAS bf16x8*)(kxp0+sl_cur); kx1=*(const ALAS bf16x8*)(kxp0+sl_cur+512);
  WAIT_BARK(2,3);
  s16x4 vlo[8],vhi[8]; u32x4 pw0,pw1,pw2,pw3;
  #define PKW(P,B) cvtpk_s(P[B],P[B+1])
  #define PAF(k) __builtin_bit_cast(bf16x8,pw##k)
  #define VFR(i) (bf16x8){vlo[i][0],vlo[i][1],vlo[i][2],vlo[i][3],vhi[i][0],vhi[i][1],vhi[i][2],vhi[i][3]}
  #define PIN(x) asm volatile("":"+v"(x))
  #define MX3(a,b,c) __builtin_fmaxf(__builtin_fmaxf((a),(b)),(c))
  #define GAPA(MF,A0,A1,A2,A3,W0,W1,PW) do{ MF; sacc+=A0; sacc+=A1; sacc+=A2; sacc+=A3; PIN(sacc); W0; W1; PIN(PW); SBAR(); }while(0)
  #define EX(v) __builtin_amdgcn_exp2f(v)
  #define GAPB(MF,X,B) do{ MF; X[B]=EX(X[B]); X[B+1]=EX(X[B+1]); X[B+2]=EX(X[B+2]); X[B+3]=EX(X[B+3]); PIN(X); SBAR(); }while(0)
  #define VRD(i) do{ vlo[i]=vtr(vp_+(((i)>>2)*4096+((i)&3)*1024)); vhi[i]=vtr(vp_+(((i)>>2)*4096+((i)&3)*1024+512)); }while(0)
  #define KRD(G,j) do{ if(G){ kload2(kf,kp0+sl_next,j); SBAR(); } }while(0)
  #define STEP(C0,C1,P0,P1,t,GK,GV,GL) do{ SBAR(); \
    const lds_cptr vp_=vp0+sl_prev; \
    VRD(0); SBAR(); float sacc=(P0[0]+P0[1]); \
    GAPA(C0=__builtin_amdgcn_mfma_f32_32x32x16_bf16(kf[0],qr[0],negm,0,0,0), P0[2],P0[3],P0[4],P0[5],     pw0[0]=PKW(P0,0), pw0[1]=PKW(P0,2), pw0); \
    VRD(4); SBAR(); GAPA(C1=__builtin_amdgcn_mfma_f32_32x32x16_bf16(kf[1],qr[0],negm,0,0,0), P0[6],P0[7],P0[8],P0[9],     pw0[2]=PKW(P0,4), pw0[3]=PKW(P0,6), pw0); \
    VRD(1); SBAR(); GAPA(C0=__builtin_amdgcn_mfma_f32_32x32x16_bf16(kf[2],qr[1],C0,0,0,0),   P0[10],P0[11],P0[12],P0[13], pw1[0]=PKW(P0,8), pw1[1]=PKW(P0,10), pw1); \
    VRD(5); SBAR(); GAPA(C1=__builtin_amdgcn_mfma_f32_32x32x16_bf16(kf[3],qr[1],C1,0,0,0),   P0[14],P0[15],P1[0],P1[1],   pw1[2]=PKW(P0,12),pw1[3]=PKW(P0,14), pw1); \
    VRD(2); SBAR(); GAPA(C0=__builtin_amdgcn_mfma_f32_32x32x16_bf16(kf[4],qr[2],C0,0,0,0),   P1[2],P1[3],P1[4],P1[5],     pw2[0]=PKW(P1,0), pw2[1]=PKW(P1,2), pw2); \
    VRD(6); SBAR(); GAPA(C1=__builtin_amdgcn_mfma_f32_32x32x16_bf16(kf[5],qr[2],C1,0,0,0),   P1[6],P1[7],P1[8],P1[9],     pw2[2]=PKW(P1,4), pw2[3]=PKW(P1,6), pw2); \
    VRD(3); SBAR(); GAPA(C0=__builtin_amdgcn_mfma_f32_32x32x16_bf16(kf[6],qr[3],C0,0,0,0),   P1[10],P1[11],P1[12],P1[13], pw3[0]=PKW(P1,8), pw3[1]=PKW(P1,10), pw3); \
    VRD(7); SBAR(); GAPA(C1=__builtin_amdgcn_mfma_f32_32x32x16_bf16(kf[7],qr[3],C1,0,0,0),   P1[14],P1[15],0.f,0.f,       pw3[2]=PKW(P1,12),pw3[3]=PKW(P1,14), pw3); \
    C0=__builtin_amdgcn_mfma_f32_32x32x16_bf16(kx0,qr4,C0,0,0,0); C1=__builtin_amdgcn_mfma_f32_32x32x16_bf16(kx1,qr4,C1,0,0,0); SBAR(); \
    l_reg+=sacc; \
    if(GK){DMA_K((t)+3,sl_cur);} if(GV){DMA_V((t)+1,sl_next);} \
    CMASK(C0,C1,t); \
    { float a=MX3(C0[0],C0[1],C1[0]),b=MX3(C0[2],C0[3],C1[1]); a=MX3(a,C1[2],C1[3]); \
      _Pragma("unroll") for(int r=4;r<16;r+=4){a=MX3(a,C0[r],C0[r+1]);b=MX3(b,C0[r+2],C0[r+3]);a=MX3(a,C1[r],C1[r+1]);b=MX3(b,C1[r+2],C1[r+3]);} \
      float rm=__builtin_fmaxf(a,b); { auto rr=__builtin_amdgcn_permlane32_swap(__float_as_uint(rm),__float_as_uint(rm),false,false); rm=__builtin_fmaxf(__uint_as_float(rr[0]),__uint_as_float(rr[1])); } \
      resc=false; \
      if(__builtin_expect(__any(rm>(float)THRL),0)){ const float dl=__builtin_fmaxf(rm,0.f); mhat+=dl; \
        _Pragma("unroll") for(int r=0;r<16;++r){C0[r]-=dl;C1[r]-=dl;} \
        _Pragma("unroll") for(int r=0;r<16;++r)negm[r]=-mhat; asm volatile("":"+v"(negm)); \
        const float f=__builtin_amdgcn_exp2f(-dl); l_reg*=f; if(hi==0)wsf[r32]=f; resc=true; } } \
    SBAR(); \
    GAPB(o[0]=__builtin_amdgcn_mfma_f32_32x32x16_bf16(PAF(0),VFR(0),o[0],0,0,0), C0,0); \
    GAPB(o[1]=__builtin_amdgcn_mfma_f32_32x32x16_bf16(PAF(0),VFR(4),o[1],0,0,0), C0,4); \
    KRD(GL,0); GAPB(o[0]=__builtin_amdgcn_mfma_f32_32x32x16_bf16(PAF(1),VFR(1),o[0],0,0,0), C0,8); \
    KRD(GL,1); GAPB(o[1]=__builtin_amdgcn_mfma_f32_32x32x16_bf16(PAF(1),VFR(5),o[1],0,0,0), C0,12); \
    KRD(GL,2); GAPB(o[0]=__builtin_amdgcn_mfma_f32_32x32x16_bf16(PAF(2),VFR(2),o[0],0,0,0), C1,0); \
    KRD(GL,3); GAPB(o[1]=__builtin_amdgcn_mfma_f32_32x32x16_bf16(PAF(2),VFR(6),o[1],0,0,0), C1,4); \
    if(GL){ kx0=*(const ALAS bf16x8*)(kxp0+sl_next); kx1=*(const ALAS bf16x8*)(kxp0+sl_next+512); SBAR(); } \
    GAPB(o[0]=__builtin_amdgcn_mfma_f32_32x32x16_bf16(PAF(3),VFR(3),o[0],0,0,0), C1,8); \
    GAPB(o[1]=__builtin_amdgcn_mfma_f32_32x32x16_bf16(PAF(3),VFR(7),o[1],0,0,0), C1,12); \
    }while(0)
  int t=1;
  #undef CMASK
  #define CMASK(P0,P1,t) do{}while(0)
  for(;t+5<NT;t+=2){
    STEP(pB0,pB1,pA0,pA1,t,true,true,true);     WAIT_BARK(2,3); RESC(); ROT();
    STEP(pA0,pA1,pB0,pB1,t+1,true,true,true);   WAIT_BARK(2,3); RESC(); ROT();
  }
  #undef CMASK
  #define CMASK(P0,P1,t) do{int jb_=(t)-(NT-4); if(jb_>=0)cmask(P0,P1,jb_,qrel,hi);}while(0)
  #define ENDW(tt) do{ if((tt)+3<NT){WAIT_BARK(2,3);} else if((tt)+2<NT){WAIT_BAR(1);} else {WAIT_BAR(0);} }while(0)
  for(;t+1<NT;t+=2){
    STEP(pB0,pB1,pA0,pA1,t,(t+3<NT),(t+1<NT),(t+1<NT));       ENDW(t);   RESC(); ROT();
    STEP(pA0,pA1,pB0,pB1,t+1,(t+4<NT),(t+2<NT),(t+2<NT));     ENDW(t+1); RESC(); ROT();
  }
  STEP(pB0,pB1,pA0,pA1,NT-1,false,false,false); RESC();
  { float sacc=pB0[0]+pB0[1]; _Pragma("unroll") for(int r=2;r<16;++r)sacc+=pB0[r]; _Pragma("unroll") for(int r=0;r<16;++r)sacc+=pB1[r]; l_reg+=sacc;
    pw0=(u32x4){PKW(pB0,0),PKW(pB0,2),PKW(pB0,4),PKW(pB0,6)};pw1=(u32x4){PKW(pB0,8),PKW(pB0,10),PKW(pB0,12),PKW(pB0,14)};pw2=(u32x4){PKW(pB1,0),PKW(pB1,2),PKW(pB1,4),PKW(pB1,6)};pw3=(u32x4){PKW(pB1,8),PKW(pB1,10),PKW(pB1,12),PKW(pB1,14)};
    SBAR(); pv(o,vb0+sl_cur,PAF(0),PAF(1),PAF(2),PAF(3)); }
  #undef PKW
  #undef PAF
  #undef VFR
  #undef PIN
  #undef MX3
  #undef GAPA
  #undef GAPB
  #undef EX
  #undef VRD
  #undef KRD
  #undef STEP
  #undef ENDW
  {auto rr=__builtin_amdgcn_permlane32_swap(__float_as_uint(l_reg),__float_as_uint(l_reg),false,false);l_reg=__uint_as_float(rr[0])+__uint_as_float(rr[1]);}
  if(hi==0)wsf[32+r32]=l_reg;asm volatile("s_waitcnt lgkmcnt(0)":::"memory");
  float rli[16];
  #pragma unroll
  for(int r=0;r<16;++r)rli[r]=__builtin_amdgcn_rcpf(wsf[32+crow(r,hi)]);
  bf16*Ow=O+(rowbase+q0+wid*QBLK)*ODM+OCOL+h*D;
  { bf16*stg=(bf16*)(shm+LDS_OST)+wid*2048;
    #pragma unroll
    for(int r=0;r<16;++r){const int orow=crow(r,hi);
      #pragma unroll
      for(int d0=0;d0<2;++d0)stg[orow*64+d0*32+r32]=__float2bfloat16(o[d0][r]*rli[r]);}
    asm volatile("s_waitcnt lgkmcnt(0)":::"memory");
    #pragma unroll
    for(int i=0;i<4;++i){const int row=i*8+(lane>>3),ch=lane&7; const u32x4 v=*(const u32x4*)(stg+row*64+ch*8); ATTN_STORE16(Ow+(long)row*ODM+ch*8,v);} }
  asm volatile("s_waitcnt lgkmcnt(0)\n\ts_barrier":::"memory");
  #undef DMA_K
  #undef DMA_V
  #undef CMASK
  #undef START
  #undef RESC
  #undef ROT
}
constexpr int ATTN_LDS_BYTES=LDS_BYTES;
struct AttnTensors { const bf16* Q; const bf16* K; const bf16* V; const bf16* KX; bf16* O; };
struct AttnUnit { int bh; int qb; };
struct StaticOrder {
  int vcu;
  __device__ __forceinline__ explicit StaticOrder(int grid,int block):vcu((block%8)*(grid/8)+block/8){}
  __device__ __forceinline__ bool next(int i,AttnUnit&u)const{ if(i>=4)return false; const int s=vcu&1; u.bh=vcu>>1; u.qb=(i==0)?(7-s):(i==1)?s:(i==2)?(5-s):(2+s); return true; }
  __device__ __forceinline__ void a_ready(const AttnUnit&)const{}
  __device__ __forceinline__ void done(const AttnUnit&)const{}
};
template<class Sched,int THRL=8> __device__ __forceinline__ void attn_phase(char*lds,const AttnTensors&T,const Sched&S){
  AttnUnit u;
  for(int i=0;S.next(i,u);++i){ S.a_ready(u); attn_unit<THRL>(u.bh/NHEAD,u.bh%NHEAD,u.qb,T.Q,T.K,T.V,T.KX,T.O,lds); S.done(u); }
}
#undef SBAR
#undef WAIT_BAR
}

namespace ssd {
typedef short bf16x8 __attribute__((ext_vector_type(8)));
typedef float f32x4 __attribute__((ext_vector_type(4)));
typedef unsigned u32x4 __attribute__((ext_vector_type(4)));
typedef unsigned u32x2 __attribute__((ext_vector_type(2)));
#define SLAS __attribute__((address_space(3)))
constexpr int LPB = 144;
constexpr int NPB = 272;
constexpr int NCH = SEQ / 64;
__device__ __forceinline__ unsigned pkbf(float lo, float hi) { return (unsigned)f2bf(lo) | ((unsigned)f2bf(hi) << 16); }

__device__ __forceinline__ float chunk_acum(const float* dt, const float* a_log, int tok0, int h, int lane, float& dtv) {
    dtv = dt[(size_t)(tok0 + lane) * 8 + h];
    float A = dtv * (-expf(a_log[h]));
#pragma unroll
    for (int o = 1; o < 64; o <<= 1) { const float y = __shfl_up(A, o); if (lane >= o) A += y; }
    return A;
}


__device__ __forceinline__ void conv_chunk(const bf16_t* xbc, const float* cw, const float* cb, bf16_t* xcb, int b, int c) {
    const int tid = threadIdx.x, cg = tid & 127, rq = tid >> 7, ch0 = cg * 8, l0 = rq * 16;
    const size_t tok0 = (size_t)b * SEQ + c * 64;
    float w[4][8], bias[8];
#pragma unroll
    for (int k = 0; k < 4; ++k) { const f32x4 a = *(const f32x4*)(cw + k * 1024 + ch0), bq = *(const f32x4*)(cw + k * 1024 + ch0 + 4);
        w[k][0] = a[0]; w[k][1] = a[1]; w[k][2] = a[2]; w[k][3] = a[3]; w[k][4] = bq[0]; w[k][5] = bq[1]; w[k][6] = bq[2]; w[k][7] = bq[3]; }
    { const f32x4 a = *(const f32x4*)(cb + ch0), bq = *(const f32x4*)(cb + ch0 + 4); bias[0] = a[0]; bias[1] = a[1]; bias[2] = a[2]; bias[3] = a[3]; bias[4] = bq[0]; bias[5] = bq[1]; bias[6] = bq[2]; bias[7] = bq[3]; }
    float win[3][8];
#pragma unroll
    for (int k = 0; k < 3; ++k) { const int l = l0 - 3 + k; u32x4 v = (u32x4){0u, 0u, 0u, 0u};
        if (c * 64 + l >= 0) v = *(const u32x4*)(xbc + (tok0 + l) * 1024 + ch0);
#pragma unroll
        for (int j = 0; j < 4; ++j) { win[k][2 * j] = __uint_as_float(v[j] << 16); win[k][2 * j + 1] = __uint_as_float(v[j] & 0xffff0000u); } }
#pragma unroll
    for (int i = 0; i < 16; ++i) {
        const u32x4 v = *(const u32x4*)(xbc + (tok0 + l0 + i) * 1024 + ch0);
        float cur[8], o[8];
#pragma unroll
        for (int j = 0; j < 4; ++j) { cur[2 * j] = __uint_as_float(v[j] << 16); cur[2 * j + 1] = __uint_as_float(v[j] & 0xffff0000u); }
#pragma unroll
        for (int j = 0; j < 8; ++j) { const float a = bias[j] + w[0][j] * win[0][j] + w[1][j] * win[1][j] + w[2][j] * win[2][j] + w[3][j] * cur[j]; o[j] = a / (1.f + expf(-a)); }
        *(u32x4*)(xcb + (tok0 + l0 + i) * 1024 + ch0) = (u32x4){pkbf(o[0], o[1]), pkbf(o[2], o[3]), pkbf(o[4], o[5]), pkbf(o[6], o[7])};
#pragma unroll
        for (int j = 0; j < 8; ++j) { win[0][j] = win[1][j]; win[1][j] = win[2][j]; win[2][j] = cur[j]; }
    }
}


__device__ __forceinline__ void conv8(const bf16_t* xbc, const float* cw, const float* cb, size_t tok0, int c, int col, int l0, float (&out)[8][8]) {
    float w[4][8], bias[8];
#pragma unroll
    for (int k = 0; k < 4; ++k) { const f32x4 a = *(const f32x4*)(cw + k * 1024 + col), bq = *(const f32x4*)(cw + k * 1024 + col + 4);
        w[k][0] = a[0]; w[k][1] = a[1]; w[k][2] = a[2]; w[k][3] = a[3]; w[k][4] = bq[0]; w[k][5] = bq[1]; w[k][6] = bq[2]; w[k][7] = bq[3]; }
    { const f32x4 a = *(const f32x4*)(cb + col), bq = *(const f32x4*)(cb + col + 4); bias[0] = a[0]; bias[1] = a[1]; bias[2] = a[2]; bias[3] = a[3]; bias[4] = bq[0]; bias[5] = bq[1]; bias[6] = bq[2]; bias[7] = bq[3]; }
    u32x4 raw[11];
#pragma unroll
    for (int k = 0; k < 11; ++k) { const int l = l0 - 3 + k; raw[k] = (u32x4){0u, 0u, 0u, 0u}; if (c * 64 + l >= 0) raw[k] = *(const u32x4*)(xbc + (tok0 + l) * 1024 + col); }
#pragma unroll
    for (int i = 0; i < 8; ++i)
#pragma unroll
        for (int j = 0; j < 8; ++j) { float a = bias[j];
#pragma unroll
            for (int k = 0; k < 4; ++k) { const unsigned wv = raw[i + k][j >> 1]; a += w[k][j] * ((j & 1) ? __uint_as_float(wv & 0xffff0000u) : __uint_as_float(wv << 16)); }
            out[i][j] = a * __builtin_amdgcn_rcpf(1.f + __builtin_amdgcn_exp2f(-a * LOG2E)); }
}

__device__ __forceinline__ void states_unit(SLAS unsigned char* lds, const bf16_t* xbc, const float* cw, const float* cb, const float* dt, const float* a_log, bf16_t* S, float* cdec, int b, int c) {
    const int tid = threadIdx.x, lane = tid & 63, w = __builtin_amdgcn_readfirstlane(tid >> 6), r = lane & 15, q = lane >> 4;
    const int tok0 = b * SEQ + c * 64;
    SLAS float* warr = (SLAS float*)lds;
    SLAS unsigned char* BT = lds + 2048;
    SLAS unsigned char* XW = lds + 2048 + 128 * LPB;
    { float dtv; const float A = chunk_acum(dt, a_log, tok0, w, lane, dtv); const float A63 = __shfl(A, 63);
      warr[w * 64 + lane] = dtv * expf(A63 - A);
      if (lane == 63) cdec[(size_t)(b * NCH + c) * 8 + w] = expf(A63); }
    __syncthreads();
#pragma unroll 1
    for (int g = 0; g < 2; ++g) {
        if (lane < 48) {
            const bool isx = lane < 32; const int col = isx ? g * 256 + lane * 8 : 512 + g * 128 + (lane - 32) * 8; const int l0 = 8 * w;
            float o[8][8]; conv8(xbc, cw, cb, (size_t)tok0, c, col, l0, o);
            if (isx) { const int hh = lane >> 3;
#pragma unroll
                for (int i = 0; i < 8; ++i) { const float sc = warr[(g * 4 + hh) * 64 + l0 + i];
#pragma unroll
                    for (int j = 0; j < 8; ++j) o[i][j] *= sc; } }
            SLAS unsigned char* dstb = isx ? (XW + (lane * 8) * LPB) : (BT + ((lane - 32) * 8) * LPB);
#pragma unroll
            for (int j = 0; j < 8; ++j) *(SLAS u32x4*)(dstb + j * LPB + l0 * 2) = (u32x4){pkbf(o[0][j], o[1][j]), pkbf(o[2][j], o[3][j]), pkbf(o[4][j], o[5][j]), pkbf(o[6][j], o[7][j])};
        }
        __syncthreads();
        f32x4 acc[8][2];
#pragma unroll
        for (int nt = 0; nt < 8; ++nt) { acc[nt][0] = (f32x4){0.f, 0.f, 0.f, 0.f}; acc[nt][1] = (f32x4){0.f, 0.f, 0.f, 0.f}; }
#pragma unroll
        for (int k = 0; k < 2; ++k) {
            bf16x8 xf[2];
#pragma unroll
            for (int ht = 0; ht < 2; ++ht) xf[ht] = *(const SLAS bf16x8*)(XW + (32 * w + 16 * ht + r) * LPB + (32 * k + 8 * q) * 2);
#pragma unroll
            for (int nt = 0; nt < 8; ++nt) { const bf16x8 bf = *(const SLAS bf16x8*)(BT + (16 * nt + r) * LPB + (32 * k + 8 * q) * 2);
#pragma unroll
                for (int ht = 0; ht < 2; ++ht) acc[nt][ht] = __builtin_amdgcn_mfma_f32_16x16x32_bf16(bf, xf[ht], acc[nt][ht], 0, 0, 0); }
        }
        const int h = g * 4 + (w >> 1);
#pragma unroll
        for (int ht = 0; ht < 2; ++ht) { const int p = (w & 1) * 32 + 16 * ht + r; bf16_t* dst = S + ((size_t)((b * NCH + c) * 8 + h) * 64 + p) * 128 + 4 * q;
#pragma unroll
            for (int nt = 0; nt < 8; ++nt) *(u32x2*)(dst + 16 * nt) = (u32x2){pkbf(acc[nt][ht][0], acc[nt][ht][1]), pkbf(acc[nt][ht][2], acc[nt][ht][3])}; }
        __syncthreads();
    }
}

__device__ __forceinline__ void scan_unit(bf16_t* S, const float* cdec, int bh, int half) {
    const int tid = threadIdx.x, b = bh >> 3, h = bh & 7;
    const size_t e0 = (size_t)(half * 512 + tid) * 8;
    float st[8];
#pragma unroll
    for (int i = 0; i < 8; ++i) st[i] = 0.f;
#pragma unroll 1
    for (int c0 = 0; c0 < NCH; c0 += 8) {
        u32x4 v[8];
#pragma unroll
        for (int j = 0; j < 8; ++j) v[j] = *(const u32x4*)(S + (size_t)((b * NCH + c0 + j) * 8 + h) * 8192 + e0);
#pragma unroll
        for (int j = 0; j < 8; ++j) {
            *(u32x4*)(S + (size_t)((b * NCH + c0 + j) * 8 + h) * 8192 + e0) = (u32x4){pkbf(st[0], st[1]), pkbf(st[2], st[3]), pkbf(st[4], st[5]), pkbf(st[6], st[7])};
            const float d = cdec[(size_t)(b * NCH + c0 + j) * 8 + h];
#pragma unroll
            for (int i = 0; i < 4; ++i) { const unsigned wv = v[j][i]; st[2 * i] = st[2 * i] * d + __uint_as_float(wv << 16); st[2 * i + 1] = st[2 * i + 1] * d + __uint_as_float(wv & 0xffff0000u); }
        }
    }
}

__device__ __forceinline__ void out_unit(SLAS unsigned char* lds, const bf16_t* xbc, const float* cw, const float* cb, const bf16_t* z, const float* dt, const float* a_log, const float* d_skip, const float* norm_g,
                                         const bf16_t* Sin, bf16_t* merged, int b, int c) {
    const int tid = threadIdx.x, lane = tid & 63, w = __builtin_amdgcn_readfirstlane(tid >> 6), r = lane & 15, q = lane >> 4;
    const int tok0 = b * SEQ + c * 64;
    SLAS float* Aarr = (SLAS float*)lds;
    SLAS float* dtarr = (SLAS float*)(lds + 2048);
    SLAS float* npart = (SLAS float*)(lds + 4096);
    SLAS unsigned char* Cg = lds + 6144;
    SLAS unsigned char* Bg = Cg + 64 * NPB;
    SLAS unsigned char* XT = Bg + 64 * NPB;
    SLAS unsigned char* Mm = XT + 256 * LPB;
    { float dtv; const float A = chunk_acum(dt, a_log, tok0, w, lane, dtv); Aarr[w * 64 + lane] = A; dtarr[w * 64 + lane] = dtv; }
    __syncthreads();
#pragma unroll 1
    for (int g = 0; g < 2; ++g) {
        { const int l0 = 8 * w; const int col = lane < 32 ? g * 256 + lane * 8 : (lane < 48 ? 512 + g * 128 + (lane - 32) * 8 : 768 + g * 128 + (lane - 48) * 8);
          float o[8][8]; conv8(xbc, cw, cb, (size_t)tok0, c, col, l0, o);
          if (lane < 32) {
#pragma unroll
              for (int j = 0; j < 8; ++j) *(SLAS u32x4*)(XT + (lane * 8 + j) * LPB + l0 * 2) = (u32x4){pkbf(o[0][j], o[1][j]), pkbf(o[2][j], o[3][j]), pkbf(o[4][j], o[5][j]), pkbf(o[6][j], o[7][j])};
          } else { SLAS unsigned char* dstb = lane < 48 ? (Bg + (lane - 32) * 16) : (Cg + (lane - 48) * 16);
#pragma unroll
              for (int i = 0; i < 8; ++i) *(SLAS u32x4*)(dstb + (l0 + i) * NPB) = (u32x4){pkbf(o[i][0], o[i][1]), pkbf(o[i][2], o[i][3]), pkbf(o[i][4], o[i][5]), pkbf(o[i][6], o[i][7])}; } }
        __syncthreads();
        {
            const int lt = w >> 1, st0 = 2 * (w & 1);
            f32x4 accG[2]; accG[0] = (f32x4){0.f, 0.f, 0.f, 0.f}; accG[1] = (f32x4){0.f, 0.f, 0.f, 0.f};
#pragma unroll
            for (int k = 0; k < 4; ++k) { const bf16x8 cf = *(const SLAS bf16x8*)(Cg + (16 * lt + r) * NPB + (32 * k + 8 * q) * 2);
#pragma unroll
                for (int j = 0; j < 2; ++j) { const bf16x8 bf = *(const SLAS bf16x8*)(Bg + (16 * (st0 + j) + r) * NPB + (32 * k + 8 * q) * 2); accG[j] = __builtin_amdgcn_mfma_f32_16x16x32_bf16(bf, cf, accG[j], 0, 0, 0); } }
            const int l = 16 * lt + r;
#pragma unroll
            for (int hh = 0; hh < 4; ++hh) { const int h = g * 4 + hh; const float Al = Aarr[h * 64 + l];
#pragma unroll
                for (int j = 0; j < 2; ++j) { const int s0 = 16 * (st0 + j) + 4 * q; float m[4];
#pragma unroll
                    for (int e = 0; e < 4; ++e) { const int s = s0 + e; m[e] = (s <= l) ? accG[j][e] * __builtin_amdgcn_exp2f((Al - Aarr[h * 64 + s]) * LOG2E) * dtarr[h * 64 + s] : 0.f; }
                    *(SLAS u32x2*)(Mm + hh * 64 * LPB + l * LPB + s0 * 2) = (u32x2){pkbf(m[0], m[1]), pkbf(m[2], m[3])}; } }
        }
        __syncthreads();
        {
            const int hh = w >> 1, h = g * 4 + hh;
            f32x4 acc[4][2];
#pragma unroll
            for (int lt = 0; lt < 4; ++lt) { acc[lt][0] = (f32x4){0.f, 0.f, 0.f, 0.f}; acc[lt][1] = (f32x4){0.f, 0.f, 0.f, 0.f}; }
            const bf16_t* sin = Sin + ((size_t)((b * NCH + c) * 8 + h) * 64 + (w & 1) * 32 + r) * 128 + 8 * q;
#pragma unroll
            for (int k = 0; k < 4; ++k) { bf16x8 sf[2];
#pragma unroll
                for (int ht = 0; ht < 2; ++ht) sf[ht] = *(const bf16x8*)(sin + (size_t)(16 * ht) * 128 + 32 * k);
#pragma unroll
                for (int lt = 0; lt < 4; ++lt) { const bf16x8 cf = *(const SLAS bf16x8*)(Cg + (16 * lt + r) * NPB + (32 * k + 8 * q) * 2);
#pragma unroll
                    for (int ht = 0; ht < 2; ++ht) acc[lt][ht] = __builtin_amdgcn_mfma_f32_16x16x32_bf16(sf[ht], cf, acc[lt][ht], 0, 0, 0); } }
#pragma unroll
            for (int lt = 0; lt < 4; ++lt) { const float e = __builtin_amdgcn_exp2f(Aarr[h * 64 + 16 * lt + r] * LOG2E); acc[lt][0] = acc[lt][0] * e; acc[lt][1] = acc[lt][1] * e; }
#pragma unroll
            for (int k = 0; k < 2; ++k) { bf16x8 xf[2];
#pragma unroll
                for (int ht = 0; ht < 2; ++ht) xf[ht] = *(const SLAS bf16x8*)(XT + (32 * w + 16 * ht + r) * LPB + (32 * k + 8 * q) * 2);
#pragma unroll
                for (int lt = 0; lt < 4; ++lt) { const bf16x8 mf = *(const SLAS bf16x8*)(Mm + hh * 64 * LPB + (16 * lt + r) * LPB + (32 * k + 8 * q) * 2);
#pragma unroll
                    for (int ht = 0; ht < 2; ++ht) acc[lt][ht] = __builtin_amdgcn_mfma_f32_16x16x32_bf16(xf[ht], mf, acc[lt][ht], 0, 0, 0); } }
            const float dsk = d_skip[h];
            float ss[4];
#pragma unroll
            for (int lt = 0; lt < 4; ++lt) { const int l = 16 * lt + r; float s2 = 0.f;
#pragma unroll
                for (int ht = 0; ht < 2; ++ht) { const int ch = g * 256 + 32 * w + 16 * ht + 4 * q;
                    const u32x2 zv = *(const u32x2*)(z + (size_t)(tok0 + l) * 512 + ch);
                    float xs4[4];
#pragma unroll
                    for (int e = 0; e < 4; ++e) xs4[e] = bf2f(*(const SLAS bf16_t*)(XT + (32 * w + 16 * ht + 4 * q + e) * LPB + l * 2));
                    const float z4[4] = {__uint_as_float(zv.x << 16), __uint_as_float(zv.x & 0xffff0000u), __uint_as_float(zv.y << 16), __uint_as_float(zv.y & 0xffff0000u)};
#pragma unroll
                    for (int e = 0; e < 4; ++e) { const float y = acc[lt][ht][e] + dsk * xs4[e]; const float yg = y * z4[e] * __builtin_amdgcn_rcpf(1.f + __builtin_amdgcn_exp2f(-z4[e] * LOG2E)); acc[lt][ht][e] = yg; s2 += yg * yg; } }
                s2 += __shfl_xor(s2, 16); s2 += __shfl_xor(s2, 32); ss[lt] = s2; }
            if (q == 0) {
#pragma unroll
                for (int lt = 0; lt < 4; ++lt) npart[w * 64 + 16 * lt + r] = ss[lt]; }
            __syncthreads();
#pragma unroll
            for (int lt = 0; lt < 4; ++lt) { const int l = 16 * lt + r; float tot = 0.f;
#pragma unroll
                for (int ww = 0; ww < 8; ++ww) tot += npart[ww * 64 + l];
                const float rs = rsqrtf(tot * (1.f / 256.f) + RMS_EPS);
#pragma unroll
                for (int ht = 0; ht < 2; ++ht) { const int ch = g * 256 + 32 * w + 16 * ht + 4 * q; const f32x4 gv = *(const f32x4*)(norm_g + ch);
                    *(u32x2*)(merged + (size_t)(tok0 + l) * 1024 + ch) = (u32x2){pkbf(acc[lt][ht][0] * rs * gv[0], acc[lt][ht][1] * rs * gv[1]), pkbf(acc[lt][ht][2] * rs * gv[2], acc[lt][ht][3] * rs * gv[3])}; } }
        }
        __syncthreads();
    }
}
#undef SLAS
}

__global__ void k_convb(const bf16_t* xbc, const float* conv_w, const float* conv_b, bf16_t* xc) {
    const size_t idx = (size_t)blockIdx.x * 256 + threadIdx.x;
    const int c = (int)(idx & 1023); const int t = (int)(idx >> 10); const int s = t & (SEQ - 1);
    float acc = conv_b[c];
#pragma unroll
    for (int k = 0; k < 4; ++k) { const int ss = s - 3 + k; if (ss >= 0) acc += conv_w[k * 1024 + c] * bf2f(xbc[(size_t)(t - 3 + k) * 1024 + c]); }
    xc[idx] = f2bf(acc / (1.f + expf(-acc)));
}


constexpr int NWAVES = 8;
constexpr int RING_OFF = 0, RING_BYTES = 131072;
constexpr int LDSCTL_OFF = RING_BYTES, MISC_OFF = LDSCTL_OFF + 320;
constexpr int TAB_OFF = RING_BYTES + 1024;
constexpr int LDS_BYTES = 147456;
#define GAS __attribute__((address_space(1)))
#define LAS __attribute__((address_space(3)))
typedef unsigned v4u __attribute__((ext_vector_type(4)));
typedef float f32x4 __attribute__((ext_vector_type(4)));
typedef GAS unsigned gu32;
#define RLX_AGENT __ATOMIC_RELAXED, __HIP_MEMORY_SCOPE_AGENT
#define LDS_WAIT() asm volatile("s_waitcnt lgkmcnt(0)" ::: "memory")
#define VM_WAIT() asm volatile("s_waitcnt vmcnt(0)" ::: "memory")
__device__ __forceinline__ unsigned pk2(float lo, float hi) { return (unsigned)f2bf(lo) | ((unsigned)f2bf(hi) << 16); }

#define XB_TMO      128
#define XB_XCNT(j)  (256  + 64 * (j))
#define XB_XSUB(j)  (1280 + 64 * (j))
#define XB_XGEN(j)  (2304 + 64 * (j))
#define XB_TOP      3328
#define XB_TOPGEN   3392
#define XCD_BAR_WORDS 3456
#define XB_SPIN_CAP (1u << 18)
__device__ __forceinline__ unsigned xb_ld(unsigned* p)              { return __hip_atomic_load(p, __ATOMIC_RELAXED, __HIP_MEMORY_SCOPE_AGENT); }
__device__ __forceinline__ unsigned xb_add(unsigned* p, unsigned v) { return __hip_atomic_fetch_add(p, v, __ATOMIC_RELAXED, __HIP_MEMORY_SCOPE_AGENT); }
__device__ __forceinline__ unsigned xb_xcc_id() { return (unsigned)__builtin_amdgcn_s_getreg((3 << 11) | 20) & 0xFu; }
#define XB_SPIN(cond, bar) do { unsigned _sp = 0; while (cond) { __builtin_amdgcn_s_sleep(1); \
    if ((++_sp & 255u) == 0u) { if (xb_ld(&(bar)[XB_TMO])) break; if (_sp > XB_SPIN_CAP) { atomicAdd(&(bar)[XB_TMO], 1u); break; } } } } while (0)
struct XcdBarrier { unsigned* bar; unsigned x; volatile LAS unsigned* st; };
__device__ __forceinline__ XcdBarrier xcd_barrier_post(unsigned* bar, volatile LAS unsigned* st) {
    XcdBarrier b; b.bar = bar; b.x = xb_xcc_id(); b.st = st;
    if (threadIdx.x == 0) (void)xb_add(&bar[XB_XCNT(b.x)], 1u);
    return b;
}
__device__ __forceinline__ void xcd_barrier_complete(unsigned* bar, unsigned x, unsigned& nloc, unsigned& nx) {
    const unsigned G = gridDim.x * gridDim.y * gridDim.z;
    unsigned sum, cnt, mine, sp = 0u;
    for (;;) {
        sum = 0u; cnt = 0u; mine = 0u;
#pragma unroll
        for (unsigned j = 0; j < 16; ++j) { const unsigned c = xb_ld(&bar[XB_XCNT(j)]); sum += c; cnt += (c > 0u) ? 1u : 0u; mine = (j == x) ? c : mine; }
        if (sum == G) break;
        __builtin_amdgcn_s_sleep(1);
        if ((++sp & 255u) == 0u) { if (xb_ld(&bar[XB_TMO])) break; if (sp > XB_SPIN_CAP) { atomicAdd(&bar[XB_TMO], 1u); break; } }
    }
    nloc = mine > 0u ? mine : 1u; nx = cnt > 0u ? cnt : 1u;
}
__device__ __forceinline__ void xcd_barrier(const XcdBarrier& b) {
    asm volatile("s_waitcnt vmcnt(0)" ::: "memory");
    __syncthreads();
    if (threadIdx.x == 0) {
        unsigned* bar = b.bar;
        __builtin_amdgcn_s_waitcnt(0);
        unsigned nloc = b.st[0], nx = b.st[1];
        if (nloc == 0u) { xcd_barrier_complete(bar, b.x, nloc, nx); b.st[0] = nloc; b.st[1] = nx; }
        const unsigned old = xb_add(&bar[XB_XSUB(b.x)], 1u);
        const unsigned gen = old / nloc;
        if (old + 1u == (gen + 1u) * nloc) {
            __builtin_amdgcn_fence(__ATOMIC_RELEASE, "agent");
            asm volatile("s_waitcnt vmcnt(0)" ::: "memory");
            const unsigned og = xb_add(&bar[XB_TOP], 1u);
            const unsigned tg = og / nx;
            if (og + 1u == (tg + 1u) * nx) xb_add(&bar[XB_TOPGEN], 1u);
            else XB_SPIN(xb_ld(&bar[XB_TOPGEN]) == tg, bar);
            __builtin_amdgcn_fence(__ATOMIC_ACQUIRE, "agent");
            xb_add(&bar[XB_XGEN(b.x)], 1u);
            asm volatile("s_waitcnt vmcnt(0)" ::: "memory");
        } else {
            XB_SPIN(xb_ld(&bar[XB_XGEN(b.x)]) == gen, bar);
            __builtin_amdgcn_fence(__ATOMIC_ACQUIRE, "agent");
            asm volatile("s_waitcnt vmcnt(0)" ::: "memory");
        }
    }
    __syncthreads();
}

struct Frame {
    LAS unsigned char* lds;
    volatile LAS unsigned* MISC;
    gu32* ctl;
    int tid, lane, wave, vcu, G;
};
__device__ __forceinline__ int tid_now() { int t; asm volatile("v_mov_b32 %0, %1" : "=v"(t) : "v"(threadIdx.x)); return t; }
__device__ __forceinline__ int lane_now() { int l; asm volatile("v_and_b32 %0, 63, %1" : "=v"(l) : "v"(threadIdx.x)); return l; }
__device__ __forceinline__ float wave_sum(float v) {
#pragma unroll
    for (int o = 1; o < 64; o <<= 1) v += __shfl_xor(v, o);
    return v;
}

__device__ __forceinline__ void p0_transpose_item(const float* W, int ldw, int k0, int n0, bf16_t* WT, int ldt, int drow0, LAS float* scr, int lane) {
    float tv[32];
#pragma unroll
    for (int i = 0; i < 32; ++i) { const int kk = 2 * i + (lane >> 5); tv[i] = W[(size_t)(k0 + kk) * ldw + n0 + (lane & 31)]; }
#pragma unroll
    for (int i = 0; i < 32; ++i) { const int kk = 2 * i + (lane >> 5); scr[kk * 33 + (lane & 31)] = tv[i]; }
    LDS_WAIT(); asm volatile("" ::: "memory");
    const int c = lane & 7;
#pragma unroll
    for (int j = 0; j < 4; ++j) { const int n = (lane >> 3) + 8 * j; const LAS float* s = scr + (8 * c) * 33 + n;
        v4u o; o.x = pk2(s[0 * 33], s[1 * 33]); o.y = pk2(s[2 * 33], s[3 * 33]); o.z = pk2(s[4 * 33], s[5 * 33]); o.w = pk2(s[6 * 33], s[7 * 33]);
        *(GAS v4u*)(WT + (size_t)(drow0 + n) * ldt + k0 + 8 * c) = o; }
    LDS_WAIT(); asm volatile("" ::: "memory");
}
__device__ __forceinline__ float softplus_d(float x) { return fmaxf(x, 0.f) + log1pf(expf(-fabsf(x))); }

__device__ __forceinline__ void p0_prologue(Frame& F, const P& p) {
    unsigned char* ws = p.ws;
    bf16_t* Win_t = (bf16_t*)(ws + WS_WIN); bf16_t* Wout_t = (bf16_t*)(ws + WS_WOUT); bf16_t* Wgu_t = (bf16_t*)(ws + WS_WGU); bf16_t* Wd_t = (bf16_t*)(ws + WS_WD);
    LAS float* scr = (LAS float*)(F.lds + RING_OFF + F.wave * 16384);
    const int gw = F.vcu * NWAVES + F.wave, NGW = F.G * NWAVES;
    constexpr int I_IN = 16 * 96, I_OUT = 16 * 32, I_GU = 16 * 2 * 256, I_D = 16 * 256, NITEMS = I_IN + I_OUT + I_GU + I_D;
    for (int it = gw; it < NITEMS; it += NGW) {
        int r = it;
        if (r < I_IN) { const int kb = r / 96, nb = r % 96, n0 = 32 * nb; p0_transpose_item(p.w_in, NPROJ, 64 * kb, n0 + (n0 >= 1536 ? 8 : 0), Win_t, 1024, n0, scr, F.lane); continue; } r -= I_IN;
        if (r < I_OUT) { const int kb = r / 32, nb = r % 32; p0_transpose_item(p.w_out, 1024, 64 * kb, 32 * nb, Wout_t, 1024, 32 * nb, scr, F.lane); continue; } r -= I_OUT;
        if (r < I_GU) { const int e = r / 512, rr = r % 512, mat = rr / 256, r2 = rr % 256, kb = r2 / 16, nb = r2 % 16, n0 = 32 * nb, q = n0 / 128;
            p0_transpose_item((mat ? p.w_up : p.w_gate) + (size_t)e * 1024 * 512, 512, 64 * kb, n0, Wgu_t, 1024, (e * 4 + q) * 256 + mat * 128 + (n0 % 128), scr, F.lane); continue; } r -= I_GU;
        { const int e = r / 256, r2 = r % 256, kb = r2 / 32, nb = r2 % 32;
            p0_transpose_item(p.w_down + (size_t)e * 512 * 1024, 1024, 64 * kb, 32 * nb, Wd_t + (size_t)e * 1024 * 512, 512, 32 * nb, scr, F.lane); }
    }
    __syncthreads();
    LAS float* w16 = (LAS float*)(F.lds + RING_OFF);
    for (int idx = F.tid; idx < 16 * 1024; idx += NWAVES * 64) { const int k = idx >> 4, c = idx & 15; w16[c * 1024 + k] = p.w_in[(size_t)k * NPROJ + (c < 8 ? 1536 + c : 3080 + c - 8)]; }
    __syncthreads();
    bf16_t* xb = (bf16_t*)(ws + WS_XB); float* dt = (float*)(ws + WS_DT); float* logf = (float*)(ws + WS_LOGF);
#pragma unroll 1
    for (int grp = gw; grp < T / 2; grp += NGW) {
        float a[32];
#pragma unroll
        for (int r = 0; r < 2; ++r) {
            const int m = grp * 2 + r;
            const GAS f32x4* xr = (const GAS f32x4*)(p.x + (size_t)m * D) + F.lane;
            f32x4 v[4];
#pragma unroll
            for (int j = 0; j < 4; ++j) v[j] = xr[64 * j];
            GAS unsigned long long* o8 = (GAS unsigned long long*)(xb + (size_t)m * D) + F.lane;
#pragma unroll
            for (int j = 0; j < 4; ++j) o8[64 * j] = (unsigned long long)pk2(v[j].x, v[j].y) | ((unsigned long long)pk2(v[j].z, v[j].w) << 32);
#pragma unroll
            for (int c = 0; c < 16; ++c) {
                float s = 0.f;
#pragma unroll
                for (int j = 0; j < 4; ++j) { const f32x4 w = *(const LAS f32x4*)(w16 + c * 1024 + 256 * j + 4 * F.lane); s += (v[j].x * w.x + v[j].y * w.y) + (v[j].z * w.z + v[j].w * w.w); }
                a[r * 16 + c] = s; asm volatile("" ::: "memory");
            }
        }
#define TRSTEP(HALFN, SB) do { const bool up = (F.lane >> (SB)) & 1; _Pragma("unroll") for (int i = 0; i < (HALFN); ++i) { const float keep = up ? a[i + (HALFN)] : a[i]; const float send = up ? a[i] : a[i + (HALFN)]; a[i] = keep + __shfl_xor(send, 1 << (SB)); } } while (0)
        TRSTEP(16, 0); TRSTEP(8, 1); TRSTEP(4, 2); TRSTEP(2, 3); TRSTEP(1, 4);
#undef TRSTEP
        const float tot = a[0] + __shfl_xor(a[0], 32);
        const int L = F.lane & 31; const int idx = ((L & 1) << 4) | ((L & 2) << 2) | (L & 4) | ((L & 8) >> 2) | ((L & 16) >> 4);
        const int r = idx >> 4, c = idx & 15, m = grp * 2 + r;
        if (F.lane < 32) {
            if (c < 8) dt[(size_t)m * 8 + c] = softplus_d(tot + p.b_in[1536 + c]);
            else logf[(size_t)m * 8 + (c - 8)] = -softplus_d(-(tot + p.b_in[3080 + c - 8]));
        }
    }
}

__device__ __forceinline__ void scanF_unit(Frame& F, const P& p, int bh) {
    const int b = bh >> 3, h = bh & 7;
    const float* logf = (const float*)(p.ws + WS_LOGF); float* Fo = (float*)(p.ws + WS_F); bf16_t* kx = (bf16_t*)(p.ws + WS_KX);
    LAS float* wsum8 = (LAS float*)(F.lds + RING_OFF);
    float v[4]; float s = 0.f;
#pragma unroll
    for (int i = 0; i < 4; ++i) { v[i] = logf[(size_t)(b * SEQ + F.tid * 4 + i) * 8 + h]; s += v[i]; v[i] = s; }
    float inc = s;
#pragma unroll
    for (int o = 1; o < 64; o <<= 1) { const float y = __shfl_up(inc, o); if (F.lane >= o) inc += y; }
    if (F.lane == 63) wsum8[F.wave] = inc;
    __syncthreads();
    float base = inc - s;
    for (int w = 0; w < F.wave; ++w) base += wsum8[w];
#pragma unroll
    for (int i = 0; i < 4; ++i) { const size_t tok = (size_t)(b * SEQ + F.tid * 4 + i); const float f = base + v[i]; Fo[tok * 8 + h] = f;
        const float g = -f * LOG2E; const bf16_t g0 = f2bf(g); const float r1 = g - bf2f(g0); const bf16_t g1 = f2bf(r1); const float r2 = r1 - bf2f(g1); const bf16_t g2 = f2bf(r2);
        v4u o; o.x = (unsigned)g0 | ((unsigned)g1 << 16); o.y = (unsigned)g2; o.z = 0u; o.w = 0u;
        *(GAS v4u*)(kx + (tok * 8 + h) * 8) = o; }
    __syncthreads();
}


__device__ __forceinline__ void ln1_stage_weights(const P& p, LAS f32x4* RG, int tid) {
    for (int idx = tid; idx < 5 * 1024; idx += NWAVES * 64) { const int m = idx >> 10, cc = idx & 1023, j = cc >> 8, ln = (cc & 255) >> 2, i = cc & 3;
        const f32x4 w = m == 0 ? *(const GAS f32x4*)(p.rg_w + (size_t)cc * 4) : *(const GAS f32x4*)(p.re_w + ((size_t)(m - 1) * D + cc) * 4);
        RG[m * 1024 + (j * 4 + i) * 64 + ln] = w; }
}
template <int R>
__device__ __forceinline__ void ln1_router_rows(const P& p, int t0, int lane, const LAS f32x4* RG, bf16_t* hb, LAS unsigned* lcnt, LAS f32x4* rowinfo, LAS int* rowtok, int slot0) {
    float* hio = p.out;
    f32x4 v[R][4];
#pragma unroll
    for (int r = 0; r < R; ++r)
#pragma unroll
        for (int j = 0; j < 4; ++j) v[r][j] = *(const GAS f32x4*)(hio + (size_t)(t0 + r) * D + j * 256 + lane * 4);
    f32x4 g1[4], b1[4];
#pragma unroll
    for (int j = 0; j < 4; ++j) { g1[j] = *(const GAS f32x4*)(p.ln1_g + j * 256 + lane * 4); b1[j] = *(const GAS f32x4*)(p.ln1_b + j * 256 + lane * 4); }
#pragma unroll
    for (int r = 0; r < R; ++r) {
        const int t = t0 + r;
        if (lane == 0) rowtok[slot0 + r] = t;
        float s = 0.f;
#pragma unroll
        for (int j = 0; j < 4; ++j) s += (v[r][j].x + v[r][j].y) + (v[r][j].z + v[r][j].w);
        const float mu = wave_sum(s) * (1.f / D); float s2 = 0.f;
#pragma unroll
        for (int j = 0; j < 4; ++j) { v[r][j] = v[r][j] - mu; s2 += (v[r][j].x * v[r][j].x + v[r][j].y * v[r][j].y) + (v[r][j].z * v[r][j].z + v[r][j].w * v[r][j].w); }
        const float rstd = rsqrtf(wave_sum(s2) * (1.f / D) + LN_EPS);
        f32x4 gl = (f32x4){0.f, 0.f, 0.f, 0.f};
#pragma unroll
        for (int j = 0; j < 4; ++j) { const f32x4 hv = v[r][j] * rstd * g1[j] + b1[j]; v[r][j] = hv;
            *(GAS f32x4*)(hio + (size_t)t * D + j * 256 + lane * 4) = hv;
            *(GAS unsigned long long*)(hb + (size_t)t * D + j * 256 + lane * 4) = (unsigned long long)pk2(hv.x, hv.y) | ((unsigned long long)pk2(hv.z, hv.w) << 32);
            gl += RG[(j * 4 + 0) * 64 + lane] * hv.x; gl += RG[(j * 4 + 1) * 64 + lane] * hv.y; gl += RG[(j * 4 + 2) * 64 + lane] * hv.z; gl += RG[(j * 4 + 3) * 64 + lane] * hv.w; }
        float glv[4];
#pragma unroll
        for (int e = 0; e < 4; ++e) glv[e] = wave_sum(gl[e]) + p.rg_b[e];
        int gi = 0; float gm = glv[0];
#pragma unroll
        for (int e = 1; e < 4; ++e) if (glv[e] > gm) { gm = glv[e]; gi = e; }
        gi = __builtin_amdgcn_readfirstlane(gi);
        float gden = 0.f;
#pragma unroll
        for (int e = 0; e < 4; ++e) gden += expf(glv[e] - gm);
        const float gval = 1.f / gden;
        const LAS f32x4* RE = RG + (1 + gi) * 1024;
        f32x4 el4 = (f32x4){0.f, 0.f, 0.f, 0.f};
#pragma unroll
        for (int j = 0; j < 4; ++j) { el4 += RE[(j * 4 + 0) * 64 + lane] * v[r][j].x; el4 += RE[(j * 4 + 1) * 64 + lane] * v[r][j].y; el4 += RE[(j * 4 + 2) * 64 + lane] * v[r][j].z; el4 += RE[(j * 4 + 3) * 64 + lane] * v[r][j].w; }
        float el[4];
#pragma unroll
        for (int e = 0; e < 4; ++e) el[e] = wave_sum(el4[e]) + p.re_b[gi * 4 + e];
        int i1 = 0;
#pragma unroll
        for (int e = 1; e < 4; ++e) if (el[e] > el[i1]) i1 = e;
        int i2 = -1;
#pragma unroll
        for (int e = 0; e < 4; ++e) if (e != i1 && (i2 < 0 || el[e] > el[i2])) i2 = e;
        const float e1v = i1 == 0 ? el[0] : i1 == 1 ? el[1] : i1 == 2 ? el[2] : el[3];
        const float e2v = i2 == 0 ? el[0] : i2 == 1 ? el[1] : i2 == 2 ? el[2] : el[3];
        const float p2 = expf(e2v - e1v); const float w1 = gval / (1.f + p2), w2 = gval * p2 / (1.f + p2);
        const int lo = i1 < i2 ? i1 : i2, hi = i1 < i2 ? i2 : i1; const float wlo = i1 < i2 ? w1 : w2, whi = i1 < i2 ? w2 : w1;
        const int pairidx = lo == 0 ? (hi - 1) : (lo == 1 ? (hi + 1) : 5);
        const int cls = gi * 6 + pairidx;
        if (lane == 0) {
            const unsigned lpos = __hip_atomic_fetch_add(lcnt + cls, 1u, __ATOMIC_RELAXED, __HIP_MEMORY_SCOPE_WORKGROUP);
            rowinfo[slot0 + r] = (f32x4){__int_as_float(cls), __int_as_float((int)lpos), wlo, whi};
        }
    }
}
__device__ __forceinline__ void ln1_commit(int tid, LAS unsigned* lcnt, LAS unsigned* gbase, const LAS f32x4* rowinfo, const LAS int* rowtok, int nrows, gu32* cnt, int* perm, float* tokinfo) {
    __syncthreads();
    if (tid < NCLS) { const unsigned n = lcnt[tid]; gbase[tid] = n ? __hip_atomic_fetch_add(cnt + 64 * tid, n, RLX_AGENT) : 0u; lcnt[tid] = 0u; }
    __syncthreads();
    if (tid < nrows) { const f32x4 ri = rowinfo[tid]; const int cls = __float_as_int(ri[0]); const int pos = __float_as_int(ri[1]) + (int)gbase[cls]; const int t = rowtok[tid];
        perm[(size_t)cls * T + pos] = t; *(GAS f32x4*)(tokinfo + (size_t)t * 4) = (f32x4){ri[0], __int_as_float(pos), ri[2], ri[3]}; }
}
__device__ __forceinline__ void ln2_row(const P& p, int t, int lane) {
    float* io = p.out;
    f32x4 v[4]; float s = 0.f;
#pragma unroll
    for (int j = 0; j < 4; ++j) { v[j] = *(const GAS f32x4*)(io + (size_t)t * D + j * 256 + lane * 4); s += (v[j].x + v[j].y) + (v[j].z + v[j].w); }
    const float mu = wave_sum(s) * (1.f / D); float s2 = 0.f;
#pragma unroll
    for (int j = 0; j < 4; ++j) { v[j] = v[j] - mu; s2 += (v[j].x * v[j].x + v[j].y * v[j].y) + (v[j].z * v[j].z + v[j].w * v[j].w); }
    const float rstd = rsqrtf(wave_sum(s2) * (1.f / D) + LN_EPS);
#pragma unroll
    for (int j = 0; j < 4; ++j) { const int c = j * 256 + lane * 4; const f32x4 g2 = *(const GAS f32x4*)(p.ln2_g + c), b2 = *(const GAS f32x4*)(p.ln2_b + c);
        *(GAS f32x4*)(io + (size_t)t * D + c) = v[j] * rstd * g2 + b2; }
}

struct Args { P p; int ph_lo, ph_hi, li, pad; };
constexpr int N_PHASES = 2;
__global__ void __launch_bounds__(NWAVES * 64, 2) mega_fwd(Args args) {
    extern __shared__ __attribute__((aligned(16))) unsigned char lds[];
    Frame F;
    F.lds = (LAS unsigned char*)lds;
    F.MISC = (volatile LAS unsigned*)(F.lds + MISC_OFF);
    F.tid = threadIdx.x; F.lane = F.tid & 63; F.wave = __builtin_amdgcn_readfirstlane(F.tid >> 6);
    F.G = gridDim.x; { const int bx = blockIdx.x; F.vcu = (F.G % 8 == 0) ? (bx % 8) * (F.G / 8) + bx / 8 : bx; }
    const P& p = args.p;
    unsigned char* ws = p.ws;
    F.ctl = (gu32*)(ws + WS_CTL);
    for (int u = F.tid; u < (LDS_BYTES - LDSCTL_OFF) / 4; u += NWAVES * 64) ((LAS unsigned*)(F.lds + LDSCTL_OFF))[u] = 0u;
    __syncthreads();
    XcdBarrier bar = xcd_barrier_post((unsigned*)(F.ctl + CW_BAR) + args.li * XCD_BAR_WORDS, F.MISC + 8);
    const int lo = args.ph_lo, hi = args.ph_hi;
#ifndef PROBE_PH
#define PROBE_PH (-1)
#endif
#if PROBE_PH >= 0
    unsigned long long t_prev = __builtin_amdgcn_s_memrealtime(); unsigned long long t_sel = 0ull;
#define PSTAMP(k) do { const unsigned long long t_now = __builtin_amdgcn_s_memrealtime(); if ((k) == PROBE_PH) t_sel = t_now - t_prev; t_prev = t_now; } while (0)
#else
#define PSTAMP(k) do { } while (0)
#endif
#define IN(k) (lo <= (k) && (k) < hi)
#define BOTH(k) (IN(k) && IN((k) + 1))
#define GRID_BAR() xcd_barrier(bar)
    if (IN(0)) { p0_prologue(F, p); if (BOTH(0)) GRID_BAR(); PSTAMP(0); }
    if (IN(1)) {
        if (blockIdx.x < BATCH * NH) scanF_unit(F, p, blockIdx.x);
        pg8::PlainProb pr{(const bf16_t*)(ws + WS_XB), (const bf16_t*)(ws + WS_WIN), 1024, 1024, 16};
        pg8::StaticOrder S; S.init(T, 3072, F.G, (int)blockIdx.x);
        pg8::EpiInproj E{p.b_in, (bf16_t*)(ws + WS_Z), (bf16_t*)(ws + WS_XBC), (bf16_t*)(ws + WS_Q), (bf16_t*)(ws + WS_K), (bf16_t*)(ws + WS_V)};
        pg8::gemm_phase<pg8::PlainProb, pg8::StaticOrder, pg8::EpiInproj, true>(F.lds + RING_OFF, pr, S, E);
        if (BOTH(1)) GRID_BAR(); PSTAMP(1);
    }

    if (IN(2)) {
#pragma unroll 1
        for (int u = F.vcu; u < BATCH * ssd::NCH; u += F.G) { ssd::states_unit(F.lds + RING_OFF, (const bf16_t*)(ws + WS_XBC), p.conv_w, p.conv_b, (const float*)(ws + WS_DT), p.a_log, (bf16_t*)(ws + WS_S), (float*)(ws + WS_CDEC), u / ssd::NCH, u % ssd::NCH); }
        if (BOTH(2)) GRID_BAR(); PSTAMP(2);
    }
    if (IN(3)) {
#pragma unroll 1
        for (int u = F.vcu; u < BATCH * NH * 2; u += F.G) ssd::scan_unit((bf16_t*)(ws + WS_S), (const float*)(ws + WS_CDEC), u >> 1, u & 1);
        __syncthreads();
        const attn_body::AttnTensors AT{(const attn_body::bf16*)(ws + WS_Q), (const attn_body::bf16*)(ws + WS_K), (const attn_body::bf16*)(ws + WS_V), (const attn_body::bf16*)(ws + WS_KX), (attn_body::bf16*)(ws + WS_MERGED)};
        const attn_body::StaticOrder S((int)F.G, (int)blockIdx.x);
        attn_body::attn_phase<attn_body::StaticOrder>((char*)lds + RING_OFF, AT, S);
        if (BOTH(3)) GRID_BAR(); PSTAMP(3);
    }
    if (IN(4)) {
#pragma unroll 1
        for (int u = F.vcu; u < BATCH * ssd::NCH; u += F.G) ssd::out_unit(F.lds + RING_OFF, (const bf16_t*)(ws + WS_XBC), p.conv_w, p.conv_b, (const bf16_t*)(ws + WS_Z), (const float*)(ws + WS_DT), p.a_log, p.d_skip, p.ssd_norm_g,
                                                                          (const bf16_t*)(ws + WS_S), (bf16_t*)(ws + WS_MERGED), u / ssd::NCH, u % ssd::NCH);
        if (BOTH(4)) GRID_BAR(); PSTAMP(4);
    }
    if (IN(5)) {
        pg8::PlainProb pr{(const bf16_t*)(ws + WS_MERGED), (const bf16_t*)(ws + WS_WOUT), 1024, 1024, 16};
        pg8::StaticOrder S; S.init(T, 1024, F.G, (int)blockIdx.x);
        pg8::EpiOutproj E{p.x, p.out};
        pg8::gemm_phase<pg8::PlainProb, pg8::StaticOrder, pg8::EpiOutproj, true>(F.lds + RING_OFF, pr, S, E);
        if (BOTH(5)) GRID_BAR(); PSTAMP(5);
    }
    if (IN(6)) {
        const int gw = F.vcu * NWAVES + F.wave, NGW = F.G * NWAVES;
        LAS f32x4* RG = (LAS f32x4*)(F.lds + RING_OFF);
        LAS unsigned* lcnt = (LAS unsigned*)(F.lds + RING_OFF + 81920);
        LAS unsigned* gbase = lcnt + 32;
        LAS f32x4* rowinfo = (LAS f32x4*)(F.lds + RING_OFF + 81920 + 256);
        LAS int* rowtok = (LAS int*)(F.lds + RING_OFF + 81920 + 256 + 512);
        const int tid6 = tid_now();
        ln1_stage_weights(p, RG, tid6);
        if (tid6 < 32) lcnt[tid6] = 0u;
        __syncthreads();
        const int lane6 = lane_now();
#pragma unroll 1
        for (int bt = F.vcu; bt < T / 32; bt += F.G) {
            ln1_router_rows<4>(p, bt * 32 + F.wave * 4, lane6, RG, (bf16_t*)(ws + WS_HB), lcnt, rowinfo, rowtok, F.wave * 4);
            ln1_commit(tid6, lcnt, gbase, rowinfo, rowtok, 32, F.ctl + CW_CNT, (int*)(ws + WS_PERM), (float*)(ws + WS_TOK));
        }
        if (BOTH(6)) GRID_BAR(); PSTAMP(6);
    }
    if (IN(7) || IN(8)) {
        LAS int* gt = (LAS int*)(F.lds + TAB_OFF);
        if (tid_now() == 0) { int acc = 0; for (int c = 0; c < NCLS; ++c) { const int n = (int)__hip_atomic_load(F.ctl + CW_CNT + 64 * c, RLX_AGENT); gt[c] = acc; gt[32 + c] = n; acc += (n + 255) >> 8; } gt[24] = acc; }
        __syncthreads();
    }
    if (IN(7)) {
        const LAS int* gt = (const LAS int*)(F.lds + TAB_OFF);
        LAS unsigned* rofft = (LAS unsigned*)(F.lds + TAB_OFF + 256); LAS int* tokt = (LAS int*)(F.lds + TAB_OFF + 256 + 6144);
        pg8::MoeGeo geo{gt}; pg8::MoeOrder S{geo.np() * 8, 8, F.G, F.vcu};
        const int* perm = (const int*)(ws + WS_PERM);
        { const int tid7 = tid_now(); pg8::Unit u; for (int i = 0; S.next(i, u); ++i) if (tid7 < 256) { const int c = geo.cls_of(u.pm); const int pos = (u.pm - gt[c]) * 256 + tid7; const int tok = pos < gt[32 + c] ? perm[(size_t)c * T + pos] : -1;
            rofft[i * 256 + tid7] = (unsigned)(tok < 0 ? 0 : tok) * 2048u; tokt[i * 256 + tid7] = tok; } }
        __syncthreads();
        pg8::Moe1Prob pr{(const bf16_t*)(ws + WS_HB), (const bf16_t*)(ws + WS_WGU), geo, rofft, 1024, 1024, 16};
        pg8::EpiMoe1 E{(bf16_t*)(ws + WS_ACT), (const float*)(ws + WS_TOK), tokt};
        pg8::gemm_phase<pg8::Moe1Prob, pg8::MoeOrder, pg8::EpiMoe1, true>(F.lds + RING_OFF, pr, S, E);
        if (BOTH(7)) GRID_BAR(); PSTAMP(7);
    }
    if (IN(8)) {
        const LAS int* gt = (const LAS int*)(F.lds + TAB_OFF);
        LAS int* tokt = (LAS int*)(F.lds + TAB_OFF + 256 + 6144);
        pg8::MoeGeo geo{gt}; pg8::MoeOrder S{geo.np() * 4, 4, F.G, F.vcu};
        const int* perm = (const int*)(ws + WS_PERM);
        __syncthreads();
        { const int tid8 = tid_now(); pg8::Unit u; for (int i = 0; S.next(i, u); ++i) if (tid8 < 256) { const int c = geo.cls_of(u.pm); const int pos = (u.pm - gt[c]) * 256 + tid8; tokt[i * 256 + tid8] = pos < gt[32 + c] ? perm[(size_t)c * T + pos] : -1; } }
        __syncthreads();
        pg8::Moe2Prob pr{(const bf16_t*)(ws + WS_ACT), (const bf16_t*)(ws + WS_WD), geo, 1024, 512, 16};
        pg8::EpiMoe2 E{p.out, tokt};
        pg8::gemm_phase<pg8::Moe2Prob, pg8::MoeOrder, pg8::EpiMoe2, true>(F.lds + RING_OFF, pr, S, E);
        if (BOTH(8)) GRID_BAR(); PSTAMP(8);
    }
    if (IN(9)) {
        const int gw = F.vcu * NWAVES + F.wave, NGW = F.G * NWAVES;
        const int lane9 = lane_now();
#pragma unroll 1
        for (int m = gw; m < T; m += NGW) ln2_row(p, m, lane9);
    }
    PSTAMP(9);
#if PROBE_PH >= 0
    if (blockIdx.x == 0) { const unsigned long long t_end = __builtin_amdgcn_s_memrealtime(); while (__builtin_amdgcn_s_memrealtime() - t_end < 7ull * t_sel) __builtin_amdgcn_s_sleep(8); }
#endif
#undef IN
#undef BOTH
#undef GRID_BAR
}

static void launch_mega(const P& p, int lo, int hi, int li, hipStream_t stream) {
    Args a{}; a.p = p; a.ph_lo = lo; a.ph_hi = hi; a.li = li; a.pad = 0;
    hipLaunchKernelGGL(mega_fwd, dim3(256), dim3(NWAVES * 64), LDS_BYTES, stream, a);
}

extern "C" void kernel_launch(void* const* d_in, const int* in_sizes, int n_in, void* d_out, int out_size, void* d_ws, size_t ws_size, hipStream_t stream) {
    static int inited = 0;
    if (!inited) { (void)hipFuncSetAttribute((const void*)mega_fwd, hipFuncAttributeMaxDynamicSharedMemorySize, LDS_BYTES); inited = 1; }
    P p{};
    const float** ins = (const float**)&p;
    for (int i = 0; i < 20; ++i) ins[i] = (const float*)d_in[i];
    p.out = (float*)d_out; p.ws = (unsigned char*)d_ws;
    unsigned char* ws = p.ws;
    (void)hipMemsetAsync(ws + WS_CTL, 0, CTL_ZERO_BYTES, stream);
    unsigned* cnt = (unsigned*)(ws + WS_CTL) + CW_CNT;
    float* dt = (float*)(ws + WS_DT); float* F = (float*)(ws + WS_F);
    int* perm = (int*)(ws + WS_PERM); float* tokinfo = (float*)(ws + WS_TOK);
    float* yraw = (float*)(ws + WS_YRAW); bf16_t* z = (bf16_t*)(ws + WS_Z); bf16_t* xbc = (bf16_t*)(ws + WS_XBC); bf16_t* merged = (bf16_t*)(ws + WS_MERGED);
    bf16_t *q = (bf16_t*)(ws + WS_Q), *k = (bf16_t*)(ws + WS_K), *v = (bf16_t*)(ws + WS_V), *act = (bf16_t*)(ws + WS_ACT);
    float* xconv = (float*)(ws + WS_XCONV); bf16_t* hb = (bf16_t*)(ws + WS_HB);

    launch_mega(p, 0, 10, 0, stream);
}
```

```cpp
#include <hip/hip_runtime.h>
#include <hip/hip_bf16.h>
#include <stdint.h>
#include <cstdio>

typedef unsigned short bf16_t;
__device__ __forceinline__ float bf2f(bf16_t v) { return __uint_as_float(((unsigned)v) << 16); }
__device__ __forceinline__ bf16_t f2bf(float f) { unsigned u = __float_as_uint(f); return (bf16_t)((u + 0x7fffu + ((u >> 16) & 1u)) >> 16); }

constexpr int BATCH = 16, SEQ = 2048, T = BATCH * SEQ, D = 1024;
constexpr int NPROJ = 3088;
constexpr int NH = 8, HD = 64, NG = 2, NS = 128;
constexpr int NCLS = 24;
constexpr float ALPHA = 1.189207115002721f;
constexpr float LN_EPS = 1e-5f, RMS_EPS = 1e-5f;
constexpr float LOG2E = 1.4426950408889634f;
constexpr float C2 = 0.125f * LOG2E;

constexpr size_t MiB = 1u << 20;
constexpr size_t WS_CTL = 0, CTL_ZERO_BYTES = 1 * MiB;
constexpr size_t WS_WIN = 1 * MiB;
constexpr size_t WS_WOUT = 7 * MiB;
constexpr size_t WS_WGU = 9 * MiB;
constexpr size_t WS_WD = 41 * MiB;
constexpr size_t WS_DT = 58 * MiB;
constexpr size_t WS_LOGF = 59 * MiB;
constexpr size_t WS_F = 60 * MiB;
constexpr size_t WS_PERM = 61 * MiB;
constexpr size_t WS_TOK = 64 * MiB;
constexpr size_t WS_KX = 65 * MiB;
constexpr size_t WS_XB = 72 * MiB;
constexpr size_t WS_S = 72 * MiB;
constexpr size_t WS_CDEC = 69 * MiB;
constexpr size_t WS_MIX = 72 * MiB;
constexpr size_t WS_FFN = 408 * MiB;
constexpr size_t WS_XCB = 328 * MiB;
constexpr size_t WS_YRAW = 72 * MiB;
constexpr size_t WS_Z = 136 * MiB;
constexpr size_t WS_XBC = 168 * MiB;
constexpr size_t WS_HB = 136 * MiB;
constexpr size_t WS_Q = 232 * MiB, WS_K = 264 * MiB, WS_V = 296 * MiB;
constexpr size_t WS_ACT = 232 * MiB;
constexpr size_t WS_XCONV = 328 * MiB;
constexpr size_t WS_MERGED = 408 * MiB;
constexpr int CW_CNT = 1024;
constexpr int CW_TMO = 64, CW_CODE = 65;
constexpr int CW_BAR = 4096;

struct P {
    const float *x, *w_in, *b_in, *conv_w, *conv_b, *a_log, *d_skip, *ssd_norm_g, *w_out, *ln1_g, *ln1_b,
        *rg_w, *rg_b, *re_w, *re_b, *w_gate, *w_up, *w_down, *ln2_g, *ln2_b;
    float* out; unsigned char* ws;
};

__device__ __forceinline__ float softplus_f(float x) { return fmaxf(x, 0.f) + log1pf(expf(-fabsf(x))); }
__device__ __forceinline__ float silu_f(float x) { return x / (1.f + expf(-x)); }

template <int NB, class AL, class BL, class EP>
__global__ __launch_bounds__(256) void ngemm(AL al, BL bl, EP ep, int K) {
    __shared__ float As[16][68];
    __shared__ float Bs[NB][16][68];
    const int tm = blockIdx.y * 64, tn = blockIdx.x * 64;
    if (!al.tile_ok(tm)) return;
    const int tx = threadIdx.x & 15, ty = threadIdx.x >> 4;
    float acc[NB][4][4];
#pragma unroll
    for (int b = 0; b < NB; ++b)
#pragma unroll
        for (int i = 0; i < 4; ++i)
#pragma unroll
            for (int j = 0; j < 4; ++j) acc[b][i][j] = 0.f;
    for (int k0 = 0; k0 < K; k0 += 16) {
#pragma unroll
        for (int i = 0; i < 4; ++i) { const int idx = threadIdx.x + i * 256; const int r = idx >> 4, kk = idx & 15; As[kk][r] = al(tm + r, k0 + kk); }
#pragma unroll
        for (int b = 0; b < NB; ++b)
#pragma unroll
            for (int i = 0; i < 4; ++i) { const int idx = threadIdx.x + i * 256; const int kk = idx >> 6, n = idx & 63; Bs[b][kk][n] = bl(b, tm, k0 + kk, tn + n); }
        __syncthreads();
#pragma unroll
        for (int kk = 0; kk < 16; ++kk) {
            float a[4];
#pragma unroll
            for (int i = 0; i < 4; ++i) a[i] = As[kk][ty * 4 + i];
#pragma unroll
            for (int b = 0; b < NB; ++b) {
                float bb[4];
#pragma unroll
                for (int j = 0; j < 4; ++j) bb[j] = Bs[b][kk][tx * 4 + j];
#pragma unroll
                for (int i = 0; i < 4; ++i)
#pragma unroll
                    for (int j = 0; j < 4; ++j) acc[b][i][j] += a[i] * bb[j];
            }
        }
        __syncthreads();
    }
#pragma unroll
    for (int i = 0; i < 4; ++i)
#pragma unroll
        for (int j = 0; j < 4; ++j) {
            if (NB == 1) ep(tm + ty * 4 + i, tn + tx * 4 + j, acc[0][i][j], 0.f);
            else ep(tm + ty * 4 + i, tn + tx * 4 + j, acc[0][i][j], acc[NB - 1][i][j]);
        }
}

struct AL_x { const float* x; __device__ bool tile_ok(int) const { return true; } __device__ float operator()(int r, int k) const { return x[(size_t)r * D + k]; } };
struct BL_win { const float* w; __device__ float operator()(int, int, int k, int n) const { return n < NPROJ ? w[(size_t)k * NPROJ + n] : 0.f; } };
struct EP_inproj {
    const float* b_in; bf16_t *z, *xbc, *q, *k, *v; float *dt, *logf;
    __device__ void operator()(int r, int c, float v0, float) const {
        if (c >= NPROJ) return;
        const float val = v0 + b_in[c];
        if (c < 512) z[(size_t)r * 512 + c] = f2bf(val);
        else if (c < 1536) xbc[(size_t)r * 1024 + (c - 512)] = f2bf(val);
        else if (c < 1544) dt[(size_t)r * 8 + (c - 1536)] = softplus_f(val);
        else if (c < 2056) q[(size_t)r * 512 + (c - 1544)] = f2bf(val * C2);
        else if (c < 2568) k[(size_t)r * 512 + (c - 2056)] = f2bf(val);
        else if (c < 3080) v[(size_t)r * 512 + (c - 2568)] = f2bf(val);
        else logf[(size_t)r * 8 + (c - 3080)] = -softplus_f(-val);
    }
};

__global__ void k_conv(const bf16_t* xbc, const float* conv_w, const float* conv_b, float* xconv) {
    const size_t idx = (size_t)blockIdx.x * 256 + threadIdx.x;
    const int c = (int)(idx & 1023); const int t = (int)(idx >> 10); const int s = t & (SEQ - 1);
    float acc = conv_b[c];
#pragma unroll
    for (int k = 0; k < 4; ++k) { const int ss = s - 3 + k; if (ss >= 0) acc += conv_w[k * 1024 + c] * bf2f(xbc[(size_t)(t - 3 + k) * 1024 + c]); }
    xconv[idx] = silu_f(acc);
}

__global__ __launch_bounds__(64) void k_ssd(const float* xconv, const float* dt, const float* a_log, const float* d_skip, float* yraw) {
    __shared__ float Bs[16][128], Cs[16][128];
    const int b = blockIdx.x >> 3, h = blockIdx.x & 7, g = h >> 2, p = threadIdx.x;
    const float a = -expf(a_log[h]), dsk = d_skip[h];
    float st[128];
#pragma unroll
    for (int n = 0; n < 128; ++n) st[n] = 0.f;
    for (int t0 = 0; t0 < SEQ; t0 += 16) {
        __syncthreads();
        for (int i = p; i < 16 * 128; i += 64) { const int tt = i >> 7, n = i & 127; const size_t row = (size_t)(b * SEQ + t0 + tt) * 1024;
            Bs[tt][n] = xconv[row + 512 + g * 128 + n]; Cs[tt][n] = xconv[row + 768 + g * 128 + n]; }
        __syncthreads();
        for (int tt = 0; tt < 16; ++tt) {
            const size_t tok = (size_t)(b * SEQ + t0 + tt);
            const float xs = xconv[tok * 1024 + h * 64 + p], dtv = dt[tok * 8 + h];
            const float dA = expf(dtv * a), xdt = xs * dtv;
            float y = 0.f;
#pragma unroll
            for (int n = 0; n < 128; ++n) { st[n] = st[n] * dA + xdt * Bs[tt][n]; y += Cs[tt][n] * st[n]; }
            yraw[tok * 512 + h * 64 + p] = y + dsk * xs;
        }
    }
}

__global__ __launch_bounds__(256) void k_gatenorm(const float* yraw, const bf16_t* z, const float* norm_g, bf16_t* merged) {
    const int w = blockIdx.x * 4 + (threadIdx.x >> 6), lane = threadIdx.x & 63;
    const int t = w >> 1, g = w & 1;
    float v[4]; float ss = 0.f;
#pragma unroll
    for (int j = 0; j < 4; ++j) { const int c = g * 256 + lane * 4 + j; const float y = yraw[(size_t)t * 512 + c] * silu_f(bf2f(z[(size_t)t * 512 + c])); v[j] = y; ss += y * y; }
#pragma unroll
    for (int o = 1; o < 64; o <<= 1) ss += __shfl_xor(ss, o);
    const float r = rsqrtf(ss * (1.f / 256.f) + RMS_EPS);
#pragma unroll
    for (int j = 0; j < 4; ++j) { const int c = g * 256 + lane * 4 + j; merged[(size_t)t * 1024 + c] = f2bf(v[j] * r * norm_g[c]); }
}

__global__ void k_scanF(const float* logf, float* F) {
    const int i = blockIdx.x * 64 + threadIdx.x; if (i >= BATCH * NH) return;
    const int b = i >> 3, h = i & 7; float s = 0.f;
    for (int t = 0; t < SEQ; ++t) { const size_t o = (size_t)(b * SEQ + t) * 8 + h; s += logf[o]; F[o] = s; }
}

__global__ __launch_bounds__(64) void k_attn(const bf16_t* Q, const bf16_t* K, const bf16_t* V, const float* F, bf16_t* merged) {
    const int bh = blockIdx.y, b = bh >> 3, h = bh & 7; const int t = blockIdx.x * 64 + threadIdx.x;
    const size_t row = (size_t)(b * SEQ + t);
    float q[64], o[64];
#pragma unroll
    for (int d = 0; d < 64; ++d) { q[d] = bf2f(Q[row * 512 + h * 64 + d]); o[d] = 0.f; }
    const float Ft = F[row * 8 + h];
    float m = -INFINITY, l = 0.f;
    const int smax = blockIdx.x * 64 + 63;
    for (int s = 0; s <= smax; ++s) {
        const size_t kr = (size_t)(b * SEQ + s);
        const bf16_t* kp = K + kr * 512 + h * 64; const bf16_t* vp = V + kr * 512 + h * 64;
        float dot = 0.f;
#pragma unroll
        for (int d = 0; d < 64; ++d) dot += q[d] * bf2f(kp[d]);
        const float logit = dot + (Ft - F[kr * 8 + h]) * LOG2E;
        if (s <= t) {
            const float mn = fmaxf(m, logit), corr = exp2f(m - mn), pp = exp2f(logit - mn);
            l = l * corr + pp;
#pragma unroll
            for (int d = 0; d < 64; ++d) o[d] = o[d] * corr + pp * bf2f(vp[d]);
            m = mn;
        }
    }
    const float rl = 1.f / l;
#pragma unroll
    for (int d = 0; d < 64; ++d) merged[row * 1024 + 512 + h * 64 + d] = f2bf(o[d] * rl);
}

struct AL_bf { const bf16_t* a; int lda; int pad; __device__ bool tile_ok(int) const { return true; } __device__ float operator()(int r, int k) const { return bf2f(a[(size_t)r * lda + k]); } };
struct BL_plain { const float* w; int ldb; int pad; __device__ float operator()(int, int, int k, int n) const { return w[(size_t)k * ldb + n]; } };
struct EP_outproj { const float* x; float* out; __device__ void operator()(int r, int c, float v, float) const { out[(size_t)r * D + c] = ALPHA * x[(size_t)r * D + c] + v; } };

__device__ __forceinline__ float wsum(float v) {
#pragma unroll
    for (int o = 1; o < 64; o <<= 1) v += __shfl_xor(v, o);
    return v;
}
__global__ __launch_bounds__(256) void k_ln1_router(float* hio, const float* g1, const float* b1, const float* rg_w, const float* rg_b, const float* re_w, const float* re_b,
                                                    bf16_t* hb, unsigned* cnt, int* perm, float* tokinfo) {
    const int t = blockIdx.x * 4 + (threadIdx.x >> 6), lane = threadIdx.x & 63;
    float v[16]; float s = 0.f;
#pragma unroll
    for (int j = 0; j < 4; ++j) { const float4 u = *(const float4*)(hio + (size_t)t * D + j * 256 + lane * 4); v[4 * j] = u.x; v[4 * j + 1] = u.y; v[4 * j + 2] = u.z; v[4 * j + 3] = u.w; s += (u.x + u.y) + (u.z + u.w); }
    const float mu = wsum(s) * (1.f / D); float s2 = 0.f;
#pragma unroll
    for (int i = 0; i < 16; ++i) { v[i] -= mu; s2 += v[i] * v[i]; }
    const float rstd = rsqrtf(wsum(s2) * (1.f / D) + LN_EPS);
    float gl[4] = {0.f, 0.f, 0.f, 0.f};
#pragma unroll
    for (int j = 0; j < 4; ++j)
#pragma unroll
        for (int i = 0; i < 4; ++i) { const int c = j * 256 + lane * 4 + i; const float hv = v[4 * j + i] * rstd * g1[c] + b1[c]; v[4 * j + i] = hv;
            hio[(size_t)t * D + c] = hv; hb[(size_t)t * D + c] = f2bf(hv);
#pragma unroll
            for (int e = 0; e < 4; ++e) gl[e] += hv * rg_w[c * 4 + e]; }
#pragma unroll
    for (int e = 0; e < 4; ++e) gl[e] = wsum(gl[e]) + rg_b[e];
    int gi = 0; float gm = gl[0];
#pragma unroll
    for (int e = 1; e < 4; ++e) if (gl[e] > gm) { gm = gl[e]; gi = e; }
    float gden = 0.f;
#pragma unroll
    for (int e = 0; e < 4; ++e) gden += expf(gl[e] - gm);
    const float gval = 1.f / gden;
    float el[4] = {0.f, 0.f, 0.f, 0.f};
#pragma unroll
    for (int j = 0; j < 4; ++j)
#pragma unroll
        for (int i = 0; i < 4; ++i) { const int c = j * 256 + lane * 4 + i;
#pragma unroll
            for (int e = 0; e < 4; ++e) el[e] += v[4 * j + i] * re_w[((size_t)gi * D + c) * 4 + e]; }
#pragma unroll
    for (int e = 0; e < 4; ++e) el[e] = wsum(el[e]) + re_b[gi * 4 + e];
    int i1 = 0;
#pragma unroll
    for (int e = 1; e < 4; ++e) if (el[e] > el[i1]) i1 = e;
    int i2 = -1;
#pragma unroll
    for (int e = 0; e < 4; ++e) if (e != i1 && (i2 < 0 || el[e] > el[i2])) i2 = e;
    const float mx = el[i1]; const float p2 = expf(el[i2] - mx); const float w1 = gval / (1.f + p2), w2 = gval * p2 / (1.f + p2);
    const int lo = i1 < i2 ? i1 : i2, hi = i1 < i2 ? i2 : i1; const float wlo = i1 < i2 ? w1 : w2, whi = i1 < i2 ? w2 : w1;
    const int pairidx = lo == 0 ? (hi - 1) : (lo == 1 ? (hi + 1) : 5);
    const int cls = gi * 6 + pairidx;
    if (lane == 0) {
        const unsigned pos = atomicAdd(&cnt[cls], 1u);
        perm[(size_t)cls * T + pos] = t;
        tokinfo[(size_t)t * 4 + 0] = __int_as_float(cls); tokinfo[(size_t)t * 4 + 1] = __int_as_float((int)pos); tokinfo[(size_t)t * 4 + 2] = wlo; tokinfo[(size_t)t * 4 + 3] = whi;
    }
}

struct ClsGeo { const unsigned* cnt;
    __device__ bool find(int row, int& cls, int& pos, int& n) const {
        int off = 0;
        for (int c = 0; c < NCLS; ++c) { const int nc = (int)cnt[c], pc = (nc + 255) & ~255; if (row < off + pc) { cls = c; pos = row - off; n = nc; return true; } off += pc; }
        return false;
    }
};
__device__ __forceinline__ void cls_experts(int cls, int& ea, int& eb) { const int g = cls / 6, pi = cls % 6; const int lo = pi < 3 ? 0 : (pi < 5 ? 1 : 2); const int hi = pi < 3 ? pi + 1 : (pi < 5 ? pi - 1 : 3); ea = g * 4 + lo; eb = g * 4 + hi; }

struct AL_moe1 { const bf16_t* hb; const int* perm; ClsGeo geo;
    __device__ bool tile_ok(int tm) const { int c, p, n; if (!geo.find(tm, c, p, n)) return false; return p < n; }
    __device__ float operator()(int r, int k) const { int c, p, n; if (!geo.find(r, c, p, n) || p >= n) return 0.f; const int tok = perm[(size_t)c * T + p]; return bf2f(hb[(size_t)tok * D + k]); } };
struct BL_moe1 { const float *wg, *wu; ClsGeo geo;
    __device__ float operator()(int b, int tm, int k, int n) const { int c, p, nn; geo.find(tm, c, p, nn); int ea, eb; cls_experts(c, ea, eb); const int e = n < 512 ? ea : eb; const int col = n & 511;
        const float* w = b == 0 ? wg : wu; return w[((size_t)e * D + k) * 512 + col]; } };
struct EP_moe1 { bf16_t* act; const int* perm; const float* tokinfo; ClsGeo geo;
    __device__ void operator()(int r, int c, float g, float u) const { int cl, p, n; float w = 0.f; if (geo.find(r, cl, p, n) && p < n) { const int tok = perm[(size_t)cl * T + p]; w = tokinfo[(size_t)tok * 4 + (c < 512 ? 2 : 3)]; }
        act[(size_t)r * 1024 + c] = f2bf(silu_f(g) * u * w); } };
struct AL_moe2 { const bf16_t* act; ClsGeo geo;
    __device__ bool tile_ok(int tm) const { int c, p, n; if (!geo.find(tm, c, p, n)) return false; return p < n; }
    __device__ float operator()(int r, int k) const { return bf2f(act[(size_t)r * 1024 + k]); } };
struct BL_moe2 { const float* wd; ClsGeo geo;
    __device__ float operator()(int, int tm, int k, int n) const { int c, p, nn; geo.find(tm, c, p, nn); int ea, eb; cls_experts(c, ea, eb); const int e = k < 512 ? ea : eb; return wd[((size_t)e * 512 + (k & 511)) * D + n]; } };
struct EP_moe2 { float* out; const int* perm; ClsGeo geo;
    __device__ void operator()(int r, int c, float v, float) const { int cl, p, n; if (!geo.find(r, cl, p, n) || p >= n) return; const int tok = perm[(size_t)cl * T + p]; float* o = out + (size_t)tok * D + c; *o = ALPHA * (*o) + v; } };

__global__ __launch_bounds__(256) void k_ln2(float* io, const float* g2, const float* b2) {
    const int t = blockIdx.x * 4 + (threadIdx.x >> 6), lane = threadIdx.x & 63;
    float v[16]; float s = 0.f;
#pragma unroll
    for (int j = 0; j < 4; ++j) { const float4 u = *(const float4*)(io + (size_t)t * D + j * 256 + lane * 4); v[4 * j] = u.x; v[4 * j + 1] = u.y; v[4 * j + 2] = u.z; v[4 * j + 3] = u.w; s += (u.x + u.y) + (u.z + u.w); }
    const float mu = wsum(s) * (1.f / D); float s2 = 0.f;
#pragma unroll
    for (int i = 0; i < 16; ++i) { v[i] -= mu; s2 += v[i] * v[i]; }
    const float rstd = rsqrtf(wsum(s2) * (1.f / D) + LN_EPS);
#pragma unroll
    for (int j = 0; j < 4; ++j) { float4 o; const int c = j * 256 + lane * 4;
        o.x = v[4 * j] * rstd * g2[c] + b2[c]; o.y = v[4 * j + 1] * rstd * g2[c + 1] + b2[c + 1]; o.z = v[4 * j + 2] * rstd * g2[c + 2] + b2[c + 2]; o.w = v[4 * j + 3] * rstd * g2[c + 3] + b2[c + 3];
        *(float4*)(io + (size_t)t * D + c) = o; }
}

namespace pg8 {
#define PG8_LAS __attribute__((address_space(3)))
typedef short bf16x8 __attribute__((ext_vector_type(8)));
typedef float f32x4 __attribute__((ext_vector_type(4)));
typedef float f32x2 __attribute__((ext_vector_type(2)));
typedef unsigned u32x4 __attribute__((ext_vector_type(4)));
typedef unsigned u32x2 __attribute__((ext_vector_type(2)));
constexpr int BM = 256, BK = 64, HALF = 128, HTB = HALF * BK * 2, STAGE_BYTES = 8 * HTB, NXCD = 8, WGM = 8;
__host__ __device__ __forceinline__ int lds_byte(int r, int c) { const int st = (r >> 4) * 2 + (c >> 5), rr = r & 15, cc = c & 31, ob = rr * 64 + cc * 2; return st * 1024 + (ob ^ (((ob >> 9) & 1) << 5)); }
__host__ __device__ __forceinline__ void stage_rc(int b, int& R, int& C) { const int st = b / 1024, sb = b % 1024, swz = sb ^ (((sb >> 9) & 1) << 5); R = (st >> 1) * 16 + swz / 64; C = (st & 1) * 32 + (swz % 64) / 2; }
__host__ __device__ __forceinline__ int perm32(int rho) { const int n = rho >> 4, i = rho & 15; return 8 * (i >> 2) + 4 * n + (i & 3); }
__device__ __forceinline__ unsigned cvt_pk_bf16(float lo, float hi) { unsigned r; asm volatile("v_cvt_pk_bf16_f32 %0, %1, %2" : "=v"(r) : "v"(lo), "v"(hi)); return r; }

struct Unit { int pm, pn; };
struct StaticOrder {
    int nM, nN, nwg, G, c;
    __device__ void init(int M, int N, int G_, int c_) { nM = M / BM; nN = N / BM; nwg = nM * nN; G = G_; c = c_; }
    __device__ bool next(int i, Unit& u) const {
        const long L = (long)i * G + c; if (L >= nwg) return false;
        int wgid = (int)L; { const int q = nwg / NXCD, r = nwg % NXCD, xcd = wgid % NXCD, off = wgid / NXCD; wgid = (xcd < r ? xcd * (q + 1) : r * (q + 1) + (xcd - r) * q) + off; }
        const int nig = WGM * nN, gid = wgid / nig, fm = gid * WGM, gsz = (nM - fm) < WGM ? (nM - fm) : WGM;
        u.pm = fm + ((wgid % nig) % gsz); u.pn = (wgid % nig) / gsz; return true;
    }
};
struct PlainProb {
    static constexpr bool GATHER = false;
    const bf16_t* A; const bf16_t* Bt; int lda, ldb, nt;
    __device__ __forceinline__ const char* a_base(const Unit& u) const { return (const char*)(A + (size_t)u.pm * BM * lda); }
    __device__ __forceinline__ void b_base(const Unit& u, const char*& b0, const char*& b1) const { b0 = (const char*)(Bt + (size_t)u.pn * BM * ldb); b1 = b0; }
    __device__ __forceinline__ int ksplit() const { return nt; }
    __device__ __forceinline__ unsigned rowoff(int, int) const { return 0u; }
};

template <class PR, class Sched, class Epi, bool ALIGN_EPI>
__device__ __forceinline__ void gemm_phase(PG8_LAS unsigned char* lds, const PR& pr, const Sched& S, const Epi& E) {
    const int tid = threadIdx.x, wid = __builtin_amdgcn_readfirstlane(tid >> 6), lane = tid & 63, wr = wid >> 2, wc = wid & 3, fr = lane & 15, fq = lane >> 4;
    const int nt = pr.nt, ksp = pr.ksplit();
    unsigned voffA[2][2], nvA[2][2], voffB[2]; int RA[2], CA[2];
#pragma unroll
    for (int i = 0; i < 2; ++i) { int R, C; stage_rc(tid * 16 + i * 8192, R, C); const int Rb = Epi::PERM ? ((R & ~31) + perm32(R & 31)) : R;
        RA[i] = R; CA[i] = C; voffB[i] = (unsigned)(Rb * pr.ldb + C) * 2u; }
    const size_t kstep = (size_t)(BK * 2);
    const size_t hstepB = (size_t)HALF * pr.ldb * 2;
    const unsigned ldsw = (unsigned)wid * 1024u;
    const int aoff = lds_byte(wr * 64 + fr, fq * 8), boff = lds_byte(wc * 32 + fr, fq * 8);
#define PG8_SA(b, h) (((b) * 2 + (h)) * HTB)
#define PG8_SB(b, h) ((4 + (b) * 2 + (h)) * HTB)
#define PG8_STAGE(bufoff, gbase, voff) do { _Pragma("unroll") for (int _i = 0; _i < 2; ++_i) \
        __builtin_amdgcn_global_load_lds((const unsigned*)((const char*)(gbase) + (voff)[_i]), (PG8_LAS unsigned*)(lds + (bufoff) + ldsw + _i * 8192), 16, 0, 0); } while (0)
#define PG8_LDA(dst, b, h) do { _Pragma("unroll") for (int m = 0; m < 4; ++m) _Pragma("unroll") for (int k = 0; k < 2; ++k) dst[m][k] = *(const PG8_LAS bf16x8*)(lds + PG8_SA(b, h) + aoff + m * 2048 + k * 1024); } while (0)
#define PG8_LDB(dst, b, h) do { _Pragma("unroll") for (int n = 0; n < 2; ++n) _Pragma("unroll") for (int k = 0; k < 2; ++k) dst[n][k] = *(const PG8_LAS bf16x8*)(lds + PG8_SB(b, h) + boff + n * 2048 + k * 1024); } while (0)
#define PG8_MMA(ai, bj, At, Bt) do { __builtin_amdgcn_s_setprio(1); _Pragma("unroll") for (int m = 0; m < 4; ++m) _Pragma("unroll") for (int n = 0; n < 2; ++n) _Pragma("unroll") for (int k = 0; k < 2; ++k) \
        acc[ai][bj][m][n] = __builtin_amdgcn_mfma_f32_16x16x32_bf16(Bt[n][k], At[m][k], acc[ai][bj][m][n], 0, 0, 0); __builtin_amdgcn_s_setprio(0); } while (0)
#define PG8_WAIT_V(n) asm volatile("s_waitcnt vmcnt(" #n ")" ::: "memory")
#define PG8_WAIT_L(n) asm volatile("s_waitcnt lgkmcnt(" #n ")" ::: "memory")
#define PG8_BAR __builtin_amdgcn_s_barrier()
#define PG8_SCHED __builtin_amdgcn_sched_barrier(0)
#define PG8_SETVA(dst, slot) do { _Pragma("unroll") for (int _h = 0; _h < 2; ++_h) _Pragma("unroll") for (int _i = 0; _i < 2; ++_i) \
        dst[_h][_i] = PR::GATHER ? (pr.rowoff((slot), _h * HALF + RA[_i]) + (unsigned)CA[_i] * 2u) : (unsigned)((_h * HALF + RA[_i]) * pr.lda + CA[_i]) * 2u; } while (0)
    Unit cur, nxt; int ui = 0;
    if (!S.next(0, cur)) return;
    f32x4 acc[2][2][4][2];
#pragma unroll
    for (int a = 0; a < 2; ++a)
#pragma unroll
        for (int b = 0; b < 2; ++b)
#pragma unroll
            for (int m = 0; m < 4; ++m)
#pragma unroll
                for (int n = 0; n < 2; ++n) acc[a][b][m][n] = (f32x4){0.f, 0.f, 0.f, 0.f};
    bf16x8 At[4][2], B0[2][2], B1[2][2];
    PG8_SETVA(voffA, 0);
    const char* cA = pr.a_base(cur); const char *cB0, *cB1; pr.b_base(cur, cB0, cB1);
    PG8_STAGE(PG8_SB(0, 0), cB0, voffB); PG8_STAGE(PG8_SB(0, 1), cB0 + hstepB, voffB); PG8_STAGE(PG8_SA(0, 0), cA, voffA[0]); PG8_STAGE(PG8_SA(0, 1), cA, voffA[1]);
    if (wr == 1) PG8_BAR;
    PG8_WAIT_V(2); PG8_BAR;
    PG8_STAGE(PG8_SB(1, 0), cB0 + kstep, voffB); PG8_STAGE(PG8_SA(1, 0), cA + kstep, voffA[0]); PG8_STAGE(PG8_SB(1, 1), cB0 + hstepB + kstep, voffB);
    PG8_WAIT_V(6); PG8_BAR;
    for (;;) {
        const bool has_next = S.next(ui + 1, nxt);
        const char *nA = cA, *nB0 = cB0, *nB1 = cB1;
        if (has_next) { nA = pr.a_base(nxt); pr.b_base(nxt, nB0, nB1); }
        if (PR::GATHER) { if (has_next) { PG8_SETVA(nvA, ui + 1); } else {
#pragma unroll
            for (int h = 0; h < 2; ++h)
#pragma unroll
                for (int i = 0; i < 2; ++i) nvA[h][i] = voffA[h][i]; } }
        for (int t = 0; t < nt; t += 2) {
            const bool last = (t == nt - 2);
            const char* a1 = cA + (size_t)(t + 1) * kstep;
            const char* a2 = last ? nA : cA + (size_t)(t + 2) * kstep;
            const char* b2 = last ? nB0 : ((t + 2 < ksp) ? cB0 + (size_t)(t + 2) * kstep : cB1 + (size_t)(t + 2 - ksp) * kstep);
            const char* a3 = a2 + kstep; const char* b3 = b2 + kstep;
            unsigned va2[2][2];
#pragma unroll
            for (int h = 0; h < 2; ++h)
#pragma unroll
                for (int i = 0; i < 2; ++i) va2[h][i] = (PR::GATHER && last) ? nvA[h][i] : voffA[h][i];
            PG8_LDB(B0, 0, 0); PG8_LDB(B1, 0, 1); PG8_SCHED; PG8_LDA(At, 0, 0); PG8_STAGE(PG8_SA(1, 1), a1, voffA[1]);
            PG8_WAIT_V(8); PG8_WAIT_L(0); PG8_BAR; PG8_MMA(0, 0, At, B0); PG8_MMA(0, 1, At, B1); PG8_BAR; PG8_SCHED;
            PG8_LDA(At, 0, 1); PG8_STAGE(PG8_SB(0, 0), b2, voffB); PG8_STAGE(PG8_SB(0, 1), b2 + hstepB, voffB); PG8_STAGE(PG8_SA(0, 0), a2, va2[0]);
            PG8_WAIT_V(8); PG8_WAIT_L(0); PG8_BAR; PG8_MMA(1, 0, At, B0); PG8_MMA(1, 1, At, B1); PG8_BAR; PG8_SCHED;
            PG8_LDB(B0, 1, 0); PG8_LDB(B1, 1, 1); PG8_SCHED; PG8_LDA(At, 1, 0); PG8_STAGE(PG8_SA(0, 1), a2, va2[1]);
            PG8_WAIT_V(8); PG8_WAIT_L(0); PG8_BAR; PG8_MMA(0, 0, At, B0); PG8_MMA(0, 1, At, B1); PG8_BAR; PG8_SCHED;
            PG8_LDA(At, 1, 1); PG8_STAGE(PG8_SB(1, 0), b3, voffB); PG8_STAGE(PG8_SB(1, 1), b3 + hstepB, voffB); PG8_STAGE(PG8_SA(1, 0), a3, va2[0]);
            PG8_WAIT_V(8); PG8_WAIT_L(0); PG8_BAR; PG8_MMA(1, 0, At, B0); PG8_MMA(1, 1, At, B1); PG8_BAR; PG8_SCHED;
        }
        if constexpr (ALIGN_EPI) { if (wr == 0) PG8_BAR; }
        if constexpr (!Epi::AFTER_DRAIN) { E(acc, cur, ui, wr, wc, fr, fq); }
        if (!has_next) break;
#pragma unroll
        for (int a = 0; a < 2; ++a)
#pragma unroll
            for (int b = 0; b < 2; ++b)
#pragma unroll
                for (int m = 0; m < 4; ++m)
#pragma unroll
                    for (int n = 0; n < 2; ++n) acc[a][b][m][n] = (f32x4){0.f, 0.f, 0.f, 0.f};
        cur = nxt; cA = nA; cB0 = nB0; cB1 = nB1; ++ui;
        if (PR::GATHER) {
#pragma unroll
            for (int h = 0; h < 2; ++h)
#pragma unroll
                for (int i = 0; i < 2; ++i) voffA[h][i] = nvA[h][i]; }
        if constexpr (ALIGN_EPI) { if (wr == 1) PG8_BAR; }
    }
    PG8_WAIT_V(0);
    if constexpr (!ALIGN_EPI) { if (wr == 0) PG8_BAR; }
    PG8_BAR;
    if constexpr (Epi::AFTER_DRAIN) { E.fused(acc, cur, ui, wr, wc, fr, fq, lds, wid, lane); }
#undef PG8_SA
#undef PG8_SB
#undef PG8_STAGE
#undef PG8_LDA
#undef PG8_LDB
#undef PG8_MMA
#undef PG8_WAIT_V
#undef PG8_WAIT_L
#undef PG8_BAR
#undef PG8_SCHED
#undef PG8_SETVA
}

struct EpiInproj {
    static constexpr bool PERM = true, AFTER_DRAIN = false;
    const float* b_in; bf16_t *z, *xbc, *q, *k, *v;
    __device__ __forceinline__ void operator()(const f32x4 (&acc)[2][2][4][2], const Unit& u, int, int wr, int wc, int fr, int fq) const {
        const int pn = u.pn; bf16_t* base; int ldc, colt; float sc = 1.f;
        if (pn < 2) { base = z; ldc = 512; colt = pn * 256; }
        else if (pn < 6) { base = xbc; ldc = 1024; colt = (pn - 2) * 256; }
        else if (pn < 8) { base = q; ldc = 512; colt = (pn - 6) * 256; sc = C2; }
        else if (pn < 10) { base = k; ldc = 512; colt = (pn - 8) * 256; }
        else { base = v; ldc = 512; colt = (pn - 10) * 256; }
        const int row0 = u.pm * BM + wr * 64 + fr;
        const int col0 = colt + wc * 32 + 8 * fq, bcol0 = pn * BM + (pn >= 6 ? 8 : 0) + wc * 32 + 8 * fq;
        f32x4 bv[2][2];
#pragma unroll
        for (int bj = 0; bj < 2; ++bj)
#pragma unroll
            for (int n = 0; n < 2; ++n) bv[bj][n] = *(const f32x4*)(b_in + bcol0 + bj * HALF + 4 * n);
#pragma unroll
        for (int ai = 0; ai < 2; ++ai)
#pragma unroll
            for (int m = 0; m < 4; ++m) { bf16_t* rowp = base + (size_t)(row0 + ai * HALF + m * 16) * ldc + col0;
#pragma unroll
                for (int bj = 0; bj < 2; ++bj) { f32x4 v0 = (acc[ai][bj][m][0] + bv[bj][0]) * sc, v1 = (acc[ai][bj][m][1] + bv[bj][1]) * sc;
                    u32x4 w; w.x = cvt_pk_bf16(v0[0], v0[1]); w.y = cvt_pk_bf16(v0[2], v0[3]); w.z = cvt_pk_bf16(v1[0], v1[1]); w.w = cvt_pk_bf16(v1[2], v1[3]);
                    *(u32x4*)(rowp + bj * HALF) = w; } }
    }
};

struct EpiOutproj {
    static constexpr bool PERM = true, AFTER_DRAIN = false;
    bf16_t* mix;
    __device__ __forceinline__ void operator()(const f32x4 (&acc)[2][2][4][2], const Unit& u, int, int wr, int wc, int fr, int fq) const {
        const int col0 = u.pn * BM + wc * 32 + 8 * fq;
#pragma unroll
        for (int ai = 0; ai < 2; ++ai)
#pragma unroll
            for (int m = 0; m < 4; ++m) { bf16_t* rowp = mix + (size_t)(u.pm * BM + ai * HALF + wr * 64 + m * 16 + fr) * D + col0;
#pragma unroll
                for (int bj = 0; bj < 2; ++bj) { const f32x4 v0 = acc[ai][bj][m][0], v1 = acc[ai][bj][m][1];
                    u32x4 w; w.x = cvt_pk_bf16(v0[0], v0[1]); w.y = cvt_pk_bf16(v0[2], v0[3]); w.z = cvt_pk_bf16(v1[0], v1[1]); w.w = cvt_pk_bf16(v1[2], v1[3]);
                    *(u32x4*)(rowp + bj * HALF) = w; } }
    }
};

struct MoeGeo {
    const PG8_LAS int* tab;
    __device__ __forceinline__ int np() const { return tab[24]; }
    __device__ __forceinline__ int cls_of(int panel) const { int c = 0;
#pragma unroll 1
        for (int j = 1; j < 24; ++j) if (panel >= tab[j]) c = j;
        return c; }
};
struct MoeOrder {
    int total, npn, G, c;
    __device__ __forceinline__ bool next(int i, Unit& u) const { const int L = i * G + c; if (L >= total) return false; u.pm = L / npn; u.pn = L % npn; return true; }
};
struct Moe1Prob {
    static constexpr bool GATHER = true;
    const bf16_t* A; const bf16_t* Wgu; MoeGeo geo; const PG8_LAS unsigned* rofftab; int lda, ldb, nt;
    __device__ __forceinline__ const char* a_base(const Unit&) const { return (const char*)A; }
    __device__ __forceinline__ void b_base(const Unit& u, const char*& b0, const char*& b1) const { int ea, eb; cls_experts(geo.cls_of(u.pm), ea, eb); const int e = u.pn < 4 ? ea : eb;
        b0 = (const char*)(Wgu + (size_t)((e * 4 + (u.pn & 3)) * 256) * 1024); b1 = b0; }
    __device__ __forceinline__ int ksplit() const { return nt; }
    __device__ __forceinline__ unsigned rowoff(int slot, int r) const { return rofftab[slot * 256 + r]; }
};
__device__ __forceinline__ float silu_fast(float g) { return g * __builtin_amdgcn_rcpf(1.f + __builtin_amdgcn_exp2f(-g * LOG2E)); }
struct EpiMoe1 {
    static constexpr bool PERM = true, AFTER_DRAIN = false;
    bf16_t* act; const float* tokinfo; const PG8_LAS int* toktab;
    __device__ __forceinline__ void operator()(const f32x4 (&acc)[2][2][4][2], const Unit& u, int slot, int wr, int wc, int fr, int fq) const {
        const int ex = u.pn >> 2; const int col0 = ex * 512 + (u.pn & 3) * 128 + wc * 32 + 8 * fq;
#pragma unroll
        for (int ai = 0; ai < 2; ++ai)
#pragma unroll
            for (int m = 0; m < 4; ++m) { const int r = ai * HALF + wr * 64 + m * 16 + fr; const int tok = toktab[slot * 256 + r];
                const float w = tok >= 0 ? tokinfo[(size_t)tok * 4 + 2 + ex] : 0.f;
                const f32x4 g0 = acc[ai][0][m][0], g1 = acc[ai][0][m][1], u0 = acc[ai][1][m][0], u1 = acc[ai][1][m][1];
                float o[8];
#pragma unroll
                for (int j = 0; j < 4; ++j) { o[j] = silu_fast(g0[j]) * u0[j] * w; o[4 + j] = silu_fast(g1[j]) * u1[j] * w; }
                u32x4 wv; wv.x = cvt_pk_bf16(o[0], o[1]); wv.y = cvt_pk_bf16(o[2], o[3]); wv.z = cvt_pk_bf16(o[4], o[5]); wv.w = cvt_pk_bf16(o[6], o[7]);
                *(u32x4*)(act + (size_t)(u.pm * BM + r) * 1024 + col0) = wv; }
    }
};
struct Moe2Prob {
    static constexpr bool GATHER = false;
    const bf16_t* A; const bf16_t* Wd; MoeGeo geo; int lda, ldb, nt;
    __device__ __forceinline__ const char* a_base(const Unit& u) const { return (const char*)(A + (size_t)u.pm * BM * lda); }
    __device__ __forceinline__ void b_base(const Unit& u, const char*& b0, const char*& b1) const { int ea, eb; cls_experts(geo.cls_of(u.pm), ea, eb);
        b0 = (const char*)(Wd + ((size_t)ea * 1024 + u.pn * 256) * 512); b1 = (const char*)(Wd + ((size_t)eb * 1024 + u.pn * 256) * 512); }
    __device__ __forceinline__ int ksplit() const { return 8; }
    __device__ __forceinline__ unsigned rowoff(int, int) const { return 0u; }
};
struct EpiMoe2 {
    static constexpr bool PERM = true, AFTER_DRAIN = false;
    bf16_t* ffn; const PG8_LAS int* toktab;
    __device__ __forceinline__ void operator()(const f32x4 (&acc)[2][2][4][2], const Unit& u, int slot, int wr, int wc, int fr, int fq) const {
        const int col0 = u.pn * BM + wc * 32 + 8 * fq;
#pragma unroll
        for (int ai = 0; ai < 2; ++ai)
#pragma unroll
            for (int m = 0; m < 4; ++m) { const int r = ai * HALF + wr * 64 + m * 16 + fr; const int tok = toktab[slot * 256 + r];
                if (tok >= 0) { bf16_t* rowp = ffn + (size_t)tok * D + col0;
#pragma unroll
                    for (int bj = 0; bj < 2; ++bj) { const f32x4 v0 = acc[ai][bj][m][0], v1 = acc[ai][bj][m][1];
                        u32x4 w; w.x = cvt_pk_bf16(v0[0], v0[1]); w.y = cvt_pk_bf16(v0[2], v0[3]); w.z = cvt_pk_bf16(v1[0], v1[1]); w.w = cvt_pk_bf16(v1[2], v1[3]);
                        *(u32x4*)(rowp + bj * HALF) = w; } } }
    }
};
}

#include <cmath>
namespace attn_body {

using bf16=__hip_bfloat16;
#define ALAS __attribute__((address_space(3)))
using bf16x8=__attribute__((ext_vector_type(8)))short;
using s16x4=__attribute__((ext_vector_type(4)))short;
using f32x16=__attribute__((ext_vector_type(16)))float;
using u32x4=__attribute__((ext_vector_type(4)))unsigned;
constexpr int BATCH=16,NHEAD=8,SEQ=2048,D=64,DM=NHEAD*D,ODM=1024,OCOL=512;
constexpr int NW=8,QBLK=32,QB=QBLK*NW,KVBLK=64,NQB=SEQ/QB;
constexpr int ATTN_PITCH=DM, ATTN_UNIT_ROWS=QB;
__device__ __forceinline__ int crow(int r,int hi){return (r&3)+8*(r>>2)+4*hi;}
#define SBAR() __builtin_amdgcn_sched_barrier(0)
__device__ __forceinline__ void cmask(f32x16&p0,f32x16&p1,int jb,int qrel,int hi){
  const float NEG=-INFINITY; int kb=64*jb+4*hi;
  #pragma unroll
  for(int r=0;r<16;++r){int kv=kb+(r&3)+8*(r>>2); if(kv>qrel)p0[r]=NEG; if(kv+32>qrel)p1[r]=NEG;}
}

constexpr int NSLOT=3, SLOTB=9216, KXOFF=8192;
constexpr int LDS_K=0, LDS_V=NSLOT*SLOTB, LDS_WS=2*NSLOT*SLOTB, LDS_OST=LDS_WS+NW*64*4, LDS_BYTES=LDS_OST+NW*4096;
constexpr float C2=0.125f*1.4426950408889634f;
__device__ __forceinline__ void glds16(const void*gsrc,unsigned lds_dst){unsigned keep;
  asm volatile("s_mov_b32 %0, m0\n\ts_mov_b32 m0, %2\n\ts_nop 0\n\tglobal_load_lds_dwordx4 %1, off\n\ts_mov_b32 m0, %0":"=&s"(keep):"v"(gsrc),"s"(lds_dst):"memory");}
__device__ __forceinline__ float max3f(float a,float b,float c){float r;asm("v_max3_f32 %0, %1, %2, %3":"=v"(r):"v"(a),"v"(b),"v"(c));return r;}
__device__ __forceinline__ float max2f(float a,float b){float r;asm("v_max_f32_e32 %0, %1, %2":"=v"(r):"v"(a),"v"(b));return r;}
__device__ __forceinline__ float fadd_s(float a,float b){float r;asm("v_add_f32_e32 %0, %1, %2":"=v"(r):"v"(a),"v"(b));return r;}
__device__ __forceinline__ float fsub_s(float a,float b){float r;asm("v_sub_f32_e32 %0, %1, %2":"=v"(r):"v"(a),"v"(b));return r;}
typedef float f32x2_t __attribute__((ext_vector_type(2))); typedef __bf16 bf16x2_t __attribute__((ext_vector_type(2)));
__device__ __forceinline__ unsigned cvtpk_s(float lo,float hi){f32x2_t v={lo,hi};bf16x2_t b=__builtin_convertvector(v,bf16x2_t);return __builtin_bit_cast(unsigned,b);}
#define WAIT_BAR(N) asm volatile("s_waitcnt vmcnt(" #N ") lgkmcnt(0)\n\ts_barrier":::"memory")
#define WAIT_BARK(N,N0) do{ if(wid==0){WAIT_BAR(N0);} else {WAIT_BAR(N);} }while(0)

__device__ __forceinline__ void qkt(f32x16&p0,f32x16&p1,const char*Kslot,const bf16x8*qr,const bf16x8 qr4,const f32x16&negm,int r32,int hi){
  const char*kb=Kslot+hi*1024+r32*16;
  #pragma unroll
  for(int d0=0;d0<4;++d0){
    const bf16x8 b0=*reinterpret_cast<const bf16x8*>(kb+d0*2048);
    const bf16x8 b1=*reinterpret_cast<const bf16x8*>(kb+d0*2048+512);
    if(d0==0){p0=__builtin_amdgcn_mfma_f32_32x32x16_bf16(b0,qr[0],negm,0,0,0);p1=__builtin_amdgcn_mfma_f32_32x32x16_bf16(b1,qr[0],negm,0,0,0);}
    else{p0=__builtin_amdgcn_mfma_f32_32x32x16_bf16(b0,qr[d0],p0,0,0,0);p1=__builtin_amdgcn_mfma_f32_32x32x16_bf16(b1,qr[d0],p1,0,0,0);}}
  { const bf16x8 x0=*reinterpret_cast<const bf16x8*>(Kslot+KXOFF+r32*16); const bf16x8 x1=*reinterpret_cast<const bf16x8*>(Kslot+KXOFF+r32*16+512);
    p0=__builtin_amdgcn_mfma_f32_32x32x16_bf16(x0,qr4,p0,0,0,0);p1=__builtin_amdgcn_mfma_f32_32x32x16_bf16(x1,qr4,p1,0,0,0); }
}
typedef __attribute__((address_space(3))) const char* lds_cptr;
typedef short v4i16_t __attribute__((ext_vector_type(4)));
__device__ __forceinline__ void kload8(bf16x8*kf,lds_cptr kp){
  kf[0]=*(const __attribute__((address_space(3))) bf16x8*)(kp);      kf[1]=*(const __attribute__((address_space(3))) bf16x8*)(kp+512);
  kf[2]=*(const __attribute__((address_space(3))) bf16x8*)(kp+2048); kf[3]=*(const __attribute__((address_space(3))) bf16x8*)(kp+2560);
  kf[4]=*(const __attribute__((address_space(3))) bf16x8*)(kp+4096); kf[5]=*(const __attribute__((address_space(3))) bf16x8*)(kp+4608);
  kf[6]=*(const __attribute__((address_space(3))) bf16x8*)(kp+6144); kf[7]=*(const __attribute__((address_space(3))) bf16x8*)(kp+6656);
}
__device__ __forceinline__ void kload2(bf16x8*kf,lds_cptr kp,int j){ kf[2*j]=*(const __attribute__((address_space(3))) bf16x8*)(kp+j*2048); kf[2*j+1]=*(const __attribute__((address_space(3))) bf16x8*)(kp+j*2048+512); }
__device__ __forceinline__ s16x4 vtr(lds_cptr p){ return __builtin_bit_cast(s16x4,__builtin_amdgcn_ds_read_tr16_b64_v4i16((__attribute__((address_space(3))) v4i16_t*)p)); }
__device__ __forceinline__ float rowmax(const f32x16&p0,const f32x16&p1){
  float a=max3f(p0[0],p0[1],p1[0]),b=max3f(p0[2],p0[3],p1[1]);a=max3f(a,p1[2],p1[3]);
  #pragma unroll
  for(int r=4;r<16;r+=4){a=max3f(a,p0[r],p0[r+1]);b=max3f(b,p0[r+2],p0[r+3]);a=max3f(a,p1[r],p1[r+1]);b=max3f(b,p1[r+2],p1[r+3]);}
  const float m=max2f(a,b);
  auto rr=__builtin_amdgcn_permlane32_swap(__float_as_uint(m),__float_as_uint(m),false,false);
  return max2f(__uint_as_float(rr[0]),__uint_as_float(rr[1]));
}
__device__ __forceinline__ void pv(f32x16*o,int vb,bf16x8 pa0,bf16x8 pa1,bf16x8 pa2,bf16x8 pa3){
  #pragma unroll
  for(int d0=0;d0<2;++d0){s16x4 lo[4],hi[4];
    #pragma unroll
    for(int ks=0;ks<4;++ks){
      asm volatile("ds_read_b64_tr_b16 %0,%1 offset:%c2":"=&v"(lo[ks]):"v"(vb),"i"(d0*4096+ks*1024):"memory");
      asm volatile("ds_read_b64_tr_b16 %0,%1 offset:%c2":"=&v"(hi[ks]):"v"(vb),"i"(d0*4096+ks*1024+512):"memory");}
    asm volatile("s_waitcnt lgkmcnt(0)":::"memory");SBAR();
    #define PK(k) (bf16x8){lo[k][0],lo[k][1],lo[k][2],lo[k][3],hi[k][0],hi[k][1],hi[k][2],hi[k][3]}
    o[d0]=__builtin_amdgcn_mfma_f32_32x32x16_bf16(pa0,PK(0),o[d0],0,0,0);
    o[d0]=__builtin_amdgcn_mfma_f32_32x32x16_bf16(pa1,PK(1),o[d0],0,0,0);
    o[d0]=__builtin_amdgcn_mfma_f32_32x32x16_bf16(pa2,PK(2),o[d0],0,0,0);
    o[d0]=__builtin_amdgcn_mfma_f32_32x32x16_bf16(pa3,PK(3),o[d0],0,0,0);
    #undef PK
  }
}

#ifndef ATTN_STORE16
#define ATTN_STORE16(p,v) (*(u32x4*)(p)=(v))
#endif
template<int THRL> __device__ __forceinline__ void attn_unit(int b,int h,int qb,const bf16*Q,const bf16*__restrict__ K,const bf16*__restrict__ V,const bf16*__restrict__ KX,bf16*O,char*shm){
  const int tid=threadIdx.x,lane=tid&63,r32=lane&31,hi=lane>>5; const int wid=__builtin_amdgcn_readfirstlane(tid>>6);
  const long rowbase=(long)b*SEQ; const int q0=qb*QB;
  const bf16*Qw=Q+(rowbase+q0+wid*QBLK)*DM+h*D;
  const bf16*Kh=K+rowbase*DM+h*D,*Vh=V+rowbase*DM+h*D;
  const unsigned lds0=(unsigned)(uintptr_t)shm;
  float*wsf=(float*)(shm+LDS_WS)+wid*64;
  const bf16*ksrc=Kh+(long)lane*DM+wid*8;
  const bf16*vsrc=Vh+(long)(16*(wid&3)+(lane>>2))*DM+(wid>>2)*32+(lane&3)*8;
  const unsigned kdst=lds0+LDS_K+wid*1024, vdst=lds0+LDS_V+wid*1024, kxdst=lds0+LDS_K+KXOFF;
  const bf16*kxsrc=KX+((rowbase+lane)*NHEAD+h)*8;
  #define DMA_K(t,slot) do{ glds16(ksrc+(long)(t)*KVBLK*DM,(unsigned)__builtin_amdgcn_readfirstlane(kdst+(slot))); if(wid==0) glds16(kxsrc+(long)(t)*KVBLK*NHEAD*8,(unsigned)__builtin_amdgcn_readfirstlane(kxdst+(slot))); }while(0)
  #define DMA_V(t,slot) glds16(vsrc+(long)(t)*KVBLK*DM,(unsigned)__builtin_amdgcn_readfirstlane(vdst+(slot)))
  const int vb0=(int)(lds0+LDS_V)+((lane>>4)&1)*32+(lane&3)*8+(4*hi+((lane&15)>>2))*64;
  const char*Kbase=shm+LDS_K; bf16x8 kf[8]; bf16x8 kx0,kx1;
  const lds_cptr shm3=(lds_cptr)shm; const lds_cptr kxp0=shm3+LDS_K+KXOFF+r32*16; const lds_cptr kp0=shm3+LDS_K+hi*1024+r32*16; const lds_cptr vp0=shm3+LDS_V+((lane>>4)&1)*32+(lane&3)*8+(4*hi+((lane&15)>>2))*64;
  const int NT=(q0+QB)/KVBLK;
  DMA_K(0,0);DMA_V(0,0);DMA_K(1,SLOTB);
  bf16x8 qr[4]; bf16x8 qr4={0,0,0,0,0,0,0,0}; if(hi==0){qr4[0]=(short)0x3F80;qr4[1]=(short)0x3F80;qr4[2]=(short)0x3F80;}
  #pragma unroll
  for(int d0=0;d0<4;++d0)qr[d0]=*reinterpret_cast<const bf16x8*>(&Qw[(long)r32*DM+d0*16+hi*8]);
  float mhat=0.f,l_reg=0.f;f32x16 o[2];o[0]=f32x16{};o[1]=f32x16{};f32x16 negm=f32x16{};asm volatile("":"+v"(negm));
  const int qrel=wid*QBLK+r32;
  #define CMASK(P0,P1,t) do{int jb_=(t)-(NT-4); if(jb_>=0)cmask(P0,P1,jb_,qrel,hi);}while(0)
  bool resc=false;
  #define START(P0,P1) do{ const float rm=rowmax(P0,P1); resc=false; \
    { const float dl=rm; mhat=fadd_s(mhat,dl); \
      _Pragma("unroll") for(int r=0;r<16;++r){P0[r]=fsub_s(P0[r],dl);P1[r]=fsub_s(P1[r],dl);} \
      _Pragma("unroll") for(int r=0;r<16;++r)negm[r]=-mhat; asm volatile("":"+v"(negm)); } \
    _Pragma("unroll") for(int r=0;r<16;++r)P0[r]=__builtin_amdgcn_exp2f(P0[r]); }while(0)
  #define RESC() do{ if(resc){ asm volatile("s_waitcnt lgkmcnt(0)":::"memory"); \
      _Pragma("unroll") for(int d_=0;d_<2;++d_) _Pragma("unroll") for(int r=0;r<16;++r)o[d_][r]*=wsf[crow(r,hi)]; } }while(0)
  f32x16 pA0,pA1,pB0,pB1;
  int sl_prev=0,sl_cur=0,sl_next=SLOTB;
  #define ROT() do{sl_prev=sl_cur;sl_cur=sl_next;sl_next=(sl_next==(NSLOT-1)*SLOTB)?0:sl_next+SLOTB;}while(0)
  DMA_K(2,2*SLOTB);
  WAIT_BARK(3,5);
  qkt(pA0,pA1,Kbase,qr,qr4,negm,r32,hi);asm volatile("s_nop 15\n\ts_nop 7":"+v"(pA0),"+v"(pA1));CMASK(pA0,pA1,0);
  START(pA0,pA1);
  _Pragma("unroll") for(int r=0;r<16;++r)pA1[r]=__builtin_amdgcn_exp2f(pA1[r]);
  WAIT_BAR(0);
  DMA_K(3,0);DMA_V(1,SLOTB);
  ROT();
  kload8(kf,kp0+sl_cur); kx0=*(const ALAS bf16x8*)(kxp0+sl_cur); kx1=*(const ALAS bf16x8*)(kxp0+sl_cur+512);
  WAIT_BARK(2,3);
  s16x4 vlo[8],vhi[8]; u32x4 pw0,pw1,pw2,pw3;
  #define PKW(P,B) cvtpk_s(P[B],P[B+1])
  #define PAF(k) __builtin_bit_cast(bf16x8,pw##k)
  #define VFR(i) (bf16x8){vlo[i][0],vlo[i][1],vlo[i][2],vlo[i][3],vhi[i][0],vhi[i][1],vhi[i][2],vhi[i][3]}
  #define PIN(x) asm volatile("":"+v"(x))
  #define MX3(a,b,c) __builtin_fmaxf(__builtin_fmaxf((a),(b)),(c))
  #define GAPA(MF,A0,A1,A2,A3,W0,W1,PW) do{ MF; sacc+=A0; sacc+=A1; sacc+=A2; sacc+=A3; PIN(sacc); W0; W1; PIN(PW); SBAR(); }while(0)
  #define EX(v) __builtin_amdgcn_exp2f(v)
  #define GAPB(MF,X,B) do{ MF; X[B]=EX(X[B]); X[B+1]=EX(X[B+1]); X[B+2]=EX(X[B+2]); X[B+3]=EX(X[B+3]); PIN(X); SBAR(); }while(0)
  #define VRD(i) do{ vlo[i]=vtr(vp_+(((i)>>2)*4096+((i)&3)*1024)); vhi[i]=vtr(vp_+(((i)>>2)*4096+((i)&3)*1024+512)); }while(0)
  #define KRD(G,j) do{ if(G){ kload2(kf,kp0+sl_next,j); SBAR(); } }while(0)
  #define STEP(C0,C1,P0,P1,t,GK,GV,GL) do{ SBAR(); \
    const lds_cptr vp_=vp0+sl_prev; \
    VRD(0); SBAR(); float sacc=(P0[0]+P0[1]); \
    GAPA(C0=__builtin_amdgcn_mfma_f32_32x32x16_bf16(kf[0],qr[0],negm,0,0,0), P0[2],P0[3],P0[4],P0[5],     pw0[0]=PKW(P0,0), pw0[1]=PKW(P0,2), pw0); \
    VRD(4); SBAR(); GAPA(C1=__builtin_amdgcn_mfma_f32_32x32x16_bf16(kf[1],qr[0],negm,0,0,0), P0[6],P0[7],P0[8],P0[9],     pw0[2]=PKW(P0,4), pw0[3]=PKW(P0,6), pw0); \
    VRD(1); SBAR(); GAPA(C0=__builtin_amdgcn_mfma_f32_32x32x16_bf16(kf[2],qr[1],C0,0,0,0),   P0[10],P0[11],P0[12],P0[13], pw1[0]=PKW(P0,8), pw1[1]=PKW(P0,10), pw1); \
    VRD(5); SBAR(); GAPA(C1=__builtin_amdgcn_mfma_f32_32x32x16_bf16(kf[3],qr[1],C1,0,0,0),   P0[14],P0[15],P1[0],P1[1],   pw1[2]=PKW(P0,12),pw1[3]=PKW(P0,14), pw1); \
    VRD(2); SBAR(); GAPA(C0=__builtin_amdgcn_mfma_f32_32x32x16_bf16(kf[4],qr[2],C0,0,0,0),   P1[2],P1[3],P1[4],P1[5],     pw2[0]=PKW(P1,0), pw2[1]=PKW(P1,2), pw2); \
    VRD(6); SBAR(); GAPA(C1=__builtin_amdgcn_mfma_f32_32x32x16_bf16(kf[5],qr[2],C1,0,0,0),   P1[6],P1[7],P1[8],P1[9],     pw2[2]=PKW(P1,4), pw2[3]=PKW(P1,6), pw2); \
    VRD(3); SBAR(); GAPA(C0=__builtin_amdgcn_mfma_f32_32x32x16_bf16(kf[6],qr[3],C0,0,0,0),   P1[10],P1[11],P1[12],P1[13], pw3[0]=PKW(P1,8), pw3[1]=PKW(P1,10), pw3); \
    VRD(7); SBAR(); GAPA(C1=__builtin_amdgcn_mfma_f32_32x32x16_bf16(kf[7],qr[3],C1,0,0,0),   P1[14],P1[15],0.f,0.f,       pw3[2]=PKW(P1,12),pw3[3]=PKW(P1,14), pw3); \
    C0=__builtin_amdgcn_mfma_f32_32x32x16_bf16(kx0,qr4,C0,0,0,0); C1=__builtin_amdgcn_mfma_f32_32x32x16_bf16(kx1,qr4,C1,0,0,0); SBAR(); \
    l_reg+=sacc; \
    if(GK){DMA_K((t)+3,sl_cur);} if(GV){DMA_V((t)+1,sl_next);} \
    CMASK(C0,C1,t); \
    { float a=MX3(C0[0],C0[1],C1[0]),b=MX3(C0[2],C0[3],C1[1]); a=MX3(a,C1[2],C1[3]); \
      _Pragma("unroll") for(int r=4;r<16;r+=4){a=MX3(a,C0[r],C0[r+1]);b=MX3(b,C0[r+2],C0[r+3]);a=MX3(a,C1[r],C1[r+1]);b=MX3(b,C1[r+2],C1[r+3]);} \
      float rm=__builtin_fmaxf(a,b); { auto rr=__builtin_amdgcn_permlane32_swap(__float_as_uint(rm),__float_as_uint(rm),false,false); rm=__builtin_fmaxf(__uint_as_float(rr[0]),__uint_as_float(rr[1])); } \
      resc=false; \
      if(__builtin_expect(__any(rm>(float)THRL),0)){ const float dl=__builtin_fmaxf(rm,0.f); mhat+=dl; \
        _Pragma("unroll") for(int r=0;r<16;++r){C0[r]-=dl;C1[r]-=dl;} \
        _Pragma("unroll") for(int r=0;r<16;++r)negm[r]=-mhat; asm volatile("":"+v"(negm)); \
        const float f=__builtin_amdgcn_exp2f(-dl); l_reg*=f; if(hi==0)wsf[r32]=f; resc=true; } } \
    SBAR(); \
    GAPB(o[0]=__builtin_amdgcn_mfma_f32_32x32x16_bf16(PAF(0),VFR(0),o[0],0,0,0), C0,0); \
    GAPB(o[1]=__builtin_amdgcn_mfma_f32_32x32x16_bf16(PAF(0),VFR(4),o[1],0,0,0), C0,4); \
    KRD(GL,0); GAPB(o[0]=__builtin_amdgcn_mfma_f32_32x32x16_bf16(PAF(1),VFR(1),o[0],0,0,0), C0,8); \
    KRD(GL,1); GAPB(o[1]=__builtin_amdgcn_mfma_f32_32x32x16_bf16(PAF(1),VFR(5),o[1],0,0,0), C0,12); \
    KRD(GL,2); GAPB(o[0]=__builtin_amdgcn_mfma_f32_32x32x16_bf16(PAF(2),VFR(2),o[0],0,0,0), C1,0); \
    KRD(GL,3); GAPB(o[1]=__builtin_amdgcn_mfma_f32_32x32x16_bf16(PAF(2),VFR(6),o[1],0,0,0), C1,4); \
    if(GL){ kx0=*(const ALAS bf16x8*)(kxp0+sl_next); kx1=*(const ALAS bf16x8*)(kxp0+sl_next+512); SBAR(); } \
    GAPB(o[0]=__builtin_amdgcn_mfma_f32_32x32x16_bf16(PAF(3),VFR(3),o[0],0,0,0), C1,8); \
    GAPB(o[1]=__builtin_amdgcn_mfma_f32_32x32x16_bf16(PAF(3),VFR(7),o[1],0,0,0), C1,12); \
    }while(0)
  int t=1;
  #undef CMASK
  #define CMASK(P0,P1,t) do{}while(0)
  for(;t+5<NT;t+=2){
    STEP(pB0,pB1,pA0,pA1,t,true,true,true);     WAIT_BARK(2,3); RESC(); ROT();
    STEP(pA0,pA1,pB0,pB1,t+1,true,true,true);   WAIT_BARK(2,3); RESC(); ROT();
  }
  #undef CMASK
  #define CMASK(P0,P1,t) do{int jb_=(t)-(NT-4); if(jb_>=0)cmask(P0,P1,jb_,qrel,hi);}while(0)
  #define ENDW(tt) do{ if((tt)+3<NT){WAIT_BARK(2,3);} else if((tt)+2<NT){WAIT_BAR(1);} else {WAIT_BAR(0);} }while(0)
  for(;t+1<NT;t+=2){
    STEP(pB0,pB1,pA0,pA1,t,(t+3<NT),(t+1<NT),(t+1<NT));       ENDW(t);   RESC(); ROT();
    STEP(pA0,pA1,pB0,pB1,t+1,(t+4<NT),(t+2<NT),(t+2<NT));     ENDW(t+1); RESC(); ROT();
  }
  STEP(pB0,pB1,pA0,pA1,NT-1,false,false,false); RESC();
  { float sacc=pB0[0]+pB0[1]; _Pragma("unroll") for(int r=2;r<16;++r)sacc+=pB0[r]; _Pragma("unroll") for(int r=0;r<16;++r)sacc+=pB1[r]; l_reg+=sacc;
    pw0=(u32x4){PKW(pB0,0),PKW(pB0,2),PKW(pB0,4),PKW(pB0,6)};pw1=(u32x4){PKW(pB0,8),PKW(pB0,10),PKW(pB0,12),PKW(pB0,14)};pw2=(u32x4){PKW(pB1,0),PKW(pB1,2),PKW(pB1,4),PKW(pB1,6)};pw3=(u32x4){PKW(pB1,8),PKW(pB1,10),PKW(pB1,12),PKW(pB1,14)};
    SBAR(); pv(o,vb0+sl_cur,PAF(0),PAF(1),PAF(2),PAF(3)); }
  #undef PKW
  #undef PAF
  #undef VFR
  #undef PIN
  #undef MX3
  #undef GAPA
  #undef GAPB
  #undef EX
  #undef VRD
  #undef KRD
  #undef STEP
  #undef ENDW
  {auto rr=__builtin_amdgcn_permlane32_swap(__float_as_uint(l_reg),__float_as_uint(l_reg),false,false);l_reg=__uint_as_float(rr[0])+__uint_as_float(rr[1]);}
  if(hi==0)wsf[32+r32]=l_reg;asm volatile("s_waitcnt lgkmcnt(0)":::"memory");
  float rli[16];
  #pragma unroll
  for(int r=0;r<16;++r)rli[r]=__builtin_amdgcn_rcpf(wsf[32+crow(r,hi)]);
  bf16*Ow=O+(rowbase+q0+wid*QBLK)*ODM+OCOL+h*D;
  { bf16*stg=(bf16*)(shm+LDS_OST)+wid*2048;
    #pragma unroll
    for(int r=0;r<16;++r){const int orow=crow(r,hi);
      #pragma unroll
      for(int d0=0;d0<2;++d0)stg[orow*64+d0*32+r32]=__float2bfloat16(o[d0][r]*rli[r]);}
    asm volatile("s_waitcnt lgkmcnt(0)":::"memory");
    #pragma unroll
    for(int i=0;i<4;++i){const int row=i*8+(lane>>3),ch=lane&7; const u32x4 v=*(const u32x4*)(stg+row*64+ch*8); ATTN_STORE16(Ow+(long)row*ODM+ch*8,v);} }
  asm volatile("s_waitcnt lgkmcnt(0)\n\ts_barrier":::"memory");
  #undef DMA_K
  #undef DMA_V
  #undef CMASK
  #undef START
  #undef RESC
  #undef ROT
}
constexpr int ATTN_LDS_BYTES=LDS_BYTES;
struct AttnTensors { const bf16* Q; const bf16* K; const bf16* V; const bf16* KX; bf16* O; };
struct AttnUnit { int bh; int qb; };
struct StaticOrder {
  int vcu;
  __device__ __forceinline__ explicit StaticOrder(int grid,int block):vcu((block%8)*(grid/8)+block/8){}
  __device__ __forceinline__ bool next(int i,AttnUnit&u)const{ if(i>=4)return false; const int s=vcu&1; u.bh=vcu>>1; u.qb=(i==0)?(7-s):(i==1)?s:(i==2)?(5-s):(2+s); return true; }
  __device__ __forceinline__ void a_ready(const AttnUnit&)const{}
  __device__ __forceinline__ void done(const AttnUnit&)const{}
};
template<class Sched,int THRL=8> __device__ __forceinline__ void attn_phase(char*lds,const AttnTensors&T,const Sched&S){
  AttnUnit u;
  for(int i=0;S.next(i,u);++i){ S.a_ready(u); attn_unit<THRL>(u.bh/NHEAD,u.bh%NHEAD,u.qb,T.Q,T.K,T.V,T.KX,T.O,lds); S.done(u); }
}
#undef SBAR
#undef WAIT_BAR
}

namespace ssd {
typedef short bf16x8 __attribute__((ext_vector_type(8)));
typedef float f32x4 __attribute__((ext_vector_type(4)));
typedef unsigned u32x4 __attribute__((ext_vector_type(4)));
typedef unsigned u32x2 __attribute__((ext_vector_type(2)));
#define SLAS __attribute__((address_space(3)))
constexpr int LPB = 144;
constexpr int NPB = 272;
constexpr int NCH = SEQ / 64;
__device__ __forceinline__ unsigned pkbf(float lo, float hi) { unsigned r; asm volatile("v_cvt_pk_bf16_f32 %0, %1, %2" : "=v"(r) : "v"(lo), "v"(hi)); return r; }

__device__ __forceinline__ float chunk_acum(const float* dt, const float* a_log, int tok0, int h, int lane, float& dtv) {
    dtv = dt[(size_t)(tok0 + lane) * 8 + h];
    float A = dtv * (-expf(a_log[h]));
#pragma unroll
    for (int o = 1; o < 64; o <<= 1) { const float y = __shfl_up(A, o); if (lane >= o) A += y; }
    return A;
}


__device__ __forceinline__ void conv_chunk(const bf16_t* xbc, const float* cw, const float* cb, bf16_t* xcb, int b, int c) {
    const int tid = threadIdx.x, cg = tid & 127, rq = tid >> 7, ch0 = cg * 8, l0 = rq * 16;
    const size_t tok0 = (size_t)b * SEQ + c * 64;
    float w[4][8], bias[8];
#pragma unroll
    for (int k = 0; k < 4; ++k) { const f32x4 a = *(const f32x4*)(cw + k * 1024 + ch0), bq = *(const f32x4*)(cw + k * 1024 + ch0 + 4);
        w[k][0] = a[0]; w[k][1] = a[1]; w[k][2] = a[2]; w[k][3] = a[3]; w[k][4] = bq[0]; w[k][5] = bq[1]; w[k][6] = bq[2]; w[k][7] = bq[3]; }
    { const f32x4 a = *(const f32x4*)(cb + ch0), bq = *(const f32x4*)(cb + ch0 + 4); bias[0] = a[0]; bias[1] = a[1]; bias[2] = a[2]; bias[3] = a[3]; bias[4] = bq[0]; bias[5] = bq[1]; bias[6] = bq[2]; bias[7] = bq[3]; }
    float win[3][8];
#pragma unroll
    for (int k = 0; k < 3; ++k) { const int l = l0 - 3 + k; u32x4 v = (u32x4){0u, 0u, 0u, 0u};
        if (c * 64 + l >= 0) v = *(const u32x4*)(xbc + (tok0 + l) * 1024 + ch0);
#pragma unroll
        for (int j = 0; j < 4; ++j) { win[k][2 * j] = __uint_as_float(v[j] << 16); win[k][2 * j + 1] = __uint_as_float(v[j] & 0xffff0000u); } }
#pragma unroll
    for (int i = 0; i < 16; ++i) {
        const u32x4 v = *(const u32x4*)(xbc + (tok0 + l0 + i) * 1024 + ch0);
        float cur[8], o[8];
#pragma unroll
        for (int j = 0; j < 4; ++j) { cur[2 * j] = __uint_as_float(v[j] << 16); cur[2 * j + 1] = __uint_as_float(v[j] & 0xffff0000u); }
#pragma unroll
        for (int j = 0; j < 8; ++j) { const float a = bias[j] + w[0][j] * win[0][j] + w[1][j] * win[1][j] + w[2][j] * win[2][j] + w[3][j] * cur[j]; o[j] = a / (1.f + expf(-a)); }
        *(u32x4*)(xcb + (tok0 + l0 + i) * 1024 + ch0) = (u32x4){pkbf(o[0], o[1]), pkbf(o[2], o[3]), pkbf(o[4], o[5]), pkbf(o[6], o[7])};
#pragma unroll
        for (int j = 0; j < 8; ++j) { win[0][j] = win[1][j]; win[1][j] = win[2][j]; win[2][j] = cur[j]; }
    }
}


struct Conv8 {
    float w[4][8], bias[8]; u32x4 raw[11];
    __device__ __forceinline__ void load(const bf16_t* xbc, const float* cw, const float* cb, size_t tok0, int c, int col, int l0) {
#pragma unroll
        for (int k = 0; k < 4; ++k) { const f32x4 a = *(const f32x4*)(cw + k * 1024 + col), bq = *(const f32x4*)(cw + k * 1024 + col + 4);
            w[k][0] = a[0]; w[k][1] = a[1]; w[k][2] = a[2]; w[k][3] = a[3]; w[k][4] = bq[0]; w[k][5] = bq[1]; w[k][6] = bq[2]; w[k][7] = bq[3]; }
        { const f32x4 a = *(const f32x4*)(cb + col), bq = *(const f32x4*)(cb + col + 4); bias[0] = a[0]; bias[1] = a[1]; bias[2] = a[2]; bias[3] = a[3]; bias[4] = bq[0]; bias[5] = bq[1]; bias[6] = bq[2]; bias[7] = bq[3]; }
#pragma unroll
        for (int k = 0; k < 11; ++k) { const int l = l0 - 3 + k; raw[k] = (u32x4){0u, 0u, 0u, 0u}; if (c * 64 + l >= 0) raw[k] = *(const u32x4*)(xbc + (tok0 + l) * 1024 + col); }
    }
    __device__ __forceinline__ float val(int i, int j) const { float a = bias[j];
#pragma unroll
        for (int k = 0; k < 4; ++k) { const unsigned wv = raw[i + k][j >> 1]; a += w[k][j] * ((j & 1) ? __uint_as_float(wv & 0xffff0000u) : __uint_as_float(wv << 16)); }
        return a * __builtin_amdgcn_rcpf(1.f + __builtin_amdgcn_exp2f(-a * LOG2E)); }
};

__device__ __forceinline__ void states_unit(SLAS unsigned char* lds, const bf16_t* xbc, const float* cw, const float* cb, const float* dt, const float* a_log, bf16_t* S, float* cdec, int b, int c) {
    const int tid = threadIdx.x, lane = tid & 63, w = __builtin_amdgcn_readfirstlane(tid >> 6), r = lane & 15, q = lane >> 4;
    const int tok0 = b * SEQ + c * 64;
    SLAS float* warr = (SLAS float*)lds;
    SLAS unsigned char* BT = lds + 2048;
    SLAS unsigned char* XW = lds + 2048 + 128 * LPB;
    { float dtv; const float A = chunk_acum(dt, a_log, tok0, w, lane, dtv); const float A63 = __shfl(A, 63);
      warr[w * 64 + lane] = dtv * expf(A63 - A);
      if (lane == 63) cdec[(size_t)(b * NCH + c) * 8 + w] = expf(A63); }
    __syncthreads();
#pragma unroll 1
    for (int g = 0; g < 2; ++g) {
        if (lane < 48) {
            const bool isx = lane < 32; const int col = isx ? g * 256 + lane * 8 : 512 + g * 128 + (lane - 32) * 8; const int l0 = 8 * w;
            Conv8 cv; cv.load(xbc, cw, cb, (size_t)tok0, c, col, l0);
            float sc[8];
#pragma unroll
            for (int i = 0; i < 8; ++i) sc[i] = isx ? warr[(g * 4 + (lane >> 3)) * 64 + l0 + i] : 1.f;
            SLAS unsigned char* dstb = isx ? (XW + (lane * 8) * LPB) : (BT + ((lane - 32) * 8) * LPB);
#pragma unroll
            for (int j = 0; j < 8; ++j) { float o[8];
#pragma unroll
                for (int i = 0; i < 8; ++i) o[i] = cv.val(i, j) * sc[i];
                *(SLAS u32x4*)(dstb + j * LPB + l0 * 2) = (u32x4){pkbf(o[0], o[1]), pkbf(o[2], o[3]), pkbf(o[4], o[5]), pkbf(o[6], o[7])}; }
        }
        __syncthreads();
        f32x4 acc[8][2];
#pragma unroll
        for (int nt = 0; nt < 8; ++nt) { acc[nt][0] = (f32x4){0.f, 0.f, 0.f, 0.f}; acc[nt][1] = (f32x4){0.f, 0.f, 0.f, 0.f}; }
#pragma unroll
        for (int k = 0; k < 2; ++k) {
            bf16x8 xf[2];
#pragma unroll
            for (int ht = 0; ht < 2; ++ht) xf[ht] = *(const SLAS bf16x8*)(XW + (32 * w + 16 * ht + r) * LPB + (32 * k + 8 * q) * 2);
#pragma unroll
            for (int nt = 0; nt < 8; ++nt) { const bf16x8 bf = *(const SLAS bf16x8*)(BT + (16 * nt + r) * LPB + (32 * k + 8 * q) * 2);
#pragma unroll
                for (int ht = 0; ht < 2; ++ht) acc[nt][ht] = __builtin_amdgcn_mfma_f32_16x16x32_bf16(bf, xf[ht], acc[nt][ht], 0, 0, 0); }
        }
        const int h = g * 4 + (w >> 1);
#pragma unroll
        for (int ht = 0; ht < 2; ++ht) { const int p = (w & 1) * 32 + 16 * ht + r; bf16_t* dst = S + ((size_t)((b * NCH + c) * 8 + h) * 64 + p) * 128 + 4 * q;
#pragma unroll
            for (int nt = 0; nt < 8; ++nt) *(u32x2*)(dst + 16 * nt) = (u32x2){pkbf(acc[nt][ht][0], acc[nt][ht][1]), pkbf(acc[nt][ht][2], acc[nt][ht][3])}; }
        __syncthreads();
    }
}

__device__ __forceinline__ void scan_unit(bf16_t* S, const float* cdec, int bh, int half) {
    const int tid = threadIdx.x, b = bh >> 3, h = bh & 7;
    const size_t e0 = (size_t)(half * 512 + tid) * 8;
    float st[8];
#pragma unroll
    for (int i = 0; i < 8; ++i) st[i] = 0.f;
#pragma unroll 1
    for (int c0 = 0; c0 < NCH; c0 += 8) {
        u32x4 v[8];
#pragma unroll
        for (int j = 0; j < 8; ++j) v[j] = *(const u32x4*)(S + (size_t)((b * NCH + c0 + j) * 8 + h) * 8192 + e0);
#pragma unroll
        for (int j = 0; j < 8; ++j) {
            *(u32x4*)(S + (size_t)((b * NCH + c0 + j) * 8 + h) * 8192 + e0) = (u32x4){pkbf(st[0], st[1]), pkbf(st[2], st[3]), pkbf(st[4], st[5]), pkbf(st[6], st[7])};
            const float d = cdec[(size_t)(b * NCH + c0 + j) * 8 + h];
#pragma unroll
            for (int i = 0; i < 4; ++i) { const unsigned wv = v[j][i]; st[2 * i] = st[2 * i] * d + __uint_as_float(wv << 16); st[2 * i + 1] = st[2 * i + 1] * d + __uint_as_float(wv & 0xffff0000u); }
        }
    }
}

__device__ __forceinline__ void out_unit(SLAS unsigned char* lds, const bf16_t* xbc, const float* cw, const float* cb, const bf16_t* z, const float* dt, const float* a_log, const float* d_skip, const float* norm_g,
                                         const bf16_t* Sin, bf16_t* merged, int b, int c) {
    const int tid = threadIdx.x, lane = tid & 63, w = __builtin_amdgcn_readfirstlane(tid >> 6), r = lane & 15, q = lane >> 4;
    const int tok0 = b * SEQ + c * 64;
    SLAS float* Aarr = (SLAS float*)lds;
    SLAS float* dtarr = (SLAS float*)(lds + 2048);
    SLAS float* npart = (SLAS float*)(lds + 4096);
    SLAS unsigned char* Cg = lds + 6144;
    SLAS unsigned char* Bg = Cg + 64 * NPB;
    SLAS unsigned char* XT = Bg + 64 * NPB;
    SLAS unsigned char* Mm = XT + 256 * LPB;
    { float dtv; const float A = chunk_acum(dt, a_log, tok0, w, lane, dtv); Aarr[w * 64 + lane] = A; dtarr[w * 64 + lane] = dtv; }
    __syncthreads();
#pragma unroll 1
    for (int g = 0; g < 2; ++g) {
        bf16x8 sfr[4][2];
        { const int hE = g * 4 + (w >> 1); const bf16_t* sinE = Sin + ((size_t)((b * NCH + c) * 8 + hE) * 64 + (w & 1) * 32 + r) * 128 + 8 * q;
#pragma unroll
          for (int k = 0; k < 4; ++k)
#pragma unroll
              for (int ht = 0; ht < 2; ++ht) sfr[k][ht] = *(const bf16x8*)(sinE + (size_t)(16 * ht) * 128 + 32 * k);
 }
        { const int l0 = 8 * w; const int col = lane < 32 ? g * 256 + lane * 8 : (lane < 48 ? 512 + g * 128 + (lane - 32) * 8 : 768 + g * 128 + (lane - 48) * 8);
          Conv8 cv; cv.load(xbc, cw, cb, (size_t)tok0, c, col, l0);
          if (lane < 32) {
#pragma unroll
              for (int j = 0; j < 8; ++j) { float o[8];
#pragma unroll
                  for (int i = 0; i < 8; ++i) o[i] = cv.val(i, j);
                  *(SLAS u32x4*)(XT + (lane * 8 + j) * LPB + l0 * 2) = (u32x4){pkbf(o[0], o[1]), pkbf(o[2], o[3]), pkbf(o[4], o[5]), pkbf(o[6], o[7])}; }
          } else { SLAS unsigned char* dstb = lane < 48 ? (Bg + (lane - 32) * 16) : (Cg + (lane - 48) * 16);
#pragma unroll
              for (int i = 0; i < 8; ++i) { float o[8];
#pragma unroll
                  for (int j = 0; j < 8; ++j) o[j] = cv.val(i, j);
                  *(SLAS u32x4*)(dstb + (l0 + i) * NPB) = (u32x4){pkbf(o[0], o[1]), pkbf(o[2], o[3]), pkbf(o[4], o[5]), pkbf(o[6], o[7])}; } } }
        __syncthreads();
        {
            const int lt = w >> 1, st0 = 2 * (w & 1);
            f32x4 accG[2]; accG[0] = (f32x4){0.f, 0.f, 0.f, 0.f}; accG[1] = (f32x4){0.f, 0.f, 0.f, 0.f};
#pragma unroll
            for (int k = 0; k < 4; ++k) { const bf16x8 cf = *(const SLAS bf16x8*)(Cg + (16 * lt + r) * NPB + (32 * k + 8 * q) * 2);
#pragma unroll
                for (int j = 0; j < 2; ++j) { const bf16x8 bf = *(const SLAS bf16x8*)(Bg + (16 * (st0 + j) + r) * NPB + (32 * k + 8 * q) * 2); accG[j] = __builtin_amdgcn_mfma_f32_16x16x32_bf16(bf, cf, accG[j], 0, 0, 0); } }
            const int l = 16 * lt + r;
#pragma unroll
            for (int hh = 0; hh < 4; ++hh) { const int h = g * 4 + hh; const float Al = Aarr[h * 64 + l];
#pragma unroll
                for (int j = 0; j < 2; ++j) { const int s0 = 16 * (st0 + j) + 4 * q; float m[4];
#pragma unroll
                    for (int e = 0; e < 4; ++e) { const int s = s0 + e; m[e] = (s <= l) ? accG[j][e] * __builtin_amdgcn_exp2f((Al - Aarr[h * 64 + s]) * LOG2E) * dtarr[h * 64 + s] : 0.f; }
                    *(SLAS u32x2*)(Mm + hh * 64 * LPB + l * LPB + s0 * 2) = (u32x2){pkbf(m[0], m[1]), pkbf(m[2], m[3])}; } }
        }
        __syncthreads();
        {
            const int hh = w >> 1, h = g * 4 + hh;
            f32x4 acc[4][2];
#pragma unroll
            for (int lt = 0; lt < 4; ++lt) { acc[lt][0] = (f32x4){0.f, 0.f, 0.f, 0.f}; acc[lt][1] = (f32x4){0.f, 0.f, 0.f, 0.f}; }
#pragma unroll
            for (int k = 0; k < 4; ++k) { bf16x8 sf[2]; sf[0] = sfr[k][0]; sf[1] = sfr[k][1];
#pragma unroll
                for (int lt = 0; lt < 4; ++lt) { const bf16x8 cf = *(const SLAS bf16x8*)(Cg + (16 * lt + r) * NPB + (32 * k + 8 * q) * 2);
#pragma unroll
                    for (int ht = 0; ht < 2; ++ht) acc[lt][ht] = __builtin_amdgcn_mfma_f32_16x16x32_bf16(sf[ht], cf, acc[lt][ht], 0, 0, 0); } }
#pragma unroll
            for (int lt = 0; lt < 4; ++lt) { const float e = __builtin_amdgcn_exp2f(Aarr[h * 64 + 16 * lt + r] * LOG2E); acc[lt][0] = acc[lt][0] * e; acc[lt][1] = acc[lt][1] * e; }
#pragma unroll
            for (int k = 0; k < 2; ++k) { bf16x8 xf[2];
#pragma unroll
                for (int ht = 0; ht < 2; ++ht) xf[ht] = *(const SLAS bf16x8*)(XT + (32 * w + 16 * ht + r) * LPB + (32 * k + 8 * q) * 2);
#pragma unroll
                for (int lt = 0; lt < 4; ++lt) { const bf16x8 mf = *(const SLAS bf16x8*)(Mm + hh * 64 * LPB + (16 * lt + r) * LPB + (32 * k + 8 * q) * 2);
#pragma unroll
                    for (int ht = 0; ht < 2; ++ht) acc[lt][ht] = __builtin_amdgcn_mfma_f32_16x16x32_bf16(xf[ht], mf, acc[lt][ht], 0, 0, 0); } }
            const float dsk = d_skip[h];
            float ss[4];
#pragma unroll
            for (int lt = 0; lt < 4; ++lt) { const int l = 16 * lt + r; float s2 = 0.f;
#pragma unroll
                for (int ht = 0; ht < 2; ++ht) { const int ch = g * 256 + 32 * w + 16 * ht + 4 * q;
                    const u32x2 zv = *(const u32x2*)(z + (size_t)(tok0 + l) * 512 + ch);
                    float xs4[4];
#pragma unroll
                    for (int e = 0; e < 4; ++e) xs4[e] = bf2f(*(const SLAS bf16_t*)(XT + (32 * w + 16 * ht + 4 * q + e) * LPB + l * 2));
                    const float z4[4] = {__uint_as_float(zv.x << 16), __uint_as_float(zv.x & 0xffff0000u), __uint_as_float(zv.y << 16), __uint_as_float(zv.y & 0xffff0000u)};
#pragma unroll
                    for (int e = 0; e < 4; ++e) { const float y = acc[lt][ht][e] + dsk * xs4[e]; const float yg = y * z4[e] * __builtin_amdgcn_rcpf(1.f + __builtin_amdgcn_exp2f(-z4[e] * LOG2E)); acc[lt][ht][e] = yg; s2 += yg * yg; } }
                s2 += __shfl_xor(s2, 16); s2 += __shfl_xor(s2, 32); ss[lt] = s2; }
            if (q == 0) {
#pragma unroll
                for (int lt = 0; lt < 4; ++lt) npart[w * 64 + 16 * lt + r] = ss[lt]; }
            __syncthreads();
#pragma unroll
            for (int lt = 0; lt < 4; ++lt) { const int l = 16 * lt + r; float tot = 0.f;
#pragma unroll
                for (int ww = 0; ww < 8; ++ww) tot += npart[ww * 64 + l];
                const float rs = rsqrtf(tot * (1.f / 256.f) + RMS_EPS);
#pragma unroll
                for (int ht = 0; ht < 2; ++ht) { const int ch = g * 256 + 32 * w + 16 * ht + 4 * q; const f32x4 gv = *(const f32x4*)(norm_g + ch);
                    *(u32x2*)(merged + (size_t)(tok0 + l) * 1024 + ch) = (u32x2){pkbf(acc[lt][ht][0] * rs * gv[0], acc[lt][ht][1] * rs * gv[1]), pkbf(acc[lt][ht][2] * rs * gv[2], acc[lt][ht][3] * rs * gv[3])}; } }
        }
        __syncthreads();
    }
}
#undef SLAS
}

__global__ void k_convb(const bf16_t* xbc, const float* conv_w, const float* conv_b, bf16_t* xc) {
    const size_t idx = (size_t)blockIdx.x * 256 + threadIdx.x;
    const int c = (int)(idx & 1023); const int t = (int)(idx >> 10); const int s = t & (SEQ - 1);
    float acc = conv_b[c];
#pragma unroll
    for (int k = 0; k < 4; ++k) { const int ss = s - 3 + k; if (ss >= 0) acc += conv_w[k * 1024 + c] * bf2f(xbc[(size_t)(t - 3 + k) * 1024 + c]); }
    xc[idx] = f2bf(acc / (1.f + expf(-acc)));
}


constexpr int NWAVES = 8;
constexpr int RING_OFF = 0, RING_BYTES = 131072;
constexpr int LDSCTL_OFF = RING_BYTES, MISC_OFF = LDSCTL_OFF + 320;
constexpr int TAB_OFF = RING_BYTES + 1024;
constexpr int LDS_BYTES = 147456;
#define GAS __attribute__((address_space(1)))
#define LAS __attribute__((address_space(3)))
typedef unsigned v4u __attribute__((ext_vector_type(4)));
typedef float f32x4 __attribute__((ext_vector_type(4)));
typedef GAS unsigned gu32;
#define RLX_AGENT __ATOMIC_RELAXED, __HIP_MEMORY_SCOPE_AGENT
#define LDS_WAIT() asm volatile("s_waitcnt lgkmcnt(0)" ::: "memory")
#define VM_WAIT() asm volatile("s_waitcnt vmcnt(0)" ::: "memory")
__device__ __forceinline__ unsigned pk2(float lo, float hi) { return (unsigned)f2bf(lo) | ((unsigned)f2bf(hi) << 16); }

#define XB_TMO      128
#define XB_XCNT(j)  (256  + 64 * (j))
#define XB_XSUB(j)  (1280 + 64 * (j))
#define XB_XGEN(j)  (2304 + 64 * (j))
#define XB_TOP      3328
#define XB_TOPGEN   3392
#define XCD_BAR_WORDS 3456
#define XB_SPIN_CAP (1u << 18)
__device__ __forceinline__ unsigned xb_ld(unsigned* p)              { return __hip_atomic_load(p, __ATOMIC_RELAXED, __HIP_MEMORY_SCOPE_AGENT); }
__device__ __forceinline__ unsigned xb_add(unsigned* p, unsigned v) { return __hip_atomic_fetch_add(p, v, __ATOMIC_RELAXED, __HIP_MEMORY_SCOPE_AGENT); }
__device__ __forceinline__ unsigned xb_xcc_id() { return (unsigned)__builtin_amdgcn_s_getreg((3 << 11) | 20) & 0xFu; }
#define XB_SPIN(cond, bar) do { unsigned _sp = 0; while (cond) { __builtin_amdgcn_s_sleep(1); \
    if ((++_sp & 255u) == 0u) { if (xb_ld(&(bar)[XB_TMO])) break; if (_sp > XB_SPIN_CAP) { atomicAdd(&(bar)[XB_TMO], 1u); break; } } } } while (0)
struct XcdBarrier { unsigned* bar; unsigned x; volatile LAS unsigned* st; };
__device__ __forceinline__ XcdBarrier xcd_barrier_post(unsigned* bar, volatile LAS unsigned* st) {
    XcdBarrier b; b.bar = bar; b.x = xb_xcc_id(); b.st = st;
    if (threadIdx.x == 0) (void)xb_add(&bar[XB_XCNT(b.x)], 1u);
    return b;
}
__device__ __forceinline__ void xcd_barrier_complete(unsigned* bar, unsigned x, unsigned& nloc, unsigned& nx) {
    const unsigned G = gridDim.x * gridDim.y * gridDim.z;
    unsigned sum, cnt, mine, sp = 0u;
    for (;;) {
        sum = 0u; cnt = 0u; mine = 0u;
#pragma unroll
        for (unsigned j = 0; j < 16; ++j) { const unsigned c = xb_ld(&bar[XB_XCNT(j)]); sum += c; cnt += (c > 0u) ? 1u : 0u; mine = (j == x) ? c : mine; }
        if (sum == G) break;
        __builtin_amdgcn_s_sleep(1);
        if ((++sp & 255u) == 0u) { if (xb_ld(&bar[XB_TMO])) break; if (sp > XB_SPIN_CAP) { atomicAdd(&bar[XB_TMO], 1u); break; } }
    }
    nloc = mine > 0u ? mine : 1u; nx = cnt > 0u ? cnt : 1u;
}
__device__ __forceinline__ void xcd_barrier(const XcdBarrier& b) {
    asm volatile("s_waitcnt vmcnt(0)" ::: "memory");
    __syncthreads();
    if (threadIdx.x == 0) {
        unsigned* bar = b.bar;
        __builtin_amdgcn_s_waitcnt(0);
        unsigned nloc = b.st[0], nx = b.st[1];
        if (nloc == 0u) { xcd_barrier_complete(bar, b.x, nloc, nx); b.st[0] = nloc; b.st[1] = nx; }
        const unsigned old = xb_add(&bar[XB_XSUB(b.x)], 1u);
        const unsigned gen = old / nloc;
        if (old + 1u == (gen + 1u) * nloc) {
            __builtin_amdgcn_fence(__ATOMIC_RELEASE, "agent");
            asm volatile("s_waitcnt vmcnt(0)" ::: "memory");
            const unsigned og = xb_add(&bar[XB_TOP], 1u);
            const unsigned tg = og / nx;
            if (og + 1u == (tg + 1u) * nx) xb_add(&bar[XB_TOPGEN], 1u);
            else XB_SPIN(xb_ld(&bar[XB_TOPGEN]) == tg, bar);
            __builtin_amdgcn_fence(__ATOMIC_ACQUIRE, "agent");
            xb_add(&bar[XB_XGEN(b.x)], 1u);
            asm volatile("s_waitcnt vmcnt(0)" ::: "memory");
        } else {
            XB_SPIN(xb_ld(&bar[XB_XGEN(b.x)]) == gen, bar);
            __builtin_amdgcn_fence(__ATOMIC_ACQUIRE, "agent");
            asm volatile("s_waitcnt vmcnt(0)" ::: "memory");
        }
    }
    __syncthreads();
}

struct Frame {
    LAS unsigned char* lds;
    volatile LAS unsigned* MISC;
    gu32* ctl;
    int tid, lane, wave, vcu, G;
};
__device__ __forceinline__ int tid_now() { int t; asm volatile("v_mov_b32 %0, %1" : "=v"(t) : "v"(threadIdx.x)); return t; }
__device__ __forceinline__ int lane_now() { int l; asm volatile("v_and_b32 %0, 63, %1" : "=v"(l) : "v"(threadIdx.x)); return l; }
__device__ __forceinline__ float wave_sum(float v) {
#pragma unroll
    for (int o = 1; o < 64; o <<= 1) v += __shfl_xor(v, o);
    return v;
}

__device__ __forceinline__ void p0_transpose_item(const float* W, int ldw, int k0, int n0, bf16_t* WT, int ldt, int drow0, LAS float* scr, int lane) {
    float tv[32];
#pragma unroll
    for (int i = 0; i < 32; ++i) { const int kk = 2 * i + (lane >> 5); tv[i] = W[(size_t)(k0 + kk) * ldw + n0 + (lane & 31)]; }
#pragma unroll
    for (int i = 0; i < 32; ++i) { const int kk = 2 * i + (lane >> 5); scr[kk * 33 + (lane & 31)] = tv[i]; }
    LDS_WAIT(); asm volatile("" ::: "memory");
    const int c = lane & 7;
#pragma unroll
    for (int j = 0; j < 4; ++j) { const int n = (lane >> 3) + 8 * j; const LAS float* s = scr + (8 * c) * 33 + n;
        v4u o; o.x = pk2(s[0 * 33], s[1 * 33]); o.y = pk2(s[2 * 33], s[3 * 33]); o.z = pk2(s[4 * 33], s[5 * 33]); o.w = pk2(s[6 * 33], s[7 * 33]);
        *(GAS v4u*)(WT + (size_t)(drow0 + n) * ldt + k0 + 8 * c) = o; }
    LDS_WAIT(); asm volatile("" ::: "memory");
}
__device__ __forceinline__ float softplus_d(float x) { return fmaxf(x, 0.f) + log1pf(expf(-fabsf(x))); }

__device__ __forceinline__ void p0_prologue(Frame& F, const P& p) {
    unsigned char* ws = p.ws;
    bf16_t* Win_t = (bf16_t*)(ws + WS_WIN); bf16_t* Wout_t = (bf16_t*)(ws + WS_WOUT); bf16_t* Wgu_t = (bf16_t*)(ws + WS_WGU); bf16_t* Wd_t = (bf16_t*)(ws + WS_WD);
    LAS float* scr = (LAS float*)(F.lds + RING_OFF + F.wave * 16384);
    const int gw = F.vcu * NWAVES + F.wave, NGW = F.G * NWAVES;
    constexpr int I_IN = 16 * 96, I_OUT = 16 * 32, I_GU = 16 * 2 * 256, I_D = 16 * 256, NITEMS = I_IN + I_OUT + I_GU + I_D;
    for (int it = gw; it < NITEMS; it += NGW) {
        int r = it;
        if (r < I_IN) { const int kb = r / 96, nb = r % 96, n0 = 32 * nb; p0_transpose_item(p.w_in, NPROJ, 64 * kb, n0 + (n0 >= 1536 ? 8 : 0), Win_t, 1024, n0, scr, F.lane); continue; } r -= I_IN;
        if (r < I_OUT) { const int kb = r / 32, nb = r % 32; p0_transpose_item(p.w_out, 1024, 64 * kb, 32 * nb, Wout_t, 1024, 32 * nb, scr, F.lane); continue; } r -= I_OUT;
        if (r < I_GU) { const int e = r / 512, rr = r % 512, mat = rr / 256, r2 = rr % 256, kb = r2 / 16, nb = r2 % 16, n0 = 32 * nb, q = n0 / 128;
            p0_transpose_item((mat ? p.w_up : p.w_gate) + (size_t)e * 1024 * 512, 512, 64 * kb, n0, Wgu_t, 1024, (e * 4 + q) * 256 + mat * 128 + (n0 % 128), scr, F.lane); continue; } r -= I_GU;
        { const int e = r / 256, r2 = r % 256, kb = r2 / 32, nb = r2 % 32;
            p0_transpose_item(p.w_down + (size_t)e * 512 * 1024, 1024, 64 * kb, 32 * nb, Wd_t + (size_t)e * 1024 * 512, 512, 32 * nb, scr, F.lane); }
    }
    __syncthreads();
    LAS float* w16 = (LAS float*)(F.lds + RING_OFF);
    { float wv[32];
#pragma unroll
      for (int i = 0; i < 32; ++i) { const int idx = F.tid + i * NWAVES * 64; const int k = idx >> 4, c = idx & 15; wv[i] = p.w_in[(size_t)k * NPROJ + (c < 8 ? 1536 + c : 3080 + c - 8)]; }
#pragma unroll
      for (int i = 0; i < 32; ++i) { const int idx = F.tid + i * NWAVES * 64; const int k = idx >> 4, c = idx & 15; w16[c * 1024 + k] = wv[i]; } }
    __syncthreads();
    bf16_t* xb = (bf16_t*)(ws + WS_XB); float* dt = (float*)(ws + WS_DT); float* logf = (float*)(ws + WS_LOGF);
#pragma unroll 1
    for (int grp = gw; grp < T / 2; grp += NGW) {
        float a[32];
#pragma unroll
        for (int r = 0; r < 2; ++r) {
            const int m = grp * 2 + r;
            const GAS f32x4* xr = (const GAS f32x4*)(p.x + (size_t)m * D) + F.lane;
            f32x4 v[4];
#pragma unroll
            for (int j = 0; j < 4; ++j) v[j] = xr[64 * j];
            GAS unsigned long long* o8 = (GAS unsigned long long*)(xb + (size_t)m * D) + F.lane;
#pragma unroll
            for (int j = 0; j < 4; ++j) o8[64 * j] = (unsigned long long)pk2(v[j].x, v[j].y) | ((unsigned long long)pk2(v[j].z, v[j].w) << 32);
#pragma unroll
            for (int c = 0; c < 16; ++c) {
                float s = 0.f;
#pragma unroll
                for (int j = 0; j < 4; ++j) { const f32x4 w = *(const LAS f32x4*)(w16 + c * 1024 + 256 * j + 4 * F.lane); s += (v[j].x * w.x + v[j].y * w.y) + (v[j].z * w.z + v[j].w * w.w); }
                a[r * 16 + c] = s; asm volatile("" ::: "memory");
            }
        }
#define TRSTEP(HALFN, SB) do { const bool up = (F.lane >> (SB)) & 1; _Pragma("unroll") for (int i = 0; i < (HALFN); ++i) { const float keep = up ? a[i + (HALFN)] : a[i]; const float send = up ? a[i] : a[i + (HALFN)]; a[i] = keep + __shfl_xor(send, 1 << (SB)); } } while (0)
        TRSTEP(16, 0); TRSTEP(8, 1); TRSTEP(4, 2); TRSTEP(2, 3); TRSTEP(1, 4);
#undef TRSTEP
        const float tot = a[0] + __shfl_xor(a[0], 32);
        const int L = F.lane & 31; const int idx = ((L & 1) << 4) | ((L & 2) << 2) | (L & 4) | ((L & 8) >> 2) | ((L & 16) >> 4);
        const int r = idx >> 4, c = idx & 15, m = grp * 2 + r;
        if (F.lane < 32) {
            if (c < 8) dt[(size_t)m * 8 + c] = softplus_d(tot + p.b_in[1536 + c]);
            else logf[(size_t)m * 8 + (c - 8)] = -softplus_d(-(tot + p.b_in[3080 + c - 8]));
        }
    }
}

__device__ __forceinline__ void scanF_unit(Frame& F, const P& p, int bh) {
    const int b = bh >> 3, h = bh & 7;
    const float* logf = (const float*)(p.ws + WS_LOGF); float* Fo = (float*)(p.ws + WS_F); bf16_t* kx = (bf16_t*)(p.ws + WS_KX);
    LAS float* wsum8 = (LAS float*)(F.lds + RING_OFF);
    float v[4]; float s = 0.f;
#pragma unroll
    for (int i = 0; i < 4; ++i) { v[i] = logf[(size_t)(b * SEQ + F.tid * 4 + i) * 8 + h]; s += v[i]; v[i] = s; }
    float inc = s;
#pragma unroll
    for (int o = 1; o < 64; o <<= 1) { const float y = __shfl_up(inc, o); if (F.lane >= o) inc += y; }
    if (F.lane == 63) wsum8[F.wave] = inc;
    __syncthreads();
    float base = inc - s;
    for (int w = 0; w < F.wave; ++w) base += wsum8[w];
#pragma unroll
    for (int i = 0; i < 4; ++i) { const size_t tok = (size_t)(b * SEQ + F.tid * 4 + i); const float f = base + v[i]; Fo[tok * 8 + h] = f;
        const float g = -f * LOG2E; const bf16_t g0 = f2bf(g); const float r1 = g - bf2f(g0); const bf16_t g1 = f2bf(r1); const float r2 = r1 - bf2f(g1); const bf16_t g2 = f2bf(r2);
        v4u o; o.x = (unsigned)g0 | ((unsigned)g1 << 16); o.y = (unsigned)g2; o.z = 0u; o.w = 0u;
        *(GAS v4u*)(kx + (tok * 8 + h) * 8) = o; }
    __syncthreads();
}


__device__ __forceinline__ void ln1_stage_weights(const P& p, LAS f32x4* RG, int tid) {
    f32x4 wv[10];
#pragma unroll
    for (int it = 0; it < 10; ++it) { const int idx = tid + it * NWAVES * 64; const int m = idx >> 10, cc = idx & 1023;
        wv[it] = m == 0 ? *(const GAS f32x4*)(p.rg_w + (size_t)cc * 4) : *(const GAS f32x4*)(p.re_w + ((size_t)(m - 1) * D + cc) * 4); }
#pragma unroll
    for (int it = 0; it < 10; ++it) { const int idx = tid + it * NWAVES * 64; const int m = idx >> 10, cc = idx & 1023, j = cc >> 8, ln = (cc & 255) >> 2, i = cc & 3;
        RG[m * 1024 + (j * 4 + i) * 64 + ln] = wv[it]; }
}
template <int R>
__device__ __forceinline__ void ln1_router_rows(const P& p, int t0, int lane, const LAS f32x4* RG, bf16_t* hb, LAS unsigned* lcnt, LAS f32x4* rowinfo, LAS int* rowtok, int slot0) {
    float* hio = p.out; const bf16_t* mix = (const bf16_t*)(p.ws + WS_MIX);
    f32x4 v[R][4];
#pragma unroll
    for (int r = 0; r < R; ++r)
#pragma unroll
        for (int j = 0; j < 4; ++j) { const f32x4 xv = *(const GAS f32x4*)(p.x + (size_t)(t0 + r) * D + j * 256 + lane * 4);
            const unsigned long long mv = *(const GAS unsigned long long*)(mix + (size_t)(t0 + r) * D + j * 256 + lane * 4); const unsigned m0 = (unsigned)mv, m1 = (unsigned)(mv >> 32);
            v[r][j] = xv * ALPHA + (f32x4){__uint_as_float(m0 << 16), __uint_as_float(m0 & 0xffff0000u), __uint_as_float(m1 << 16), __uint_as_float(m1 & 0xffff0000u)}; }
    f32x4 g1[4], b1[4];
#pragma unroll
    for (int j = 0; j < 4; ++j) { g1[j] = *(const GAS f32x4*)(p.ln1_g + j * 256 + lane * 4); b1[j] = *(const GAS f32x4*)(p.ln1_b + j * 256 + lane * 4); }
#pragma unroll
    for (int r = 0; r < R; ++r) {
        const int t = t0 + r;
        if (lane == 0) rowtok[slot0 + r] = t;
        float s = 0.f;
#pragma unroll
        for (int j = 0; j < 4; ++j) s += (v[r][j].x + v[r][j].y) + (v[r][j].z + v[r][j].w);
        const float mu = wave_sum(s) * (1.f / D); float s2 = 0.f;
#pragma unroll
        for (int j = 0; j < 4; ++j) { v[r][j] = v[r][j] - mu; s2 += (v[r][j].x * v[r][j].x + v[r][j].y * v[r][j].y) + (v[r][j].z * v[r][j].z + v[r][j].w * v[r][j].w); }
        const float rstd = rsqrtf(wave_sum(s2) * (1.f / D) + LN_EPS);
        f32x4 gl = (f32x4){0.f, 0.f, 0.f, 0.f};
#pragma unroll
        for (int j = 0; j < 4; ++j) { const f32x4 hv = v[r][j] * rstd * g1[j] + b1[j]; v[r][j] = hv;
            *(GAS f32x4*)(hio + (size_t)t * D + j * 256 + lane * 4) = hv;
            *(GAS unsigned long long*)(hb + (size_t)t * D + j * 256 + lane * 4) = (unsigned long long)pk2(hv.x, hv.y) | ((unsigned long long)pk2(hv.z, hv.w) << 32);
            gl += RG[(j * 4 + 0) * 64 + lane] * hv.x; gl += RG[(j * 4 + 1) * 64 + lane] * hv.y; gl += RG[(j * 4 + 2) * 64 + lane] * hv.z; gl += RG[(j * 4 + 3) * 64 + lane] * hv.w; }
        float glv[4];
#pragma unroll
        for (int e = 0; e < 4; ++e) glv[e] = wave_sum(gl[e]) + p.rg_b[e];
        int gi = 0; float gm = glv[0];
#pragma unroll
        for (int e = 1; e < 4; ++e) if (glv[e] > gm) { gm = glv[e]; gi = e; }
        gi = __builtin_amdgcn_readfirstlane(gi);
        float gden = 0.f;
#pragma unroll
        for (int e = 0; e < 4; ++e) gden += expf(glv[e] - gm);
        const float gval = 1.f / gden;
        const LAS f32x4* RE = RG + (1 + gi) * 1024;
        f32x4 el4 = (f32x4){0.f, 0.f, 0.f, 0.f};
#pragma unroll
        for (int j = 0; j < 4; ++j) { el4 += RE[(j * 4 + 0) * 64 + lane] * v[r][j].x; el4 += RE[(j * 4 + 1) * 64 + lane] * v[r][j].y; el4 += RE[(j * 4 + 2) * 64 + lane] * v[r][j].z; el4 += RE[(j * 4 + 3) * 64 + lane] * v[r][j].w; }
        float el[4];
#pragma unroll
        for (int e = 0; e < 4; ++e) el[e] = wave_sum(el4[e]) + p.re_b[gi * 4 + e];
        int i1 = 0;
#pragma unroll
        for (int e = 1; e < 4; ++e) if (el[e] > el[i1]) i1 = e;
        int i2 = -1;
#pragma unroll
        for (int e = 0; e < 4; ++e) if (e != i1 && (i2 < 0 || el[e] > el[i2])) i2 = e;
        const float e1v = i1 == 0 ? el[0] : i1 == 1 ? el[1] : i1 == 2 ? el[2] : el[3];
        const float e2v = i2 == 0 ? el[0] : i2 == 1 ? el[1] : i2 == 2 ? el[2] : el[3];
        const float p2 = expf(e2v - e1v); const float w1 = gval / (1.f + p2), w2 = gval * p2 / (1.f + p2);
        const int lo = i1 < i2 ? i1 : i2, hi = i1 < i2 ? i2 : i1; const float wlo = i1 < i2 ? w1 : w2, whi = i1 < i2 ? w2 : w1;
        const int pairidx = lo == 0 ? (hi - 1) : (lo == 1 ? (hi + 1) : 5);
        const int cls = gi * 6 + pairidx;
        if (lane == 0) {
            const unsigned lpos = __hip_atomic_fetch_add(lcnt + cls, 1u, __ATOMIC_RELAXED, __HIP_MEMORY_SCOPE_WORKGROUP);
            rowinfo[slot0 + r] = (f32x4){__int_as_float(cls), __int_as_float((int)lpos), wlo, whi};
        }
    }
}
__device__ __forceinline__ void ln1_commit(int tid, LAS unsigned* lcnt, LAS unsigned* gbase, const LAS f32x4* rowinfo, const LAS int* rowtok, int nrows, gu32* cnt, int* perm, float* tokinfo) {
    __syncthreads();
    if (tid < NCLS) { const unsigned n = lcnt[tid]; gbase[tid] = n ? __hip_atomic_fetch_add(cnt + 64 * tid, n, RLX_AGENT) : 0u; lcnt[tid] = 0u; }
    __syncthreads();
    if (tid < nrows) { const f32x4 ri = rowinfo[tid]; const int cls = __float_as_int(ri[0]); const int pos = __float_as_int(ri[1]) + (int)gbase[cls]; const int t = rowtok[tid];
        perm[(size_t)cls * T + pos] = t; *(GAS f32x4*)(tokinfo + (size_t)t * 4) = (f32x4){ri[0], __int_as_float(pos), ri[2], ri[3]}; }
}
__device__ __forceinline__ void ln2_row(const P& p, int t, int lane) {
    float* io = p.out;
    f32x4 v[4]; float s = 0.f;
#pragma unroll
    for (int j = 0; j < 4; ++j) { const f32x4 hv = *(const GAS f32x4*)(io + (size_t)t * D + j * 256 + lane * 4);
        const unsigned long long mv = *(const GAS unsigned long long*)((const bf16_t*)(p.ws + WS_FFN) + (size_t)t * D + j * 256 + lane * 4); const unsigned m0 = (unsigned)mv, m1 = (unsigned)(mv >> 32);
        v[j] = hv * ALPHA + (f32x4){__uint_as_float(m0 << 16), __uint_as_float(m0 & 0xffff0000u), __uint_as_float(m1 << 16), __uint_as_float(m1 & 0xffff0000u)};
        s += (v[j].x + v[j].y) + (v[j].z + v[j].w); }
    const float mu = wave_sum(s) * (1.f / D); float s2 = 0.f;
#pragma unroll
    for (int j = 0; j < 4; ++j) { v[j] = v[j] - mu; s2 += (v[j].x * v[j].x + v[j].y * v[j].y) + (v[j].z * v[j].z + v[j].w * v[j].w); }
    const float rstd = rsqrtf(wave_sum(s2) * (1.f / D) + LN_EPS);
#pragma unroll
    for (int j = 0; j < 4; ++j) { const int c = j * 256 + lane * 4; const f32x4 g2 = *(const GAS f32x4*)(p.ln2_g + c), b2 = *(const GAS f32x4*)(p.ln2_b + c);
        *(GAS f32x4*)(io + (size_t)t * D + c) = v[j] * rstd * g2 + b2; }
}

struct Args { P p; int ph_lo, ph_hi, li, pad; };
constexpr int N_PHASES = 2;
__global__ void __launch_bounds__(NWAVES * 64, 2) mega_fwd(Args args) {
    extern __shared__ __attribute__((aligned(16))) unsigned char lds[];
    Frame F;
    F.lds = (LAS unsigned char*)lds;
    F.MISC = (volatile LAS unsigned*)(F.lds + MISC_OFF);
    F.tid = threadIdx.x; F.lane = F.tid & 63; F.wave = __builtin_amdgcn_readfirstlane(F.tid >> 6);
    F.G = gridDim.x; { const int bx = blockIdx.x; F.vcu = (F.G % 8 == 0) ? (bx % 8) * (F.G / 8) + bx / 8 : bx; }
    const P& p = args.p;
    unsigned char* ws = p.ws;
    F.ctl = (gu32*)(ws + WS_CTL);
    for (int u = F.tid; u < (LDS_BYTES - LDSCTL_OFF) / 4; u += NWAVES * 64) ((LAS unsigned*)(F.lds + LDSCTL_OFF))[u] = 0u;
    __syncthreads();
    XcdBarrier bar = xcd_barrier_post((unsigned*)(F.ctl + CW_BAR) + args.li * XCD_BAR_WORDS, F.MISC + 8);
    const int lo = args.ph_lo, hi = args.ph_hi;
#ifndef PROBE_PH
#define PROBE_PH (-1)
#endif
#if PROBE_PH >= 0
    unsigned long long t_prev = __builtin_amdgcn_s_memrealtime(); unsigned long long t_sel = 0ull;
#define PSTAMP(k) do { const unsigned long long t_now = __builtin_amdgcn_s_memrealtime(); if ((k) == PROBE_PH) t_sel = t_now - t_prev; t_prev = t_now; } while (0)
#else
#define PSTAMP(k) do { } while (0)
#endif
#define IN(k) (lo <= (k) && (k) < hi)
#define BOTH(k) (IN(k) && IN((k) + 1))
#define GRID_BAR() xcd_barrier(bar)
    if (IN(0)) { p0_prologue(F, p); if (BOTH(0)) GRID_BAR(); PSTAMP(0); }
    if (IN(1)) {
        if (blockIdx.x < BATCH * NH) scanF_unit(F, p, blockIdx.x);
        pg8::PlainProb pr{(const bf16_t*)(ws + WS_XB), (const bf16_t*)(ws + WS_WIN), 1024, 1024, 16};
        pg8::StaticOrder S; S.init(T, 3072, F.G, (int)blockIdx.x);
        pg8::EpiInproj E{p.b_in, (bf16_t*)(ws + WS_Z), (bf16_t*)(ws + WS_XBC), (bf16_t*)(ws + WS_Q), (bf16_t*)(ws + WS_K), (bf16_t*)(ws + WS_V)};
        pg8::gemm_phase<pg8::PlainProb, pg8::StaticOrder, pg8::EpiInproj, true>(F.lds + RING_OFF, pr, S, E);
        if (BOTH(1)) GRID_BAR(); PSTAMP(1);
    }

    if (IN(2)) {
#pragma unroll 1
        for (int u = F.vcu; u < BATCH * ssd::NCH; u += F.G) { ssd::states_unit(F.lds + RING_OFF, (const bf16_t*)(ws + WS_XBC), p.conv_w, p.conv_b, (const float*)(ws + WS_DT), p.a_log, (bf16_t*)(ws + WS_S), (float*)(ws + WS_CDEC), u / ssd::NCH, u % ssd::NCH); }
        if (BOTH(2)) GRID_BAR(); PSTAMP(2);
    }
    if (IN(3)) {
#pragma unroll 1
        for (int u = F.vcu; u < BATCH * NH * 2; u += F.G) ssd::scan_unit((bf16_t*)(ws + WS_S), (const float*)(ws + WS_CDEC), u >> 1, u & 1);
        __syncthreads();
        const attn_body::AttnTensors AT{(const attn_body::bf16*)(ws + WS_Q), (const attn_body::bf16*)(ws + WS_K), (const attn_body::bf16*)(ws + WS_V), (const attn_body::bf16*)(ws + WS_KX), (attn_body::bf16*)(ws + WS_MERGED)};
        const attn_body::StaticOrder S((int)F.G, (int)blockIdx.x);
        attn_body::attn_phase<attn_body::StaticOrder>((char*)lds + RING_OFF, AT, S);
        if (BOTH(3)) GRID_BAR(); PSTAMP(3);
    }
    if (IN(4)) {
#pragma unroll 1
        for (int u = F.vcu; u < BATCH * ssd::NCH; u += F.G) ssd::out_unit(F.lds + RING_OFF, (const bf16_t*)(ws + WS_XBC), p.conv_w, p.conv_b, (const bf16_t*)(ws + WS_Z), (const float*)(ws + WS_DT), p.a_log, p.d_skip, p.ssd_norm_g,
                                                                          (const bf16_t*)(ws + WS_S), (bf16_t*)(ws + WS_MERGED), u / ssd::NCH, u % ssd::NCH);
        if (BOTH(4)) GRID_BAR(); PSTAMP(4);
    }
    if (IN(5)) {
        pg8::PlainProb pr{(const bf16_t*)(ws + WS_MERGED), (const bf16_t*)(ws + WS_WOUT), 1024, 1024, 16};
        pg8::StaticOrder S; S.init(T, 1024, F.G, (int)blockIdx.x);
        pg8::EpiOutproj E{(bf16_t*)(ws + WS_MIX)};
        pg8::gemm_phase<pg8::PlainProb, pg8::StaticOrder, pg8::EpiOutproj, true>(F.lds + RING_OFF, pr, S, E);
        if (BOTH(5)) GRID_BAR(); PSTAMP(5);
    }
    if (IN(6)) {
        const int gw = F.vcu * NWAVES + F.wave, NGW = F.G * NWAVES;
        LAS f32x4* RG = (LAS f32x4*)(F.lds + RING_OFF);
        LAS unsigned* lcnt = (LAS unsigned*)(F.lds + RING_OFF + 81920);
        LAS unsigned* gbase = lcnt + 32;
        LAS f32x4* rowinfo = (LAS f32x4*)(F.lds + RING_OFF + 81920 + 256);
        LAS int* rowtok = (LAS int*)(F.lds + RING_OFF + 81920 + 256 + 512);
        const int tid6 = tid_now();
        ln1_stage_weights(p, RG, tid6);
        if (tid6 < 32) lcnt[tid6] = 0u;
        __syncthreads();
        const int lane6 = lane_now();
#pragma unroll 1
        for (int bt = F.vcu; bt < T / 32; bt += F.G) {
            ln1_router_rows<4>(p, bt * 32 + F.wave * 4, lane6, RG, (bf16_t*)(ws + WS_HB), lcnt, rowinfo, rowtok, F.wave * 4);
            ln1_commit(tid6, lcnt, gbase, rowinfo, rowtok, 32, F.ctl + CW_CNT, (int*)(ws + WS_PERM), (float*)(ws + WS_TOK));
        }
        if (BOTH(6)) GRID_BAR(); PSTAMP(6);
    }
    if (IN(7) || IN(8)) {
        LAS int* gt = (LAS int*)(F.lds + TAB_OFF);
        { const int tg = tid_now(); if (tg < NCLS) gt[32 + tg] = (int)__hip_atomic_load(F.ctl + CW_CNT + 64 * tg, RLX_AGENT);
          __syncthreads();
          if (tg == 0) { int acc = 0; for (int c = 0; c < NCLS; ++c) { gt[c] = acc; acc += (gt[32 + c] + 255) >> 8; } gt[24] = acc; } }
        __syncthreads();
    }
    if (IN(7)) {
        const LAS int* gt = (const LAS int*)(F.lds + TAB_OFF);
        LAS unsigned* rofft = (LAS unsigned*)(F.lds + TAB_OFF + 256); LAS int* tokt = (LAS int*)(F.lds + TAB_OFF + 256 + 6144);
        pg8::MoeGeo geo{gt}; pg8::MoeOrder S{geo.np() * 8, 8, F.G, F.vcu};
        const int* perm = (const int*)(ws + WS_PERM);
        { const int tid7 = tid_now(); pg8::Unit u; for (int i = 0; S.next(i, u); ++i) if (tid7 < 256) { const int c = geo.cls_of(u.pm); const int pos = (u.pm - gt[c]) * 256 + tid7; const int tok = pos < gt[32 + c] ? perm[(size_t)c * T + pos] : -1;
            rofft[i * 256 + tid7] = (unsigned)(tok < 0 ? 0 : tok) * 2048u; tokt[i * 256 + tid7] = tok; } }
        __syncthreads();
        pg8::Moe1Prob pr{(const bf16_t*)(ws + WS_HB), (const bf16_t*)(ws + WS_WGU), geo, rofft, 1024, 1024, 16};
        pg8::EpiMoe1 E{(bf16_t*)(ws + WS_ACT), (const float*)(ws + WS_TOK), tokt};
        pg8::gemm_phase<pg8::Moe1Prob, pg8::MoeOrder, pg8::EpiMoe1, true>(F.lds + RING_OFF, pr, S, E);
        if (BOTH(7)) GRID_BAR(); PSTAMP(7);
    }
    if (IN(8)) {
        const LAS int* gt = (const LAS int*)(F.lds + TAB_OFF);
        LAS int* tokt = (LAS int*)(F.lds + TAB_OFF + 256 + 6144);
        pg8::MoeGeo geo{gt}; pg8::MoeOrder S{geo.np() * 4, 4, F.G, F.vcu};
        const int* perm = (const int*)(ws + WS_PERM);
        __syncthreads();
        { const int tid8 = tid_now(); pg8::Unit u; for (int i = 0; S.next(i, u); ++i) if (tid8 < 256) { const int c = geo.cls_of(u.pm); const int pos = (u.pm - gt[c]) * 256 + tid8; tokt[i * 256 + tid8] = pos < gt[32 + c] ? perm[(size_t)c * T + pos] : -1; } }
        __syncthreads();
        pg8::Moe2Prob pr{(const bf16_t*)(ws + WS_ACT), (const bf16_t*)(ws + WS_WD), geo, 1024, 512, 16};
        pg8::EpiMoe2 E{(bf16_t*)(ws + WS_FFN), tokt};
        pg8::gemm_phase<pg8::Moe2Prob, pg8::MoeOrder, pg8::EpiMoe2, true>(F.lds + RING_OFF, pr, S, E);
        if (BOTH(8)) GRID_BAR(); PSTAMP(8);
    }
    if (IN(9)) {
        const int gw = F.vcu * NWAVES + F.wave, NGW = F.G * NWAVES;
        const int lane9 = lane_now();
#pragma unroll 1
        for (int m = gw; m < T; m += NGW) ln2_row(p, m, lane9);
    }
    PSTAMP(9);
#if PROBE_PH >= 0
    if (blockIdx.x == 0) { const unsigned long long t_end = __builtin_amdgcn_s_memrealtime(); while (__builtin_amdgcn_s_memrealtime() - t_end < 7ull * t_sel) __builtin_amdgcn_s_sleep(8); }
#endif
#undef IN
#undef BOTH
#undef GRID_BAR
}

static void launch_mega(const P& p, int lo, int hi, int li, hipStream_t stream) {
    Args a{}; a.p = p; a.ph_lo = lo; a.ph_hi = hi; a.li = li; a.pad = 0;
    hipLaunchKernelGGL(mega_fwd, dim3(256), dim3(NWAVES * 64), LDS_BYTES, stream, a);
}

extern "C" void kernel_launch(void* const* d_in, const int* in_sizes, int n_in, void* d_out, int out_size, void* d_ws, size_t ws_size, hipStream_t stream) {
    static int inited = 0;
    if (!inited) { (void)hipFuncSetAttribute((const void*)mega_fwd, hipFuncAttributeMaxDynamicSharedMemorySize, LDS_BYTES); inited = 1; }
    P p{};
    const float** ins = (const float**)&p;
    for (int i = 0; i < 20; ++i) ins[i] = (const float*)d_in[i];
    p.out = (float*)d_out; p.ws = (unsigned char*)d_ws;
    unsigned char* ws = p.ws;
    (void)hipMemsetAsync(ws + WS_CTL, 0, CTL_ZERO_BYTES, stream);
    unsigned* cnt = (unsigned*)(ws + WS_CTL) + CW_CNT;
    float* dt = (float*)(ws + WS_DT); float* F = (float*)(ws + WS_F);
    int* perm = (int*)(ws + WS_PERM); float* tokinfo = (float*)(ws + WS_TOK);
    float* yraw = (float*)(ws + WS_YRAW); bf16_t* z = (bf16_t*)(ws + WS_Z); bf16_t* xbc = (bf16_t*)(ws + WS_XBC); bf16_t* merged = (bf16_t*)(ws + WS_MERGED);
    bf16_t *q = (bf16_t*)(ws + WS_Q), *k = (bf16_t*)(ws + WS_K), *v = (bf16_t*)(ws + WS_V), *act = (bf16_t*)(ws + WS_ACT);
    float* xconv = (float*)(ws + WS_XCONV); bf16_t* hb = (bf16_t*)(ws + WS_HB);

    launch_mega(p, 0, 10, 0, stream);
}
```

```cpp
#include <hip/hip_runtime.h>
#include <hip/hip_bf16.h>
#include <stdint.h>
#include <cstdio>

typedef unsigned short bf16_t;
__device__ __forceinline__ float bf2f(bf16_t v) { return __uint_as_float(((unsigned)v) << 16); }
__device__ __forceinline__ bf16_t f2bf(float f) { unsigned u = __float_as_uint(f); return (bf16_t)((u + 0x7fffu + ((u >> 16) & 1u)) >> 16); }

constexpr int BATCH = 16, SEQ = 2048, T = BATCH * SEQ, D = 1024;
constexpr int NPROJ = 3088;
constexpr int NH = 8, HD = 64, NG = 2, NS = 128;
constexpr int NCLS = 24;
constexpr float ALPHA = 1.189207115002721f;
constexpr float LN_EPS = 1e-5f, RMS_EPS = 1e-5f;
constexpr float LOG2E = 1.4426950408889634f;
constexpr float C2 = 0.125f * LOG2E;

constexpr size_t MiB = 1u << 20;
constexpr size_t WS_CTL = 0, CTL_ZERO_BYTES = 1 * MiB;
constexpr size_t WS_WIN = 1 * MiB;
constexpr size_t WS_WOUT = 7 * MiB;
constexpr size_t WS_WGU = 9 * MiB;
constexpr size_t WS_WD = 41 * MiB;
constexpr size_t WS_DT = 58 * MiB;
constexpr size_t WS_LOGF = 59 * MiB;
constexpr size_t WS_F = 60 * MiB;
constexpr size_t WS_PERM = 61 * MiB;
constexpr size_t WS_TOK = 64 * MiB;
constexpr size_t WS_KX = 65 * MiB;
constexpr size_t WS_XB = 72 * MiB;
constexpr size_t WS_S = 72 * MiB;
constexpr size_t WS_CDEC = 69 * MiB;
constexpr size_t WS_MIX = 72 * MiB;
constexpr size_t WS_FFN = 408 * MiB;
constexpr size_t WS_XCB = 328 * MiB;
constexpr size_t WS_YRAW = 72 * MiB;
constexpr size_t WS_Z = 136 * MiB;
constexpr size_t WS_XBC = 168 * MiB;
constexpr size_t WS_HB = 136 * MiB;
constexpr size_t WS_Q = 232 * MiB, WS_K = 264 * MiB, WS_V = 296 * MiB;
constexpr size_t WS_ACT = 232 * MiB;
constexpr size_t WS_XCONV = 328 * MiB;
constexpr size_t WS_MERGED = 408 * MiB;
constexpr int CW_CNT = 1024;
constexpr int CW_TMO = 64, CW_CODE = 65;
constexpr int CW_BAR = 4096;

struct P {
    const float *x, *w_in, *b_in, *conv_w, *conv_b, *a_log, *d_skip, *ssd_norm_g, *w_out, *ln1_g, *ln1_b,
        *rg_w, *rg_b, *re_w, *re_b, *w_gate, *w_up, *w_down, *ln2_g, *ln2_b;
    float* out; unsigned char* ws;
};

__device__ __forceinline__ float softplus_f(float x) { return fmaxf(x, 0.f) + log1pf(expf(-fabsf(x))); }
__device__ __forceinline__ float silu_f(float x) { return x / (1.f + expf(-x)); }

template <int NB, class AL, class BL, class EP>
__global__ __launch_bounds__(256) void ngemm(AL al, BL bl, EP ep, int K) {
    __shared__ float As[16][68];
    __shared__ float Bs[NB][16][68];
    const int tm = blockIdx.y * 64, tn = blockIdx.x * 64;
    if (!al.tile_ok(tm)) return;
    const int tx = threadIdx.x & 15, ty = threadIdx.x >> 4;
    float acc[NB][4][4];
#pragma unroll
    for (int b = 0; b < NB; ++b)
#pragma unroll
        for (int i = 0; i < 4; ++i)
#pragma unroll
            for (int j = 0; j < 4; ++j) acc[b][i][j] = 0.f;
    for (int k0 = 0; k0 < K; k0 += 16) {
#pragma unroll
        for (int i = 0; i < 4; ++i) { const int idx = threadIdx.x + i * 256; const int r = idx >> 4, kk = idx & 15; As[kk][r] = al(tm + r, k0 + kk); }
#pragma unroll
        for (int b = 0; b < NB; ++b)
#pragma unroll
            for (int i = 0; i < 4; ++i) { const int idx = threadIdx.x + i * 256; const int kk = idx >> 6, n = idx & 63; Bs[b][kk][n] = bl(b, tm, k0 + kk, tn + n); }
        __syncthreads();
#pragma unroll
        for (int kk = 0; kk < 16; ++kk) {
            float a[4];
#pragma unroll
            for (int i = 0; i < 4; ++i) a[i] = As[kk][ty * 4 + i];
#pragma unroll
            for (int b = 0; b < NB; ++b) {
                float bb[4];
#pragma unroll
                for (int j = 0; j < 4; ++j) bb[j] = Bs[b][kk][tx * 4 + j];
#pragma unroll
                for (int i = 0; i < 4; ++i)
#pragma unroll
                    for (int j = 0; j < 4; ++j) acc[b][i][j] += a[i] * bb[j];
            }
        }
        __syncthreads();
    }
#pragma unroll
    for (int i = 0; i < 4; ++i)
#pragma unroll
        for (int j = 0; j < 4; ++j) {
            if (NB == 1) ep(tm + ty * 4 + i, tn + tx * 4 + j, acc[0][i][j], 0.f);
            else ep(tm + ty * 4 + i, tn + tx * 4 + j, acc[0][i][j], acc[NB - 1][i][j]);
        }
}

struct AL_x { const float* x; __device__ bool tile_ok(int) const { return true; } __device__ float operator()(int r, int k) const { return x[(size_t)r * D + k]; } };
struct BL_win { const float* w; __device__ float operator()(int, int, int k, int n) const { return n < NPROJ ? w[(size_t)k * NPROJ + n] : 0.f; } };
struct EP_inproj {
    const float* b_in; bf16_t *z, *xbc, *q, *k, *v; float *dt, *logf;
    __device__ void operator()(int r, int c, float v0, float) const {
        if (c >= NPROJ) return;
        const float val = v0 + b_in[c];
        if (c < 512) z[(size_t)r * 512 + c] = f2bf(val);
        else if (c < 1536) xbc[(size_t)r * 1024 + (c - 512)] = f2bf(val);
        else if (c < 1544) dt[(size_t)r * 8 + (c - 1536)] = softplus_f(val);
        else if (c < 2056) q[(size_t)r * 512 + (c - 1544)] = f2bf(val * C2);
        else if (c < 2568) k[(size_t)r * 512 + (c - 2056)] = f2bf(val);
        else if (c < 3080) v[(size_t)r * 512 + (c - 2568)] = f2bf(val);
        else logf[(size_t)r * 8 + (c - 3080)] = -softplus_f(-val);
    }
};

__global__ void k_conv(const bf16_t* xbc, const float* conv_w, const float* conv_b, float* xconv) {
    const size_t idx = (size_t)blockIdx.x * 256 + threadIdx.x;
    const int c = (int)(idx & 1023); const int t = (int)(idx >> 10); const int s = t & (SEQ - 1);
    float acc = conv_b[c];
#pragma unroll
    for (int k = 0; k < 4; ++k) { const int ss = s - 3 + k; if (ss >= 0) acc += conv_w[k * 1024 + c] * bf2f(xbc[(size_t)(t - 3 + k) * 1024 + c]); }
    xconv[idx] = silu_f(acc);
}

__global__ __launch_bounds__(64) void k_ssd(const float* xconv, const float* dt, const float* a_log, const float* d_skip, float* yraw) {
    __shared__ float Bs[16][128], Cs[16][128];
    const int b = blockIdx.x >> 3, h = blockIdx.x & 7, g = h >> 2, p = threadIdx.x;
    const float a = -expf(a_log[h]), dsk = d_skip[h];
    float st[128];
#pragma unroll
    for (int n = 0; n < 128; ++n) st[n] = 0.f;
    for (int t0 = 0; t0 < SEQ; t0 += 16) {
        __syncthreads();
        for (int i = p; i < 16 * 128; i += 64) { const int tt = i >> 7, n = i & 127; const size_t row = (size_t)(b * SEQ + t0 + tt) * 1024;
            Bs[tt][n] = xconv[row + 512 + g * 128 + n]; Cs[tt][n] = xconv[row + 768 + g * 128 + n]; }
        __syncthreads();
        for (int tt = 0; tt < 16; ++tt) {
            const size_t tok = (size_t)(b * SEQ + t0 + tt);
            const float xs = xconv[tok * 1024 + h * 64 + p], dtv = dt[tok * 8 + h];
            const float dA = expf(dtv * a), xdt = xs * dtv;
            float y = 0.f;
#pragma unroll
            for (int n = 0; n < 128; ++n) { st[n] = st[n] * dA + xdt * Bs[tt][n]; y += Cs[tt][n] * st[n]; }
            yraw[tok * 512 + h * 64 + p] = y + dsk * xs;
        }
    }
}

__global__ __launch_bounds__(256) void k_gatenorm(const float* yraw, const bf16_t* z, const float* norm_g, bf16_t* merged) {
    const int w = blockIdx.x * 4 + (threadIdx.x >> 6), lane = threadIdx.x & 63;
    const int t = w >> 1, g = w & 1;
    float v[4]; float ss = 0.f;
#pragma unroll
    for (int j = 0; j < 4; ++j) { const int c = g * 256 + lane * 4 + j; const float y = yraw[(size_t)t * 512 + c] * silu_f(bf2f(z[(size_t)t * 512 + c])); v[j] = y; ss += y * y; }
#pragma unroll
    for (int o = 1; o < 64; o <<= 1) ss += __shfl_xor(ss, o);
    const float r = rsqrtf(ss * (1.f / 256.f) + RMS_EPS);
#pragma unroll
    for (int j = 0; j < 4; ++j) { const int c = g * 256 + lane * 4 + j; merged[(size_t)t * 1024 + c] = f2bf(v[j] * r * norm_g[c]); }
}

__global__ void k_scanF(const float* logf, float* F) {
    const int i = blockIdx.x * 64 + threadIdx.x; if (i >= BATCH * NH) return;
    const int b = i >> 3, h = i & 7; float s = 0.f;
    for (int t = 0; t < SEQ; ++t) { const size_t o = (size_t)(b * SEQ + t) * 8 + h; s += logf[o]; F[o] = s; }
}

__global__ __launch_bounds__(64) void k_attn(const bf16_t* Q, const bf16_t* K, const bf16_t* V, const float* F, bf16_t* merged) {
    const int bh = blockIdx.y, b = bh >> 3, h = bh & 7; const int t = blockIdx.x * 64 + threadIdx.x;
    const size_t row = (size_t)(b * SEQ + t);
    float q[64], o[64];
#pragma unroll
    for (int d = 0; d < 64; ++d) { q[d] = bf2f(Q[row * 512 + h * 64 + d]); o[d] = 0.f; }
    const float Ft = F[row * 8 + h];
    float m = -INFINITY, l = 0.f;
    const int smax = blockIdx.x * 64 + 63;
    for (int s = 0; s <= smax; ++s) {
        const size_t kr = (size_t)(b * SEQ + s);
        const bf16_t* kp = K + kr * 512 + h * 64; const bf16_t* vp = V + kr * 512 + h * 64;
        float dot = 0.f;
#pragma unroll
        for (int d = 0; d < 64; ++d) dot += q[d] * bf2f(kp[d]);
        const float logit = dot + (Ft - F[kr * 8 + h]) * LOG2E;
        if (s <= t) {
            const float mn = fmaxf(m, logit), corr = exp2f(m - mn), pp = exp2f(logit - mn);
            l = l * corr + pp;
#pragma unroll
            for (int d = 0; d < 64; ++d) o[d] = o[d] * corr + pp * bf2f(vp[d]);
            m = mn;
        }
    }
    const float rl = 1.f / l;
#pragma unroll
    for (int d = 0; d < 64; ++d) merged[row * 1024 + 512 + h * 64 + d] = f2bf(o[d] * rl);
}

struct AL_bf { const bf16_t* a; int lda; int pad; __device__ bool tile_ok(int) const { return true; } __device__ float operator()(int r, int k) const { return bf2f(a[(size_t)r * lda + k]); } };
struct BL_plain { const float* w; int ldb; int pad; __device__ float operator()(int, int, int k, int n) const { return w[(size_t)k * ldb + n]; } };
struct EP_outproj { const float* x; float* out; __device__ void operator()(int r, int c, float v, float) const { out[(size_t)r * D + c] = ALPHA * x[(size_t)r * D + c] + v; } };

__device__ __forceinline__ float wsum(float v) {
#pragma unroll
    for (int o = 1; o < 64; o <<= 1) v += __shfl_xor(v, o);
    return v;
}
__global__ __launch_bounds__(256) void k_ln1_router(float* hio, const float* g1, const float* b1, const float* rg_w, const float* rg_b, const float* re_w, const float* re_b,
                                                    bf16_t* hb, unsigned* cnt, int* perm, float* tokinfo) {
    const int t = blockIdx.x * 4 + (threadIdx.x >> 6), lane = threadIdx.x & 63;
    float v[16]; float s = 0.f;
#pragma unroll
    for (int j = 0; j < 4; ++j) { const float4 u = *(const float4*)(hio + (size_t)t * D + j * 256 + lane * 4); v[4 * j] = u.x; v[4 * j + 1] = u.y; v[4 * j + 2] = u.z; v[4 * j + 3] = u.w; s += (u.x + u.y) + (u.z + u.w); }
    const float mu = wsum(s) * (1.f / D); float s2 = 0.f;
#pragma unroll
    for (int i = 0; i < 16; ++i) { v[i] -= mu; s2 += v[i] * v[i]; }
    const float rstd = rsqrtf(wsum(s2) * (1.f / D) + LN_EPS);
    float gl[4] = {0.f, 0.f, 0.f, 0.f};
#pragma unroll
    for (int j = 0; j < 4; ++j)
#pragma unroll
        for (int i = 0; i < 4; ++i) { const int c = j * 256 + lane * 4 + i; const float hv = v[4 * j + i] * rstd * g1[c] + b1[c]; v[4 * j + i] = hv;
            hio[(size_t)t * D + c] = hv; hb[(size_t)t * D + c] = f2bf(hv);
#pragma unroll
            for (int e = 0; e < 4; ++e) gl[e] += hv * rg_w[c * 4 + e]; }
#pragma unroll
    for (int e = 0; e < 4; ++e) gl[e] = wsum(gl[e]) + rg_b[e];
    int gi = 0; float gm = gl[0];
#pragma unroll
    for (int e = 1; e < 4; ++e) if (gl[e] > gm) { gm = gl[e]; gi = e; }
    float gden = 0.f;
#pragma unroll
    for (int e = 0; e < 4; ++e) gden += expf(gl[e] - gm);
    const float gval = 1.f / gden;
    float el[4] = {0.f, 0.f, 0.f, 0.f};
#pragma unroll
    for (int j = 0; j < 4; ++j)
#pragma unroll
        for (int i = 0; i < 4; ++i) { const int c = j * 256 + lane * 4 + i;
#pragma unroll
            for (int e = 0; e < 4; ++e) el[e] += v[4 * j + i] * re_w[((size_t)gi * D + c) * 4 + e]; }
#pragma unroll
    for (int e = 0; e < 4; ++e) el[e] = wsum(el[e]) + re_b[gi * 4 + e];
    int i1 = 0;
#pragma unroll
    for (int e = 1; e < 4; ++e) if (el[e] > el[i1]) i1 = e;
    int i2 = -1;
#pragma unroll
    for (int e = 0; e < 4; ++e) if (e != i1 && (i2 < 0 || el[e] > el[i2])) i2 = e;
    const float mx = el[i1]; const float p2 = expf(el[i2] - mx); const float w1 = gval / (1.f + p2), w2 = gval * p2 / (1.f + p2);
    const int lo = i1 < i2 ? i1 : i2, hi = i1 < i2 ? i2 : i1; const float wlo = i1 < i2 ? w1 : w2, whi = i1 < i2 ? w2 : w1;
    const int pairidx = lo == 0 ? (hi - 1) : (lo == 1 ? (hi + 1) : 5);
    const int cls = gi * 6 + pairidx;
    if (lane == 0) {
        const unsigned pos = atomicAdd(&cnt[cls], 1u);
        perm[(size_t)cls * T + pos] = t;
        tokinfo[(size_t)t * 4 + 0] = __int_as_float(cls); tokinfo[(size_t)t * 4 + 1] = __int_as_float((int)pos); tokinfo[(size_t)t * 4 + 2] = wlo; tokinfo[(size_t)t * 4 + 3] = whi;
    }
}

struct ClsGeo { const unsigned* cnt;
    __device__ bool find(int row, int& cls, int& pos, int& n) const {
        int off = 0;
        for (int c = 0; c < NCLS; ++c) { const int nc = (int)cnt[c], pc = (nc + 255) & ~255; if (row < off + pc) { cls = c; pos = row - off; n = nc; return true; } off += pc; }
        return false;
    }
};
__device__ __forceinline__ void cls_experts(int cls, int& ea, int& eb) { const int g = cls / 6, pi = cls % 6; const int lo = pi < 3 ? 0 : (pi < 5 ? 1 : 2); const int hi = pi < 3 ? pi + 1 : (pi < 5 ? pi - 1 : 3); ea = g * 4 + lo; eb = g * 4 + hi; }

struct AL_moe1 { const bf16_t* hb; const int* perm; ClsGeo geo;
    __device__ bool tile_ok(int tm) const { int c, p, n; if (!geo.find(tm, c, p, n)) return false; return p < n; }
    __device__ float operator()(int r, int k) const { int c, p, n; if (!geo.find(r, c, p, n) || p >= n) return 0.f; const int tok = perm[(size_t)c * T + p]; return bf2f(hb[(size_t)tok * D + k]); } };
struct BL_moe1 { const float *wg, *wu; ClsGeo geo;
    __device__ float operator()(int b, int tm, int k, int n) const { int c, p, nn; geo.find(tm, c, p, nn); int ea, eb; cls_experts(c, ea, eb); const int e = n < 512 ? ea : eb; const int col = n & 511;
        const float* w = b == 0 ? wg : wu; return w[((size_t)e * D + k) * 512 + col]; } };
struct EP_moe1 { bf16_t* act; const int* perm; const float* tokinfo; ClsGeo geo;
    __device__ void operator()(int r, int c, float g, float u) const { int cl, p, n; float w = 0.f; if (geo.find(r, cl, p, n) && p < n) { const int tok = perm[(size_t)cl * T + p]; w = tokinfo[(size_t)tok * 4 + (c < 512 ? 2 : 3)]; }
        act[(size_t)r * 1024 + c] = f2bf(silu_f(g) * u * w); } };
struct AL_moe2 { const bf16_t* act; ClsGeo geo;
    __device__ bool tile_ok(int tm) const { int c, p, n; if (!geo.find(tm, c, p, n)) return false; return p < n; }
    __device__ float operator()(int r, int k) const { return bf2f(act[(size_t)r * 1024 + k]); } };
struct BL_moe2 { const float* wd; ClsGeo geo;
    __device__ float operator()(int, int tm, int k, int n) const { int c, p, nn; geo.find(tm, c, p, nn); int ea, eb; cls_experts(c, ea, eb); const int e = k < 512 ? ea : eb; return wd[((size_t)e * 512 + (k & 511)) * D + n]; } };
struct EP_moe2 { float* out; const int* perm; ClsGeo geo;
    __device__ void operator()(int r, int c, float v, float) const { int cl, p, n; if (!geo.find(r, cl, p, n) || p >= n) return; const int tok = perm[(size_t)cl * T + p]; float* o = out + (size_t)tok * D + c; *o = ALPHA * (*o) + v; } };

__global__ __launch_bounds__(256) void k_ln2(float* io, const float* g2, const float* b2) {
    const int t = blockIdx.x * 4 + (threadIdx.x >> 6), lane = threadIdx.x & 63;
    float v[16]; float s = 0.f;
#pragma unroll
    for (int j = 0; j < 4; ++j) { const float4 u = *(const float4*)(io + (size_t)t * D + j * 256 + lane * 4); v[4 * j] = u.x; v[4 * j + 1] = u.y; v[4 * j + 2] = u.z; v[4 * j + 3] = u.w; s += (u.x + u.y) + (u.z + u.w); }
    const float mu = wsum(s) * (1.f / D); float s2 = 0.f;
#pragma unroll
    for (int i = 0; i < 16; ++i) { v[i] -= mu; s2 += v[i] * v[i]; }
    const float rstd = rsqrtf(wsum(s2) * (1.f / D) + LN_EPS);
#pragma unroll
    for (int j = 0; j < 4; ++j) { float4 o; const int c = j * 256 + lane * 4;
        o.x = v[4 * j] * rstd * g2[c] + b2[c]; o.y = v[4 * j + 1] * rstd * g2[c + 1] + b2[c + 1]; o.z = v[4 * j + 2] * rstd * g2[c + 2] + b2[c + 2]; o.w = v[4 * j + 3] * rstd * g2[c + 3] + b2[c + 3];
        *(float4*)(io + (size_t)t * D + c) = o; }
}

namespace pg8 {
#define PG8_LAS __attribute__((address_space(3)))
typedef short bf16x8 __attribute__((ext_vector_type(8)));
typedef float f32x4 __attribute__((ext_vector_type(4)));
typedef float f32x2 __attribute__((ext_vector_type(2)));
typedef unsigned u32x4 __attribute__((ext_vector_type(4)));
typedef unsigned u32x2 __attribute__((ext_vector_type(2)));
constexpr int BM = 256, BK = 64, HALF = 128, HTB = HALF * BK * 2, STAGE_BYTES = 8 * HTB, NXCD = 8, WGM = 8;
__host__ __device__ __forceinline__ int lds_byte(int r, int c) { const int st = (r >> 4) * 2 + (c >> 5), rr = r & 15, cc = c & 31, ob = rr * 64 + cc * 2; return st * 1024 + (ob ^ (((ob >> 9) & 1) << 5)); }
__host__ __device__ __forceinline__ void stage_rc(int b, int& R, int& C) { const int st = b / 1024, sb = b % 1024, swz = sb ^ (((sb >> 9) & 1) << 5); R = (st >> 1) * 16 + swz / 64; C = (st & 1) * 32 + (swz % 64) / 2; }
__host__ __device__ __forceinline__ int perm32(int rho) { const int n = rho >> 4, i = rho & 15; return 8 * (i >> 2) + 4 * n + (i & 3); }
__device__ __forceinline__ unsigned cvt_pk_bf16(float lo, float hi) { unsigned r; asm volatile("v_cvt_pk_bf16_f32 %0, %1, %2" : "=v"(r) : "v"(lo), "v"(hi)); return r; }

struct Unit { int pm, pn; };
struct StaticOrder {
    int nM, nN, nwg, G, c;
    __device__ void init(int M, int N, int G_, int c_) { nM = M / BM; nN = N / BM; nwg = nM * nN; G = G_; c = c_; }
    __device__ bool next(int i, Unit& u) const {
        const long L = (long)i * G + c; if (L >= nwg) return false;
        int wgid = (int)L; { const int q = nwg / NXCD, r = nwg % NXCD, xcd = wgid % NXCD, off = wgid / NXCD; wgid = (xcd < r ? xcd * (q + 1) : r * (q + 1) + (xcd - r) * q) + off; }
        const int nig = WGM * nN, gid = wgid / nig, fm = gid * WGM, gsz = (nM - fm) < WGM ? (nM - fm) : WGM;
        u.pm = fm + ((wgid % nig) % gsz); u.pn = (wgid % nig) / gsz; return true;
    }
};
struct PlainProb {
    static constexpr bool GATHER = false;
    const bf16_t* A; const bf16_t* Bt; int lda, ldb, nt;
    __device__ __forceinline__ const char* a_base(const Unit& u) const { return (const char*)(A + (size_t)u.pm * BM * lda); }
    __device__ __forceinline__ void b_base(const Unit& u, const char*& b0, const char*& b1) const { b0 = (const char*)(Bt + (size_t)u.pn * BM * ldb); b1 = b0; }
    __device__ __forceinline__ int ksplit() const { return nt; }
    __device__ __forceinline__ unsigned rowoff(int, int) const { return 0u; }
};

template <class PR, class Sched, class Epi, bool ALIGN_EPI>
__device__ __forceinline__ void gemm_phase(PG8_LAS unsigned char* lds, const PR& pr, const Sched& S, const Epi& E) {
    const int tid = threadIdx.x, wid = __builtin_amdgcn_readfirstlane(tid >> 6), lane = tid & 63, wr = wid >> 2, wc = wid & 3, fr = lane & 15, fq = lane >> 4;
    const int nt = pr.nt, ksp = pr.ksplit();
    unsigned voffA[2][2], nvA[2][2], voffB[2]; int RA[2], CA[2];
#pragma unroll
    for (int i = 0; i < 2; ++i) { int R, C; stage_rc(tid * 16 + i * 8192, R, C); const int Rb = Epi::PERM ? ((R & ~31) + perm32(R & 31)) : R;
        RA[i] = R; CA[i] = C; voffB[i] = (unsigned)(Rb * pr.ldb + C) * 2u; }
    const size_t kstep = (size_t)(BK * 2);
    const size_t hstepB = (size_t)HALF * pr.ldb * 2;
    const unsigned ldsw = (unsigned)wid * 1024u;
    const int aoff = lds_byte(wr * 64 + fr, fq * 8), boff = lds_byte(wc * 32 + fr, fq * 8);
#define PG8_SA(b, h) (((b) * 2 + (h)) * HTB)
#define PG8_SB(b, h) ((4 + (b) * 2 + (h)) * HTB)
#define PG8_STAGE(bufoff, gbase, voff) do { _Pragma("unroll") for (int _i = 0; _i < 2; ++_i) \
        __builtin_amdgcn_global_load_lds((const unsigned*)((const char*)(gbase) + (voff)[_i]), (PG8_LAS unsigned*)(lds + (bufoff) + ldsw + _i * 8192), 16, 0, 0); } while (0)
#define PG8_LDA(dst, b, h) do { _Pragma("unroll") for (int m = 0; m < 4; ++m) _Pragma("unroll") for (int k = 0; k < 2; ++k) dst[m][k] = *(const PG8_LAS bf16x8*)(lds + PG8_SA(b, h) + aoff + m * 2048 + k * 1024); } while (0)
#define PG8_LDB(dst, b, h) do { _Pragma("unroll") for (int n = 0; n < 2; ++n) _Pragma("unroll") for (int k = 0; k < 2; ++k) dst[n][k] = *(const PG8_LAS bf16x8*)(lds + PG8_SB(b, h) + boff + n * 2048 + k * 1024); } while (0)
#define PG8_MMA(ai, bj, At, Bt) do { __builtin_amdgcn_s_setprio(1); _Pragma("unroll") for (int m = 0; m < 4; ++m) _Pragma("unroll") for (int n = 0; n < 2; ++n) _Pragma("unroll") for (int k = 0; k < 2; ++k) \
        acc[ai][bj][m][n] = __builtin_amdgcn_mfma_f32_16x16x32_bf16(Bt[n][k], At[m][k], acc[ai][bj][m][n], 0, 0, 0); __builtin_amdgcn_s_setprio(0); } while (0)
#define PG8_WAIT_V(n) asm volatile("s_waitcnt vmcnt(" #n ")" ::: "memory")
#define PG8_WAIT_L(n) asm volatile("s_waitcnt lgkmcnt(" #n ")" ::: "memory")
#define PG8_BAR __builtin_amdgcn_s_barrier()
#define PG8_SCHED __builtin_amdgcn_sched_barrier(0)
#define PG8_SETVA(dst, slot) do { _Pragma("unroll") for (int _h = 0; _h < 2; ++_h) _Pragma("unroll") for (int _i = 0; _i < 2; ++_i) \
        dst[_h][_i] = PR::GATHER ? (pr.rowoff((slot), _h * HALF + RA[_i]) + (unsigned)CA[_i] * 2u) : (unsigned)((_h * HALF + RA[_i]) * pr.lda + CA[_i]) * 2u; } while (0)
    Unit cur, nxt; int ui = 0;
    if (!S.next(0, cur)) return;
    f32x4 acc[2][2][4][2];
#pragma unroll
    for (int a = 0; a < 2; ++a)
#pragma unroll
        for (int b = 0; b < 2; ++b)
#pragma unroll
            for (int m = 0; m < 4; ++m)
#pragma unroll
                for (int n = 0; n < 2; ++n) acc[a][b][m][n] = (f32x4){0.f, 0.f, 0.f, 0.f};
    bf16x8 At[4][2], B0[2][2], B1[2][2];
    PG8_SETVA(voffA, 0);
    const char* cA = pr.a_base(cur); const char *cB0, *cB1; pr.b_base(cur, cB0, cB1);
    PG8_STAGE(PG8_SB(0, 0), cB0, voffB); PG8_STAGE(PG8_SB(0, 1), cB0 + hstepB, voffB); PG8_STAGE(PG8_SA(0, 0), cA, voffA[0]); PG8_STAGE(PG8_SA(0, 1), cA, voffA[1]);
    if (wr == 1) PG8_BAR;
    PG8_WAIT_V(2); PG8_BAR;
    PG8_STAGE(PG8_SB(1, 0), cB0 + kstep, voffB); PG8_STAGE(PG8_SA(1, 0), cA + kstep, voffA[0]); PG8_STAGE(PG8_SB(1, 1), cB0 + hstepB + kstep, voffB);
    PG8_WAIT_V(6); PG8_BAR;
    for (;;) {
        const bool has_next = S.next(ui + 1, nxt);
        const char *nA = cA, *nB0 = cB0, *nB1 = cB1;
        if (has_next) { nA = pr.a_base(nxt); pr.b_base(nxt, nB0, nB1); }
        if (PR::GATHER) { if (has_next) { PG8_SETVA(nvA, ui + 1); } else {
#pragma unroll
            for (int h = 0; h < 2; ++h)
#pragma unroll
                for (int i = 0; i < 2; ++i) nvA[h][i] = voffA[h][i]; } }
        for (int t = 0; t < nt; t += 2) {
            const bool last = (t == nt - 2);
            const char* a1 = cA + (size_t)(t + 1) * kstep;
            const char* a2 = last ? nA : cA + (size_t)(t + 2) * kstep;
            const char* b2 = last ? nB0 : ((t + 2 < ksp) ? cB0 + (size_t)(t + 2) * kstep : cB1 + (size_t)(t + 2 - ksp) * kstep);
            const char* a3 = a2 + kstep; const char* b3 = b2 + kstep;
            unsigned va2[2][2];
#pragma unroll
            for (int h = 0; h < 2; ++h)
#pragma unroll
                for (int i = 0; i < 2; ++i) va2[h][i] = (PR::GATHER && last) ? nvA[h][i] : voffA[h][i];
            PG8_LDB(B0, 0, 0); PG8_LDB(B1, 0, 1); PG8_SCHED; PG8_LDA(At, 0, 0); PG8_STAGE(PG8_SA(1, 1), a1, voffA[1]);
            PG8_WAIT_V(8); PG8_WAIT_L(0); PG8_BAR; PG8_MMA(0, 0, At, B0); PG8_MMA(0, 1, At, B1); PG8_BAR; PG8_SCHED;
            PG8_LDA(At, 0, 1); PG8_STAGE(PG8_SB(0, 0), b2, voffB); PG8_STAGE(PG8_SB(0, 1), b2 + hstepB, voffB); PG8_STAGE(PG8_SA(0, 0), a2, va2[0]);
            PG8_WAIT_V(8); PG8_WAIT_L(0); PG8_BAR; PG8_MMA(1, 0, At, B0); PG8_MMA(1, 1, At, B1); PG8_BAR; PG8_SCHED;
            PG8_LDB(B0, 1, 0); PG8_LDB(B1, 1, 1); PG8_SCHED; PG8_LDA(At, 1, 0); PG8_STAGE(PG8_SA(0, 1), a2, va2[1]);
            PG8_WAIT_V(8); PG8_WAIT_L(0); PG8_BAR; PG8_MMA(0, 0, At, B0); PG8_MMA(0, 1, At, B1); PG8_BAR; PG8_SCHED;
            PG8_LDA(At, 1, 1); PG8_STAGE(PG8_SB(1, 0), b3, voffB); PG8_STAGE(PG8_SB(1, 1), b3 + hstepB, voffB); PG8_STAGE(PG8_SA(1, 0), a3, va2[0]);
            PG8_WAIT_V(8); PG8_WAIT_L(0); PG8_BAR; PG8_MMA(1, 0, At, B0); PG8_MMA(1, 1, At, B1); PG8_BAR; PG8_SCHED;
        }
        if constexpr (ALIGN_EPI) { if (wr == 0) PG8_BAR; }
        if constexpr (!Epi::AFTER_DRAIN) { E(acc, cur, ui, wr, wc, fr, fq); }
        if (!has_next) break;
#pragma unroll
        for (int a = 0; a < 2; ++a)
#pragma unroll
            for (int b = 0; b < 2; ++b)
#pragma unroll
                for (int m = 0; m < 4; ++m)
#pragma unroll
                    for (int n = 0; n < 2; ++n) acc[a][b][m][n] = (f32x4){0.f, 0.f, 0.f, 0.f};
        cur = nxt; cA = nA; cB0 = nB0; cB1 = nB1; ++ui;
        if (PR::GATHER) {
#pragma unroll
            for (int h = 0; h < 2; ++h)
#pragma unroll
                for (int i = 0; i < 2; ++i) voffA[h][i] = nvA[h][i]; }
        if constexpr (ALIGN_EPI) { if (wr == 1) PG8_BAR; }
    }
    PG8_WAIT_V(0);
    if constexpr (!ALIGN_EPI) { if (wr == 0) PG8_BAR; }
    PG8_BAR;
    if constexpr (Epi::AFTER_DRAIN) { E.fused(acc, cur, ui, wr, wc, fr, fq, lds, wid, lane); }
#undef PG8_SA
#undef PG8_SB
#undef PG8_STAGE
#undef PG8_LDA
#undef PG8_LDB
#undef PG8_MMA
#undef PG8_WAIT_V
#undef PG8_WAIT_L
#undef PG8_BAR
#undef PG8_SCHED
#undef PG8_SETVA
}

struct EpiInproj {
    static constexpr bool PERM = true, AFTER_DRAIN = false;
    const float* b_in; bf16_t *z, *xbc, *q, *k, *v;
    __device__ __forceinline__ void operator()(const f32x4 (&acc)[2][2][4][2], const Unit& u, int, int wr, int wc, int fr, int fq) const {
        const int pn = u.pn; bf16_t* base; int ldc, colt; float sc = 1.f;
        if (pn < 2) { base = z; ldc = 512; colt = pn * 256; }
        else if (pn < 6) { base = xbc; ldc = 1024; colt = (pn - 2) * 256; }
        else if (pn < 8) { base = q; ldc = 512; colt = (pn - 6) * 256; sc = C2; }
        else if (pn < 10) { base = k; ldc = 512; colt = (pn - 8) * 256; }
        else { base = v; ldc = 512; colt = (pn - 10) * 256; }
        const int row0 = u.pm * BM + wr * 64 + fr;
        const int col0 = colt + wc * 32 + 8 * fq, bcol0 = pn * BM + (pn >= 6 ? 8 : 0) + wc * 32 + 8 * fq;
        f32x4 bv[2][2];
#pragma unroll
        for (int bj = 0; bj < 2; ++bj)
#pragma unroll
            for (int n = 0; n < 2; ++n) bv[bj][n] = *(const f32x4*)(b_in + bcol0 + bj * HALF + 4 * n);
#pragma unroll
        for (int ai = 0; ai < 2; ++ai)
#pragma unroll
            for (int m = 0; m < 4; ++m) { bf16_t* rowp = base + (size_t)(row0 + ai * HALF + m * 16) * ldc + col0;
#pragma unroll
                for (int bj = 0; bj < 2; ++bj) { f32x4 v0 = (acc[ai][bj][m][0] + bv[bj][0]) * sc, v1 = (acc[ai][bj][m][1] + bv[bj][1]) * sc;
                    u32x4 w; w.x = cvt_pk_bf16(v0[0], v0[1]); w.y = cvt_pk_bf16(v0[2], v0[3]); w.z = cvt_pk_bf16(v1[0], v1[1]); w.w = cvt_pk_bf16(v1[2], v1[3]);
                    *(u32x4*)(rowp + bj * HALF) = w; } }
    }
};

struct EpiOutproj {
    static constexpr bool PERM = true, AFTER_DRAIN = false;
    bf16_t* mix;
    __device__ __forceinline__ void operator()(const f32x4 (&acc)[2][2][4][2], const Unit& u, int, int wr, int wc, int fr, int fq) const {
        const int col0 = u.pn * BM + wc * 32 + 8 * fq;
#pragma unroll
        for (int ai = 0; ai < 2; ++ai)
#pragma unroll
            for (int m = 0; m < 4; ++m) { bf16_t* rowp = mix + (size_t)(u.pm * BM + ai * HALF + wr * 64 + m * 16 + fr) * D + col0;
#pragma unroll
                for (int bj = 0; bj < 2; ++bj) { const f32x4 v0 = acc[ai][bj][m][0], v1 = acc[ai][bj][m][1];
                    u32x4 w; w.x = cvt_pk_bf16(v0[0], v0[1]); w.y = cvt_pk_bf16(v0[2], v0[3]); w.z = cvt_pk_bf16(v1[0], v1[1]); w.w = cvt_pk_bf16(v1[2], v1[3]);
                    *(u32x4*)(rowp + bj * HALF) = w; } }
    }
};

struct MoeGeo {
    const PG8_LAS int* tab;
    __device__ __forceinline__ int np() const { return tab[24]; }
    __device__ __forceinline__ int cls_of(int panel) const { int c = 0;
#pragma unroll 1
        for (int j = 1; j < 24; ++j) if (panel >= tab[j]) c = j;
        return c; }
};
struct MoeOrder {
    int total, npn, G, c;
    __device__ __forceinline__ bool next(int i, Unit& u) const { const int L = i * G + c; if (L >= total) return false; u.pm = L / npn; u.pn = L % npn; return true; }
};
struct Moe1Prob {
    static constexpr bool GATHER = true;
    const bf16_t* A; const bf16_t* Wgu; MoeGeo geo; const PG8_LAS unsigned* rofftab; int lda, ldb, nt;
    __device__ __forceinline__ const char* a_base(const Unit&) const { return (const char*)A; }
    __device__ __forceinline__ void b_base(const Unit& u, const char*& b0, const char*& b1) const { int ea, eb; cls_experts(geo.cls_of(u.pm), ea, eb); const int e = u.pn < 4 ? ea : eb;
        b0 = (const char*)(Wgu + (size_t)((e * 4 + (u.pn & 3)) * 256) * 1024); b1 = b0; }
    __device__ __forceinline__ int ksplit() const { return nt; }
    __device__ __forceinline__ unsigned rowoff(int slot, int r) const { return rofftab[slot * 256 + r]; }
};
__device__ __forceinline__ float silu_fast(float g) { return g * __builtin_amdgcn_rcpf(1.f + __builtin_amdgcn_exp2f(-g * LOG2E)); }
struct EpiMoe1 {
    static constexpr bool PERM = true, AFTER_DRAIN = false;
    bf16_t* act; const float* tokinfo; const PG8_LAS int* toktab;
    __device__ __forceinline__ void operator()(const f32x4 (&acc)[2][2][4][2], const Unit& u, int slot, int wr, int wc, int fr, int fq) const {
        const int ex = u.pn >> 2; const int col0 = ex * 512 + (u.pn & 3) * 128 + wc * 32 + 8 * fq;
#pragma unroll
        for (int ai = 0; ai < 2; ++ai)
#pragma unroll
            for (int m = 0; m < 4; ++m) { const int r = ai * HALF + wr * 64 + m * 16 + fr; const int tok = toktab[slot * 256 + r];
                const float w = tok >= 0 ? tokinfo[(size_t)tok * 4 + 2 + ex] : 0.f;
                const f32x4 g0 = acc[ai][0][m][0], g1 = acc[ai][0][m][1], u0 = acc[ai][1][m][0], u1 = acc[ai][1][m][1];
                float o[8];
#pragma unroll
                for (int j = 0; j < 4; ++j) { o[j] = silu_fast(g0[j]) * u0[j] * w; o[4 + j] = silu_fast(g1[j]) * u1[j] * w; }
                u32x4 wv; wv.x = cvt_pk_bf16(o[0], o[1]); wv.y = cvt_pk_bf16(o[2], o[3]); wv.z = cvt_pk_bf16(o[4], o[5]); wv.w = cvt_pk_bf16(o[6], o[7]);
                *(u32x4*)(act + (size_t)(u.pm * BM + r) * 1024 + col0) = wv; }
    }
};
struct Moe2Prob {
    static constexpr bool GATHER = false;
    const bf16_t* A; const bf16_t* Wd; MoeGeo geo; int lda, ldb, nt;
    __device__ __forceinline__ const char* a_base(const Unit& u) const { return (const char*)(A + (size_t)u.pm * BM * lda); }
    __device__ __forceinline__ void b_base(const Unit& u, const char*& b0, const char*& b1) const { int ea, eb; cls_experts(geo.cls_of(u.pm), ea, eb);
        b0 = (const char*)(Wd + ((size_t)ea * 1024 + u.pn * 256) * 512); b1 = (const char*)(Wd + ((size_t)eb * 1024 + u.pn * 256) * 512); }
    __device__ __forceinline__ int ksplit() const { return 8; }
    __device__ __forceinline__ unsigned rowoff(int, int) const { return 0u; }
};
struct EpiMoe2 {
    static constexpr bool PERM = true, AFTER_DRAIN = false;
    bf16_t* ffn; const PG8_LAS int* toktab;
    __device__ __forceinline__ void operator()(const f32x4 (&acc)[2][2][4][2], const Unit& u, int slot, int wr, int wc, int fr, int fq) const {
        const int col0 = u.pn * BM + wc * 32 + 8 * fq;
#pragma unroll
        for (int ai = 0; ai < 2; ++ai)
#pragma unroll
            for (int m = 0; m < 4; ++m) { const int r = ai * HALF + wr * 64 + m * 16 + fr; const int tok = toktab[slot * 256 + r];
                if (tok >= 0) { bf16_t* rowp = ffn + (size_t)tok * D + col0;
#pragma unroll
                    for (int bj = 0; bj < 2; ++bj) { const f32x4 v0 = acc[ai][bj][m][0], v1 = acc[ai][bj][m][1];
                        u32x4 w; w.x = cvt_pk_bf16(v0[0], v0[1]); w.y = cvt_pk_bf16(v0[2], v0[3]); w.z = cvt_pk_bf16(v1[0], v1[1]); w.w = cvt_pk_bf16(v1[2], v1[3]);
                        *(u32x4*)(rowp + bj * HALF) = w; } } }
    }
};
}

#include <cmath>
namespace attn_body {

using bf16=__hip_bfloat16;
#define ALAS __attribute__((address_space(3)))
using bf16x8=__attribute__((ext_vector_type(8)))short;
using s16x4=__attribute__((ext_vector_type(4)))short;
using f32x16=__attribute__((ext_vector_type(16)))float;
using u32x4=__attribute__((ext_vector_type(4)))unsigned;
constexpr int BATCH=16,NHEAD=8,SEQ=2048,D=64,DM=NHEAD*D,ODM=1024,OCOL=512;
constexpr int NW=8,QBLK=32,QB=QBLK*NW,KVBLK=64,NQB=SEQ/QB;
constexpr int ATTN_PITCH=DM, ATTN_UNIT_ROWS=QB;
__device__ __forceinline__ int crow(int r,int hi){return (r&3)+8*(r>>2)+4*hi;}
#define SBAR() __builtin_amdgcn_sched_barrier(0)
__device__ __forceinline__ void cmask(f32x16&p0,f32x16&p1,int jb,int qrel,int hi){
  const float NEG=-INFINITY; int kb=64*jb+4*hi;
  #pragma unroll
  for(int r=0;r<16;++r){int kv=kb+(r&3)+8*(r>>2); if(kv>qrel)p0[r]=NEG; if(kv+32>qrel)p1[r]=NEG;}
}

constexpr int NSLOT=3, SLOTB=9216, KXOFF=8192;
constexpr int LDS_K=0, LDS_V=NSLOT*SLOTB, LDS_WS=2*NSLOT*SLOTB, LDS_OST=LDS_WS+NW*64*4, LDS_BYTES=LDS_OST+NW*4096;
constexpr float C2=0.125f*1.4426950408889634f;
__device__ __forceinline__ void glds16(const void*gsrc,unsigned lds_dst){unsigned keep;
  asm volatile("s_mov_b32 %0, m0\n\ts_mov_b32 m0, %2\n\ts_nop 0\n\tglobal_load_lds_dwordx4 %1, off\n\ts_mov_b32 m0, %0":"=&s"(keep):"v"(gsrc),"s"(lds_dst):"memory");}
__device__ __forceinline__ void glds16s(const void*sbase,unsigned voff,unsigned lds_dst){unsigned keep;
  asm volatile("s_nop 4\n\ts_mov_b32 %0, m0\n\ts_mov_b32 m0, %3\n\ts_nop 0\n\tglobal_load_lds_dwordx4 %1, %2\n\ts_mov_b32 m0, %0":"=&s"(keep):"v"(voff),"s"(sbase),"s"(lds_dst):"memory");}
__device__ __forceinline__ const char* sptr(const void*p){ const unsigned long long v=(unsigned long long)p; const unsigned lo=__builtin_amdgcn_readfirstlane((unsigned)v), hi=__builtin_amdgcn_readfirstlane((unsigned)(v>>32)); return (const char*)(((unsigned long long)hi<<32)|lo); }
__device__ __forceinline__ float max3f(float a,float b,float c){float r;asm("v_max3_f32 %0, %1, %2, %3":"=v"(r):"v"(a),"v"(b),"v"(c));return r;}
__device__ __forceinline__ float max2f(float a,float b){float r;asm("v_max_f32_e32 %0, %1, %2":"=v"(r):"v"(a),"v"(b));return r;}
__device__ __forceinline__ float fadd_s(float a,float b){float r;asm("v_add_f32_e32 %0, %1, %2":"=v"(r):"v"(a),"v"(b));return r;}
__device__ __forceinline__ float fsub_s(float a,float b){float r;asm("v_sub_f32_e32 %0, %1, %2":"=v"(r):"v"(a),"v"(b));return r;}
typedef float f32x2_t __attribute__((ext_vector_type(2))); typedef __bf16 bf16x2_t __attribute__((ext_vector_type(2)));
__device__ __forceinline__ unsigned cvtpk_s(float lo,float hi){f32x2_t v={lo,hi};bf16x2_t b=__builtin_convertvector(v,bf16x2_t);return __builtin_bit_cast(unsigned,b);}
#define WAIT_BAR(N) asm volatile("s_waitcnt vmcnt(" #N ") lgkmcnt(0)\n\ts_barrier":::"memory")
#define WAIT_BARK(N,N0) do{ if(wid==0){WAIT_BAR(N0);} else {WAIT_BAR(N);} }while(0)

__device__ __forceinline__ void qkt(f32x16&p0,f32x16&p1,const char*Kslot,const bf16x8*qr,const bf16x8 qr4,const f32x16&negm,int r32,int hi){
  const char*kb=Kslot+hi*1024+r32*16;
  #pragma unroll
  for(int d0=0;d0<4;++d0){
    const bf16x8 b0=*reinterpret_cast<const bf16x8*>(kb+d0*2048);
    const bf16x8 b1=*reinterpret_cast<const bf16x8*>(kb+d0*2048+512);
    if(d0==0){p0=__builtin_amdgcn_mfma_f32_32x32x16_bf16(b0,qr[0],negm,0,0,0);p1=__builtin_amdgcn_mfma_f32_32x32x16_bf16(b1,qr[0],negm,0,0,0);}
    else{p0=__builtin_amdgcn_mfma_f32_32x32x16_bf16(b0,qr[d0],p0,0,0,0);p1=__builtin_amdgcn_mfma_f32_32x32x16_bf16(b1,qr[d0],p1,0,0,0);}}
  { const bf16x8 x0=*reinterpret_cast<const bf16x8*>(Kslot+KXOFF+r32*16); const bf16x8 x1=*reinterpret_cast<const bf16x8*>(Kslot+KXOFF+r32*16+512);
    p0=__builtin_amdgcn_mfma_f32_32x32x16_bf16(x0,qr4,p0,0,0,0);p1=__builtin_amdgcn_mfma_f32_32x32x16_bf16(x1,qr4,p1,0,0,0); }
}
typedef __attribute__((address_space(3))) const char* lds_cptr;
typedef short v4i16_t __attribute__((ext_vector_type(4)));
__device__ __forceinline__ void kload8(bf16x8*kf,lds_cptr kp){
  kf[0]=*(const __attribute__((address_space(3))) bf16x8*)(kp);      kf[1]=*(const __attribute__((address_space(3))) bf16x8*)(kp+512);
  kf[2]=*(const __attribute__((address_space(3))) bf16x8*)(kp+2048); kf[3]=*(const __attribute__((address_space(3))) bf16x8*)(kp+2560);
  kf[4]=*(const __attribute__((address_space(3))) bf16x8*)(kp+4096); kf[5]=*(const __attribute__((address_space(3))) bf16x8*)(kp+4608);
  kf[6]=*(const __attribute__((address_space(3))) bf16x8*)(kp+6144); kf[7]=*(const __attribute__((address_space(3))) bf16x8*)(kp+6656);
}
__device__ __forceinline__ void kload2(bf16x8*kf,lds_cptr kp,int j){ kf[2*j]=*(const __attribute__((address_space(3))) bf16x8*)(kp+j*2048); kf[2*j+1]=*(const __attribute__((address_space(3))) bf16x8*)(kp+j*2048+512); }
__device__ __forceinline__ s16x4 vtr(lds_cptr p){ return __builtin_bit_cast(s16x4,__builtin_amdgcn_ds_read_tr16_b64_v4i16((__attribute__((address_space(3))) v4i16_t*)p)); }
__device__ __forceinline__ float rowmax(const f32x16&p0,const f32x16&p1){
  float a=max3f(p0[0],p0[1],p1[0]),b=max3f(p0[2],p0[3],p1[1]);a=max3f(a,p1[2],p1[3]);
  #pragma unroll
  for(int r=4;r<16;r+=4){a=max3f(a,p0[r],p0[r+1]);b=max3f(b,p0[r+2],p0[r+3]);a=max3f(a,p1[r],p1[r+1]);b=max3f(b,p1[r+2],p1[r+3]);}
  const float m=max2f(a,b);
  auto rr=__builtin_amdgcn_permlane32_swap(__float_as_uint(m),__float_as_uint(m),false,false);
  return max2f(__uint_as_float(rr[0]),__uint_as_float(rr[1]));
}
__device__ __forceinline__ void pv(f32x16*o,int vb,bf16x8 pa0,bf16x8 pa1,bf16x8 pa2,bf16x8 pa3){
  #pragma unroll
  for(int d0=0;d0<2;++d0){s16x4 lo[4],hi[4];
    #pragma unroll
    for(int ks=0;ks<4;++ks){
      asm volatile("ds_read_b64_tr_b16 %0,%1 offset:%c2":"=&v"(lo[ks]):"v"(vb),"i"(d0*4096+ks*1024):"memory");
      asm volatile("ds_read_b64_tr_b16 %0,%1 offset:%c2":"=&v"(hi[ks]):"v"(vb),"i"(d0*4096+ks*1024+512):"memory");}
    asm volatile("s_waitcnt lgkmcnt(0)":::"memory");SBAR();
    #define PK(k) (bf16x8){lo[k][0],lo[k][1],lo[k][2],lo[k][3],hi[k][0],hi[k][1],hi[k][2],hi[k][3]}
    o[d0]=__builtin_amdgcn_mfma_f32_32x32x16_bf16(pa0,PK(0),o[d0],0,0,0);
    o[d0]=__builtin_amdgcn_mfma_f32_32x32x16_bf16(pa1,PK(1),o[d0],0,0,0);
    o[d0]=__builtin_amdgcn_mfma_f32_32x32x16_bf16(pa2,PK(2),o[d0],0,0,0);
    o[d0]=__builtin_amdgcn_mfma_f32_32x32x16_bf16(pa3,PK(3),o[d0],0,0,0);
    #undef PK
  }
}

#ifndef ATTN_STORE16
#define ATTN_STORE16(p,v) (*(u32x4*)(p)=(v))
#endif
template<int THRL> __device__ __forceinline__ void attn_unit(int b,int h,int qb,const bf16*Q,const bf16*__restrict__ K,const bf16*__restrict__ V,const bf16*__restrict__ KX,bf16*O,char*shm){
  const int tid=threadIdx.x,lane=tid&63,r32=lane&31,hi=lane>>5; const int wid=__builtin_amdgcn_readfirstlane(tid>>6);
  const long rowbase=(long)b*SEQ; const int q0=qb*QB;
  const bf16*Qw=Q+(rowbase+q0+wid*QBLK)*DM+h*D;
  const bf16*Kh=K+rowbase*DM+h*D,*Vh=V+rowbase*DM+h*D;
  const unsigned lds0=(unsigned)(uintptr_t)shm;
  float*wsf=(float*)(shm+LDS_WS)+wid*64;
  const unsigned koff=(unsigned)(lane*DM*2+wid*16), voff=(unsigned)((16*(wid&3)+(lane>>2))*DM*2+(wid>>2)*64+(lane&3)*16), kxoff=(unsigned)(lane*NHEAD*16);
  const unsigned kdst=lds0+LDS_K+wid*1024, vdst=lds0+LDS_V+wid*1024, kxdst=lds0+LDS_K+KXOFF;
  const char*Kb=sptr(Kh), *Vb=sptr(Vh), *KXb=sptr(KX+(rowbase*NHEAD+h)*8);
  #define TILE(p) ((p)==0?NT-4:((p)<=3?NT-(p):NT-1-(p)))
  #define DMA_K(t,slot) do{ const long tl_=TILE(t); glds16s(Kb+tl_*(KVBLK*DM*2),koff,(unsigned)__builtin_amdgcn_readfirstlane(kdst+(slot))); if(wid==0) glds16s(KXb+tl_*(KVBLK*NHEAD*16),kxoff,(unsigned)__builtin_amdgcn_readfirstlane(kxdst+(slot))); }while(0)
  #define DMA_V(t,slot) do{ const long tl_=TILE(t); glds16s(Vb+tl_*(KVBLK*DM*2),voff,(unsigned)__builtin_amdgcn_readfirstlane(vdst+(slot))); }while(0)
  const int vb0=(int)(lds0+LDS_V)+((lane>>4)&1)*32+(lane&3)*8+(4*hi+((lane&15)>>2))*64;
  const char*Kbase=shm+LDS_K; bf16x8 kf[8]; bf16x8 kx0,kx1;
  const lds_cptr shm3=(lds_cptr)shm; const lds_cptr kxp0=shm3+LDS_K+KXOFF+r32*16; const lds_cptr kp0=shm3+LDS_K+hi*1024+r32*16; const lds_cptr vp0=shm3+LDS_V+((lane>>4)&1)*32+(lane&3)*8+(4*hi+((lane&15)>>2))*64;
  const int NT=(q0+QB)/KVBLK;
  DMA_K(0,0);DMA_V(0,0);DMA_K(1,SLOTB);
  bf16x8 qr[4]; bf16x8 qr4={0,0,0,0,0,0,0,0}; if(hi==0){qr4[0]=(short)0x3F80;qr4[1]=(short)0x3F80;qr4[2]=(short)0x3F80;}
  #pragma unroll
  for(int d0=0;d0<4;++d0)qr[d0]=*reinterpret_cast<const bf16x8*>(&Qw[(long)r32*DM+d0*16+hi*8]);
  float mhat=0.f,l_reg=0.f;f32x16 o[2];o[0]=f32x16{};o[1]=f32x16{};f32x16 negm=f32x16{};asm volatile("":"+v"(negm));
  const int qrel=wid*QBLK+r32;
  #define CMASK(P0,P1,t) do{int jb_=(t)==0?0:((t)<=3?4-(t):-1); if(jb_>=0)cmask(P0,P1,jb_,qrel,hi);}while(0)
  bool resc=false;
  #define START(P0,P1) do{ const float rm=rowmax(P0,P1); resc=false; \
    { const float dl=rm; mhat=fadd_s(mhat,dl); \
      _Pragma("unroll") for(int r=0;r<16;++r){P0[r]=fsub_s(P0[r],dl);P1[r]=fsub_s(P1[r],dl);} \
      _Pragma("unroll") for(int r=0;r<16;++r)negm[r]=-mhat; asm volatile("":"+v"(negm)); } \
    _Pragma("unroll") for(int r=0;r<16;++r)P0[r]=__builtin_amdgcn_exp2f(P0[r]); }while(0)
  #define RESC() do{ if(resc){ asm volatile("s_waitcnt lgkmcnt(0)":::"memory"); \
      _Pragma("unroll") for(int d_=0;d_<2;++d_) _Pragma("unroll") for(int r=0;r<16;++r)o[d_][r]*=wsf[crow(r,hi)]; } }while(0)
  f32x16 pA0,pA1,pB0,pB1;
  int sl_prev=0,sl_cur=0,sl_next=SLOTB;
  #define ROT() do{sl_prev=sl_cur;sl_cur=sl_next;sl_next=(sl_next==(NSLOT-1)*SLOTB)?0:sl_next+SLOTB;}while(0)
  DMA_K(2,2*SLOTB);
  WAIT_BARK(3,5);
  qkt(pA0,pA1,Kbase,qr,qr4,negm,r32,hi);asm volatile("s_nop 15\n\ts_nop 7":"+v"(pA0),"+v"(pA1));CMASK(pA0,pA1,0);
  START(pA0,pA1);
  _Pragma("unroll") for(int r=0;r<16;++r)pA1[r]=__builtin_amdgcn_exp2f(pA1[r]);
  WAIT_BAR(0);
  DMA_K(3,0);DMA_V(1,SLOTB);
  ROT();
  kload8(kf,kp0+sl_cur); kx0=*(const ALAS bf16x8*)(kxp0+sl_cur); kx1=*(const ALAS bf16x8*)(kxp0+sl_cur+512);
  WAIT_BARK(2,3);
  s16x4 vlo[8],vhi[8]; u32x4 pw0,pw1,pw2,pw3;
  #define PKW(P,B) cvtpk_s(P[B],P[B+1])
  #define PAF(k) __builtin_bit_cast(bf16x8,pw##k)
  #define VFR(i) (bf16x8){vlo[i][0],vlo[i][1],vlo[i][2],vlo[i][3],vhi[i][0],vhi[i][1],vhi[i][2],vhi[i][3]}
  #define PIN(x) asm volatile("":"+v"(x))
  #define MX3(a,b,c) __builtin_fmaxf(__builtin_fmaxf((a),(b)),(c))
  #define GAPA(MF,A0,A1,A2,A3,W0,W1,PW) do{ MF; sacc+=A0; sacc+=A1; sacc+=A2; sacc+=A3; PIN(sacc); W0; W1; PIN(PW); SBAR(); }while(0)
  #define EX(v) __builtin_amdgcn_exp2f(v)
  #define GAPB(MF,X,B) do{ MF; X[B]=EX(X[B]); X[B+1]=EX(X[B+1]); X[B+2]=EX(X[B+2]); X[B+3]=EX(X[B+3]); PIN(X); SBAR(); }while(0)
  #define VRD(i) do{ vlo[i]=vtr(vp_+(((i)>>2)*4096+((i)&3)*1024)); vhi[i]=vtr(vp_+(((i)>>2)*4096+((i)&3)*1024+512)); }while(0)
  #define KRD(G,j) do{ if(G){ kload2(kf,kp0+sl_next,j); SBAR(); } }while(0)
  #define STEP(C0,C1,P0,P1,t,GK,GV,GL) do{ SBAR(); \
    const lds_cptr vp_=vp0+sl_prev; \
    VRD(0); SBAR(); float sacc=(P0[0]+P0[1]); \
    GAPA(C0=__builtin_amdgcn_mfma_f32_32x32x16_bf16(kf[0],qr[0],negm,0,0,0), P0[2],P0[3],P0[4],P0[5],     pw0[0]=PKW(P0,0), pw0[1]=PKW(P0,2), pw0); \
    VRD(4); SBAR(); GAPA(C1=__builtin_amdgcn_mfma_f32_32x32x16_bf16(kf[1],qr[0],negm,0,0,0), P0[6],P0[7],P0[8],P0[9],     pw0[2]=PKW(P0,4), pw0[3]=PKW(P0,6), pw0); \
    VRD(1); SBAR(); GAPA(C0=__builtin_amdgcn_mfma_f32_32x32x16_bf16(kf[2],qr[1],C0,0,0,0),   P0[10],P0[11],P0[12],P0[13], pw1[0]=PKW(P0,8), pw1[1]=PKW(P0,10), pw1); \
    VRD(5); SBAR(); GAPA(C1=__builtin_amdgcn_mfma_f32_32x32x16_bf16(kf[3],qr[1],C1,0,0,0),   P0[14],P0[15],P1[0],P1[1],   pw1[2]=PKW(P0,12),pw1[3]=PKW(P0,14), pw1); \
    VRD(2); SBAR(); GAPA(C0=__builtin_amdgcn_mfma_f32_32x32x16_bf16(kf[4],qr[2],C0,0,0,0),   P1[2],P1[3],P1[4],P1[5],     pw2[0]=PKW(P1,0), pw2[1]=PKW(P1,2), pw2); \
    VRD(6); SBAR(); GAPA(C1=__builtin_amdgcn_mfma_f32_32x32x16_bf16(kf[5],qr[2],C1,0,0,0),   P1[6],P1[7],P1[8],P1[9],     pw2[2]=PKW(P1,4), pw2[3]=PKW(P1,6), pw2); \
    VRD(3); SBAR(); GAPA(C0=__builtin_amdgcn_mfma_f32_32x32x16_bf16(kf[6],qr[3],C0,0,0,0),   P1[10],P1[11],P1[12],P1[13], pw3[0]=PKW(P1,8), pw3[1]=PKW(P1,10), pw3); \
    VRD(7); SBAR(); GAPA(C1=__builtin_amdgcn_mfma_f32_32x32x16_bf16(kf[7],qr[3],C1,0,0,0),   P1[14],P1[15],0.f,0.f,       pw3[2]=PKW(P1,12),pw3[3]=PKW(P1,14), pw3); \
    C0=__builtin_amdgcn_mfma_f32_32x32x16_bf16(kx0,qr4,C0,0,0,0); C1=__builtin_amdgcn_mfma_f32_32x32x16_bf16(kx1,qr4,C1,0,0,0); SBAR(); \
    l_reg+=sacc; \
    if(GK){DMA_K((t)+3,sl_cur);} if(GV){DMA_V((t)+1,sl_next);} \
    CMASK(C0,C1,t); \
    { float a=MX3(C0[0],C0[1],C1[0]),b=MX3(C0[2],C0[3],C1[1]); a=MX3(a,C1[2],C1[3]); \
      _Pragma("unroll") for(int r=4;r<16;r+=4){a=MX3(a,C0[r],C0[r+1]);b=MX3(b,C0[r+2],C0[r+3]);a=MX3(a,C1[r],C1[r+1]);b=MX3(b,C1[r+2],C1[r+3]);} \
      float rm=__builtin_fmaxf(a,b); { auto rr=__builtin_amdgcn_permlane32_swap(__float_as_uint(rm),__float_as_uint(rm),false,false); rm=__builtin_fmaxf(__uint_as_float(rr[0]),__uint_as_float(rr[1])); } \
      resc=false; \
      if(__builtin_expect(__any(rm>(float)THRL),0)){ const float dl=__builtin_fmaxf(rm,0.f); mhat+=dl; \
        _Pragma("unroll") for(int r=0;r<16;++r){C0[r]-=dl;C1[r]-=dl;} \
        _Pragma("unroll") for(int r=0;r<16;++r)negm[r]=-mhat; asm volatile("":"+v"(negm)); \
        const float f=__builtin_amdgcn_exp2f(-dl); l_reg*=f; if(hi==0)wsf[r32]=f; resc=true; } } \
    SBAR(); \
    GAPB(o[0]=__builtin_amdgcn_mfma_f32_32x32x16_bf16(PAF(0),VFR(0),o[0],0,0,0), C0,0); \
    GAPB(o[1]=__builtin_amdgcn_mfma_f32_32x32x16_bf16(PAF(0),VFR(4),o[1],0,0,0), C0,4); \
    KRD(GL,0); GAPB(o[0]=__builtin_amdgcn_mfma_f32_32x32x16_bf16(PAF(1),VFR(1),o[0],0,0,0), C0,8); \
    KRD(GL,1); GAPB(o[1]=__builtin_amdgcn_mfma_f32_32x32x16_bf16(PAF(1),VFR(5),o[1],0,0,0), C0,12); \
    KRD(GL,2); GAPB(o[0]=__builtin_amdgcn_mfma_f32_32x32x16_bf16(PAF(2),VFR(2),o[0],0,0,0), C1,0); \
    KRD(GL,3); GAPB(o[1]=__builtin_amdgcn_mfma_f32_32x32x16_bf16(PAF(2),VFR(6),o[1],0,0,0), C1,4); \
    if(GL){ kx0=*(const ALAS bf16x8*)(kxp0+sl_next); kx1=*(const ALAS bf16x8*)(kxp0+sl_next+512); SBAR(); } \
    GAPB(o[0]=__builtin_amdgcn_mfma_f32_32x32x16_bf16(PAF(3),VFR(3),o[0],0,0,0), C1,8); \
    GAPB(o[1]=__builtin_amdgcn_mfma_f32_32x32x16_bf16(PAF(3),VFR(7),o[1],0,0,0), C1,12); \
    }while(0)
  #define ENDW(tt) do{ if((tt)+3<NT){WAIT_BARK(2,3);} else if((tt)+2<NT){WAIT_BAR(1);} else {WAIT_BAR(0);} }while(0)
  int t=1;
  for(;t<5&&t+1<NT;t+=2){
    STEP(pB0,pB1,pA0,pA1,t,(t+3<NT),(t+1<NT),(t+1<NT));       ENDW(t);   RESC(); ROT();
    STEP(pA0,pA1,pB0,pB1,t+1,(t+4<NT),(t+2<NT),(t+2<NT));     ENDW(t+1); RESC(); ROT();
  }
  #undef CMASK
  #define CMASK(P0,P1,t) do{}while(0)
  for(;t+5<NT;t+=2){
    STEP(pB0,pB1,pA0,pA1,t,true,true,true);     WAIT_BARK(2,3); RESC(); ROT();
    STEP(pA0,pA1,pB0,pB1,t+1,true,true,true);   WAIT_BARK(2,3); RESC(); ROT();
  }
  for(;t+1<NT;t+=2){
    STEP(pB0,pB1,pA0,pA1,t,(t+3<NT),(t+1<NT),(t+1<NT));       ENDW(t);   RESC(); ROT();
    STEP(pA0,pA1,pB0,pB1,t+1,(t+4<NT),(t+2<NT),(t+2<NT));     ENDW(t+1); RESC(); ROT();
  }
  #undef CMASK
  #define CMASK(P0,P1,t) do{int jb_=(t)==0?0:((t)<=3?4-(t):-1); if(jb_>=0)cmask(P0,P1,jb_,qrel,hi);}while(0)
  STEP(pB0,pB1,pA0,pA1,NT-1,false,false,false); RESC();
  { float sacc=pB0[0]+pB0[1]; _Pragma("unroll") for(int r=2;r<16;++r)sacc+=pB0[r]; _Pragma("unroll") for(int r=0;r<16;++r)sacc+=pB1[r]; l_reg+=sacc;
    pw0=(u32x4){PKW(pB0,0),PKW(pB0,2),PKW(pB0,4),PKW(pB0,6)};pw1=(u32x4){PKW(pB0,8),PKW(pB0,10),PKW(pB0,12),PKW(pB0,14)};pw2=(u32x4){PKW(pB1,0),PKW(pB1,2),PKW(pB1,4),PKW(pB1,6)};pw3=(u32x4){PKW(pB1,8),PKW(pB1,10),PKW(pB1,12),PKW(pB1,14)};
    SBAR(); pv(o,vb0+sl_cur,PAF(0),PAF(1),PAF(2),PAF(3)); }
  #undef PKW
  #undef PAF
  #undef VFR
  #undef PIN
  #undef MX3
  #undef GAPA
  #undef GAPB
  #undef EX
  #undef VRD
  #undef KRD
  #undef STEP
  #undef ENDW
  {auto rr=__builtin_amdgcn_permlane32_swap(__float_as_uint(l_reg),__float_as_uint(l_reg),false,false);l_reg=__uint_as_float(rr[0])+__uint_as_float(rr[1]);}
  if(hi==0)wsf[32+r32]=l_reg;asm volatile("s_waitcnt lgkmcnt(0)":::"memory");
  int hi_e=hi; asm volatile("":"+v"(hi_e));
  float rli[16];
  #pragma unroll
  for(int r=0;r<16;++r)rli[r]=__builtin_amdgcn_rcpf(wsf[32+crow(r,hi_e)]);
  bf16*Ow=O+(rowbase+q0+wid*QBLK)*ODM+OCOL+h*D;
  { bf16*stg=(bf16*)(shm+LDS_OST)+wid*2048;
    #pragma unroll
    for(int r=0;r<16;++r){const int orow=crow(r,hi_e);
      #pragma unroll
      for(int d0=0;d0<2;++d0)stg[orow*64+d0*32+r32]=__float2bfloat16(o[d0][r]*rli[r]);}
    asm volatile("s_waitcnt lgkmcnt(0)":::"memory");
    #pragma unroll
    for(int i=0;i<4;++i){const int row=i*8+(lane>>3),ch=lane&7; const u32x4 v=*(const u32x4*)(stg+row*64+ch*8); ATTN_STORE16(Ow+(long)row*ODM+ch*8,v);} }
  asm volatile("s_waitcnt lgkmcnt(0)\n\ts_barrier":::"memory");
  #undef DMA_K
  #undef TILE
  #undef DMA_V
  #undef CMASK
  #undef START
  #undef RESC
  #undef ROT
}
constexpr int ATTN_LDS_BYTES=LDS_BYTES;
struct AttnTensors { const bf16* Q; const bf16* K; const bf16* V; const bf16* KX; bf16* O; };
struct AttnUnit { int bh; int qb; };
struct StaticOrder {
  int vcu;
  __device__ __forceinline__ explicit StaticOrder(int grid,int block):vcu((block%8)*(grid/8)+block/8){}
  __device__ __forceinline__ bool next(int i,AttnUnit&u)const{ if(i>=4)return false; const int s=vcu&1; u.bh=vcu>>1; u.qb=(i==0)?(7-s):(i==1)?s:(i==2)?(5-s):(2+s); return true; }
  __device__ __forceinline__ void a_ready(const AttnUnit&)const{}
  __device__ __forceinline__ void done(const AttnUnit&)const{}
};
template<class Sched,int THRL=8> __device__ __forceinline__ void attn_phase(char*lds,const AttnTensors&T,const Sched&S){
  AttnUnit u;
  for(int i=0;S.next(i,u);++i){ S.a_ready(u); attn_unit<THRL>(u.bh/NHEAD,u.bh%NHEAD,u.qb,T.Q,T.K,T.V,T.KX,T.O,lds); S.done(u); }
}
#undef SBAR
#undef WAIT_BAR
}

namespace ssd {
typedef short bf16x8 __attribute__((ext_vector_type(8)));
typedef float f32x4 __attribute__((ext_vector_type(4)));
typedef unsigned u32x4 __attribute__((ext_vector_type(4)));
typedef unsigned u32x2 __attribute__((ext_vector_type(2)));
#define SLAS __attribute__((address_space(3)))
constexpr int LPB = 144;
constexpr int NPB = 272;
constexpr int NCH = SEQ / 64;
__device__ __forceinline__ unsigned pkbf(float lo, float hi) { unsigned r; asm volatile("v_cvt_pk_bf16_f32 %0, %1, %2" : "=v"(r) : "v"(lo), "v"(hi)); return r; }

__device__ __forceinline__ float chunk_acum(const float* dt, const float* a_log, int tok0, int h, int lane, float& dtv) {
    dtv = dt[(size_t)(tok0 + lane) * 8 + h];
    float A = dtv * (-expf(a_log[h]));
#pragma unroll
    for (int o = 1; o < 64; o <<= 1) { const float y = __shfl_up(A, o); if (lane >= o) A += y; }
    return A;
}


__device__ __forceinline__ void conv_chunk(const bf16_t* xbc, const float* cw, const float* cb, bf16_t* xcb, int b, int c) {
    const int tid = threadIdx.x, cg = tid & 127, rq = tid >> 7, ch0 = cg * 8, l0 = rq * 16;
    const size_t tok0 = (size_t)b * SEQ + c * 64;
    float w[4][8], bias[8];
#pragma unroll
    for (int k = 0; k < 4; ++k) { const f32x4 a = *(const f32x4*)(cw + k * 1024 + ch0), bq = *(const f32x4*)(cw + k * 1024 + ch0 + 4);
        w[k][0] = a[0]; w[k][1] = a[1]; w[k][2] = a[2]; w[k][3] = a[3]; w[k][4] = bq[0]; w[k][5] = bq[1]; w[k][6] = bq[2]; w[k][7] = bq[3]; }
    { const f32x4 a = *(const f32x4*)(cb + ch0), bq = *(const f32x4*)(cb + ch0 + 4); bias[0] = a[0]; bias[1] = a[1]; bias[2] = a[2]; bias[3] = a[3]; bias[4] = bq[0]; bias[5] = bq[1]; bias[6] = bq[2]; bias[7] = bq[3]; }
    float win[3][8];
#pragma unroll
    for (int k = 0; k < 3; ++k) { const int l = l0 - 3 + k; u32x4 v = (u32x4){0u, 0u, 0u, 0u};
        if (c * 64 + l >= 0) v = *(const u32x4*)(xbc + (tok0 + l) * 1024 + ch0);
#pragma unroll
        for (int j = 0; j < 4; ++j) { win[k][2 * j] = __uint_as_float(v[j] << 16); win[k][2 * j + 1] = __uint_as_float(v[j] & 0xffff0000u); } }
#pragma unroll
    for (int i = 0; i < 16; ++i) {
        const u32x4 v = *(const u32x4*)(xbc + (tok0 + l0 + i) * 1024 + ch0);
        float cur[8], o[8];
#pragma unroll
        for (int j = 0; j < 4; ++j) { cur[2 * j] = __uint_as_float(v[j] << 16); cur[2 * j + 1] = __uint_as_float(v[j] & 0xffff0000u); }
#pragma unroll
        for (int j = 0; j < 8; ++j) { const float a = bias[j] + w[0][j] * win[0][j] + w[1][j] * win[1][j] + w[2][j] * win[2][j] + w[3][j] * cur[j]; o[j] = a / (1.f + expf(-a)); }
        *(u32x4*)(xcb + (tok0 + l0 + i) * 1024 + ch0) = (u32x4){pkbf(o[0], o[1]), pkbf(o[2], o[3]), pkbf(o[4], o[5]), pkbf(o[6], o[7])};
#pragma unroll
        for (int j = 0; j < 8; ++j) { win[0][j] = win[1][j]; win[1][j] = win[2][j]; win[2][j] = cur[j]; }
    }
}


struct Conv8 {
    float w[4][8], bias[8]; u32x4 raw[11];
    __device__ __forceinline__ void load(const bf16_t* xbc, const float* cw, const float* cb, size_t tok0, int c, int col, int l0) {
#pragma unroll
        for (int k = 0; k < 4; ++k) { const f32x4 a = *(const f32x4*)(cw + k * 1024 + col), bq = *(const f32x4*)(cw + k * 1024 + col + 4);
            w[k][0] = a[0]; w[k][1] = a[1]; w[k][2] = a[2]; w[k][3] = a[3]; w[k][4] = bq[0]; w[k][5] = bq[1]; w[k][6] = bq[2]; w[k][7] = bq[3]; }
        { const f32x4 a = *(const f32x4*)(cb + col), bq = *(const f32x4*)(cb + col + 4); bias[0] = a[0]; bias[1] = a[1]; bias[2] = a[2]; bias[3] = a[3]; bias[4] = bq[0]; bias[5] = bq[1]; bias[6] = bq[2]; bias[7] = bq[3]; }
#pragma unroll
        for (int k = 0; k < 11; ++k) { const int l = l0 - 3 + k; raw[k] = (u32x4){0u, 0u, 0u, 0u}; if (c * 64 + l >= 0) raw[k] = *(const u32x4*)(xbc + (tok0 + l) * 1024 + col); }
    }
    __device__ __forceinline__ float val(int i, int j) const { float a = bias[j];
#pragma unroll
        for (int k = 0; k < 4; ++k) { const unsigned wv = raw[i + k][j >> 1]; a += w[k][j] * ((j & 1) ? __uint_as_float(wv & 0xffff0000u) : __uint_as_float(wv << 16)); }
        return a * __builtin_amdgcn_rcpf(1.f + __builtin_amdgcn_exp2f(-a * LOG2E)); }
};

__device__ __forceinline__ void states_unit(SLAS unsigned char* lds, const bf16_t* xbc, const float* cw, const float* cb, const float* dt, const float* a_log, bf16_t* S, float* cdec, int b, int c) {
    const int tid = threadIdx.x, lane = tid & 63, w = __builtin_amdgcn_readfirstlane(tid >> 6), r = lane & 15, q = lane >> 4;
    const int tok0 = b * SEQ + c * 64;
    SLAS float* warr = (SLAS float*)lds;
    SLAS unsigned char* BT = lds + 2048;
    SLAS unsigned char* XW = lds + 2048 + 128 * LPB;
    { float dtv; const float A = chunk_acum(dt, a_log, tok0, w, lane, dtv); const float A63 = __shfl(A, 63);
      warr[w * 64 + lane] = dtv * expf(A63 - A);
      if (lane == 63) cdec[(size_t)(b * NCH + c) * 8 + w] = expf(A63); }
    __syncthreads();
#pragma unroll 1
    for (int g = 0; g < 2; ++g) {
        if (lane < 48) {
            const bool isx = lane < 32; const int col = isx ? g * 256 + lane * 8 : 512 + g * 128 + (lane - 32) * 8; const int l0 = 8 * w;
            Conv8 cv; cv.load(xbc, cw, cb, (size_t)tok0, c, col, l0);
            float sc[8];
#pragma unroll
            for (int i = 0; i < 8; ++i) sc[i] = isx ? warr[(g * 4 + (lane >> 3)) * 64 + l0 + i] : 1.f;
            SLAS unsigned char* dstb = isx ? (XW + (lane * 8) * LPB) : (BT + ((lane - 32) * 8) * LPB);
#pragma unroll
            for (int j = 0; j < 8; ++j) { float o[8];
#pragma unroll
                for (int i = 0; i < 8; ++i) o[i] = cv.val(i, j) * sc[i];
                *(SLAS u32x4*)(dstb + j * LPB + l0 * 2) = (u32x4){pkbf(o[0], o[1]), pkbf(o[2], o[3]), pkbf(o[4], o[5]), pkbf(o[6], o[7])}; }
        }
        __syncthreads();
        f32x4 acc[8][2];
#pragma unroll
        for (int nt = 0; nt < 8; ++nt) { acc[nt][0] = (f32x4){0.f, 0.f, 0.f, 0.f}; acc[nt][1] = (f32x4){0.f, 0.f, 0.f, 0.f}; }
#pragma unroll
        for (int k = 0; k < 2; ++k) {
            bf16x8 xf[2];
#pragma unroll
            for (int ht = 0; ht < 2; ++ht) xf[ht] = *(const SLAS bf16x8*)(XW + (32 * w + 16 * ht + r) * LPB + (32 * k + 8 * q) * 2);
#pragma unroll
            for (int nt = 0; nt < 8; ++nt) { const bf16x8 bf = *(const SLAS bf16x8*)(BT + (16 * nt + r) * LPB + (32 * k + 8 * q) * 2);
#pragma unroll
                for (int ht = 0; ht < 2; ++ht) acc[nt][ht] = __builtin_amdgcn_mfma_f32_16x16x32_bf16(bf, xf[ht], acc[nt][ht], 0, 0, 0); }
        }
        const int h = g * 4 + (w >> 1);
#pragma unroll
        for (int ht = 0; ht < 2; ++ht) { const int p = (w & 1) * 32 + 16 * ht + r; bf16_t* dst = S + ((size_t)((b * NCH + c) * 8 + h) * 64 + p) * 128 + 4 * q;
#pragma unroll
            for (int nt = 0; nt < 8; ++nt) *(u32x2*)(dst + 16 * nt) = (u32x2){pkbf(acc[nt][ht][0], acc[nt][ht][1]), pkbf(acc[nt][ht][2], acc[nt][ht][3])}; }
        __syncthreads();
    }
}

__device__ __forceinline__ void scan_unit(bf16_t* S, const float* cdec, int bh, int half) {
    const int tid = threadIdx.x, b = bh >> 3, h = bh & 7;
    const size_t e0 = (size_t)(half * 512 + tid) * 8;
    float st[8];
#pragma unroll
    for (int i = 0; i < 8; ++i) st[i] = 0.f;
#pragma unroll 1
    for (int c0 = 0; c0 < NCH; c0 += 8) {
        u32x4 v[8];
#pragma unroll
        for (int j = 0; j < 8; ++j) v[j] = *(const u32x4*)(S + (size_t)((b * NCH + c0 + j) * 8 + h) * 8192 + e0);
#pragma unroll
        for (int j = 0; j < 8; ++j) {
            *(u32x4*)(S + (size_t)((b * NCH + c0 + j) * 8 + h) * 8192 + e0) = (u32x4){pkbf(st[0], st[1]), pkbf(st[2], st[3]), pkbf(st[4], st[5]), pkbf(st[6], st[7])};
            const float d = cdec[(size_t)(b * NCH + c0 + j) * 8 + h];
#pragma unroll
            for (int i = 0; i < 4; ++i) { const unsigned wv = v[j][i]; st[2 * i] = st[2 * i] * d + __uint_as_float(wv << 16); st[2 * i + 1] = st[2 * i + 1] * d + __uint_as_float(wv & 0xffff0000u); }
        }
    }
}

__device__ __forceinline__ void out_unit(SLAS unsigned char* lds, const bf16_t* xbc, const float* cw, const float* cb, const bf16_t* z, const float* dt, const float* a_log, const float* d_skip, const float* norm_g,
                                         const bf16_t* Sin, bf16_t* merged, int b, int c) {
    const int tid = threadIdx.x, lane = tid & 63, w = __builtin_amdgcn_readfirstlane(tid >> 6), r = lane & 15, q = lane >> 4;
    const int tok0 = b * SEQ + c * 64;
    SLAS float* Aarr = (SLAS float*)lds;
    SLAS float* dtarr = (SLAS float*)(lds + 2048);
    SLAS float* npart = (SLAS float*)(lds + 4096);
    SLAS unsigned char* Cg = lds + 6144;
    SLAS unsigned char* Bg = Cg + 64 * NPB;
    SLAS unsigned char* XT = Bg + 64 * NPB;
    SLAS unsigned char* Mm = XT + 256 * LPB;
    { float dtv; const float A = chunk_acum(dt, a_log, tok0, w, lane, dtv); Aarr[w * 64 + lane] = A; dtarr[w * 64 + lane] = dtv; }
    __syncthreads();
#pragma unroll 1
    for (int g = 0; g < 2; ++g) {
        if (w < 4) { const int cg = lane & 31, l0 = 8 * (2 * w + (lane >> 5));
            Conv8 cv; cv.load(xbc, cw, cb, (size_t)tok0, c, g * 256 + cg * 8, l0);
#pragma unroll
            for (int j = 0; j < 8; ++j) { float o[8];
#pragma unroll
                for (int i = 0; i < 8; ++i) o[i] = cv.val(i, j);
                *(SLAS u32x4*)(XT + (cg * 8 + j) * LPB + l0 * 2) = (u32x4){pkbf(o[0], o[1]), pkbf(o[2], o[3]), pkbf(o[4], o[5]), pkbf(o[6], o[7])}; }
        } else { const int cg = lane & 15, l0 = 8 * (4 * (w & 1) + (lane >> 4)); const bool isB = w < 6;
            Conv8 cv; cv.load(xbc, cw, cb, (size_t)tok0, c, (isB ? 512 : 768) + g * 128 + cg * 8, l0);
            SLAS unsigned char* dstb = (isB ? Bg : Cg) + cg * 16;
#pragma unroll
            for (int i = 0; i < 8; ++i) { float o[8];
#pragma unroll
                for (int j = 0; j < 8; ++j) o[j] = cv.val(i, j);
                *(SLAS u32x4*)(dstb + (l0 + i) * NPB) = (u32x4){pkbf(o[0], o[1]), pkbf(o[2], o[3]), pkbf(o[4], o[5]), pkbf(o[6], o[7])}; } }
        __syncthreads();
        {
            const int lt = w >> 1, st0 = 2 * (w & 1);
            f32x4 accG[2]; accG[0] = (f32x4){0.f, 0.f, 0.f, 0.f}; accG[1] = (f32x4){0.f, 0.f, 0.f, 0.f};
#pragma unroll
            for (int k = 0; k < 4; ++k) { const bf16x8 cf = *(const SLAS bf16x8*)(Cg + (16 * lt + r) * NPB + (32 * k + 8 * q) * 2);
#pragma unroll
                for (int j = 0; j < 2; ++j) { const bf16x8 bf = *(const SLAS bf16x8*)(Bg + (16 * (st0 + j) + r) * NPB + (32 * k + 8 * q) * 2); accG[j] = __builtin_amdgcn_mfma_f32_16x16x32_bf16(bf, cf, accG[j], 0, 0, 0); } }
            const int l = 16 * lt + r;
#pragma unroll
            for (int hh = 0; hh < 4; ++hh) { const int h = g * 4 + hh; const float Al = Aarr[h * 64 + l];
#pragma unroll
                for (int j = 0; j < 2; ++j) { const int s0 = 16 * (st0 + j) + 4 * q; float m[4];
#pragma unroll
                    for (int e = 0; e < 4; ++e) { const int s = s0 + e; m[e] = (s <= l) ? accG[j][e] * __builtin_amdgcn_exp2f((Al - Aarr[h * 64 + s]) * LOG2E) * dtarr[h * 64 + s] : 0.f; }
                    *(SLAS u32x2*)(Mm + hh * 64 * LPB + l * LPB + s0 * 2) = (u32x2){pkbf(m[0], m[1]), pkbf(m[2], m[3])}; } }
        }
        __syncthreads();
        {
            const int hh = w >> 1, h = g * 4 + hh;
            f32x4 acc[4][2];
#pragma unroll
            for (int lt = 0; lt < 4; ++lt) { acc[lt][0] = (f32x4){0.f, 0.f, 0.f, 0.f}; acc[lt][1] = (f32x4){0.f, 0.f, 0.f, 0.f}; }
            const bf16_t* sin = Sin + ((size_t)((b * NCH + c) * 8 + h) * 64 + (w & 1) * 32 + r) * 128 + 8 * q;
            bf16x8 sfr[4][2];
#pragma unroll
            for (int k = 0; k < 4; ++k)
#pragma unroll
                for (int ht = 0; ht < 2; ++ht) sfr[k][ht] = *(const bf16x8*)(sin + (size_t)(16 * ht) * 128 + 32 * k);
#pragma unroll
            for (int k = 0; k < 4; ++k) { bf16x8 sf[2]; sf[0] = sfr[k][0]; sf[1] = sfr[k][1];
#pragma unroll
                for (int lt = 0; lt < 4; ++lt) { const bf16x8 cf = *(const SLAS bf16x8*)(Cg + (16 * lt + r) * NPB + (32 * k + 8 * q) * 2);
#pragma unroll
                    for (int ht = 0; ht < 2; ++ht) acc[lt][ht] = __builtin_amdgcn_mfma_f32_16x16x32_bf16(sf[ht], cf, acc[lt][ht], 0, 0, 0); } }
#pragma unroll
            for (int lt = 0; lt < 4; ++lt) { const float e = __builtin_amdgcn_exp2f(Aarr[h * 64 + 16 * lt + r] * LOG2E); acc[lt][0] = acc[lt][0] * e; acc[lt][1] = acc[lt][1] * e; }
#pragma unroll
            for (int k = 0; k < 2; ++k) { bf16x8 xf[2];
#pragma unroll
                for (int ht = 0; ht < 2; ++ht) xf[ht] = *(const SLAS bf16x8*)(XT + (32 * w + 16 * ht + r) * LPB + (32 * k + 8 * q) * 2);
#pragma unroll
                for (int lt = 0; lt < 4; ++lt) { const bf16x8 mf = *(const SLAS bf16x8*)(Mm + hh * 64 * LPB + (16 * lt + r) * LPB + (32 * k + 8 * q) * 2);
#pragma unroll
                    for (int ht = 0; ht < 2; ++ht) acc[lt][ht] = __builtin_amdgcn_mfma_f32_16x16x32_bf16(xf[ht], mf, acc[lt][ht], 0, 0, 0); } }
            const float dsk = d_skip[h];
            float ss[4];
#pragma unroll
            for (int lt = 0; lt < 4; ++lt) { const int l = 16 * lt + r; float s2 = 0.f;
#pragma unroll
                for (int ht = 0; ht < 2; ++ht) { const int ch = g * 256 + 32 * w + 16 * ht + 4 * q;
                    const u32x2 zv = *(const u32x2*)(z + (size_t)(tok0 + l) * 512 + ch);
                    float xs4[4];
#pragma unroll
                    for (int e = 0; e < 4; ++e) xs4[e] = bf2f(*(const SLAS bf16_t*)(XT + (32 * w + 16 * ht + 4 * q + e) * LPB + l * 2));
                    const float z4[4] = {__uint_as_float(zv.x << 16), __uint_as_float(zv.x & 0xffff0000u), __uint_as_float(zv.y << 16), __uint_as_float(zv.y & 0xffff0000u)};
#pragma unroll
                    for (int e = 0; e < 4; ++e) { const float y = acc[lt][ht][e] + dsk * xs4[e]; const float yg = y * z4[e] * __builtin_amdgcn_rcpf(1.f + __builtin_amdgcn_exp2f(-z4[e] * LOG2E)); acc[lt][ht][e] = yg; s2 += yg * yg; } }
                s2 += __shfl_xor(s2, 16); s2 += __shfl_xor(s2, 32); ss[lt] = s2; }
            if (q == 0) {
#pragma unroll
                for (int lt = 0; lt < 4; ++lt) npart[w * 64 + 16 * lt + r] = ss[lt]; }
            __syncthreads();
#pragma unroll
            for (int lt = 0; lt < 4; ++lt) { const int l = 16 * lt + r; float tot = 0.f;
#pragma unroll
                for (int ww = 0; ww < 8; ++ww) tot += npart[ww * 64 + l];
                const float rs = rsqrtf(tot * (1.f / 256.f) + RMS_EPS);
#pragma unroll
                for (int ht = 0; ht < 2; ++ht) { const int ch = g * 256 + 32 * w + 16 * ht + 4 * q; const f32x4 gv = *(const f32x4*)(norm_g + ch);
                    *(u32x2*)(merged + (size_t)(tok0 + l) * 1024 + ch) = (u32x2){pkbf(acc[lt][ht][0] * rs * gv[0], acc[lt][ht][1] * rs * gv[1]), pkbf(acc[lt][ht][2] * rs * gv[2], acc[lt][ht][3] * rs * gv[3])}; } }
        }
        __syncthreads();
    }
}
#undef SLAS
}

__global__ void k_convb(const bf16_t* xbc, const float* conv_w, const float* conv_b, bf16_t* xc) {
    const size_t idx = (size_t)blockIdx.x * 256 + threadIdx.x;
    const int c = (int)(idx & 1023); const int t = (int)(idx >> 10); const int s = t & (SEQ - 1);
    float acc = conv_b[c];
#pragma unroll
    for (int k = 0; k < 4; ++k) { const int ss = s - 3 + k; if (ss >= 0) acc += conv_w[k * 1024 + c] * bf2f(xbc[(size_t)(t - 3 + k) * 1024 + c]); }
    xc[idx] = f2bf(acc / (1.f + expf(-acc)));
}


constexpr int NWAVES = 8;
constexpr int RING_OFF = 0, RING_BYTES = 131072;
constexpr int LDSCTL_OFF = RING_BYTES, MISC_OFF = LDSCTL_OFF + 320;
constexpr int TAB_OFF = RING_BYTES + 1024;
constexpr int LDS_BYTES = 147456;
#define GAS __attribute__((address_space(1)))
#define LAS __attribute__((address_space(3)))
typedef unsigned v4u __attribute__((ext_vector_type(4)));
typedef float f32x4 __attribute__((ext_vector_type(4)));
typedef GAS unsigned gu32;
#define RLX_AGENT __ATOMIC_RELAXED, __HIP_MEMORY_SCOPE_AGENT
#define LDS_WAIT() asm volatile("s_waitcnt lgkmcnt(0)" ::: "memory")
#define VM_WAIT() asm volatile("s_waitcnt vmcnt(0)" ::: "memory")
__device__ __forceinline__ unsigned pk2(float lo, float hi) { return (unsigned)f2bf(lo) | ((unsigned)f2bf(hi) << 16); }

#define XB_TMO      128
#define XB_XCNT(j)  (256  + 64 * (j))
#define XB_XSUB(j)  (1280 + 64 * (j))
#define XB_XGEN(j)  (2304 + 64 * (j))
#define XB_TOP      3328
#define XB_TOPGEN   3392
#define XCD_BAR_WORDS 3456
#define XB_SPIN_CAP (1u << 18)
__device__ __forceinline__ unsigned xb_ld(unsigned* p)              { return __hip_atomic_load(p, __ATOMIC_RELAXED, __HIP_MEMORY_SCOPE_AGENT); }
__device__ __forceinline__ unsigned xb_add(unsigned* p, unsigned v) { return __hip_atomic_fetch_add(p, v, __ATOMIC_RELAXED, __HIP_MEMORY_SCOPE_AGENT); }
__device__ __forceinline__ unsigned xb_xcc_id() { return (unsigned)__builtin_amdgcn_s_getreg((3 << 11) | 20) & 0xFu; }
#define XB_SPIN(cond, bar) do { unsigned _sp = 0; while (cond) { __builtin_amdgcn_s_sleep(1); \
    if ((++_sp & 255u) == 0u) { if (xb_ld(&(bar)[XB_TMO])) break; if (_sp > XB_SPIN_CAP) { atomicAdd(&(bar)[XB_TMO], 1u); break; } } } } while (0)
struct XcdBarrier { unsigned* bar; unsigned x; volatile LAS unsigned* st; };
__device__ __forceinline__ XcdBarrier xcd_barrier_post(unsigned* bar, volatile LAS unsigned* st) {
    XcdBarrier b; b.bar = bar; b.x = xb_xcc_id(); b.st = st;
    if (threadIdx.x == 0) (void)xb_add(&bar[XB_XCNT(b.x)], 1u);
    return b;
}
__device__ __forceinline__ void xcd_barrier_complete(unsigned* bar, unsigned x, unsigned& nloc, unsigned& nx) {
    const unsigned G = gridDim.x * gridDim.y * gridDim.z;
    unsigned sum, cnt, mine, sp = 0u;
    for (;;) {
        sum = 0u; cnt = 0u; mine = 0u;
#pragma unroll
        for (unsigned j = 0; j < 16; ++j) { const unsigned c = xb_ld(&bar[XB_XCNT(j)]); sum += c; cnt += (c > 0u) ? 1u : 0u; mine = (j == x) ? c : mine; }
        if (sum == G) break;
        __builtin_amdgcn_s_sleep(1);
        if ((++sp & 255u) == 0u) { if (xb_ld(&bar[XB_TMO])) break; if (sp > XB_SPIN_CAP) { atomicAdd(&bar[XB_TMO], 1u); break; } }
    }
    nloc = mine > 0u ? mine : 1u; nx = cnt > 0u ? cnt : 1u;
}
__device__ __forceinline__ void xcd_barrier(const XcdBarrier& b) {
    asm volatile("s_waitcnt vmcnt(0)" ::: "memory");
    __syncthreads();
    if (threadIdx.x == 0) {
        unsigned* bar = b.bar;
        __builtin_amdgcn_s_waitcnt(0);
        unsigned nloc = b.st[0], nx = b.st[1];
        if (nloc == 0u) { xcd_barrier_complete(bar, b.x, nloc, nx); b.st[0] = nloc; b.st[1] = nx; }
        const unsigned old = xb_add(&bar[XB_XSUB(b.x)], 1u);
        const unsigned gen = old / nloc;
        if (old + 1u == (gen + 1u) * nloc) {
            __builtin_amdgcn_fence(__ATOMIC_RELEASE, "agent");
            asm volatile("s_waitcnt vmcnt(0)" ::: "memory");
            const unsigned og = xb_add(&bar[XB_TOP], 1u);
            const unsigned tg = og / nx;
            if (og + 1u == (tg + 1u) * nx) xb_add(&bar[XB_TOPGEN], 1u);
            else XB_SPIN(xb_ld(&bar[XB_TOPGEN]) == tg, bar);
            __builtin_amdgcn_fence(__ATOMIC_ACQUIRE, "agent");
            xb_add(&bar[XB_XGEN(b.x)], 1u);
            asm volatile("s_waitcnt vmcnt(0)" ::: "memory");
        } else {
            XB_SPIN(xb_ld(&bar[XB_XGEN(b.x)]) == gen, bar);
            __builtin_amdgcn_fence(__ATOMIC_ACQUIRE, "agent");
            asm volatile("s_waitcnt vmcnt(0)" ::: "memory");
        }
    }
    __syncthreads();
}

struct Frame {
    LAS unsigned char* lds;
    volatile LAS unsigned* MISC;
    gu32* ctl;
    int tid, lane, wave, vcu, G;
};
__device__ __forceinline__ int tid_now() { int t; asm volatile("v_mov_b32 %0, %1" : "=v"(t) : "v"(threadIdx.x)); return t; }
__device__ __forceinline__ int lane_now() { int l; asm volatile("v_and_b32 %0, 63, %1" : "=v"(l) : "v"(threadIdx.x)); return l; }
__device__ __forceinline__ float wave_sum(float v) {
#pragma unroll
    for (int o = 1; o < 64; o <<= 1) v += __shfl_xor(v, o);
    return v;
}

__device__ __forceinline__ void p0_transpose_item(const float* W, int ldw, int k0, int n0, bf16_t* WT, int ldt, int drow0, LAS float* scr, int lane) {
    float tv[32];
#pragma unroll
    for (int i = 0; i < 32; ++i) { const int kk = 2 * i + (lane >> 5); tv[i] = W[(size_t)(k0 + kk) * ldw + n0 + (lane & 31)]; }
#pragma unroll
    for (int i = 0; i < 32; ++i) { const int kk = 2 * i + (lane >> 5); scr[kk * 33 + (lane & 31)] = tv[i]; }
    LDS_WAIT(); asm volatile("" ::: "memory");
    const int c = lane & 7;
#pragma unroll
    for (int j = 0; j < 4; ++j) { const int n = (lane >> 3) + 8 * j; const LAS float* s = scr + (8 * c) * 33 + n;
        v4u o; o.x = pk2(s[0 * 33], s[1 * 33]); o.y = pk2(s[2 * 33], s[3 * 33]); o.z = pk2(s[4 * 33], s[5 * 33]); o.w = pk2(s[6 * 33], s[7 * 33]);
        *(GAS v4u*)(WT + (size_t)(drow0 + n) * ldt + k0 + 8 * c) = o; }
    LDS_WAIT(); asm volatile("" ::: "memory");
}
__device__ __forceinline__ float softplus_d(float x) { return fmaxf(x, 0.f) + log1pf(expf(-fabsf(x))); }

__device__ __forceinline__ void p0_prologue(Frame& F, const P& p) {
    unsigned char* ws = p.ws;
    bf16_t* Win_t = (bf16_t*)(ws + WS_WIN); bf16_t* Wout_t = (bf16_t*)(ws + WS_WOUT); bf16_t* Wgu_t = (bf16_t*)(ws + WS_WGU); bf16_t* Wd_t = (bf16_t*)(ws + WS_WD);
    LAS float* scr = (LAS float*)(F.lds + RING_OFF + F.wave * 16384);
    const int gw = F.vcu * NWAVES + F.wave, NGW = F.G * NWAVES;
    constexpr int I_IN = 16 * 96, I_OUT = 16 * 32, I_GU = 16 * 2 * 256, I_D = 16 * 256, NITEMS = I_IN + I_OUT + I_GU + I_D;
    for (int it = gw; it < NITEMS; it += NGW) {
        int r = it;
        if (r < I_IN) { const int kb = r / 96, nb = r % 96, n0 = 32 * nb; p0_transpose_item(p.w_in, NPROJ, 64 * kb, n0 + (n0 >= 1536 ? 8 : 0), Win_t, 1024, n0, scr, F.lane); continue; } r -= I_IN;
        if (r < I_OUT) { const int kb = r / 32, nb = r % 32; p0_transpose_item(p.w_out, 1024, 64 * kb, 32 * nb, Wout_t, 1024, 32 * nb, scr, F.lane); continue; } r -= I_OUT;
        if (r < I_GU) { const int e = r / 512, rr = r % 512, mat = rr / 256, r2 = rr % 256, kb = r2 / 16, nb = r2 % 16, n0 = 32 * nb, q = n0 / 128;
            p0_transpose_item((mat ? p.w_up : p.w_gate) + (size_t)e * 1024 * 512, 512, 64 * kb, n0, Wgu_t, 1024, (e * 4 + q) * 256 + mat * 128 + (n0 % 128), scr, F.lane); continue; } r -= I_GU;
        { const int e = r / 256, r2 = r % 256, kb = r2 / 32, nb = r2 % 32;
            p0_transpose_item(p.w_down + (size_t)e * 512 * 1024, 1024, 64 * kb, 32 * nb, Wd_t + (size_t)e * 1024 * 512, 512, 32 * nb, scr, F.lane); }
    }
    __syncthreads();
    LAS float* w16 = (LAS float*)(F.lds + RING_OFF);
    { float wv[32];
#pragma unroll
      for (int i = 0; i < 32; ++i) { const int idx = F.tid + i * NWAVES * 64; const int k = idx >> 4, c = idx & 15; wv[i] = p.w_in[(size_t)k * NPROJ + (c < 8 ? 1536 + c : 3080 + c - 8)]; }
#pragma unroll
      for (int i = 0; i < 32; ++i) { const int idx = F.tid + i * NWAVES * 64; const int k = idx >> 4, c = idx & 15; w16[c * 1024 + k] = wv[i]; } }
    __syncthreads();
    bf16_t* xb = (bf16_t*)(ws + WS_XB); float* dt = (float*)(ws + WS_DT); float* logf = (float*)(ws + WS_LOGF);
#pragma unroll 1
    for (int grp = gw; grp < T / 2; grp += NGW) {
        float a[32];
#pragma unroll
        for (int r = 0; r < 2; ++r) {
            const int m = grp * 2 + r;
            const GAS f32x4* xr = (const GAS f32x4*)(p.x + (size_t)m * D) + F.lane;
            f32x4 v[4];
#pragma unroll
            for (int j = 0; j < 4; ++j) v[j] = xr[64 * j];
            GAS unsigned long long* o8 = (GAS unsigned long long*)(xb + (size_t)m * D) + F.lane;
#pragma unroll
            for (int j = 0; j < 4; ++j) o8[64 * j] = (unsigned long long)pk2(v[j].x, v[j].y) | ((unsigned long long)pk2(v[j].z, v[j].w) << 32);
#pragma unroll
            for (int c = 0; c < 16; ++c) {
                float s = 0.f;
#pragma unroll
                for (int j = 0; j < 4; ++j) { const f32x4 w = *(const LAS f32x4*)(w16 + c * 1024 + 256 * j + 4 * F.lane); s += (v[j].x * w.x + v[j].y * w.y) + (v[j].z * w.z + v[j].w * w.w); }
                a[r * 16 + c] = s; asm volatile("" ::: "memory");
            }
        }
#define TRSTEP(HALFN, SB) do { const bool up = (F.lane >> (SB)) & 1; _Pragma("unroll") for (int i = 0; i < (HALFN); ++i) { const float keep = up ? a[i + (HALFN)] : a[i]; const float send = up ? a[i] : a[i + (HALFN)]; a[i] = keep + __shfl_xor(send, 1 << (SB)); } } while (0)
        TRSTEP(16, 0); TRSTEP(8, 1); TRSTEP(4, 2); TRSTEP(2, 3); TRSTEP(1, 4);
#undef TRSTEP
        const float tot = a[0] + __shfl_xor(a[0], 32);
        const int L = F.lane & 31; const int idx = ((L & 1) << 4) | ((L & 2) << 2) | (L & 4) | ((L & 8) >> 2) | ((L & 16) >> 4);
        const int r = idx >> 4, c = idx & 15, m = grp * 2 + r;
        if (F.lane < 32) {
            if (c < 8) dt[(size_t)m * 8 + c] = softplus_d(tot + p.b_in[1536 + c]);
            else logf[(size_t)m * 8 + (c - 8)] = -softplus_d(-(tot + p.b_in[3080 + c - 8]));
        }
    }
}

__device__ __forceinline__ void scanF_unit(Frame& F, const P& p, int bh) {
    const int b = bh >> 3, h = bh & 7;
    const float* logf = (const float*)(p.ws + WS_LOGF); float* Fo = (float*)(p.ws + WS_F); bf16_t* kx = (bf16_t*)(p.ws + WS_KX);
    LAS float* wsum8 = (LAS float*)(F.lds + RING_OFF);
    float v[4]; float s = 0.f;
#pragma unroll
    for (int i = 0; i < 4; ++i) { v[i] = logf[(size_t)(b * SEQ + F.tid * 4 + i) * 8 + h]; s += v[i]; v[i] = s; }
    float inc = s;
#pragma unroll
    for (int o = 1; o < 64; o <<= 1) { const float y = __shfl_up(inc, o); if (F.lane >= o) inc += y; }
    if (F.lane == 63) wsum8[F.wave] = inc;
    __syncthreads();
    float base = inc - s;
    for (int w = 0; w < F.wave; ++w) base += wsum8[w];
#pragma unroll
    for (int i = 0; i < 4; ++i) { const size_t tok = (size_t)(b * SEQ + F.tid * 4 + i); const float f = base + v[i]; Fo[tok * 8 + h] = f;
        const float g = -f * LOG2E; const bf16_t g0 = f2bf(g); const float r1 = g - bf2f(g0); const bf16_t g1 = f2bf(r1); const float r2 = r1 - bf2f(g1); const bf16_t g2 = f2bf(r2);
        v4u o; o.x = (unsigned)g0 | ((unsigned)g1 << 16); o.y = (unsigned)g2; o.z = 0u; o.w = 0u;
        *(GAS v4u*)(kx + (tok * 8 + h) * 8) = o; }
    __syncthreads();
}


__device__ __forceinline__ void ln1_stage_weights(const P& p, LAS f32x4* RG, int tid) {
    f32x4 wv[10];
#pragma unroll
    for (int it = 0; it < 10; ++it) { const int idx = tid + it * NWAVES * 64; const int m = idx >> 10, cc = idx & 1023;
        wv[it] = m == 0 ? *(const GAS f32x4*)(p.rg_w + (size_t)cc * 4) : *(const GAS f32x4*)(p.re_w + ((size_t)(m - 1) * D + cc) * 4); }
#pragma unroll
    for (int it = 0; it < 10; ++it) { const int idx = tid + it * NWAVES * 64; const int m = idx >> 10, cc = idx & 1023, j = cc >> 8, ln = (cc & 255) >> 2, i = cc & 3;
        RG[m * 1024 + (j * 4 + i) * 64 + ln] = wv[it]; }
}
template <int R>
__device__ __forceinline__ void ln1_router_rows(const P& p, int t0, int lane, const LAS f32x4* RG, bf16_t* hb, LAS unsigned* lcnt, LAS f32x4* rowinfo, LAS int* rowtok, int slot0) {
    const bf16_t* mix = (const bf16_t*)(p.ws + WS_MIX);
    f32x4 v[R][4];
#pragma unroll
    for (int r = 0; r < R; ++r)
#pragma unroll
        for (int j = 0; j < 4; ++j) { const f32x4 xv = *(const GAS f32x4*)(p.x + (size_t)(t0 + r) * D + j * 256 + lane * 4);
            const unsigned long long mv = *(const GAS unsigned long long*)(mix + (size_t)(t0 + r) * D + j * 256 + lane * 4); const unsigned m0 = (unsigned)mv, m1 = (unsigned)(mv >> 32);
            v[r][j] = xv * ALPHA + (f32x4){__uint_as_float(m0 << 16), __uint_as_float(m0 & 0xffff0000u), __uint_as_float(m1 << 16), __uint_as_float(m1 & 0xffff0000u)}; }
    f32x4 g1[4], b1[4];
#pragma unroll
    for (int j = 0; j < 4; ++j) { g1[j] = *(const GAS f32x4*)(p.ln1_g + j * 256 + lane * 4); b1[j] = *(const GAS f32x4*)(p.ln1_b + j * 256 + lane * 4); }
#pragma unroll
    for (int r = 0; r < R; ++r) {
        const int t = t0 + r;
        if (lane == 0) rowtok[slot0 + r] = t;
        float s = 0.f;
#pragma unroll
        for (int j = 0; j < 4; ++j) s += (v[r][j].x + v[r][j].y) + (v[r][j].z + v[r][j].w);
        const float mu = wave_sum(s) * (1.f / D); float s2 = 0.f;
#pragma unroll
        for (int j = 0; j < 4; ++j) { v[r][j] = v[r][j] - mu; s2 += (v[r][j].x * v[r][j].x + v[r][j].y * v[r][j].y) + (v[r][j].z * v[r][j].z + v[r][j].w * v[r][j].w); }
        const float rstd = rsqrtf(wave_sum(s2) * (1.f / D) + LN_EPS);
        f32x4 gl = (f32x4){0.f, 0.f, 0.f, 0.f};
#pragma unroll
        for (int j = 0; j < 4; ++j) { const f32x4 hv = v[r][j] * rstd * g1[j] + b1[j]; v[r][j] = hv;
            *(GAS unsigned long long*)(hb + (size_t)t * D + j * 256 + lane * 4) = (unsigned long long)pk2(hv.x, hv.y) | ((unsigned long long)pk2(hv.z, hv.w) << 32);
            gl += RG[(j * 4 + 0) * 64 + lane] * hv.x; gl += RG[(j * 4 + 1) * 64 + lane] * hv.y; gl += RG[(j * 4 + 2) * 64 + lane] * hv.z; gl += RG[(j * 4 + 3) * 64 + lane] * hv.w; }
        float glv[4];
#pragma unroll
        for (int e = 0; e < 4; ++e) glv[e] = wave_sum(gl[e]) + p.rg_b[e];
        int gi = 0; float gm = glv[0];
#pragma unroll
        for (int e = 1; e < 4; ++e) if (glv[e] > gm) { gm = glv[e]; gi = e; }
        gi = __builtin_amdgcn_readfirstlane(gi);
        float gden = 0.f;
#pragma unroll
        for (int e = 0; e < 4; ++e) gden += expf(glv[e] - gm);
        const float gval = 1.f / gden;
        const LAS f32x4* RE = RG + (1 + gi) * 1024;
        f32x4 el4 = (f32x4){0.f, 0.f, 0.f, 0.f};
#pragma unroll
        for (int j = 0; j < 4; ++j) { el4 += RE[(j * 4 + 0) * 64 + lane] * v[r][j].x; el4 += RE[(j * 4 + 1) * 64 + lane] * v[r][j].y; el4 += RE[(j * 4 + 2) * 64 + lane] * v[r][j].z; el4 += RE[(j * 4 + 3) * 64 + lane] * v[r][j].w; }
        float el[4];
#pragma unroll
        for (int e = 0; e < 4; ++e) el[e] = wave_sum(el4[e]) + p.re_b[gi * 4 + e];
        int i1 = 0;
#pragma unroll
        for (int e = 1; e < 4; ++e) if (el[e] > el[i1]) i1 = e;
        int i2 = -1;
#pragma unroll
        for (int e = 0; e < 4; ++e) if (e != i1 && (i2 < 0 || el[e] > el[i2])) i2 = e;
        const float e1v = i1 == 0 ? el[0] : i1 == 1 ? el[1] : i1 == 2 ? el[2] : el[3];
        const float e2v = i2 == 0 ? el[0] : i2 == 1 ? el[1] : i2 == 2 ? el[2] : el[3];
        const float p2 = expf(e2v - e1v); const float w1 = gval / (1.f + p2), w2 = gval * p2 / (1.f + p2);
        const int lo = i1 < i2 ? i1 : i2, hi = i1 < i2 ? i2 : i1; const float wlo = i1 < i2 ? w1 : w2, whi = i1 < i2 ? w2 : w1;
        const int pairidx = lo == 0 ? (hi - 1) : (lo == 1 ? (hi + 1) : 5);
        const int cls = gi * 6 + pairidx;
        if (lane == 0) {
            const unsigned lpos = __hip_atomic_fetch_add(lcnt + cls, 1u, __ATOMIC_RELAXED, __HIP_MEMORY_SCOPE_WORKGROUP);
            rowinfo[slot0 + r] = (f32x4){__int_as_float(cls), __int_as_float((int)lpos), wlo, whi};
        }
    }
}
__device__ __forceinline__ void ln1_commit(int tid, LAS unsigned* lcnt, LAS unsigned* gbase, const LAS f32x4* rowinfo, const LAS int* rowtok, int nrows, gu32* cnt, int* perm, float* tokinfo) {
    __syncthreads();
    if (tid < NCLS) { const unsigned n = lcnt[tid]; gbase[tid] = n ? __hip_atomic_fetch_add(cnt + 64 * tid, n, RLX_AGENT) : 0u; lcnt[tid] = 0u; }
    __syncthreads();
    if (tid < nrows) { const f32x4 ri = rowinfo[tid]; const int cls = __float_as_int(ri[0]); const int pos = __float_as_int(ri[1]) + (int)gbase[cls]; const int t = rowtok[tid];
        perm[(size_t)cls * T + pos] = t; *(GAS f32x4*)(tokinfo + (size_t)t * 4) = (f32x4){ri[0], __int_as_float(pos), ri[2], ri[3]}; }
}
__device__ __forceinline__ void ln2_row(const P& p, int t, int lane) {
    float* io = p.out;
    f32x4 v[4]; float s = 0.f;
#pragma unroll
    for (int j = 0; j < 4; ++j) { const unsigned long long hw = *(const GAS unsigned long long*)((const bf16_t*)(p.ws + WS_HB) + (size_t)t * D + j * 256 + lane * 4); const unsigned h0 = (unsigned)hw, h1 = (unsigned)(hw >> 32);
        const f32x4 hv = (f32x4){__uint_as_float(h0 << 16), __uint_as_float(h0 & 0xffff0000u), __uint_as_float(h1 << 16), __uint_as_float(h1 & 0xffff0000u)};
        const unsigned long long mv = *(const GAS unsigned long long*)((const bf16_t*)(p.ws + WS_FFN) + (size_t)t * D + j * 256 + lane * 4); const unsigned m0 = (unsigned)mv, m1 = (unsigned)(mv >> 32);
        v[j] = hv * ALPHA + (f32x4){__uint_as_float(m0 << 16), __uint_as_float(m0 & 0xffff0000u), __uint_as_float(m1 << 16), __uint_as_float(m1 & 0xffff0000u)};
        s += (v[j].x + v[j].y) + (v[j].z + v[j].w); }
    const float mu = wave_sum(s) * (1.f / D); float s2 = 0.f;
#pragma unroll
    for (int j = 0; j < 4; ++j) { v[j] = v[j] - mu; s2 += (v[j].x * v[j].x + v[j].y * v[j].y) + (v[j].z * v[j].z + v[j].w * v[j].w); }
    const float rstd = rsqrtf(wave_sum(s2) * (1.f / D) + LN_EPS);
#pragma unroll
    for (int j = 0; j < 4; ++j) { const int c = j * 256 + lane * 4; const f32x4 g2 = *(const GAS f32x4*)(p.ln2_g + c), b2 = *(const GAS f32x4*)(p.ln2_b + c);
        *(GAS f32x4*)(io + (size_t)t * D + c) = v[j] * rstd * g2 + b2; }
}

struct Args { P p; int ph_lo, ph_hi, li, pad; };
constexpr int N_PHASES = 2;
__global__ void __launch_bounds__(NWAVES * 64, 2) mega_fwd(Args args) {
    extern __shared__ __attribute__((aligned(16))) unsigned char lds[];
    Frame F;
    F.lds = (LAS unsigned char*)lds;
    F.MISC = (volatile LAS unsigned*)(F.lds + MISC_OFF);
    F.tid = threadIdx.x; F.lane = F.tid & 63; F.wave = __builtin_amdgcn_readfirstlane(F.tid >> 6);
    F.G = gridDim.x; { const int bx = blockIdx.x; F.vcu = (F.G % 8 == 0) ? (bx % 8) * (F.G / 8) + bx / 8 : bx; }
    const P& p = args.p;
    unsigned char* ws = p.ws;
    F.ctl = (gu32*)(ws + WS_CTL);
    for (int u = F.tid; u < (LDS_BYTES - LDSCTL_OFF) / 4; u += NWAVES * 64) ((LAS unsigned*)(F.lds + LDSCTL_OFF))[u] = 0u;
    __syncthreads();
    XcdBarrier bar = xcd_barrier_post((unsigned*)(F.ctl + CW_BAR) + args.li * XCD_BAR_WORDS, F.MISC + 8);
    const int lo = args.ph_lo, hi = args.ph_hi;
#ifndef PROBE_PH
#define PROBE_PH (-1)
#endif
#if PROBE_PH >= 0
    unsigned long long t_prev = __builtin_amdgcn_s_memrealtime(); unsigned long long t_sel = 0ull;
#define PSTAMP(k) do { const unsigned long long t_now = __builtin_amdgcn_s_memrealtime(); if ((k) == PROBE_PH) t_sel = t_now - t_prev; t_prev = t_now; } while (0)
#else
#define PSTAMP(k) do { } while (0)
#endif
#define IN(k) (lo <= (k) && (k) < hi)
#define BOTH(k) (IN(k) && IN((k) + 1))
#define GRID_BAR() xcd_barrier(bar)
    if (IN(0)) { p0_prologue(F, p); if (BOTH(0)) GRID_BAR(); PSTAMP(0); }
    if (IN(1)) {
        if (blockIdx.x < BATCH * NH) scanF_unit(F, p, blockIdx.x);
        pg8::PlainProb pr{(const bf16_t*)(ws + WS_XB), (const bf16_t*)(ws + WS_WIN), 1024, 1024, 16};
        pg8::StaticOrder S; S.init(T, 3072, F.G, (int)blockIdx.x);
        pg8::EpiInproj E{p.b_in, (bf16_t*)(ws + WS_Z), (bf16_t*)(ws + WS_XBC), (bf16_t*)(ws + WS_Q), (bf16_t*)(ws + WS_K), (bf16_t*)(ws + WS_V)};
        pg8::gemm_phase<pg8::PlainProb, pg8::StaticOrder, pg8::EpiInproj, true>(F.lds + RING_OFF, pr, S, E);
        if (BOTH(1)) GRID_BAR(); PSTAMP(1);
    }

    if (IN(2)) {
#pragma unroll 1
        for (int u = F.vcu; u < BATCH * ssd::NCH; u += F.G) { ssd::states_unit(F.lds + RING_OFF, (const bf16_t*)(ws + WS_XBC), p.conv_w, p.conv_b, (const float*)(ws + WS_DT), p.a_log, (bf16_t*)(ws + WS_S), (float*)(ws + WS_CDEC), u / ssd::NCH, u % ssd::NCH); }
        if (BOTH(2)) GRID_BAR(); PSTAMP(2);
    }
    if (IN(3)) {
#pragma unroll 1
        for (int u = F.vcu; u < BATCH * NH * 2; u += F.G) ssd::scan_unit((bf16_t*)(ws + WS_S), (const float*)(ws + WS_CDEC), u >> 1, u & 1);
        __syncthreads();
        const attn_body::AttnTensors AT{(const attn_body::bf16*)(ws + WS_Q), (const attn_body::bf16*)(ws + WS_K), (const attn_body::bf16*)(ws + WS_V), (const attn_body::bf16*)(ws + WS_KX), (attn_body::bf16*)(ws + WS_MERGED)};
        const attn_body::StaticOrder S((int)F.G, (int)blockIdx.x);
        attn_body::attn_phase<attn_body::StaticOrder>((char*)lds + RING_OFF, AT, S);
        if (BOTH(3)) GRID_BAR(); PSTAMP(3);
    }
    if (IN(4)) {
#pragma unroll 1
        for (int u = F.vcu; u < BATCH * ssd::NCH; u += F.G) ssd::out_unit(F.lds + RING_OFF, (const bf16_t*)(ws + WS_XBC), p.conv_w, p.conv_b, (const bf16_t*)(ws + WS_Z), (const float*)(ws + WS_DT), p.a_log, p.d_skip, p.ssd_norm_g,
                                                                          (const bf16_t*)(ws + WS_S), (bf16_t*)(ws + WS_MERGED), u / ssd::NCH, u % ssd::NCH);
        if (BOTH(4)) GRID_BAR(); PSTAMP(4);
    }
    if (IN(5)) {
        pg8::PlainProb pr{(const bf16_t*)(ws + WS_MERGED), (const bf16_t*)(ws + WS_WOUT), 1024, 1024, 16};
        pg8::StaticOrder S; S.init(T, 1024, F.G, (int)blockIdx.x);
        pg8::EpiOutproj E{(bf16_t*)(ws + WS_MIX)};
        pg8::gemm_phase<pg8::PlainProb, pg8::StaticOrder, pg8::EpiOutproj, true>(F.lds + RING_OFF, pr, S, E);
        if (BOTH(5)) GRID_BAR(); PSTAMP(5);
    }
    if (IN(6)) {
        const int gw = F.vcu * NWAVES + F.wave, NGW = F.G * NWAVES;
        LAS f32x4* RG = (LAS f32x4*)(F.lds + RING_OFF);
        LAS unsigned* lcnt = (LAS unsigned*)(F.lds + RING_OFF + 81920);
        LAS unsigned* gbase = lcnt + 32;
        LAS f32x4* rowinfo = (LAS f32x4*)(F.lds + RING_OFF + 81920 + 256);
        LAS int* rowtok = (LAS int*)(F.lds + RING_OFF + 81920 + 256 + 512);
        const int tid6 = tid_now();
        ln1_stage_weights(p, RG, tid6);
        if (tid6 < 32) lcnt[tid6] = 0u;
        __syncthreads();
        const int lane6 = lane_now();
#pragma unroll 1
        for (int bt = F.vcu; bt < T / 32; bt += F.G) {
            ln1_router_rows<4>(p, bt * 32 + F.wave * 4, lane6, RG, (bf16_t*)(ws + WS_HB), lcnt, rowinfo, rowtok, F.wave * 4);
            ln1_commit(tid6, lcnt, gbase, rowinfo, rowtok, 32, F.ctl + CW_CNT, (int*)(ws + WS_PERM), (float*)(ws + WS_TOK));
        }
        if (BOTH(6)) GRID_BAR(); PSTAMP(6);
    }
    if (IN(7) || IN(8)) {
        LAS int* gt = (LAS int*)(F.lds + TAB_OFF);
        { const int tg = tid_now(); if (tg < NCLS) gt[32 + tg] = (int)__hip_atomic_load(F.ctl + CW_CNT + 64 * tg, RLX_AGENT);
          __syncthreads();
          if (tg == 0) { int acc = 0; for (int c = 0; c < NCLS; ++c) { gt[c] = acc; acc += (gt[32 + c] + 255) >> 8; } gt[24] = acc; } }
        __syncthreads();
    }
    if (IN(7)) {
        const LAS int* gt = (const LAS int*)(F.lds + TAB_OFF);
        LAS unsigned* rofft = (LAS unsigned*)(F.lds + TAB_OFF + 256); LAS int* tokt = (LAS int*)(F.lds + TAB_OFF + 256 + 6144);
        pg8::MoeGeo geo{gt}; pg8::MoeOrder S{geo.np() * 8, 8, F.G, F.vcu};
        const int* perm = (const int*)(ws + WS_PERM);
        { const int tid7 = tid_now(); pg8::Unit u; for (int i = 0; S.next(i, u); ++i) if (tid7 < 256) { const int c = geo.cls_of(u.pm); const int pos = (u.pm - gt[c]) * 256 + tid7; const int tok = pos < gt[32 + c] ? perm[(size_t)c * T + pos] : -1;
            rofft[i * 256 + tid7] = (unsigned)(tok < 0 ? 0 : tok) * 2048u; tokt[i * 256 + tid7] = tok; } }
        __syncthreads();
        pg8::Moe1Prob pr{(const bf16_t*)(ws + WS_HB), (const bf16_t*)(ws + WS_WGU), geo, rofft, 1024, 1024, 16};
        pg8::EpiMoe1 E{(bf16_t*)(ws + WS_ACT), (const float*)(ws + WS_TOK), tokt};
        pg8::gemm_phase<pg8::Moe1Prob, pg8::MoeOrder, pg8::EpiMoe1, true>(F.lds + RING_OFF, pr, S, E);
        if (BOTH(7)) GRID_BAR(); PSTAMP(7);
    }
    if (IN(8)) {
        const LAS int* gt = (const LAS int*)(F.lds + TAB_OFF);
        LAS int* tokt = (LAS int*)(F.lds + TAB_OFF + 256 + 6144);
        pg8::MoeGeo geo{gt}; pg8::MoeOrder S{geo.np() * 4, 4, F.G, F.vcu};
        const int* perm = (const int*)(ws + WS_PERM);
        __syncthreads();
        { const int tid8 = tid_now(); pg8::Unit u; for (int i = 0; S.next(i, u); ++i) if (tid8 < 256) { const int c = geo.cls_of(u.pm); const int pos = (u.pm - gt[c]) * 256 + tid8; tokt[i * 256 + tid8] = pos < gt[32 + c] ? perm[(size_t)c * T + pos] : -1; } }
        __syncthreads();
        pg8::Moe2Prob pr{(const bf16_t*)(ws + WS_ACT), (const bf16_t*)(ws + WS_WD), geo, 1024, 512, 16};
        pg8::EpiMoe2 E{(bf16_t*)(ws + WS_FFN), tokt};
        pg8::gemm_phase<pg8::Moe2Prob, pg8::MoeOrder, pg8::EpiMoe2, true>(F.lds + RING_OFF, pr, S, E);
        if (BOTH(8)) GRID_BAR(); PSTAMP(8);
    }
    if (IN(9)) {
        const int gw = F.vcu * NWAVES + F.wave, NGW = F.G * NWAVES;
        const int lane9 = lane_now();
#pragma unroll 1
        for (int m = gw; m < T; m += NGW) ln2_row(p, m, lane9);
    }
    PSTAMP(9);
#if PROBE_PH >= 0
    if (blockIdx.x == 0) { const unsigned long long t_end = __builtin_amdgcn_s_memrealtime(); while (__builtin_amdgcn_s_memrealtime() - t_end < 7ull * t_sel) __builtin_amdgcn_s_sleep(8); }
#endif
#undef IN
#undef BOTH
#undef GRID_BAR
}

static void launch_mega(const P& p, int lo, int hi, int li, hipStream_t stream) {
    Args a{}; a.p = p; a.ph_lo = lo; a.ph_hi = hi; a.li = li; a.pad = 0;
    hipLaunchKernelGGL(mega_fwd, dim3(256), dim3(NWAVES * 64), LDS_BYTES, stream, a);
}

extern "C" void kernel_launch(void* const* d_in, const int* in_sizes, int n_in, void* d_out, int out_size, void* d_ws, size_t ws_size, hipStream_t stream) {
    static int inited = 0;
    if (!inited) { (void)hipFuncSetAttribute((const void*)mega_fwd, hipFuncAttributeMaxDynamicSharedMemorySize, LDS_BYTES); inited = 1; }
    P p{};
    const float** ins = (const float**)&p;
    for (int i = 0; i < 20; ++i) ins[i] = (const float*)d_in[i];
    p.out = (float*)d_out; p.ws = (unsigned char*)d_ws;
    unsigned char* ws = p.ws;
    (void)hipMemsetAsync(ws + WS_CTL, 0, CTL_ZERO_BYTES, stream);
    unsigned* cnt = (unsigned*)(ws + WS_CTL) + CW_CNT;
    float* dt = (float*)(ws + WS_DT); float* F = (float*)(ws + WS_F);
    int* perm = (int*)(ws + WS_PERM); float* tokinfo = (float*)(ws + WS_TOK);
    float* yraw = (float*)(ws + WS_YRAW); bf16_t* z = (bf16_t*)(ws + WS_Z); bf16_t* xbc = (bf16_t*)(ws + WS_XBC); bf16_t* merged = (bf16_t*)(ws + WS_MERGED);
    bf16_t *q = (bf16_t*)(ws + WS_Q), *k = (bf16_t*)(ws + WS_K), *v = (bf16_t*)(ws + WS_V), *act = (bf16_t*)(ws + WS_ACT);
    float* xconv = (float*)(ws + WS_XCONV); bf16_t* hb = (bf16_t*)(ws + WS_HB);

    launch_mega(p, 0, 10, 0, stream);
}
```

```cpp
#include <hip/hip_runtime.h>
#include <hip/hip_bf16.h>
#include <stdint.h>
#include <cstdio>

typedef unsigned short bf16_t;
__device__ __forceinline__ float bf2f(bf16_t v) { return __uint_as_float(((unsigned)v) << 16); }
__device__ __forceinline__ bf16_t f2bf(float f) { unsigned u = __float_as_uint(f); return (bf16_t)((u + 0x7fffu + ((u >> 16) & 1u)) >> 16); }

constexpr int BATCH = 16, SEQ = 2048, T = BATCH * SEQ, D = 1024;
constexpr int NPROJ = 3088;
constexpr int NH = 8, HD = 64, NG = 2, NS = 128;
constexpr int NCLS = 24;
constexpr float ALPHA = 1.189207115002721f;
constexpr float LN_EPS = 1e-5f, RMS_EPS = 1e-5f;
constexpr float LOG2E = 1.4426950408889634f;
constexpr float C2 = 0.125f * LOG2E;

constexpr size_t MiB = 1u << 20;
constexpr size_t WS_CTL = 0, CTL_ZERO_BYTES = 1 * MiB;
constexpr size_t WS_WIN = 1 * MiB;
constexpr size_t WS_WOUT = 7 * MiB;
constexpr size_t WS_WGU = 9 * MiB;
constexpr size_t WS_WD = 41 * MiB;
constexpr size_t WS_DT = 58 * MiB;
constexpr size_t WS_LOGF = 59 * MiB;
constexpr size_t WS_F = 60 * MiB;
constexpr size_t WS_PERM = 61 * MiB;
constexpr size_t WS_TOK = 64 * MiB;
constexpr size_t WS_KX = 65 * MiB;
constexpr size_t WS_XB = 72 * MiB;
constexpr size_t WS_S = 72 * MiB;
constexpr size_t WS_CDEC = 69 * MiB;
constexpr size_t WS_MIX = 72 * MiB;
constexpr size_t WS_FFN = 408 * MiB;
constexpr size_t WS_XCB = 328 * MiB;
constexpr size_t WS_YRAW = 72 * MiB;
constexpr size_t WS_Z = 136 * MiB;
constexpr size_t WS_XBC = 168 * MiB;
constexpr size_t WS_HB = 136 * MiB;
constexpr size_t WS_Q = 232 * MiB, WS_K = 264 * MiB, WS_V = 296 * MiB;
constexpr size_t WS_ACT = 232 * MiB;
constexpr size_t WS_XCONV = 328 * MiB;
constexpr size_t WS_MERGED = 408 * MiB;
constexpr int CW_CNT = 1024;
constexpr int CW_TMO = 64, CW_CODE = 65;
constexpr int CW_BAR = 4096;

struct P {
    const float *x, *w_in, *b_in, *conv_w, *conv_b, *a_log, *d_skip, *ssd_norm_g, *w_out, *ln1_g, *ln1_b,
        *rg_w, *rg_b, *re_w, *re_b, *w_gate, *w_up, *w_down, *ln2_g, *ln2_b;
    float* out; unsigned char* ws;
};

__device__ __forceinline__ float softplus_f(float x) { return fmaxf(x, 0.f) + log1pf(expf(-fabsf(x))); }
__device__ __forceinline__ float silu_f(float x) { return x / (1.f + expf(-x)); }

template <int NB, class AL, class BL, class EP>
__global__ __launch_bounds__(256) void ngemm(AL al, BL bl, EP ep, int K) {
    __shared__ float As[16][68];
    __shared__ float Bs[NB][16][68];
    const int tm = blockIdx.y * 64, tn = blockIdx.x * 64;
    if (!al.tile_ok(tm)) return;
    const int tx = threadIdx.x & 15, ty = threadIdx.x >> 4;
    float acc[NB][4][4];
#pragma unroll
    for (int b = 0; b < NB; ++b)
#pragma unroll
        for (int i = 0; i < 4; ++i)
#pragma unroll
            for (int j = 0; j < 4; ++j) acc[b][i][j] = 0.f;
    for (int k0 = 0; k0 < K; k0 += 16) {
#pragma unroll
        for (int i = 0; i < 4; ++i) { const int idx = threadIdx.x + i * 256; const int r = idx >> 4, kk = idx & 15; As[kk][r] = al(tm + r, k0 + kk); }
#pragma unroll
        for (int b = 0; b < NB; ++b)
#pragma unroll
            for (int i = 0; i < 4; ++i) { const int idx = threadIdx.x + i * 256; const int kk = idx >> 6, n = idx & 63; Bs[b][kk][n] = bl(b, tm, k0 + kk, tn + n); }
        __syncthreads();
#pragma unroll
        for (int kk = 0; kk < 16; ++kk) {
            float a[4];
#pragma unroll
            for (int i = 0; i < 4; ++i) a[i] = As[kk][ty * 4 + i];
#pragma unroll
            for (int b = 0; b < NB; ++b) {
                float bb[4];
#pragma unroll
                for (int j = 0; j < 4; ++j) bb[j] = Bs[b][kk][tx * 4 + j];
#pragma unroll
                for (int i = 0; i < 4; ++i)
#pragma unroll
                    for (int j = 0; j < 4; ++j) acc[b][i][j] += a[i] * bb[j];
            }
        }
        __syncthreads();
    }
#pragma unroll
    for (int i = 0; i < 4; ++i)
#pragma unroll
        for (int j = 0; j < 4; ++j) {
            if (NB == 1) ep(tm + ty * 4 + i, tn + tx * 4 + j, acc[0][i][j], 0.f);
            else ep(tm + ty * 4 + i, tn + tx * 4 + j, acc[0][i][j], acc[NB - 1][i][j]);
        }
}

struct AL_x { const float* x; __device__ bool tile_ok(int) const { return true; } __device__ float operator()(int r, int k) const { return x[(size_t)r * D + k]; } };
struct BL_win { const float* w; __device__ float operator()(int, int, int k, int n) const { return n < NPROJ ? w[(size_t)k * NPROJ + n] : 0.f; } };
struct EP_inproj {
    const float* b_in; bf16_t *z, *xbc, *q, *k, *v; float *dt, *logf;
    __device__ void operator()(int r, int c, float v0, float) const {
        if (c >= NPROJ) return;
        const float val = v0 + b_in[c];
        if (c < 512) z[(size_t)r * 512 + c] = f2bf(val);
        else if (c < 1536) xbc[(size_t)r * 1024 + (c - 512)] = f2bf(val);
        else if (c < 1544) dt[(size_t)r * 8 + (c - 1536)] = softplus_f(val);
        else if (c < 2056) q[(size_t)r * 512 + (c - 1544)] = f2bf(val * C2);
        else if (c < 2568) k[(size_t)r * 512 + (c - 2056)] = f2bf(val);
        else if (c < 3080) v[(size_t)r * 512 + (c - 2568)] = f2bf(val);
        else logf[(size_t)r * 8 + (c - 3080)] = -softplus_f(-val);
    }
};

__global__ void k_conv(const bf16_t* xbc, const float* conv_w, const float* conv_b, float* xconv) {
    const size_t idx = (size_t)blockIdx.x * 256 + threadIdx.x;
    const int c = (int)(idx & 1023); const int t = (int)(idx >> 10); const int s = t & (SEQ - 1);
    float acc = conv_b[c];
#pragma unroll
    for (int k = 0; k < 4; ++k) { const int ss = s - 3 + k; if (ss >= 0) acc += conv_w[k * 1024 + c] * bf2f(xbc[(size_t)(t - 3 + k) * 1024 + c]); }
    xconv[idx] = silu_f(acc);
}

__global__ __launch_bounds__(64) void k_ssd(const float* xconv, const float* dt, const float* a_log, const float* d_skip, float* yraw) {
    __shared__ float Bs[16][128], Cs[16][128];
    const int b = blockIdx.x >> 3, h = blockIdx.x & 7, g = h >> 2, p = threadIdx.x;
    const float a = -expf(a_log[h]), dsk = d_skip[h];
    float st[128];
#pragma unroll
    for (int n = 0; n < 128; ++n) st[n] = 0.f;
    for (int t0 = 0; t0 < SEQ; t0 += 16) {
        __syncthreads();
        for (int i = p; i < 16 * 128; i += 64) { const int tt = i >> 7, n = i & 127; const size_t row = (size_t)(b * SEQ + t0 + tt) * 1024;
            Bs[tt][n] = xconv[row + 512 + g * 128 + n]; Cs[tt][n] = xconv[row + 768 + g * 128 + n]; }
        __syncthreads();
        for (int tt = 0; tt < 16; ++tt) {
            const size_t tok = (size_t)(b * SEQ + t0 + tt);
            const float xs = xconv[tok * 1024 + h * 64 + p], dtv = dt[tok * 8 + h];
            const float dA = expf(dtv * a), xdt = xs * dtv;
            float y = 0.f;
#pragma unroll
            for (int n = 0; n < 128; ++n) { st[n] = st[n] * dA + xdt * Bs[tt][n]; y += Cs[tt][n] * st[n]; }
            yraw[tok * 512 + h * 64 + p] = y + dsk * xs;
        }
    }
}

__global__ __launch_bounds__(256) void k_gatenorm(const float* yraw, const bf16_t* z, const float* norm_g, bf16_t* merged) {
    const int w = blockIdx.x * 4 + (threadIdx.x >> 6), lane = threadIdx.x & 63;
    const int t = w >> 1, g = w & 1;
    float v[4]; float ss = 0.f;
#pragma unroll
    for (int j = 0; j < 4; ++j) { const int c = g * 256 + lane * 4 + j; const float y = yraw[(size_t)t * 512 + c] * silu_f(bf2f(z[(size_t)t * 512 + c])); v[j] = y; ss += y * y; }
#pragma unroll
    for (int o = 1; o < 64; o <<= 1) ss += __shfl_xor(ss, o);
    const float r = rsqrtf(ss * (1.f / 256.f) + RMS_EPS);
#pragma unroll
    for (int j = 0; j < 4; ++j) { const int c = g * 256 + lane * 4 + j; merged[(size_t)t * 1024 + c] = f2bf(v[j] * r * norm_g[c]); }
}

__global__ void k_scanF(const float* logf, float* F) {
    const int i = blockIdx.x * 64 + threadIdx.x; if (i >= BATCH * NH) return;
    const int b = i >> 3, h = i & 7; float s = 0.f;
    for (int t = 0; t < SEQ; ++t) { const size_t o = (size_t)(b * SEQ + t) * 8 + h; s += logf[o]; F[o] = s; }
}

__global__ __launch_bounds__(64) void k_attn(const bf16_t* Q, const bf16_t* K, const bf16_t* V, const float* F, bf16_t* merged) {
    const int bh = blockIdx.y, b = bh >> 3, h = bh & 7; const int t = blockIdx.x * 64 + threadIdx.x;
    const size_t row = (size_t)(b * SEQ + t);
    float q[64], o[64];
#pragma unroll
    for (int d = 0; d < 64; ++d) { q[d] = bf2f(Q[row * 512 + h * 64 + d]); o[d] = 0.f; }
    const float Ft = F[row * 8 + h];
    float m = -INFINITY, l = 0.f;
    const int smax = blockIdx.x * 64 + 63;
    for (int s = 0; s <= smax; ++s) {
        const size_t kr = (size_t)(b * SEQ + s);
        const bf16_t* kp = K + kr * 512 + h * 64; const bf16_t* vp = V + kr * 512 + h * 64;
        float dot = 0.f;
#pragma unroll
        for (int d = 0; d < 64; ++d) dot += q[d] * bf2f(kp[d]);
        const float logit = dot + (Ft - F[kr * 8 + h]) * LOG2E;
        if (s <= t) {
            const float mn = fmaxf(m, logit), corr = exp2f(m - mn), pp = exp2f(logit - mn);
            l = l * corr + pp;
#pragma unroll
            for (int d = 0; d < 64; ++d) o[d] = o[d] * corr + pp * bf2f(vp[d]);
            m = mn;
        }
    }
    const float rl = 1.f / l;
#pragma unroll
    for (int d = 0; d < 64; ++d) merged[row * 1024 + 512 + h * 64 + d] = f2bf(o[d] * rl);
}

struct AL_bf { const bf16_t* a; int lda; int pad; __device__ bool tile_ok(int) const { return true; } __device__ float operator()(int r, int k) const { return bf2f(a[(size_t)r * lda + k]); } };
struct BL_plain { const float* w; int ldb; int pad; __device__ float operator()(int, int, int k, int n) const { return w[(size_t)k * ldb + n]; } };
struct EP_outproj { const float* x; float* out; __device__ void operator()(int r, int c, float v, float) const { out[(size_t)r * D + c] = ALPHA * x[(size_t)r * D + c] + v; } };

__device__ __forceinline__ float wsum(float v) {
#pragma unroll
    for (int o = 1; o < 64; o <<= 1) v += __shfl_xor(v, o);
    return v;
}
__global__ __launch_bounds__(256) void k_ln1_router(float* hio, const float* g1, const float* b1, const float* rg_w, const float* rg_b, const float* re_w, const float* re_b,
                                                    bf16_t* hb, unsigned* cnt, int* perm, float* tokinfo) {
    const int t = blockIdx.x * 4 + (threadIdx.x >> 6), lane = threadIdx.x & 63;
    float v[16]; float s = 0.f;
#pragma unroll
    for (int j = 0; j < 4; ++j) { const float4 u = *(const float4*)(hio + (size_t)t * D + j * 256 + lane * 4); v[4 * j] = u.x; v[4 * j + 1] = u.y; v[4 * j + 2] = u.z; v[4 * j + 3] = u.w; s += (u.x + u.y) + (u.z + u.w); }
    const float mu = wsum(s) * (1.f / D); float s2 = 0.f;
#pragma unroll
    for (int i = 0; i < 16; ++i) { v[i] -= mu; s2 += v[i] * v[i]; }
    const float rstd = rsqrtf(wsum(s2) * (1.f / D) + LN_EPS);
    float gl[4] = {0.f, 0.f, 0.f, 0.f};
#pragma unroll
    for (int j = 0; j < 4; ++j)
#pragma unroll
        for (int i = 0; i < 4; ++i) { const int c = j * 256 + lane * 4 + i; const float hv = v[4 * j + i] * rstd * g1[c] + b1[c]; v[4 * j + i] = hv;
            hio[(size_t)t * D + c] = hv; hb[(size_t)t * D + c] = f2bf(hv);
#pragma unroll
            for (int e = 0; e < 4; ++e) gl[e] += hv * rg_w[c * 4 + e]; }
#pragma unroll
    for (int e = 0; e < 4; ++e) gl[e] = wsum(gl[e]) + rg_b[e];
    int gi = 0; float gm = gl[0];
#pragma unroll
    for (int e = 1; e < 4; ++e) if (gl[e] > gm) { gm = gl[e]; gi = e; }
    float gden = 0.f;
#pragma unroll
    for (int e = 0; e < 4; ++e) gden += expf(gl[e] - gm);
    const float gval = 1.f / gden;
    float el[4] = {0.f, 0.f, 0.f, 0.f};
#pragma unroll
    for (int j = 0; j < 4; ++j)
#pragma unroll
        for (int i = 0; i < 4; ++i) { const int c = j * 256 + lane * 4 + i;
#pragma unroll
            for (int e = 0; e < 4; ++e) el[e] += v[4 * j + i] * re_w[((size_t)gi * D + c) * 4 + e]; }
#pragma unroll
    for (int e = 0; e < 4; ++e) el[e] = wsum(el[e]) + re_b[gi * 4 + e];
    int i1 = 0;
#pragma unroll
    for (int e = 1; e < 4; ++e) if (el[e] > el[i1]) i1 = e;
    int i2 = -1;
#pragma unroll
    for (int e = 0; e < 4; ++e) if (e != i1 && (i2 < 0 || el[e] > el[i2])) i2 = e;
    const float mx = el[i1]; const float p2 = expf(el[i2] - mx); const float w1 = gval / (1.f + p2), w2 = gval * p2 / (1.f + p2);
    const int lo = i1 < i2 ? i1 : i2, hi = i1 < i2 ? i2 : i1; const float wlo = i1 < i2 ? w1 : w2, whi = i1 < i2 ? w2 : w1;
    const int pairidx = lo == 0 ? (hi - 1) : (lo == 1 ? (hi + 1) : 5);
    const int cls = gi * 6 + pairidx;
    if (lane == 0) {
        const unsigned pos = atomicAdd(&cnt[cls], 1u);
        perm[(size_t)cls * T + pos] = t;
        tokinfo[(size_t)t * 4 + 0] = __int_as_float(cls); tokinfo[(size_t)t * 4 + 1] = __int_as_float((int)pos); tokinfo[(size_t)t * 4 + 2] = wlo; tokinfo[(size_t)t * 4 + 3] = whi;
    }
}

struct ClsGeo { const unsigned* cnt;
    __device__ bool find(int row, int& cls, int& pos, int& n) const {
        int off = 0;
        for (int c = 0; c < NCLS; ++c) { const int nc = (int)cnt[c], pc = (nc + 255) & ~255; if (row < off + pc) { cls = c; pos = row - off; n = nc; return true; } off += pc; }
        return false;
    }
};
__device__ __forceinline__ void cls_experts(int cls, int& ea, int& eb) { const int g = cls / 6, pi = cls % 6; const int lo = pi < 3 ? 0 : (pi < 5 ? 1 : 2); const int hi = pi < 3 ? pi + 1 : (pi < 5 ? pi - 1 : 3); ea = g * 4 + lo; eb = g * 4 + hi; }

struct AL_moe1 { const bf16_t* hb; const int* perm; ClsGeo geo;
    __device__ bool tile_ok(int tm) const { int c, p, n; if (!geo.find(tm, c, p, n)) return false; return p < n; }
    __device__ float operator()(int r, int k) const { int c, p, n; if (!geo.find(r, c, p, n) || p >= n) return 0.f; const int tok = perm[(size_t)c * T + p]; return bf2f(hb[(size_t)tok * D + k]); } };
struct BL_moe1 { const float *wg, *wu; ClsGeo geo;
    __device__ float operator()(int b, int tm, int k, int n) const { int c, p, nn; geo.find(tm, c, p, nn); int ea, eb; cls_experts(c, ea, eb); const int e = n < 512 ? ea : eb; const int col = n & 511;
        const float* w = b == 0 ? wg : wu; return w[((size_t)e * D + k) * 512 + col]; } };
struct EP_moe1 { bf16_t* act; const int* perm; const float* tokinfo; ClsGeo geo;
    __device__ void operator()(int r, int c, float g, float u) const { int cl, p, n; float w = 0.f; if (geo.find(r, cl, p, n) && p < n) { const int tok = perm[(size_t)cl * T + p]; w = tokinfo[(size_t)tok * 4 + (c < 512 ? 2 : 3)]; }
        act[(size_t)r * 1024 + c] = f2bf(silu_f(g) * u * w); } };
struct AL_moe2 { const bf16_t* act; ClsGeo geo;
    __device__ bool tile_ok(int tm) const { int c, p, n; if (!geo.find(tm, c, p, n)) return false; return p < n; }
    __device__ float operator()(int r, int k) const { return bf2f(act[(size_t)r * 1024 + k]); } };
struct BL_moe2 { const float* wd; ClsGeo geo;
    __device__ float operator()(int, int tm, int k, int n) const { int c, p, nn; geo.find(tm, c, p, nn); int ea, eb; cls_experts(c, ea, eb); const int e = k < 512 ? ea : eb; return wd[((size_t)e * 512 + (k & 511)) * D + n]; } };
struct EP_moe2 { float* out; const int* perm; ClsGeo geo;
    __device__ void operator()(int r, int c, float v, float) const { int cl, p, n; if (!geo.find(r, cl, p, n) || p >= n) return; const int tok = perm[(size_t)cl * T + p]; float* o = out + (size_t)tok * D + c; *o = ALPHA * (*o) + v; } };

__global__ __launch_bounds__(256) void k_ln2(float* io, const float* g2, const float* b2) {
    const int t = blockIdx.x * 4 + (threadIdx.x >> 6), lane = threadIdx.x & 63;
    float v[16]; float s = 0.f;
#pragma unroll
    for (int j = 0; j < 4; ++j) { const float4 u = *(const float4*)(io + (size_t)t * D + j * 256 + lane * 4); v[4 * j] = u.x; v[4 * j + 1] = u.y; v[4 * j + 2] = u.z; v[4 * j + 3] = u.w; s += (u.x + u.y) + (u.z + u.w); }
    const float mu = wsum(s) * (1.f / D); float s2 = 0.f;
#pragma unroll
    for (int i = 0; i < 16; ++i) { v[i] -= mu; s2 += v[i] * v[i]; }
    const float rstd = rsqrtf(wsum(s2) * (1.f / D) + LN_EPS);
#pragma unroll
    for (int j = 0; j < 4; ++j) { float4 o; const int c = j * 256 + lane * 4;
        o.x = v[4 * j] * rstd * g2[c] + b2[c]; o.y = v[4 * j + 1] * rstd * g2[c + 1] + b2[c + 1]; o.z = v[4 * j + 2] * rstd * g2[c + 2] + b2[c + 2]; o.w = v[4 * j + 3] * rstd * g2[c + 3] + b2[c + 3];
        *(float4*)(io + (size_t)t * D + c) = o; }
}

namespace pg8 {
#define PG8_LAS __attribute__((address_space(3)))
typedef short bf16x8 __attribute__((ext_vector_type(8)));
typedef float f32x4 __attribute__((ext_vector_type(4)));
typedef float f32x2 __attribute__((ext_vector_type(2)));
typedef unsigned u32x4 __attribute__((ext_vector_type(4)));
typedef unsigned u32x2 __attribute__((ext_vector_type(2)));
constexpr int BM = 256, BK = 64, HALF = 128, HTB = HALF * BK * 2, STAGE_BYTES = 8 * HTB, NXCD = 8, WGM = 8;
__host__ __device__ __forceinline__ int lds_byte(int r, int c) { const int st = (r >> 4) * 2 + (c >> 5), rr = r & 15, cc = c & 31, ob = rr * 64 + cc * 2; return st * 1024 + (ob ^ (((ob >> 9) & 1) << 5)); }
__host__ __device__ __forceinline__ void stage_rc(int b, int& R, int& C) { const int st = b / 1024, sb = b % 1024, swz = sb ^ (((sb >> 9) & 1) << 5); R = (st >> 1) * 16 + swz / 64; C = (st & 1) * 32 + (swz % 64) / 2; }
__host__ __device__ __forceinline__ int perm32(int rho) { const int n = rho >> 4, i = rho & 15; return 8 * (i >> 2) + 4 * n + (i & 3); }
typedef float f32x2c __attribute__((ext_vector_type(2))); typedef __bf16 bf16x2c __attribute__((ext_vector_type(2)));
__device__ __forceinline__ unsigned cvt_pk_bf16(float lo, float hi) { f32x2c v = {lo, hi}; bf16x2c b = __builtin_convertvector(v, bf16x2c); return __builtin_bit_cast(unsigned, b); }

struct Unit { int pm, pn; };
struct StaticOrder {
    int nM, nN, nwg, G, c;
    __device__ void init(int M, int N, int G_, int c_) { nM = M / BM; nN = N / BM; nwg = nM * nN; G = G_; c = c_; }
    __device__ bool next(int i, Unit& u) const {
        const long L = (long)i * G + c; if (L >= nwg) return false;
        int wgid = (int)L; { const int q = nwg / NXCD, r = nwg % NXCD, xcd = wgid % NXCD, off = wgid / NXCD; wgid = (xcd < r ? xcd * (q + 1) : r * (q + 1) + (xcd - r) * q) + off; }
        const int nig = WGM * nN, gid = wgid / nig, fm = gid * WGM, gsz = (nM - fm) < WGM ? (nM - fm) : WGM;
        u.pm = fm + ((wgid % nig) % gsz); u.pn = (wgid % nig) / gsz; return true;
    }
};
struct PlainProb {
    static constexpr bool GATHER = false;
    const bf16_t* A; const bf16_t* Bt; int lda, ldb, nt;
    __device__ __forceinline__ const char* a_base(const Unit& u) const { return (const char*)(A + (size_t)u.pm * BM * lda); }
    __device__ __forceinline__ void b_base(const Unit& u, const char*& b0, const char*& b1) const { b0 = (const char*)(Bt + (size_t)u.pn * BM * ldb); b1 = b0; }
    __device__ __forceinline__ int ksplit() const { return nt; }
    __device__ __forceinline__ unsigned rowoff(int, int) const { return 0u; }
};

template <class PR, class Sched, class Epi, bool ALIGN_EPI>
__device__ __forceinline__ void gemm_phase(PG8_LAS unsigned char* lds, const PR& pr, const Sched& S, const Epi& E) {
    const int tid = threadIdx.x, wid = __builtin_amdgcn_readfirstlane(tid >> 6), lane = tid & 63, wr = wid >> 2, wc = wid & 3, fr = lane & 15, fq = lane >> 4;
    const int nt = pr.nt, ksp = pr.ksplit();
    unsigned voffA[2][2], nvA[2][2], voffB[2]; int RA[2], CA[2];
#pragma unroll
    for (int i = 0; i < 2; ++i) { int R, C; stage_rc(tid * 16 + i * 8192, R, C); const int Rb = Epi::PERM ? ((R & ~31) + perm32(R & 31)) : R;
        RA[i] = R; CA[i] = C; voffB[i] = (unsigned)(Rb * pr.ldb + C) * 2u; }
    const size_t kstep = (size_t)(BK * 2);
    const size_t hstepB = (size_t)HALF * pr.ldb * 2;
    const unsigned ldsw = (unsigned)wid * 1024u;
    const int aoff = lds_byte(wr * 64 + fr, fq * 8), boff = lds_byte(wc * 32 + fr, fq * 8);
#define PG8_SA(b, h) (((b) * 2 + (h)) * HTB)
#define PG8_SB(b, h) ((4 + (b) * 2 + (h)) * HTB)
#define PG8_STAGE(bufoff, gbase, voff) do { _Pragma("unroll") for (int _i = 0; _i < 2; ++_i) \
        __builtin_amdgcn_global_load_lds((const unsigned*)((const char*)(gbase) + (voff)[_i]), (PG8_LAS unsigned*)(lds + (bufoff) + ldsw + _i * 8192), 16, 0, 0); } while (0)
#define PG8_LDA(dst, b, h) do { _Pragma("unroll") for (int m = 0; m < 4; ++m) _Pragma("unroll") for (int k = 0; k < 2; ++k) dst[m][k] = *(const PG8_LAS bf16x8*)(lds + PG8_SA(b, h) + aoff + m * 2048 + k * 1024); } while (0)
#define PG8_LDB(dst, b, h) do { _Pragma("unroll") for (int n = 0; n < 2; ++n) _Pragma("unroll") for (int k = 0; k < 2; ++k) dst[n][k] = *(const PG8_LAS bf16x8*)(lds + PG8_SB(b, h) + boff + n * 2048 + k * 1024); } while (0)
#define PG8_MMA(ai, bj, At, Bt) do { __builtin_amdgcn_s_setprio(1); _Pragma("unroll") for (int m = 0; m < 4; ++m) _Pragma("unroll") for (int n = 0; n < 2; ++n) _Pragma("unroll") for (int k = 0; k < 2; ++k) \
        acc[ai][bj][m][n] = __builtin_amdgcn_mfma_f32_16x16x32_bf16(Bt[n][k], At[m][k], acc[ai][bj][m][n], 0, 0, 0); __builtin_amdgcn_s_setprio(0); } while (0)
#define PG8_WAIT_V(n) asm volatile("s_waitcnt vmcnt(" #n ")" ::: "memory")
#define PG8_WAIT_L(n) asm volatile("s_waitcnt lgkmcnt(" #n ")" ::: "memory")
#define PG8_BAR __builtin_amdgcn_s_barrier()
#define PG8_SCHED __builtin_amdgcn_sched_barrier(0)
#define PG8_SETVA(dst, slot) do { _Pragma("unroll") for (int _h = 0; _h < 2; ++_h) _Pragma("unroll") for (int _i = 0; _i < 2; ++_i) \
        dst[_h][_i] = PR::GATHER ? (pr.rowoff((slot), _h * HALF + RA[_i]) + (unsigned)CA[_i] * 2u) : (unsigned)((_h * HALF + RA[_i]) * pr.lda + CA[_i]) * 2u; } while (0)
    Unit cur, nxt; int ui = 0;
    if (!S.next(0, cur)) return;
    f32x4 acc[2][2][4][2];
#pragma unroll
    for (int a = 0; a < 2; ++a)
#pragma unroll
        for (int b = 0; b < 2; ++b)
#pragma unroll
            for (int m = 0; m < 4; ++m)
#pragma unroll
                for (int n = 0; n < 2; ++n) acc[a][b][m][n] = (f32x4){0.f, 0.f, 0.f, 0.f};
    bf16x8 At[4][2], B0[2][2], B1[2][2];
    PG8_SETVA(voffA, 0);
    const char* cA = pr.a_base(cur); const char *cB0, *cB1; pr.b_base(cur, cB0, cB1);
    PG8_STAGE(PG8_SB(0, 0), cB0, voffB); PG8_STAGE(PG8_SB(0, 1), cB0 + hstepB, voffB); PG8_STAGE(PG8_SA(0, 0), cA, voffA[0]); PG8_STAGE(PG8_SA(0, 1), cA, voffA[1]);
    if (wr == 1) PG8_BAR;
    PG8_WAIT_V(2); PG8_BAR;
    PG8_STAGE(PG8_SB(1, 0), cB0 + kstep, voffB); PG8_STAGE(PG8_SA(1, 0), cA + kstep, voffA[0]); PG8_STAGE(PG8_SB(1, 1), cB0 + hstepB + kstep, voffB);
    PG8_WAIT_V(6); PG8_BAR;
    for (;;) {
        const bool has_next = S.next(ui + 1, nxt);
        const char *nA = cA, *nB0 = cB0, *nB1 = cB1;
        if (has_next) { nA = pr.a_base(nxt); pr.b_base(nxt, nB0, nB1); }
        if (PR::GATHER) { if (has_next) { PG8_SETVA(nvA, ui + 1); } else {
#pragma unroll
            for (int h = 0; h < 2; ++h)
#pragma unroll
                for (int i = 0; i < 2; ++i) nvA[h][i] = voffA[h][i]; } }
        for (int t = 0; t < nt; t += 2) {
            const bool last = (t == nt - 2);
            const char* a1 = cA + (size_t)(t + 1) * kstep;
            const char* a2 = last ? nA : cA + (size_t)(t + 2) * kstep;
            const char* b2 = last ? nB0 : ((t + 2 < ksp) ? cB0 + (size_t)(t + 2) * kstep : cB1 + (size_t)(t + 2 - ksp) * kstep);
            const char* a3 = a2 + kstep; const char* b3 = b2 + kstep;
            unsigned va2[2][2];
#pragma unroll
            for (int h = 0; h < 2; ++h)
#pragma unroll
                for (int i = 0; i < 2; ++i) va2[h][i] = (PR::GATHER && last) ? nvA[h][i] : voffA[h][i];
            PG8_LDB(B0, 0, 0); PG8_LDB(B1, 0, 1); PG8_SCHED; PG8_LDA(At, 0, 0); PG8_STAGE(PG8_SA(1, 1), a1, voffA[1]);
            PG8_WAIT_V(8); PG8_WAIT_L(0); PG8_BAR; PG8_MMA(0, 0, At, B0); PG8_MMA(0, 1, At, B1); PG8_BAR; PG8_SCHED;
            PG8_LDA(At, 0, 1); PG8_STAGE(PG8_SB(0, 0), b2, voffB); PG8_STAGE(PG8_SB(0, 1), b2 + hstepB, voffB); PG8_STAGE(PG8_SA(0, 0), a2, va2[0]);
            PG8_WAIT_V(8); PG8_WAIT_L(0); PG8_BAR; PG8_MMA(1, 0, At, B0); PG8_MMA(1, 1, At, B1); PG8_BAR; PG8_SCHED;
            PG8_LDB(B0, 1, 0); PG8_LDB(B1, 1, 1); PG8_SCHED; PG8_LDA(At, 1, 0); PG8_STAGE(PG8_SA(0, 1), a2, va2[1]);
            PG8_WAIT_V(8); PG8_WAIT_L(0); PG8_BAR; PG8_MMA(0, 0, At, B0); PG8_MMA(0, 1, At, B1); PG8_BAR; PG8_SCHED;
            PG8_LDA(At, 1, 1); PG8_STAGE(PG8_SB(1, 0), b3, voffB); PG8_STAGE(PG8_SB(1, 1), b3 + hstepB, voffB); PG8_STAGE(PG8_SA(1, 0), a3, va2[0]);
            PG8_WAIT_V(8); PG8_WAIT_L(0); PG8_BAR; PG8_MMA(1, 0, At, B0); PG8_MMA(1, 1, At, B1); PG8_BAR; PG8_SCHED;
        }
        if constexpr (ALIGN_EPI) { if (wr == 0) PG8_BAR; }
        if constexpr (!Epi::AFTER_DRAIN) { E(acc, cur, ui, wr, wc, fr, fq); }
        if (!has_next) break;
#pragma unroll
        for (int a = 0; a < 2; ++a)
#pragma unroll
            for (int b = 0; b < 2; ++b)
#pragma unroll
                for (int m = 0; m < 4; ++m)
#pragma unroll
                    for (int n = 0; n < 2; ++n) acc[a][b][m][n] = (f32x4){0.f, 0.f, 0.f, 0.f};
        cur = nxt; cA = nA; cB0 = nB0; cB1 = nB1; ++ui;
        if (PR::GATHER) {
#pragma unroll
            for (int h = 0; h < 2; ++h)
#pragma unroll
                for (int i = 0; i < 2; ++i) voffA[h][i] = nvA[h][i]; }
        if constexpr (ALIGN_EPI) { if (wr == 1) PG8_BAR; }
    }
    PG8_WAIT_V(0);
    if constexpr (!ALIGN_EPI) { if (wr == 0) PG8_BAR; }
    PG8_BAR;
    if constexpr (Epi::AFTER_DRAIN) { E.fused(acc, cur, ui, wr, wc, fr, fq, lds, wid, lane); }
#undef PG8_SA
#undef PG8_SB
#undef PG8_STAGE
#undef PG8_LDA
#undef PG8_LDB
#undef PG8_MMA
#undef PG8_WAIT_V
#undef PG8_WAIT_L
#undef PG8_BAR
#undef PG8_SCHED
#undef PG8_SETVA
}

struct EpiInproj {
    static constexpr bool PERM = true, AFTER_DRAIN = false;
    const float* b_in; bf16_t *z, *xbc, *q, *k, *v;
    __device__ __forceinline__ void operator()(const f32x4 (&acc)[2][2][4][2], const Unit& u, int, int wr, int wc, int fr, int fq) const {
        const int pn = u.pn; bf16_t* base; int ldc, colt; float sc = 1.f;
        if (pn < 2) { base = z; ldc = 512; colt = pn * 256; }
        else if (pn < 6) { base = xbc; ldc = 1024; colt = (pn - 2) * 256; }
        else if (pn < 8) { base = q; ldc = 512; colt = (pn - 6) * 256; sc = C2; }
        else if (pn < 10) { base = k; ldc = 512; colt = (pn - 8) * 256; }
        else { base = v; ldc = 512; colt = (pn - 10) * 256; }
        const int row0 = u.pm * BM + wr * 64 + fr;
        const int col0 = colt + wc * 32 + 8 * fq, bcol0 = pn * BM + (pn >= 6 ? 8 : 0) + wc * 32 + 8 * fq;
        f32x4 bv[2][2];
#pragma unroll
        for (int bj = 0; bj < 2; ++bj)
#pragma unroll
            for (int n = 0; n < 2; ++n) bv[bj][n] = *(const f32x4*)(b_in + bcol0 + bj * HALF + 4 * n);
#pragma unroll
        for (int ai = 0; ai < 2; ++ai)
#pragma unroll
            for (int m = 0; m < 4; ++m) { bf16_t* rowp = base + (size_t)(row0 + ai * HALF + m * 16) * ldc + col0;
#pragma unroll
                for (int bj = 0; bj < 2; ++bj) { f32x4 v0 = (acc[ai][bj][m][0] + bv[bj][0]) * sc, v1 = (acc[ai][bj][m][1] + bv[bj][1]) * sc;
                    u32x4 w; w.x = cvt_pk_bf16(v0[0], v0[1]); w.y = cvt_pk_bf16(v0[2], v0[3]); w.z = cvt_pk_bf16(v1[0], v1[1]); w.w = cvt_pk_bf16(v1[2], v1[3]);
                    *(u32x4*)(rowp + bj * HALF) = w; } }
    }
};

struct EpiOutproj {
    static constexpr bool PERM = true, AFTER_DRAIN = false;
    bf16_t* mix;
    __device__ __forceinline__ void operator()(const f32x4 (&acc)[2][2][4][2], const Unit& u, int, int wr, int wc, int fr, int fq) const {
        const int col0 = u.pn * BM + wc * 32 + 8 * fq;
#pragma unroll
        for (int ai = 0; ai < 2; ++ai)
#pragma unroll
            for (int m = 0; m < 4; ++m) { bf16_t* rowp = mix + (size_t)(u.pm * BM + ai * HALF + wr * 64 + m * 16 + fr) * D + col0;
#pragma unroll
                for (int bj = 0; bj < 2; ++bj) { const f32x4 v0 = acc[ai][bj][m][0], v1 = acc[ai][bj][m][1];
                    u32x4 w; w.x = cvt_pk_bf16(v0[0], v0[1]); w.y = cvt_pk_bf16(v0[2], v0[3]); w.z = cvt_pk_bf16(v1[0], v1[1]); w.w = cvt_pk_bf16(v1[2], v1[3]);
                    *(u32x4*)(rowp + bj * HALF) = w; } }
    }
};

struct MoeGeo {
    const PG8_LAS int* tab;
    __device__ __forceinline__ int np() const { return tab[24]; }
    __device__ __forceinline__ int cls_of(int panel) const { int c = 0;
#pragma unroll 1
        for (int j = 1; j < 24; ++j) if (panel >= tab[j]) c = j;
        return c; }
};
struct MoeOrder {
    int total, npn, G, c;
    __device__ __forceinline__ bool next(int i, Unit& u) const { const int L = i * G + c; if (L >= total) return false; u.pm = L / npn; u.pn = L % npn; return true; }
};
struct Moe1Prob {
    static constexpr bool GATHER = true;
    const bf16_t* A; const bf16_t* Wgu; MoeGeo geo; const PG8_LAS unsigned* rofftab; int lda, ldb, nt;
    __device__ __forceinline__ const char* a_base(const Unit&) const { return (const char*)A; }
    __device__ __forceinline__ void b_base(const Unit& u, const char*& b0, const char*& b1) const { int ea, eb; cls_experts(geo.cls_of(u.pm), ea, eb); const int e = u.pn < 4 ? ea : eb;
        b0 = (const char*)(Wgu + (size_t)((e * 4 + (u.pn & 3)) * 256) * 1024); b1 = b0; }
    __device__ __forceinline__ int ksplit() const { return nt; }
    __device__ __forceinline__ unsigned rowoff(int slot, int r) const { return rofftab[slot * 256 + r]; }
};
__device__ __forceinline__ float silu_fast(float g) { return g * __builtin_amdgcn_rcpf(1.f + __builtin_amdgcn_exp2f(-g * LOG2E)); }
struct EpiMoe1 {
    static constexpr bool PERM = true, AFTER_DRAIN = false;
    bf16_t* act; const float* tokinfo; const PG8_LAS int* toktab;
    __device__ __forceinline__ void operator()(const f32x4 (&acc)[2][2][4][2], const Unit& u, int slot, int wr, int wc, int fr, int fq) const {
        const int ex = u.pn >> 2; const int col0 = ex * 512 + (u.pn & 3) * 128 + wc * 32 + 8 * fq;
#pragma unroll
        for (int ai = 0; ai < 2; ++ai)
#pragma unroll
            for (int m = 0; m < 4; ++m) { const int r = ai * HALF + wr * 64 + m * 16 + fr; const int tok = toktab[slot * 256 + r];
                const float w = tok >= 0 ? tokinfo[(size_t)tok * 4 + 2 + ex] : 0.f;
                const f32x4 g0 = acc[ai][0][m][0], g1 = acc[ai][0][m][1], u0 = acc[ai][1][m][0], u1 = acc[ai][1][m][1];
                float o[8];
#pragma unroll
                for (int j = 0; j < 4; ++j) { o[j] = silu_fast(g0[j]) * u0[j] * w; o[4 + j] = silu_fast(g1[j]) * u1[j] * w; }
                u32x4 wv; wv.x = cvt_pk_bf16(o[0], o[1]); wv.y = cvt_pk_bf16(o[2], o[3]); wv.z = cvt_pk_bf16(o[4], o[5]); wv.w = cvt_pk_bf16(o[6], o[7]);
                *(u32x4*)(act + (size_t)(u.pm * BM + r) * 1024 + col0) = wv; }
    }
};
struct Moe2Prob {
    static constexpr bool GATHER = false;
    const bf16_t* A; const bf16_t* Wd; MoeGeo geo; int lda, ldb, nt;
    __device__ __forceinline__ const char* a_base(const Unit& u) const { return (const char*)(A + (size_t)u.pm * BM * lda); }
    __device__ __forceinline__ void b_base(const Unit& u, const char*& b0, const char*& b1) const { int ea, eb; cls_experts(geo.cls_of(u.pm), ea, eb);
        b0 = (const char*)(Wd + ((size_t)ea * 1024 + u.pn * 256) * 512); b1 = (const char*)(Wd + ((size_t)eb * 1024 + u.pn * 256) * 512); }
    __device__ __forceinline__ int ksplit() const { return 8; }
    __device__ __forceinline__ unsigned rowoff(int, int) const { return 0u; }
};
struct EpiMoe2 {
    static constexpr bool PERM = true, AFTER_DRAIN = false;
    bf16_t* ffn; const PG8_LAS int* toktab;
    __device__ __forceinline__ void operator()(const f32x4 (&acc)[2][2][4][2], const Unit& u, int slot, int wr, int wc, int fr, int fq) const {
        const int col0 = u.pn * BM + wc * 32 + 8 * fq;
#pragma unroll
        for (int ai = 0; ai < 2; ++ai)
#pragma unroll
            for (int m = 0; m < 4; ++m) { const int r = ai * HALF + wr * 64 + m * 16 + fr; const int tok = toktab[slot * 256 + r];
                if (tok >= 0) { bf16_t* rowp = ffn + (size_t)tok * D + col0;
#pragma unroll
                    for (int bj = 0; bj < 2; ++bj) { const f32x4 v0 = acc[ai][bj][m][0], v1 = acc[ai][bj][m][1];
                        u32x4 w; w.x = cvt_pk_bf16(v0[0], v0[1]); w.y = cvt_pk_bf16(v0[2], v0[3]); w.z = cvt_pk_bf16(v1[0], v1[1]); w.w = cvt_pk_bf16(v1[2], v1[3]);
                        *(u32x4*)(rowp + bj * HALF) = w; } } }
    }
};
}

#include <cmath>
namespace attn_body {

using bf16=__hip_bfloat16;
#define ALAS __attribute__((address_space(3)))
using bf16x8=__attribute__((ext_vector_type(8)))short;
using s16x4=__attribute__((ext_vector_type(4)))short;
using f32x16=__attribute__((ext_vector_type(16)))float;
using u32x4=__attribute__((ext_vector_type(4)))unsigned;
constexpr int BATCH=16,NHEAD=8,SEQ=2048,D=64,DM=NHEAD*D,ODM=1024,OCOL=512;
constexpr int NW=8,QBLK=32,QB=QBLK*NW,KVBLK=64,NQB=SEQ/QB;
constexpr int ATTN_PITCH=DM, ATTN_UNIT_ROWS=QB;
__device__ __forceinline__ int crow(int r,int hi){return (r&3)+8*(r>>2)+4*hi;}
#define SBAR() __builtin_amdgcn_sched_barrier(0)
__device__ __forceinline__ void cmask(f32x16&p0,f32x16&p1,int jb,int qrel,int hi){
  const float NEG=-INFINITY; int kb=64*jb+4*hi;
  #pragma unroll
  for(int r=0;r<16;++r){int kv=kb+(r&3)+8*(r>>2); if(kv>qrel)p0[r]=NEG; if(kv+32>qrel)p1[r]=NEG;}
}

constexpr int NSLOT=3, SLOTB=9216, KXOFF=8192;
constexpr int LDS_K=0, LDS_V=NSLOT*SLOTB, LDS_WS=2*NSLOT*SLOTB, LDS_OST=LDS_WS+NW*64*4, LDS_BYTES=LDS_OST+NW*4096;
constexpr float C2=0.125f*1.4426950408889634f;
__device__ __forceinline__ void glds16(const void*gsrc,unsigned lds_dst){unsigned keep;
  asm volatile("s_mov_b32 %0, m0\n\ts_mov_b32 m0, %2\n\ts_nop 0\n\tglobal_load_lds_dwordx4 %1, off\n\ts_mov_b32 m0, %0":"=&s"(keep):"v"(gsrc),"s"(lds_dst):"memory");}
__device__ __forceinline__ void glds16s(const void*sbase,unsigned voff,unsigned lds_dst){unsigned keep;
  asm volatile("s_nop 4\n\ts_mov_b32 %0, m0\n\ts_mov_b32 m0, %3\n\ts_nop 0\n\tglobal_load_lds_dwordx4 %1, %2\n\ts_mov_b32 m0, %0":"=&s"(keep):"v"(voff),"s"(sbase),"s"(lds_dst):"memory");}
__device__ __forceinline__ const char* sptr(const void*p){ const unsigned long long v=(unsigned long long)p; const unsigned lo=__builtin_amdgcn_readfirstlane((unsigned)v), hi=__builtin_amdgcn_readfirstlane((unsigned)(v>>32)); return (const char*)(((unsigned long long)hi<<32)|lo); }
__device__ __forceinline__ float max3f(float a,float b,float c){float r;asm("v_max3_f32 %0, %1, %2, %3":"=v"(r):"v"(a),"v"(b),"v"(c));return r;}
__device__ __forceinline__ float max2f(float a,float b){float r;asm("v_max_f32_e32 %0, %1, %2":"=v"(r):"v"(a),"v"(b));return r;}
__device__ __forceinline__ float fadd_s(float a,float b){float r;asm("v_add_f32_e32 %0, %1, %2":"=v"(r):"v"(a),"v"(b));return r;}
__device__ __forceinline__ float fsub_s(float a,float b){float r;asm("v_sub_f32_e32 %0, %1, %2":"=v"(r):"v"(a),"v"(b));return r;}
typedef float f32x2_t __attribute__((ext_vector_type(2))); typedef __bf16 bf16x2_t __attribute__((ext_vector_type(2)));
__device__ __forceinline__ unsigned cvtpk_s(float lo,float hi){f32x2_t v={lo,hi};bf16x2_t b=__builtin_convertvector(v,bf16x2_t);return __builtin_bit_cast(unsigned,b);}
#define WAIT_BAR(N) asm volatile("s_waitcnt vmcnt(" #N ") lgkmcnt(0)\n\ts_barrier":::"memory")
#define WAIT_BARK(N,N0) do{ if(wid==0){WAIT_BAR(N0);} else {WAIT_BAR(N);} }while(0)

__device__ __forceinline__ void qkt(f32x16&p0,f32x16&p1,const char*Kslot,const bf16x8*qr,const bf16x8 qr4,int r32,int hi){ const f32x16 zc=f32x16{};
  const char*kb=Kslot+hi*1024+r32*16;
  #pragma unroll
  for(int d0=0;d0<4;++d0){
    const bf16x8 b0=*reinterpret_cast<const bf16x8*>(kb+d0*2048);
    const bf16x8 b1=*reinterpret_cast<const bf16x8*>(kb+d0*2048+512);
    if(d0==0){p0=__builtin_amdgcn_mfma_f32_32x32x16_bf16(b0,qr[0],zc,0,0,0);p1=__builtin_amdgcn_mfma_f32_32x32x16_bf16(b1,qr[0],zc,0,0,0);}
    else{p0=__builtin_amdgcn_mfma_f32_32x32x16_bf16(b0,qr[d0],p0,0,0,0);p1=__builtin_amdgcn_mfma_f32_32x32x16_bf16(b1,qr[d0],p1,0,0,0);}}
  { const bf16x8 x0=*reinterpret_cast<const bf16x8*>(Kslot+KXOFF+r32*16); const bf16x8 x1=*reinterpret_cast<const bf16x8*>(Kslot+KXOFF+r32*16+512);
    p0=__builtin_amdgcn_mfma_f32_32x32x16_bf16(x0,qr4,p0,0,0,0);p1=__builtin_amdgcn_mfma_f32_32x32x16_bf16(x1,qr4,p1,0,0,0); }
}
typedef __attribute__((address_space(3))) const char* lds_cptr;
typedef short v4i16_t __attribute__((ext_vector_type(4)));
__device__ __forceinline__ void kload8(bf16x8*kf,lds_cptr kp){
  kf[0]=*(const __attribute__((address_space(3))) bf16x8*)(kp);      kf[1]=*(const __attribute__((address_space(3))) bf16x8*)(kp+512);
  kf[2]=*(const __attribute__((address_space(3))) bf16x8*)(kp+2048); kf[3]=*(const __attribute__((address_space(3))) bf16x8*)(kp+2560);
  kf[4]=*(const __attribute__((address_space(3))) bf16x8*)(kp+4096); kf[5]=*(const __attribute__((address_space(3))) bf16x8*)(kp+4608);
  kf[6]=*(const __attribute__((address_space(3))) bf16x8*)(kp+6144); kf[7]=*(const __attribute__((address_space(3))) bf16x8*)(kp+6656);
}
__device__ __forceinline__ void kload2(bf16x8*kf,lds_cptr kp,int j){ kf[2*j]=*(const __attribute__((address_space(3))) bf16x8*)(kp+j*2048); kf[2*j+1]=*(const __attribute__((address_space(3))) bf16x8*)(kp+j*2048+512); }
__device__ __forceinline__ s16x4 vtr(lds_cptr p){ return __builtin_bit_cast(s16x4,__builtin_amdgcn_ds_read_tr16_b64_v4i16((__attribute__((address_space(3))) v4i16_t*)p)); }
__device__ __forceinline__ float rowmax(const f32x16&p0,const f32x16&p1){
  float a=max3f(p0[0],p0[1],p1[0]),b=max3f(p0[2],p0[3],p1[1]);a=max3f(a,p1[2],p1[3]);
  #pragma unroll
  for(int r=4;r<16;r+=4){a=max3f(a,p0[r],p0[r+1]);b=max3f(b,p0[r+2],p0[r+3]);a=max3f(a,p1[r],p1[r+1]);b=max3f(b,p1[r+2],p1[r+3]);}
  const float m=max2f(a,b);
  auto rr=__builtin_amdgcn_permlane32_swap(__float_as_uint(m),__float_as_uint(m),false,false);
  return max2f(__uint_as_float(rr[0]),__uint_as_float(rr[1]));
}
__device__ __forceinline__ void pv(f32x16*o,int vb,bf16x8 pa0,bf16x8 pa1,bf16x8 pa2,bf16x8 pa3){
  #pragma unroll
  for(int d0=0;d0<2;++d0){s16x4 lo[4],hi[4];
    #pragma unroll
    for(int ks=0;ks<4;++ks){
      asm volatile("ds_read_b64_tr_b16 %0,%1 offset:%c2":"=&v"(lo[ks]):"v"(vb),"i"(d0*4096+ks*1024):"memory");
      asm volatile("ds_read_b64_tr_b16 %0,%1 offset:%c2":"=&v"(hi[ks]):"v"(vb),"i"(d0*4096+ks*1024+512):"memory");}
    asm volatile("s_waitcnt lgkmcnt(0)":::"memory");SBAR();
    #define PK(k) (bf16x8){lo[k][0],lo[k][1],lo[k][2],lo[k][3],hi[k][0],hi[k][1],hi[k][2],hi[k][3]}
    o[d0]=__builtin_amdgcn_mfma_f32_32x32x16_bf16(pa0,PK(0),o[d0],0,0,0);
    o[d0]=__builtin_amdgcn_mfma_f32_32x32x16_bf16(pa1,PK(1),o[d0],0,0,0);
    o[d0]=__builtin_amdgcn_mfma_f32_32x32x16_bf16(pa2,PK(2),o[d0],0,0,0);
    o[d0]=__builtin_amdgcn_mfma_f32_32x32x16_bf16(pa3,PK(3),o[d0],0,0,0);
    #undef PK
  }
}

#ifndef ATTN_STORE16
#define ATTN_STORE16(p,v) (*(u32x4*)(p)=(v))
#endif
template<int THRL> __device__ __forceinline__ void attn_unit(int b,int h,int qb,const bf16*Q,const bf16*__restrict__ K,const bf16*__restrict__ V,const bf16*__restrict__ KX,bf16*O,char*shm){
  const int tid=threadIdx.x; int lane_o=tid&63; asm volatile("":"+v"(lane_o));
  const int lane=lane_o,r32=lane&31,hi=lane>>5; const int wid=__builtin_amdgcn_readfirstlane(tid>>6);
  const long rowbase=(long)b*SEQ; const int q0=qb*QB;
  const bf16*Qw=Q+(rowbase+q0+wid*QBLK)*DM+h*D;
  const bf16*Kh=K+rowbase*DM+h*D,*Vh=V+rowbase*DM+h*D;
  const unsigned lds0=(unsigned)(uintptr_t)shm;
  float*wsf=(float*)(shm+LDS_WS)+wid*64;
  const unsigned koff=(unsigned)(lane*DM*2+wid*16), voff=(unsigned)((16*(wid&3)+(lane>>2))*DM*2+(wid>>2)*64+(lane&3)*16), kxoff=(unsigned)(lane*NHEAD*16);
  const unsigned kdst=lds0+LDS_K+wid*1024, vdst=lds0+LDS_V+wid*1024, kxdst=lds0+LDS_K+KXOFF;
  const char*Kb=sptr(Kh), *Vb=sptr(Vh), *KXb=sptr(KX+(rowbase*NHEAD+h)*8);
  #define TILE(p) ((p)==0?NT-4:((p)<=3?NT-(p):NT-1-(p)))
  #define DMA_K(t,slot) do{ const long tl_=TILE(t); glds16s(Kb+tl_*(KVBLK*DM*2),koff,(unsigned)__builtin_amdgcn_readfirstlane(kdst+(slot))); if(wid==0) glds16s(KXb+tl_*(KVBLK*NHEAD*16),kxoff,(unsigned)__builtin_amdgcn_readfirstlane(kxdst+(slot))); }while(0)
  #define DMA_V(t,slot) do{ const long tl_=TILE(t); glds16s(Vb+tl_*(KVBLK*DM*2),voff,(unsigned)__builtin_amdgcn_readfirstlane(vdst+(slot))); }while(0)
  const int vb0=(int)(lds0+LDS_V)+((lane>>4)&1)*32+(lane&3)*8+(4*hi+((lane&15)>>2))*64;
  const char*Kbase=shm+LDS_K; bf16x8 kf[8]; bf16x8 kx0,kx1;
  const lds_cptr shm3=(lds_cptr)shm; const lds_cptr kxp0=shm3+LDS_K+KXOFF+r32*16; const lds_cptr kp0=shm3+LDS_K+hi*1024+r32*16; const lds_cptr vp0=shm3+LDS_V+((lane>>4)&1)*32+(lane&3)*8+(4*hi+((lane&15)>>2))*64;
  const int NT=(q0+QB)/KVBLK;
  DMA_K(0,0);DMA_V(0,0);DMA_K(1,SLOTB);
  bf16x8 qr[4]; u32x4 qr4w={0u,0u,0u,0u}; if(hi==0){qr4w[0]=0x3F803F80u;qr4w[1]=0x00003F80u;}
  #define QR4 __builtin_bit_cast(bf16x8,qr4w)
  #define SETM() do{ const float nm_=-mhat; const unsigned b0_=__float_as_uint(nm_)&0xffff0000u; const float r1_=nm_-__uint_as_float(b0_); const unsigned b1_=__float_as_uint(r1_)&0xffff0000u; const float r2_=r1_-__uint_as_float(b1_); const unsigned b2_=__float_as_uint(r2_)&0xffff0000u; \
    if(hi==0){ qr4w[1]=0x00003F80u|b0_; qr4w[2]=(b1_>>16)|b2_; } asm volatile("":"+v"(qr4w)); }while(0)
  #pragma unroll
  for(int d0=0;d0<4;++d0)qr[d0]=*reinterpret_cast<const bf16x8*>(&Qw[(long)r32*DM+d0*16+hi*8]);
  float mhat=0.f,l_reg=0.f;f32x16 o[2];o[0]=f32x16{};o[1]=f32x16{};const f32x16 zc16=f32x16{};
  const int qrel=wid*QBLK+r32;
  #define CMASK(P0,P1,t) do{int jb_=(t)==0?0:((t)<=3?4-(t):-1); if(jb_>=0)cmask(P0,P1,jb_,qrel,hi);}while(0)
  bool resc=false;
  #define START(P0,P1) do{ const float rm=rowmax(P0,P1); resc=false; \
    { const float dl=rm; mhat=fadd_s(mhat,dl); \
      _Pragma("unroll") for(int r=0;r<16;++r){P0[r]=fsub_s(P0[r],dl);P1[r]=fsub_s(P1[r],dl);} \
      SETM(); } \
    _Pragma("unroll") for(int r=0;r<16;++r)P0[r]=__builtin_amdgcn_exp2f(P0[r]); }while(0)
  #define RESC() do{ if(resc){ asm volatile("s_waitcnt lgkmcnt(0)":::"memory"); \
      _Pragma("unroll") for(int d_=0;d_<2;++d_) _Pragma("unroll") for(int r=0;r<16;++r)o[d_][r]*=wsf[crow(r,hi)]; } }while(0)
  f32x16 pA0,pA1,pB0,pB1;
  int sl_prev=0,sl_cur=0,sl_next=SLOTB;
  #define ROT() do{sl_prev=sl_cur;sl_cur=sl_next;sl_next=(sl_next==(NSLOT-1)*SLOTB)?0:sl_next+SLOTB;}while(0)
  DMA_K(2,2*SLOTB);
  WAIT_BARK(3,5);
  qkt(pA0,pA1,Kbase,qr,QR4,r32,hi);asm volatile("s_nop 15\n\ts_nop 7":"+v"(pA0),"+v"(pA1));CMASK(pA0,pA1,0);
  START(pA0,pA1);
  _Pragma("unroll") for(int r=0;r<16;++r)pA1[r]=__builtin_amdgcn_exp2f(pA1[r]);
  WAIT_BAR(0);
  DMA_K(3,0);DMA_V(1,SLOTB);
  ROT();
  kload8(kf,kp0+sl_cur); kx0=*(const ALAS bf16x8*)(kxp0+sl_cur); kx1=*(const ALAS bf16x8*)(kxp0+sl_cur+512);
  WAIT_BARK(2,3);
  s16x4 vlo[8],vhi[8]; u32x4 pw0,pw1,pw2,pw3;
  #define PKW(P,B) cvtpk_s(P[B],P[B+1])
  #define PAF(k) __builtin_bit_cast(bf16x8,pw##k)
  #define VFR(i) (bf16x8){vlo[i][0],vlo[i][1],vlo[i][2],vlo[i][3],vhi[i][0],vhi[i][1],vhi[i][2],vhi[i][3]}
  #define PIN(x) asm volatile("":"+v"(x))
  #define MX3(a,b,c) __builtin_fmaxf(__builtin_fmaxf((a),(b)),(c))
  #define GAPA(MF,A0,A1,A2,A3,W0,W1,PW) do{ MF; sacc+=A0; sacc+=A1; sacc+=A2; sacc+=A3; PIN(sacc); W0; W1; PIN(PW); SBAR(); }while(0)
  #define EX(v) __builtin_amdgcn_exp2f(v)
  #define GAPB(MF,X,B) do{ MF; X[B]=EX(X[B]); X[B+1]=EX(X[B+1]); X[B+2]=EX(X[B+2]); X[B+3]=EX(X[B+3]); PIN(X); SBAR(); }while(0)
  #define VRD(i) do{ vlo[i]=vtr(vp_+(((i)>>2)*4096+((i)&3)*1024)); vhi[i]=vtr(vp_+(((i)>>2)*4096+((i)&3)*1024+512)); }while(0)
  #define KRD(G,j) do{ if(G){ kload2(kf,kp0+sl_next,j); SBAR(); } }while(0)
  #define STEP(C0,C1,P0,P1,t,GK,GV,GL) do{ SBAR(); \
    const lds_cptr vp_=vp0+sl_prev; \
    VRD(0); SBAR(); float sacc=(P0[0]+P0[1]); \
    GAPA(C0=__builtin_amdgcn_mfma_f32_32x32x16_bf16(kf[0],qr[0],zc16,0,0,0), P0[2],P0[3],P0[4],P0[5],     pw0[0]=PKW(P0,0), pw0[1]=PKW(P0,2), pw0); \
    VRD(4); SBAR(); GAPA(C1=__builtin_amdgcn_mfma_f32_32x32x16_bf16(kf[1],qr[0],zc16,0,0,0), P0[6],P0[7],P0[8],P0[9],     pw0[2]=PKW(P0,4), pw0[3]=PKW(P0,6), pw0); \
    VRD(1); SBAR(); GAPA(C0=__builtin_amdgcn_mfma_f32_32x32x16_bf16(kf[2],qr[1],C0,0,0,0),   P0[10],P0[11],P0[12],P0[13], pw1[0]=PKW(P0,8), pw1[1]=PKW(P0,10), pw1); \
    VRD(5); SBAR(); GAPA(C1=__builtin_amdgcn_mfma_f32_32x32x16_bf16(kf[3],qr[1],C1,0,0,0),   P0[14],P0[15],P1[0],P1[1],   pw1[2]=PKW(P0,12),pw1[3]=PKW(P0,14), pw1); \
    VRD(2); SBAR(); GAPA(C0=__builtin_amdgcn_mfma_f32_32x32x16_bf16(kf[4],qr[2],C0,0,0,0),   P1[2],P1[3],P1[4],P1[5],     pw2[0]=PKW(P1,0), pw2[1]=PKW(P1,2), pw2); \
    VRD(6); SBAR(); GAPA(C1=__builtin_amdgcn_mfma_f32_32x32x16_bf16(kf[5],qr[2],C1,0,0,0),   P1[6],P1[7],P1[8],P1[9],     pw2[2]=PKW(P1,4), pw2[3]=PKW(P1,6), pw2); \
    VRD(3); SBAR(); GAPA(C0=__builtin_amdgcn_mfma_f32_32x32x16_bf16(kf[6],qr[3],C0,0,0,0),   P1[10],P1[11],P1[12],P1[13], pw3[0]=PKW(P1,8), pw3[1]=PKW(P1,10), pw3); \
    VRD(7); SBAR(); GAPA(C1=__builtin_amdgcn_mfma_f32_32x32x16_bf16(kf[7],qr[3],C1,0,0,0),   P1[14],P1[15],0.f,0.f,       pw3[2]=PKW(P1,12),pw3[3]=PKW(P1,14), pw3); \
    C0=__builtin_amdgcn_mfma_f32_32x32x16_bf16(kx0,QR4,C0,0,0,0); C1=__builtin_amdgcn_mfma_f32_32x32x16_bf16(kx1,QR4,C1,0,0,0); SBAR(); \
    l_reg+=sacc; \
    if(GK){DMA_K((t)+3,sl_cur);} if(GV){DMA_V((t)+1,sl_next);} \
    CMASK(C0,C1,t); \
    { float a=MX3(C0[0],C0[1],C1[0]),b=MX3(C0[2],C0[3],C1[1]); a=MX3(a,C1[2],C1[3]); \
      _Pragma("unroll") for(int r=4;r<16;r+=4){a=MX3(a,C0[r],C0[r+1]);b=MX3(b,C0[r+2],C0[r+3]);a=MX3(a,C1[r],C1[r+1]);b=MX3(b,C1[r+2],C1[r+3]);} \
      float rm=__builtin_fmaxf(a,b); { auto rr=__builtin_amdgcn_permlane32_swap(__float_as_uint(rm),__float_as_uint(rm),false,false); rm=__builtin_fmaxf(__uint_as_float(rr[0]),__uint_as_float(rr[1])); } \
      resc=false; \
      if(__builtin_expect(__any(rm>(float)THRL),0)){ const float dl=__builtin_fmaxf(rm,0.f); mhat+=dl; \
        _Pragma("unroll") for(int r=0;r<16;++r){C0[r]-=dl;C1[r]-=dl;} \
        SETM(); \
        const float f=__builtin_amdgcn_exp2f(-dl); l_reg*=f; if(hi==0)wsf[r32]=f; resc=true; } } \
    SBAR(); \
    GAPB(o[0]=__builtin_amdgcn_mfma_f32_32x32x16_bf16(PAF(0),VFR(0),o[0],0,0,0), C0,0); \
    GAPB(o[1]=__builtin_amdgcn_mfma_f32_32x32x16_bf16(PAF(0),VFR(4),o[1],0,0,0), C0,4); \
    KRD(GL,0); GAPB(o[0]=__builtin_amdgcn_mfma_f32_32x32x16_bf16(PAF(1),VFR(1),o[0],0,0,0), C0,8); \
    KRD(GL,1); GAPB(o[1]=__builtin_amdgcn_mfma_f32_32x32x16_bf16(PAF(1),VFR(5),o[1],0,0,0), C0,12); \
    KRD(GL,2); GAPB(o[0]=__builtin_amdgcn_mfma_f32_32x32x16_bf16(PAF(2),VFR(2),o[0],0,0,0), C1,0); \
    KRD(GL,3); GAPB(o[1]=__builtin_amdgcn_mfma_f32_32x32x16_bf16(PAF(2),VFR(6),o[1],0,0,0), C1,4); \
    if(GL){ kx0=*(const ALAS bf16x8*)(kxp0+sl_next); kx1=*(const ALAS bf16x8*)(kxp0+sl_next+512); SBAR(); } \
    GAPB(o[0]=__builtin_amdgcn_mfma_f32_32x32x16_bf16(PAF(3),VFR(3),o[0],0,0,0), C1,8); \
    GAPB(o[1]=__builtin_amdgcn_mfma_f32_32x32x16_bf16(PAF(3),VFR(7),o[1],0,0,0), C1,12); \
    }while(0)
  #define ENDW(tt) do{ if((tt)+3<NT){WAIT_BARK(2,3);} else if((tt)+2<NT){WAIT_BAR(1);} else {WAIT_BAR(0);} }while(0)
  int t=1;
  for(;t<5&&t+1<NT;t+=2){
    STEP(pB0,pB1,pA0,pA1,t,(t+3<NT),(t+1<NT),(t+1<NT));       ENDW(t);   RESC(); ROT();
    STEP(pA0,pA1,pB0,pB1,t+1,(t+4<NT),(t+2<NT),(t+2<NT));     ENDW(t+1); RESC(); ROT();
  }
  #undef CMASK
  #define CMASK(P0,P1,t) do{}while(0)
  for(;t+5<NT;t+=2){
    STEP(pB0,pB1,pA0,pA1,t,true,true,true);     WAIT_BARK(2,3); RESC(); ROT();
    STEP(pA0,pA1,pB0,pB1,t+1,true,true,true);   WAIT_BARK(2,3); RESC(); ROT();
  }
  for(;t+1<NT;t+=2){
    STEP(pB0,pB1,pA0,pA1,t,(t+3<NT),(t+1<NT),(t+1<NT));       ENDW(t);   RESC(); ROT();
    STEP(pA0,pA1,pB0,pB1,t+1,(t+4<NT),(t+2<NT),(t+2<NT));     ENDW(t+1); RESC(); ROT();
  }
  #undef CMASK
  #define CMASK(P0,P1,t) do{int jb_=(t)==0?0:((t)<=3?4-(t):-1); if(jb_>=0)cmask(P0,P1,jb_,qrel,hi);}while(0)
  STEP(pB0,pB1,pA0,pA1,NT-1,false,false,false); RESC();
  { float sacc=pB0[0]+pB0[1]; _Pragma("unroll") for(int r=2;r<16;++r)sacc+=pB0[r]; _Pragma("unroll") for(int r=0;r<16;++r)sacc+=pB1[r]; l_reg+=sacc;
    pw0=(u32x4){PKW(pB0,0),PKW(pB0,2),PKW(pB0,4),PKW(pB0,6)};pw1=(u32x4){PKW(pB0,8),PKW(pB0,10),PKW(pB0,12),PKW(pB0,14)};pw2=(u32x4){PKW(pB1,0),PKW(pB1,2),PKW(pB1,4),PKW(pB1,6)};pw3=(u32x4){PKW(pB1,8),PKW(pB1,10),PKW(pB1,12),PKW(pB1,14)};
    SBAR(); pv(o,vb0+sl_cur,PAF(0),PAF(1),PAF(2),PAF(3)); }
  #undef PKW
  #undef PAF
  #undef VFR
  #undef PIN
  #undef MX3
  #undef GAPA
  #undef GAPB
  #undef EX
  #undef VRD
  #undef KRD
  #undef STEP
  #undef ENDW
  {auto rr=__builtin_amdgcn_permlane32_swap(__float_as_uint(l_reg),__float_as_uint(l_reg),false,false);l_reg=__uint_as_float(rr[0])+__uint_as_float(rr[1]);}
  if(hi==0)wsf[32+r32]=l_reg;asm volatile("s_waitcnt lgkmcnt(0)":::"memory");
  int hi_e=hi; asm volatile("":"+v"(hi_e));
  float rli[16];
  #pragma unroll
  for(int r=0;r<16;++r)rli[r]=__builtin_amdgcn_rcpf(wsf[32+crow(r,hi_e)]);
  bf16*Ow=O+(rowbase+q0+wid*QBLK)*ODM+OCOL+h*D;
  { bf16*stg=(bf16*)(shm+LDS_OST)+wid*2048;
    #pragma unroll
    for(int r=0;r<16;++r){const int orow=crow(r,hi_e);
      #pragma unroll
      for(int d0=0;d0<2;++d0)stg[orow*64+d0*32+r32]=__float2bfloat16(o[d0][r]*rli[r]);}
    asm volatile("s_waitcnt lgkmcnt(0)":::"memory");
    #pragma unroll
    for(int i=0;i<4;++i){const int row=i*8+(lane>>3),ch=lane&7; const u32x4 v=*(const u32x4*)(stg+row*64+ch*8); ATTN_STORE16(Ow+(long)row*ODM+ch*8,v);} }
  asm volatile("s_waitcnt lgkmcnt(0)\n\ts_barrier":::"memory");
  #undef DMA_K
  #undef TILE
  #undef DMA_V
  #undef CMASK
  #undef START
  #undef RESC
  #undef ROT
}
constexpr int ATTN_LDS_BYTES=LDS_BYTES;
struct AttnTensors { const bf16* Q; const bf16* K; const bf16* V; const bf16* KX; bf16* O; };
struct AttnUnit { int bh; int qb; };
struct StaticOrder {
  int vcu;
  __device__ __forceinline__ explicit StaticOrder(int grid,int block):vcu((block%8)*(grid/8)+block/8){}
  __device__ __forceinline__ bool next(int i,AttnUnit&u)const{ if(i>=4)return false; const int s=vcu&1; u.bh=vcu>>1; u.qb=(i==0)?(7-s):(i==1)?s:(i==2)?(5-s):(2+s); return true; }
  __device__ __forceinline__ void a_ready(const AttnUnit&)const{}
  __device__ __forceinline__ void done(const AttnUnit&)const{}
};
template<class Sched,int THRL=8> __device__ __forceinline__ void attn_phase(char*lds,const AttnTensors&T,const Sched&S){
  AttnUnit u;
  for(int i=0;S.next(i,u);++i){ S.a_ready(u); attn_unit<THRL>(u.bh/NHEAD,u.bh%NHEAD,u.qb,T.Q,T.K,T.V,T.KX,T.O,lds); S.done(u); }
}
#undef SBAR
#undef WAIT_BAR
}

namespace ssd {
typedef short bf16x8 __attribute__((ext_vector_type(8)));
typedef float f32x4 __attribute__((ext_vector_type(4)));
typedef unsigned u32x4 __attribute__((ext_vector_type(4)));
typedef unsigned u32x2 __attribute__((ext_vector_type(2)));
#define SLAS __attribute__((address_space(3)))
constexpr int LPB = 144;
constexpr int NPB = 272;
constexpr int NCH = SEQ / 64;
typedef float f32x2_t __attribute__((ext_vector_type(2))); typedef __bf16 bf16x2_t __attribute__((ext_vector_type(2)));
__device__ __forceinline__ unsigned pkbf(float lo, float hi) { f32x2_t v = {lo, hi}; bf16x2_t b = __builtin_convertvector(v, bf16x2_t); return __builtin_bit_cast(unsigned, b); }

__device__ __forceinline__ float chunk_acum(const float* dt, const float* a_log, int tok0, int h, int lane, float& dtv) {
    dtv = dt[(size_t)(tok0 + lane) * 8 + h];
    float A = dtv * (-expf(a_log[h]));
#pragma unroll
    for (int o = 1; o < 64; o <<= 1) { const float y = __shfl_up(A, o); if (lane >= o) A += y; }
    return A;
}


__device__ __forceinline__ void conv_chunk(const bf16_t* xbc, const float* cw, const float* cb, bf16_t* xcb, int b, int c) {
    const int tid = threadIdx.x, cg = tid & 127, rq = tid >> 7, ch0 = cg * 8, l0 = rq * 16;
    const size_t tok0 = (size_t)b * SEQ + c * 64;
    float w[4][8], bias[8];
#pragma unroll
    for (int k = 0; k < 4; ++k) { const f32x4 a = *(const f32x4*)(cw + k * 1024 + ch0), bq = *(const f32x4*)(cw + k * 1024 + ch0 + 4);
        w[k][0] = a[0]; w[k][1] = a[1]; w[k][2] = a[2]; w[k][3] = a[3]; w[k][4] = bq[0]; w[k][5] = bq[1]; w[k][6] = bq[2]; w[k][7] = bq[3]; }
    { const f32x4 a = *(const f32x4*)(cb + ch0), bq = *(const f32x4*)(cb + ch0 + 4); bias[0] = a[0]; bias[1] = a[1]; bias[2] = a[2]; bias[3] = a[3]; bias[4] = bq[0]; bias[5] = bq[1]; bias[6] = bq[2]; bias[7] = bq[3]; }
    float win[3][8];
#pragma unroll
    for (int k = 0; k < 3; ++k) { const int l = l0 - 3 + k; u32x4 v = (u32x4){0u, 0u, 0u, 0u};
        if (c * 64 + l >= 0) v = *(const u32x4*)(xbc + (tok0 + l) * 1024 + ch0);
#pragma unroll
        for (int j = 0; j < 4; ++j) { win[k][2 * j] = __uint_as_float(v[j] << 16); win[k][2 * j + 1] = __uint_as_float(v[j] & 0xffff0000u); } }
#pragma unroll
    for (int i = 0; i < 16; ++i) {
        const u32x4 v = *(const u32x4*)(xbc + (tok0 + l0 + i) * 1024 + ch0);
        float cur[8], o[8];
#pragma unroll
        for (int j = 0; j < 4; ++j) { cur[2 * j] = __uint_as_float(v[j] << 16); cur[2 * j + 1] = __uint_as_float(v[j] & 0xffff0000u); }
#pragma unroll
        for (int j = 0; j < 8; ++j) { const float a = bias[j] + w[0][j] * win[0][j] + w[1][j] * win[1][j] + w[2][j] * win[2][j] + w[3][j] * cur[j]; o[j] = a / (1.f + expf(-a)); }
        *(u32x4*)(xcb + (tok0 + l0 + i) * 1024 + ch0) = (u32x4){pkbf(o[0], o[1]), pkbf(o[2], o[3]), pkbf(o[4], o[5]), pkbf(o[6], o[7])};
#pragma unroll
        for (int j = 0; j < 8; ++j) { win[0][j] = win[1][j]; win[1][j] = win[2][j]; win[2][j] = cur[j]; }
    }
}


struct Conv8 {
    float w[4][8], bias[8]; u32x4 raw[11];
    __device__ __forceinline__ void load(const bf16_t* xbc, const float* cw, const float* cb, size_t tok0, int c, int col, int l0) {
#pragma unroll
        for (int k = 0; k < 4; ++k) { const f32x4 a = *(const f32x4*)(cw + k * 1024 + col), bq = *(const f32x4*)(cw + k * 1024 + col + 4);
            w[k][0] = a[0]; w[k][1] = a[1]; w[k][2] = a[2]; w[k][3] = a[3]; w[k][4] = bq[0]; w[k][5] = bq[1]; w[k][6] = bq[2]; w[k][7] = bq[3]; }
        { const f32x4 a = *(const f32x4*)(cb + col), bq = *(const f32x4*)(cb + col + 4); bias[0] = a[0]; bias[1] = a[1]; bias[2] = a[2]; bias[3] = a[3]; bias[4] = bq[0]; bias[5] = bq[1]; bias[6] = bq[2]; bias[7] = bq[3]; }
#pragma unroll
        for (int k = 0; k < 11; ++k) { const int l = l0 - 3 + k; raw[k] = (u32x4){0u, 0u, 0u, 0u}; if (c * 64 + l >= 0) raw[k] = *(const u32x4*)(xbc + (tok0 + l) * 1024 + col); }
    }
    __device__ __forceinline__ float val(int i, int j) const { float a = bias[j];
#pragma unroll
        for (int k = 0; k < 4; ++k) { const unsigned wv = raw[i + k][j >> 1]; a += w[k][j] * ((j & 1) ? __uint_as_float(wv & 0xffff0000u) : __uint_as_float(wv << 16)); }
        return a * __builtin_amdgcn_rcpf(1.f + __builtin_amdgcn_exp2f(-a * LOG2E)); }
};

__device__ __forceinline__ void states_unit(SLAS unsigned char* lds, const bf16_t* xbc, const float* cw, const float* cb, const float* dt, const float* a_log, bf16_t* S, float* cdec, int b, int c) {
    const int tid = threadIdx.x, lane = tid & 63, w = __builtin_amdgcn_readfirstlane(tid >> 6), r = lane & 15, q = lane >> 4;
    const int tok0 = b * SEQ + c * 64;
    SLAS float* warr = (SLAS float*)lds;
    SLAS unsigned char* BT = lds + 2048;
    SLAS unsigned char* XW = lds + 2048 + 128 * LPB;
    { float dtv; const float A = chunk_acum(dt, a_log, tok0, w, lane, dtv); const float A63 = __shfl(A, 63);
      warr[w * 64 + lane] = dtv * expf(A63 - A);
      if (lane == 63) cdec[(size_t)(b * NCH + c) * 8 + w] = expf(A63); }
    __syncthreads();
#pragma unroll 1
    for (int g = 0; g < 2; ++g) {
        if (lane < 48) {
            const bool isx = lane < 32; const int col = isx ? g * 256 + lane * 8 : 512 + g * 128 + (lane - 32) * 8; const int l0 = 8 * w;
            Conv8 cv; cv.load(xbc, cw, cb, (size_t)tok0, c, col, l0);
            float sc[8];
#pragma unroll
            for (int i = 0; i < 8; ++i) sc[i] = isx ? warr[(g * 4 + (lane >> 3)) * 64 + l0 + i] : 1.f;
            SLAS unsigned char* dstb = isx ? (XW + (lane * 8) * LPB) : (BT + ((lane - 32) * 8) * LPB);
#pragma unroll
            for (int j = 0; j < 8; ++j) { float o[8];
#pragma unroll
                for (int i = 0; i < 8; ++i) o[i] = cv.val(i, j) * sc[i];
                *(SLAS u32x4*)(dstb + j * LPB + l0 * 2) = (u32x4){pkbf(o[0], o[1]), pkbf(o[2], o[3]), pkbf(o[4], o[5]), pkbf(o[6], o[7])}; }
        }
        __syncthreads();
        f32x4 acc[8][2];
#pragma unroll
        for (int nt = 0; nt < 8; ++nt) { acc[nt][0] = (f32x4){0.f, 0.f, 0.f, 0.f}; acc[nt][1] = (f32x4){0.f, 0.f, 0.f, 0.f}; }
#pragma unroll
        for (int k = 0; k < 2; ++k) {
            bf16x8 xf[2];
#pragma unroll
            for (int ht = 0; ht < 2; ++ht) xf[ht] = *(const SLAS bf16x8*)(XW + (32 * w + 16 * ht + r) * LPB + (32 * k + 8 * q) * 2);
#pragma unroll
            for (int nt = 0; nt < 8; ++nt) { const bf16x8 bf = *(const SLAS bf16x8*)(BT + (16 * nt + r) * LPB + (32 * k + 8 * q) * 2);
#pragma unroll
                for (int ht = 0; ht < 2; ++ht) acc[nt][ht] = __builtin_amdgcn_mfma_f32_16x16x32_bf16(bf, xf[ht], acc[nt][ht], 0, 0, 0); }
        }
        const int h = g * 4 + (w >> 1);
#pragma unroll
        for (int ht = 0; ht < 2; ++ht) { const int p = (w & 1) * 32 + 16 * ht + r; bf16_t* dst = S + ((size_t)((b * NCH + c) * 8 + h) * 64 + p) * 128 + 4 * q;
#pragma unroll
            for (int nt = 0; nt < 8; ++nt) *(u32x2*)(dst + 16 * nt) = (u32x2){pkbf(acc[nt][ht][0], acc[nt][ht][1]), pkbf(acc[nt][ht][2], acc[nt][ht][3])}; }
        __syncthreads();
    }
}

__device__ __forceinline__ void scan_unit(bf16_t* S, const float* cdec, int bh, int half) {
    const int tid = threadIdx.x, b = bh >> 3, h = bh & 7;
    const size_t e0 = (size_t)(half * 512 + tid) * 8;
    float st[8];
#pragma unroll
    for (int i = 0; i < 8; ++i) st[i] = 0.f;
#pragma unroll 1
    for (int c0 = 0; c0 < NCH; c0 += 8) {
        u32x4 v[8];
#pragma unroll
        for (int j = 0; j < 8; ++j) v[j] = *(const u32x4*)(S + (size_t)((b * NCH + c0 + j) * 8 + h) * 8192 + e0);
#pragma unroll
        for (int j = 0; j < 8; ++j) {
            *(u32x4*)(S + (size_t)((b * NCH + c0 + j) * 8 + h) * 8192 + e0) = (u32x4){pkbf(st[0], st[1]), pkbf(st[2], st[3]), pkbf(st[4], st[5]), pkbf(st[6], st[7])};
            const float d = cdec[(size_t)(b * NCH + c0 + j) * 8 + h];
#pragma unroll
            for (int i = 0; i < 4; ++i) { const unsigned wv = v[j][i]; st[2 * i] = st[2 * i] * d + __uint_as_float(wv << 16); st[2 * i + 1] = st[2 * i + 1] * d + __uint_as_float(wv & 0xffff0000u); }
        }
    }
}

__device__ __forceinline__ void out_unit(SLAS unsigned char* lds, const bf16_t* xbc, const float* cw, const float* cb, const bf16_t* z, const float* dt, const float* a_log, const float* d_skip, const float* norm_g,
                                         const bf16_t* Sin, bf16_t* merged, int b, int c) {
    const int tid = threadIdx.x, lane = tid & 63, w = __builtin_amdgcn_readfirstlane(tid >> 6), r = lane & 15, q = lane >> 4;
    const int tok0 = b * SEQ + c * 64;
    SLAS float* Aarr = (SLAS float*)lds;
    SLAS float* dtarr = (SLAS float*)(lds + 2048);
    SLAS float* npart = (SLAS float*)(lds + 4096);
    SLAS unsigned char* Cg = lds + 6144;
    SLAS unsigned char* Bg = Cg + 64 * NPB;
    SLAS unsigned char* XT = Bg + 64 * NPB;
    SLAS unsigned char* Mm = XT + 256 * LPB;
    { float dtv; const float A = chunk_acum(dt, a_log, tok0, w, lane, dtv); Aarr[w * 64 + lane] = A; dtarr[w * 64 + lane] = dtv; }
    __syncthreads();
#pragma unroll 1
    for (int g = 0; g < 2; ++g) {
        if (w < 4) { const int cg = lane & 31, l0 = 8 * (2 * w + (lane >> 5));
            Conv8 cv; cv.load(xbc, cw, cb, (size_t)tok0, c, g * 256 + cg * 8, l0);
#pragma unroll
            for (int j = 0; j < 8; ++j) { float o[8];
#pragma unroll
                for (int i = 0; i < 8; ++i) o[i] = cv.val(i, j);
                *(SLAS u32x4*)(XT + (cg * 8 + j) * LPB + l0 * 2) = (u32x4){pkbf(o[0], o[1]), pkbf(o[2], o[3]), pkbf(o[4], o[5]), pkbf(o[6], o[7])}; }
        } else { const int cg = lane & 15, l0 = 8 * (4 * (w & 1) + (lane >> 4)); const bool isB = w < 6;
            Conv8 cv; cv.load(xbc, cw, cb, (size_t)tok0, c, (isB ? 512 : 768) + g * 128 + cg * 8, l0);
            SLAS unsigned char* dstb = (isB ? Bg : Cg) + cg * 16;
#pragma unroll
            for (int i = 0; i < 8; ++i) { float o[8];
#pragma unroll
                for (int j = 0; j < 8; ++j) o[j] = cv.val(i, j);
                *(SLAS u32x4*)(dstb + (l0 + i) * NPB) = (u32x4){pkbf(o[0], o[1]), pkbf(o[2], o[3]), pkbf(o[4], o[5]), pkbf(o[6], o[7])}; } }
        __syncthreads();
        {
            const int lt = w >> 1, st0 = 2 * (w & 1);
            f32x4 accG[2]; accG[0] = (f32x4){0.f, 0.f, 0.f, 0.f}; accG[1] = (f32x4){0.f, 0.f, 0.f, 0.f};
#pragma unroll
            for (int k = 0; k < 4; ++k) { const bf16x8 cf = *(const SLAS bf16x8*)(Cg + (16 * lt + r) * NPB + (32 * k + 8 * q) * 2);
#pragma unroll
                for (int j = 0; j < 2; ++j) { const bf16x8 bf = *(const SLAS bf16x8*)(Bg + (16 * (st0 + j) + r) * NPB + (32 * k + 8 * q) * 2); accG[j] = __builtin_amdgcn_mfma_f32_16x16x32_bf16(bf, cf, accG[j], 0, 0, 0); } }
            const int l = 16 * lt + r;
#pragma unroll
            for (int hh = 0; hh < 4; ++hh) { const int h = g * 4 + hh; const float Al = Aarr[h * 64 + l];
#pragma unroll
                for (int j = 0; j < 2; ++j) { const int s0 = 16 * (st0 + j) + 4 * q; float m[4];
#pragma unroll
                    for (int e = 0; e < 4; ++e) { const int s = s0 + e; m[e] = (s <= l) ? accG[j][e] * __builtin_amdgcn_exp2f((Al - Aarr[h * 64 + s]) * LOG2E) * dtarr[h * 64 + s] : 0.f; }
                    *(SLAS u32x2*)(Mm + hh * 64 * LPB + l * LPB + s0 * 2) = (u32x2){pkbf(m[0], m[1]), pkbf(m[2], m[3])}; } }
        }
        __syncthreads();
        {
            const int hh = w >> 1, h = g * 4 + hh;
            f32x4 acc[4][2];
#pragma unroll
            for (int lt = 0; lt < 4; ++lt) { acc[lt][0] = (f32x4){0.f, 0.f, 0.f, 0.f}; acc[lt][1] = (f32x4){0.f, 0.f, 0.f, 0.f}; }
            const bf16_t* sin = Sin + ((size_t)((b * NCH + c) * 8 + h) * 64 + (w & 1) * 32 + r) * 128 + 8 * q;
            bf16x8 sfr[4][2];
#pragma unroll
            for (int k = 0; k < 4; ++k)
#pragma unroll
                for (int ht = 0; ht < 2; ++ht) sfr[k][ht] = *(const bf16x8*)(sin + (size_t)(16 * ht) * 128 + 32 * k);
#pragma unroll
            for (int k = 0; k < 4; ++k) { bf16x8 sf[2]; sf[0] = sfr[k][0]; sf[1] = sfr[k][1];
#pragma unroll
                for (int lt = 0; lt < 4; ++lt) { const bf16x8 cf = *(const SLAS bf16x8*)(Cg + (16 * lt + r) * NPB + (32 * k + 8 * q) * 2);
#pragma unroll
                    for (int ht = 0; ht < 2; ++ht) acc[lt][ht] = __builtin_amdgcn_mfma_f32_16x16x32_bf16(sf[ht], cf, acc[lt][ht], 0, 0, 0); } }
#pragma unroll
            for (int lt = 0; lt < 4; ++lt) { const float e = __builtin_amdgcn_exp2f(Aarr[h * 64 + 16 * lt + r] * LOG2E); acc[lt][0] = acc[lt][0] * e; acc[lt][1] = acc[lt][1] * e; }
#pragma unroll
            for (int k = 0; k < 2; ++k) { bf16x8 xf[2];
#pragma unroll
                for (int ht = 0; ht < 2; ++ht) xf[ht] = *(const SLAS bf16x8*)(XT + (32 * w + 16 * ht + r) * LPB + (32 * k + 8 * q) * 2);
#pragma unroll
                for (int lt = 0; lt < 4; ++lt) { const bf16x8 mf = *(const SLAS bf16x8*)(Mm + hh * 64 * LPB + (16 * lt + r) * LPB + (32 * k + 8 * q) * 2);
#pragma unroll
                    for (int ht = 0; ht < 2; ++ht) acc[lt][ht] = __builtin_amdgcn_mfma_f32_16x16x32_bf16(xf[ht], mf, acc[lt][ht], 0, 0, 0); } }
            const float dsk = d_skip[h];
            float ss[4];
#pragma unroll
            for (int lt = 0; lt < 4; ++lt) { const int l = 16 * lt + r; float s2 = 0.f;
#pragma unroll
                for (int ht = 0; ht < 2; ++ht) { const int ch = g * 256 + 32 * w + 16 * ht + 4 * q;
                    const u32x2 zv = *(const u32x2*)(z + (size_t)(tok0 + l) * 512 + ch);
                    float xs4[4];
#pragma unroll
                    for (int e = 0; e < 4; ++e) xs4[e] = bf2f(*(const SLAS bf16_t*)(XT + (32 * w + 16 * ht + 4 * q + e) * LPB + l * 2));
                    const float z4[4] = {__uint_as_float(zv.x << 16), __uint_as_float(zv.x & 0xffff0000u), __uint_as_float(zv.y << 16), __uint_as_float(zv.y & 0xffff0000u)};
#pragma unroll
                    for (int e = 0; e < 4; ++e) { const float y = acc[lt][ht][e] + dsk * xs4[e]; const float yg = y * z4[e] * __builtin_amdgcn_rcpf(1.f + __builtin_amdgcn_exp2f(-z4[e] * LOG2E)); acc[lt][ht][e] = yg; s2 += yg * yg; } }
                s2 += __shfl_xor(s2, 16); s2 += __shfl_xor(s2, 32); ss[lt] = s2; }
            if (q == 0) {
#pragma unroll
                for (int lt = 0; lt < 4; ++lt) npart[w * 64 + 16 * lt + r] = ss[lt]; }
            __syncthreads();
#pragma unroll
            for (int lt = 0; lt < 4; ++lt) { const int l = 16 * lt + r; float tot = 0.f;
#pragma unroll
                for (int ww = 0; ww < 8; ++ww) tot += npart[ww * 64 + l];
                const float rs = rsqrtf(tot * (1.f / 256.f) + RMS_EPS);
#pragma unroll
                for (int ht = 0; ht < 2; ++ht) { const int ch = g * 256 + 32 * w + 16 * ht + 4 * q; const f32x4 gv = *(const f32x4*)(norm_g + ch);
                    *(u32x2*)(merged + (size_t)(tok0 + l) * 1024 + ch) = (u32x2){pkbf(acc[lt][ht][0] * rs * gv[0], acc[lt][ht][1] * rs * gv[1]), pkbf(acc[lt][ht][2] * rs * gv[2], acc[lt][ht][3] * rs * gv[3])}; } }
        }
        __syncthreads();
    }
}
#undef SLAS
}

__global__ void k_convb(const bf16_t* xbc, const float* conv_w, const float* conv_b, bf16_t* xc) {
    const size_t idx = (size_t)blockIdx.x * 256 + threadIdx.x;
    const int c = (int)(idx & 1023); const int t = (int)(idx >> 10); const int s = t & (SEQ - 1);
    float acc = conv_b[c];
#pragma unroll
    for (int k = 0; k < 4; ++k) { const int ss = s - 3 + k; if (ss >= 0) acc += conv_w[k * 1024 + c] * bf2f(xbc[(size_t)(t - 3 + k) * 1024 + c]); }
    xc[idx] = f2bf(acc / (1.f + expf(-acc)));
}


constexpr int NWAVES = 8;
constexpr int RING_OFF = 0, RING_BYTES = 131072;
constexpr int LDSCTL_OFF = RING_BYTES, MISC_OFF = LDSCTL_OFF + 320;
constexpr int TAB_OFF = RING_BYTES + 1024;
constexpr int LDS_BYTES = 147456;
#define GAS __attribute__((address_space(1)))
#define LAS __attribute__((address_space(3)))
typedef unsigned v4u __attribute__((ext_vector_type(4)));
typedef float f32x4 __attribute__((ext_vector_type(4)));
typedef GAS unsigned gu32;
#define RLX_AGENT __ATOMIC_RELAXED, __HIP_MEMORY_SCOPE_AGENT
#define LDS_WAIT() asm volatile("s_waitcnt lgkmcnt(0)" ::: "memory")
#define VM_WAIT() asm volatile("s_waitcnt vmcnt(0)" ::: "memory")
__device__ __forceinline__ unsigned pk2(float lo, float hi) { return (unsigned)f2bf(lo) | ((unsigned)f2bf(hi) << 16); }

#define XB_TMO      128
#define XB_XCNT(j)  (256  + 64 * (j))
#define XB_XSUB(j)  (1280 + 64 * (j))
#define XB_XGEN(j)  (2304 + 64 * (j))
#define XB_TOP      3328
#define XB_TOPGEN   3392
#define XCD_BAR_WORDS 3456
#define XB_SPIN_CAP (1u << 18)
__device__ __forceinline__ unsigned xb_ld(unsigned* p)              { return __hip_atomic_load(p, __ATOMIC_RELAXED, __HIP_MEMORY_SCOPE_AGENT); }
__device__ __forceinline__ unsigned xb_add(unsigned* p, unsigned v) { return __hip_atomic_fetch_add(p, v, __ATOMIC_RELAXED, __HIP_MEMORY_SCOPE_AGENT); }
__device__ __forceinline__ unsigned xb_xcc_id() { return (unsigned)__builtin_amdgcn_s_getreg((3 << 11) | 20) & 0xFu; }
#define XB_SPIN(cond, bar) do { unsigned _sp = 0; while (cond) { __builtin_amdgcn_s_sleep(1); \
    if ((++_sp & 255u) == 0u) { if (xb_ld(&(bar)[XB_TMO])) break; if (_sp > XB_SPIN_CAP) { atomicAdd(&(bar)[XB_TMO], 1u); break; } } } } while (0)
struct XcdBarrier { unsigned* bar; unsigned x; volatile LAS unsigned* st; };
__device__ __forceinline__ XcdBarrier xcd_barrier_post(unsigned* bar, volatile LAS unsigned* st) {
    XcdBarrier b; b.bar = bar; b.x = xb_xcc_id(); b.st = st;
    if (threadIdx.x == 0) (void)xb_add(&bar[XB_XCNT(b.x)], 1u);
    return b;
}
__device__ __forceinline__ void xcd_barrier_complete(unsigned* bar, unsigned x, unsigned& nloc, unsigned& nx) {
    const unsigned G = gridDim.x * gridDim.y * gridDim.z;
    unsigned sum, cnt, mine, sp = 0u;
    for (;;) {
        sum = 0u; cnt = 0u; mine = 0u;
#pragma unroll
        for (unsigned j = 0; j < 16; ++j) { const unsigned c = xb_ld(&bar[XB_XCNT(j)]); sum += c; cnt += (c > 0u) ? 1u : 0u; mine = (j == x) ? c : mine; }
        if (sum == G) break;
        __builtin_amdgcn_s_sleep(1);
        if ((++sp & 255u) == 0u) { if (xb_ld(&bar[XB_TMO])) break; if (sp > XB_SPIN_CAP) { atomicAdd(&bar[XB_TMO], 1u); break; } }
    }
    nloc = mine > 0u ? mine : 1u; nx = cnt > 0u ? cnt : 1u;
}
__device__ __forceinline__ void xcd_barrier(const XcdBarrier& b) {
    asm volatile("s_waitcnt vmcnt(0)" ::: "memory");
    __syncthreads();
    if (threadIdx.x == 0) {
        unsigned* bar = b.bar;
        __builtin_amdgcn_s_waitcnt(0);
        unsigned nloc = b.st[0], nx = b.st[1];
        if (nloc == 0u) { xcd_barrier_complete(bar, b.x, nloc, nx); b.st[0] = nloc; b.st[1] = nx; }
        const unsigned old = xb_add(&bar[XB_XSUB(b.x)], 1u);
        const unsigned gen = old / nloc;
        if (old + 1u == (gen + 1u) * nloc) {
            __builtin_amdgcn_fence(__ATOMIC_RELEASE, "agent");
            asm volatile("s_waitcnt vmcnt(0)" ::: "memory");
            const unsigned og = xb_add(&bar[XB_TOP], 1u);
            const unsigned tg = og / nx;
            if (og + 1u == (tg + 1u) * nx) xb_add(&bar[XB_TOPGEN], 1u);
            else XB_SPIN(xb_ld(&bar[XB_TOPGEN]) == tg, bar);
            __builtin_amdgcn_fence(__ATOMIC_ACQUIRE, "agent");
            xb_add(&bar[XB_XGEN(b.x)], 1u);
            asm volatile("s_waitcnt vmcnt(0)" ::: "memory");
        } else {
            XB_SPIN(xb_ld(&bar[XB_XGEN(b.x)]) == gen, bar);
            __builtin_amdgcn_fence(__ATOMIC_ACQUIRE, "agent");
            asm volatile("s_waitcnt vmcnt(0)" ::: "memory");
        }
    }
    __syncthreads();
}

struct Frame {
    LAS unsigned char* lds;
    volatile LAS unsigned* MISC;
    gu32* ctl;
    int tid, lane, wave, vcu, G;
};
__device__ __forceinline__ int tid_now() { int t; asm volatile("v_mov_b32 %0, %1" : "=v"(t) : "v"(threadIdx.x)); return t; }
__device__ __forceinline__ int lane_now() { int l; asm volatile("v_and_b32 %0, 63, %1" : "=v"(l) : "v"(threadIdx.x)); return l; }
__device__ __forceinline__ float wave_sum(float v) {
#pragma unroll
    for (int o = 1; o < 64; o <<= 1) v += __shfl_xor(v, o);
    return v;
}

__device__ __forceinline__ void p0_transpose_item(const float* W, int ldw, int k0, int n0, bf16_t* WT, int ldt, int drow0, LAS float* scr, int lane) {
    float tv[32];
#pragma unroll
    for (int i = 0; i < 32; ++i) { const int kk = 2 * i + (lane >> 5); tv[i] = W[(size_t)(k0 + kk) * ldw + n0 + (lane & 31)]; }
#pragma unroll
    for (int i = 0; i < 32; ++i) { const int kk = 2 * i + (lane >> 5); scr[kk * 33 + (lane & 31)] = tv[i]; }
    LDS_WAIT(); asm volatile("" ::: "memory");
    const int c = lane & 7;
#pragma unroll
    for (int j = 0; j < 4; ++j) { const int n = (lane >> 3) + 8 * j; const LAS float* s = scr + (8 * c) * 33 + n;
        v4u o; o.x = pk2(s[0 * 33], s[1 * 33]); o.y = pk2(s[2 * 33], s[3 * 33]); o.z = pk2(s[4 * 33], s[5 * 33]); o.w = pk2(s[6 * 33], s[7 * 33]);
        *(GAS v4u*)(WT + (size_t)(drow0 + n) * ldt + k0 + 8 * c) = o; }
    LDS_WAIT(); asm volatile("" ::: "memory");
}
__device__ __forceinline__ float softplus_d(float x) { return fmaxf(x, 0.f) + log1pf(expf(-fabsf(x))); }

__device__ __forceinline__ void p0_prologue(Frame& F, const P& p) {
    unsigned char* ws = p.ws;
    bf16_t* Win_t = (bf16_t*)(ws + WS_WIN); bf16_t* Wout_t = (bf16_t*)(ws + WS_WOUT); bf16_t* Wgu_t = (bf16_t*)(ws + WS_WGU); bf16_t* Wd_t = (bf16_t*)(ws + WS_WD);
    LAS float* scr = (LAS float*)(F.lds + RING_OFF + F.wave * 16384);
    const int gw = F.vcu * NWAVES + F.wave, NGW = F.G * NWAVES;
    constexpr int I_IN = 16 * 96, I_OUT = 16 * 32, I_GU = 16 * 2 * 256, I_D = 16 * 256, NITEMS = I_IN + I_OUT + I_GU + I_D;
    for (int it = gw; it < NITEMS; it += NGW) {
        int r = it;
        if (r < I_IN) { const int kb = r / 96, nb = r % 96, n0 = 32 * nb; p0_transpose_item(p.w_in, NPROJ, 64 * kb, n0 + (n0 >= 1536 ? 8 : 0), Win_t, 1024, n0, scr, F.lane); continue; } r -= I_IN;
        if (r < I_OUT) { const int kb = r / 32, nb = r % 32; p0_transpose_item(p.w_out, 1024, 64 * kb, 32 * nb, Wout_t, 1024, 32 * nb, scr, F.lane); continue; } r -= I_OUT;
        if (r < I_GU) { const int e = r / 512, rr = r % 512, mat = rr / 256, r2 = rr % 256, kb = r2 / 16, nb = r2 % 16, n0 = 32 * nb, q = n0 / 128;
            p0_transpose_item((mat ? p.w_up : p.w_gate) + (size_t)e * 1024 * 512, 512, 64 * kb, n0, Wgu_t, 1024, (e * 4 + q) * 256 + mat * 128 + (n0 % 128), scr, F.lane); continue; } r -= I_GU;
        { const int e = r / 256, r2 = r % 256, kb = r2 / 32, nb = r2 % 32;
            p0_transpose_item(p.w_down + (size_t)e * 512 * 1024, 1024, 64 * kb, 32 * nb, Wd_t + (size_t)e * 1024 * 512, 512, 32 * nb, scr, F.lane); }
    }
    __syncthreads();
    LAS float* w16 = (LAS float*)(F.lds + RING_OFF);
    { float wv[32];
#pragma unroll
      for (int i = 0; i < 32; ++i) { const int idx = F.tid + i * NWAVES * 64; const int k = idx >> 4, c = idx & 15; wv[i] = p.w_in[(size_t)k * NPROJ + (c < 8 ? 1536 + c : 3080 + c - 8)]; }
#pragma unroll
      for (int i = 0; i < 32; ++i) { const int idx = F.tid + i * NWAVES * 64; const int k = idx >> 4, c = idx & 15; w16[c * 1024 + k] = wv[i]; } }
    __syncthreads();
    bf16_t* xb = (bf16_t*)(ws + WS_XB); float* dt = (float*)(ws + WS_DT); float* logf = (float*)(ws + WS_LOGF);
#pragma unroll 1
    for (int grp = gw; grp < T / 2; grp += NGW) {
        float a[32];
#pragma unroll
        for (int r = 0; r < 2; ++r) {
            const int m = grp * 2 + r;
            const GAS f32x4* xr = (const GAS f32x4*)(p.x + (size_t)m * D) + F.lane;
            f32x4 v[4];
#pragma unroll
            for (int j = 0; j < 4; ++j) v[j] = xr[64 * j];
            GAS unsigned long long* o8 = (GAS unsigned long long*)(xb + (size_t)m * D) + F.lane;
#pragma unroll
            for (int j = 0; j < 4; ++j) o8[64 * j] = (unsigned long long)pk2(v[j].x, v[j].y) | ((unsigned long long)pk2(v[j].z, v[j].w) << 32);
#pragma unroll
            for (int c = 0; c < 16; ++c) {
                float s = 0.f;
#pragma unroll
                for (int j = 0; j < 4; ++j) { const f32x4 w = *(const LAS f32x4*)(w16 + c * 1024 + 256 * j + 4 * F.lane); s += (v[j].x * w.x + v[j].y * w.y) + (v[j].z * w.z + v[j].w * w.w); }
                a[r * 16 + c] = s; asm volatile("" ::: "memory");
            }
        }
#define TRSTEP(HALFN, SB) do { const bool up = (F.lane >> (SB)) & 1; _Pragma("unroll") for (int i = 0; i < (HALFN); ++i) { const float keep = up ? a[i + (HALFN)] : a[i]; const float send = up ? a[i] : a[i + (HALFN)]; a[i] = keep + __shfl_xor(send, 1 << (SB)); } } while (0)
        TRSTEP(16, 0); TRSTEP(8, 1); TRSTEP(4, 2); TRSTEP(2, 3); TRSTEP(1, 4);
#undef TRSTEP
        const float tot = a[0] + __shfl_xor(a[0], 32);
        const int L = F.lane & 31; const int idx = ((L & 1) << 4) | ((L & 2) << 2) | (L & 4) | ((L & 8) >> 2) | ((L & 16) >> 4);
        const int r = idx >> 4, c = idx & 15, m = grp * 2 + r;
        if (F.lane < 32) {
            if (c < 8) dt[(size_t)m * 8 + c] = softplus_d(tot + p.b_in[1536 + c]);
            else logf[(size_t)m * 8 + (c - 8)] = -softplus_d(-(tot + p.b_in[3080 + c - 8]));
        }
    }
}

__device__ __forceinline__ void scanF_unit(Frame& F, const P& p, int bh) {
    const int b = bh >> 3, h = bh & 7;
    const float* logf = (const float*)(p.ws + WS_LOGF); float* Fo = (float*)(p.ws + WS_F); bf16_t* kx = (bf16_t*)(p.ws + WS_KX);
    LAS float* wsum8 = (LAS float*)(F.lds + RING_OFF);
    float v[4]; float s = 0.f;
#pragma unroll
    for (int i = 0; i < 4; ++i) { v[i] = logf[(size_t)(b * SEQ + F.tid * 4 + i) * 8 + h]; s += v[i]; v[i] = s; }
    float inc = s;
#pragma unroll
    for (int o = 1; o < 64; o <<= 1) { const float y = __shfl_up(inc, o); if (F.lane >= o) inc += y; }
    if (F.lane == 63) wsum8[F.wave] = inc;
    __syncthreads();
    float base = inc - s;
    for (int w = 0; w < F.wave; ++w) base += wsum8[w];
#pragma unroll
    for (int i = 0; i < 4; ++i) { const size_t tok = (size_t)(b * SEQ + F.tid * 4 + i); const float f = base + v[i]; Fo[tok * 8 + h] = f;
        const float g = -f * LOG2E; const bf16_t g0 = f2bf(g); const float r1 = g - bf2f(g0); const bf16_t g1 = f2bf(r1); const float r2 = r1 - bf2f(g1); const bf16_t g2 = f2bf(r2);
        v4u o; o.x = (unsigned)g0 | ((unsigned)g1 << 16); o.y = (unsigned)g2 | 0x3F800000u; o.z = 0x3F803F80u; o.w = 0u;
        *(GAS v4u*)(kx + (tok * 8 + h) * 8) = o; }
    __syncthreads();
}


__device__ __forceinline__ void ln1_stage_weights(const P& p, LAS f32x4* RG, int tid) {
    f32x4 wv[10];
#pragma unroll
    for (int it = 0; it < 10; ++it) { const int idx = tid + it * NWAVES * 64; const int m = idx >> 10, cc = idx & 1023;
        wv[it] = m == 0 ? *(const GAS f32x4*)(p.rg_w + (size_t)cc * 4) : *(const GAS f32x4*)(p.re_w + ((size_t)(m - 1) * D + cc) * 4); }
#pragma unroll
    for (int it = 0; it < 10; ++it) { const int idx = tid + it * NWAVES * 64; const int m = idx >> 10, cc = idx & 1023, j = cc >> 8, ln = (cc & 255) >> 2, i = cc & 3;
        RG[m * 1024 + (j * 4 + i) * 64 + ln] = wv[it]; }
}
template <int R>
__device__ __forceinline__ void ln1_router_rows(const P& p, int t0, int lane, const LAS f32x4* RG, bf16_t* hb, LAS unsigned* lcnt, LAS f32x4* rowinfo, LAS int* rowtok, int slot0) {
    const bf16_t* mix = (const bf16_t*)(p.ws + WS_MIX);
    f32x4 v[R][4];
#pragma unroll
    for (int r = 0; r < R; ++r)
#pragma unroll
        for (int j = 0; j < 4; ++j) { const f32x4 xv = *(const GAS f32x4*)(p.x + (size_t)(t0 + r) * D + j * 256 + lane * 4);
            const unsigned long long mv = *(const GAS unsigned long long*)(mix + (size_t)(t0 + r) * D + j * 256 + lane * 4); const unsigned m0 = (unsigned)mv, m1 = (unsigned)(mv >> 32);
            v[r][j] = xv * ALPHA + (f32x4){__uint_as_float(m0 << 16), __uint_as_float(m0 & 0xffff0000u), __uint_as_float(m1 << 16), __uint_as_float(m1 & 0xffff0000u)}; }
    f32x4 g1[4], b1[4];
#pragma unroll
    for (int j = 0; j < 4; ++j) { g1[j] = *(const GAS f32x4*)(p.ln1_g + j * 256 + lane * 4); b1[j] = *(const GAS f32x4*)(p.ln1_b + j * 256 + lane * 4); }
#pragma unroll
    for (int r = 0; r < R; ++r) {
        const int t = t0 + r;
        if (lane == 0) rowtok[slot0 + r] = t;
        float s = 0.f;
#pragma unroll
        for (int j = 0; j < 4; ++j) s += (v[r][j].x + v[r][j].y) + (v[r][j].z + v[r][j].w);
        const float mu = wave_sum(s) * (1.f / D); float s2 = 0.f;
#pragma unroll
        for (int j = 0; j < 4; ++j) { v[r][j] = v[r][j] - mu; s2 += (v[r][j].x * v[r][j].x + v[r][j].y * v[r][j].y) + (v[r][j].z * v[r][j].z + v[r][j].w * v[r][j].w); }
        const float rstd = rsqrtf(wave_sum(s2) * (1.f / D) + LN_EPS);
        f32x4 gl = (f32x4){0.f, 0.f, 0.f, 0.f};
#pragma unroll
        for (int j = 0; j < 4; ++j) { const f32x4 hv = v[r][j] * rstd * g1[j] + b1[j]; v[r][j] = hv;
            *(GAS unsigned long long*)(hb + (size_t)t * D + j * 256 + lane * 4) = (unsigned long long)pk2(hv.x, hv.y) | ((unsigned long long)pk2(hv.z, hv.w) << 32);
            gl += RG[(j * 4 + 0) * 64 + lane] * hv.x; gl += RG[(j * 4 + 1) * 64 + lane] * hv.y; gl += RG[(j * 4 + 2) * 64 + lane] * hv.z; gl += RG[(j * 4 + 3) * 64 + lane] * hv.w; }
        float glv[4];
#pragma unroll
        for (int e = 0; e < 4; ++e) glv[e] = wave_sum(gl[e]) + p.rg_b[e];
        int gi = 0; float gm = glv[0];
#pragma unroll
        for (int e = 1; e < 4; ++e) if (glv[e] > gm) { gm = glv[e]; gi = e; }
        gi = __builtin_amdgcn_readfirstlane(gi);
        float gden = 0.f;
#pragma unroll
        for (int e = 0; e < 4; ++e) gden += expf(glv[e] - gm);
        const float gval = 1.f / gden;
        const LAS f32x4* RE = RG + (1 + gi) * 1024;
        f32x4 el4 = (f32x4){0.f, 0.f, 0.f, 0.f};
#pragma unroll
        for (int j = 0; j < 4; ++j) { el4 += RE[(j * 4 + 0) * 64 + lane] * v[r][j].x; el4 += RE[(j * 4 + 1) * 64 + lane] * v[r][j].y; el4 += RE[(j * 4 + 2) * 64 + lane] * v[r][j].z; el4 += RE[(j * 4 + 3) * 64 + lane] * v[r][j].w; }
        float el[4];
#pragma unroll
        for (int e = 0; e < 4; ++e) el[e] = wave_sum(el4[e]) + p.re_b[gi * 4 + e];
        int i1 = 0;
#pragma unroll
        for (int e = 1; e < 4; ++e) if (el[e] > el[i1]) i1 = e;
        int i2 = -1;
#pragma unroll
        for (int e = 0; e < 4; ++e) if (e != i1 && (i2 < 0 || el[e] > el[i2])) i2 = e;
        const float e1v = i1 == 0 ? el[0] : i1 == 1 ? el[1] : i1 == 2 ? el[2] : el[3];
        const float e2v = i2 == 0 ? el[0] : i2 == 1 ? el[1] : i2 == 2 ? el[2] : el[3];
        const float p2 = expf(e2v - e1v); const float w1 = gval / (1.f + p2), w2 = gval * p2 / (1.f + p2);
        const int lo = i1 < i2 ? i1 : i2, hi = i1 < i2 ? i2 : i1; const float wlo = i1 < i2 ? w1 : w2, whi = i1 < i2 ? w2 : w1;
        const int pairidx = lo == 0 ? (hi - 1) : (lo == 1 ? (hi + 1) : 5);
        const int cls = gi * 6 + pairidx;
        if (lane == 0) {
            const unsigned lpos = __hip_atomic_fetch_add(lcnt + cls, 1u, __ATOMIC_RELAXED, __HIP_MEMORY_SCOPE_WORKGROUP);
            rowinfo[slot0 + r] = (f32x4){__int_as_float(cls), __int_as_float((int)lpos), wlo, whi};
        }
    }
}
__device__ __forceinline__ void ln1_commit(int tid, LAS unsigned* lcnt, LAS unsigned* gbase, const LAS f32x4* rowinfo, const LAS int* rowtok, int nrows, gu32* cnt, int* perm, float* tokinfo) {
    __syncthreads();
    if (tid < NCLS) { const unsigned n = lcnt[tid]; gbase[tid] = n ? __hip_atomic_fetch_add(cnt + 64 * tid, n, RLX_AGENT) : 0u; lcnt[tid] = 0u; }
    __syncthreads();
    if (tid < nrows) { const f32x4 ri = rowinfo[tid]; const int cls = __float_as_int(ri[0]); const int pos = __float_as_int(ri[1]) + (int)gbase[cls]; const int t = rowtok[tid];
        perm[(size_t)cls * T + pos] = t; *(GAS f32x4*)(tokinfo + (size_t)t * 4) = (f32x4){ri[0], __int_as_float(pos), ri[2], ri[3]}; }
}
__device__ __forceinline__ void ln2_row(const P& p, int t, int lane) {
    float* io = p.out;
    f32x4 v[4]; float s = 0.f;
#pragma unroll
    for (int j = 0; j < 4; ++j) { const unsigned long long hw = *(const GAS unsigned long long*)((const bf16_t*)(p.ws + WS_HB) + (size_t)t * D + j * 256 + lane * 4); const unsigned h0 = (unsigned)hw, h1 = (unsigned)(hw >> 32);
        const f32x4 hv = (f32x4){__uint_as_float(h0 << 16), __uint_as_float(h0 & 0xffff0000u), __uint_as_float(h1 << 16), __uint_as_float(h1 & 0xffff0000u)};
        const unsigned long long mv = *(const GAS unsigned long long*)((const bf16_t*)(p.ws + WS_FFN) + (size_t)t * D + j * 256 + lane * 4); const unsigned m0 = (unsigned)mv, m1 = (unsigned)(mv >> 32);
        v[j] = hv * ALPHA + (f32x4){__uint_as_float(m0 << 16), __uint_as_float(m0 & 0xffff0000u), __uint_as_float(m1 << 16), __uint_as_float(m1 & 0xffff0000u)};
        s += (v[j].x + v[j].y) + (v[j].z + v[j].w); }
    const float mu = wave_sum(s) * (1.f / D); float s2 = 0.f;
#pragma unroll
    for (int j = 0; j < 4; ++j) { v[j] = v[j] - mu; s2 += (v[j].x * v[j].x + v[j].y * v[j].y) + (v[j].z * v[j].z + v[j].w * v[j].w); }
    const float rstd = rsqrtf(wave_sum(s2) * (1.f / D) + LN_EPS);
#pragma unroll
    for (int j = 0; j < 4; ++j) { const int c = j * 256 + lane * 4; const f32x4 g2 = *(const GAS f32x4*)(p.ln2_g + c), b2 = *(const GAS f32x4*)(p.ln2_b + c);
        *(GAS f32x4*)(io + (size_t)t * D + c) = v[j] * rstd * g2 + b2; }
}

struct Args { P p; int ph_lo, ph_hi, li, pad; };
constexpr int N_PHASES = 2;
__global__ void __launch_bounds__(NWAVES * 64, 2) mega_fwd(Args args) {
    extern __shared__ __attribute__((aligned(16))) unsigned char lds[];
    Frame F;
    F.lds = (LAS unsigned char*)lds;
    F.MISC = (volatile LAS unsigned*)(F.lds + MISC_OFF);
    F.tid = threadIdx.x; F.lane = F.tid & 63; F.wave = __builtin_amdgcn_readfirstlane(F.tid >> 6);
    F.G = gridDim.x; { const int bx = blockIdx.x; F.vcu = (F.G % 8 == 0) ? (bx % 8) * (F.G / 8) + bx / 8 : bx; }
    const P& p = args.p;
    unsigned char* ws = p.ws;
    F.ctl = (gu32*)(ws + WS_CTL);
    for (int u = F.tid; u < (LDS_BYTES - LDSCTL_OFF) / 4; u += NWAVES * 64) ((LAS unsigned*)(F.lds + LDSCTL_OFF))[u] = 0u;
    __syncthreads();
    XcdBarrier bar = xcd_barrier_post((unsigned*)(F.ctl + CW_BAR) + args.li * XCD_BAR_WORDS, F.MISC + 8);
    const int lo = args.ph_lo, hi = args.ph_hi;
#ifndef PROBE_PH
#define PROBE_PH (-1)
#endif
#if PROBE_PH >= 0
    unsigned long long t_prev = __builtin_amdgcn_s_memrealtime(); unsigned long long t_sel = 0ull;
#define PSTAMP(k) do { const unsigned long long t_now = __builtin_amdgcn_s_memrealtime(); if ((k) == PROBE_PH) t_sel = t_now - t_prev; t_prev = t_now; } while (0)
#else
#define PSTAMP(k) do { } while (0)
#endif
#define IN(k) (lo <= (k) && (k) < hi)
#define BOTH(k) (IN(k) && IN((k) + 1))
#define GRID_BAR() xcd_barrier(bar)
    if (IN(0)) { p0_prologue(F, p); if (BOTH(0)) GRID_BAR(); PSTAMP(0); }
    if (IN(1)) {
        if (blockIdx.x < BATCH * NH) scanF_unit(F, p, blockIdx.x);
        pg8::PlainProb pr{(const bf16_t*)(ws + WS_XB), (const bf16_t*)(ws + WS_WIN), 1024, 1024, 16};
        pg8::StaticOrder S; S.init(T, 3072, F.G, (int)blockIdx.x);
        pg8::EpiInproj E{p.b_in, (bf16_t*)(ws + WS_Z), (bf16_t*)(ws + WS_XBC), (bf16_t*)(ws + WS_Q), (bf16_t*)(ws + WS_K), (bf16_t*)(ws + WS_V)};
        pg8::gemm_phase<pg8::PlainProb, pg8::StaticOrder, pg8::EpiInproj, true>(F.lds + RING_OFF, pr, S, E);
        if (BOTH(1)) GRID_BAR(); PSTAMP(1);
    }

    if (IN(2)) {
#pragma unroll 1
        for (int u = F.vcu; u < BATCH * ssd::NCH; u += F.G) { ssd::states_unit(F.lds + RING_OFF, (const bf16_t*)(ws + WS_XBC), p.conv_w, p.conv_b, (const float*)(ws + WS_DT), p.a_log, (bf16_t*)(ws + WS_S), (float*)(ws + WS_CDEC), u / ssd::NCH, u % ssd::NCH); }
        if (BOTH(2)) GRID_BAR(); PSTAMP(2);
    }
    if (IN(3)) {
#pragma unroll 1
        for (int u = F.vcu; u < BATCH * NH * 2; u += F.G) ssd::scan_unit((bf16_t*)(ws + WS_S), (const float*)(ws + WS_CDEC), u >> 1, u & 1);
        __syncthreads();
        const attn_body::AttnTensors AT{(const attn_body::bf16*)(ws + WS_Q), (const attn_body::bf16*)(ws + WS_K), (const attn_body::bf16*)(ws + WS_V), (const attn_body::bf16*)(ws + WS_KX), (attn_body::bf16*)(ws + WS_MERGED)};
        const attn_body::StaticOrder S((int)F.G, (int)blockIdx.x);
        attn_body::attn_phase<attn_body::StaticOrder>((char*)lds + RING_OFF, AT, S);
        if (BOTH(3)) GRID_BAR(); PSTAMP(3);
    }
    if (IN(4)) {
#pragma unroll 1
        for (int u = F.vcu; u < BATCH * ssd::NCH; u += F.G) ssd::out_unit(F.lds + RING_OFF, (const bf16_t*)(ws + WS_XBC), p.conv_w, p.conv_b, (const bf16_t*)(ws + WS_Z), (const float*)(ws + WS_DT), p.a_log, p.d_skip, p.ssd_norm_g,
                                                                          (const bf16_t*)(ws + WS_S), (bf16_t*)(ws + WS_MERGED), u / ssd::NCH, u % ssd::NCH);
        if (BOTH(4)) GRID_BAR(); PSTAMP(4);
    }
    if (IN(5)) {
        pg8::PlainProb pr{(const bf16_t*)(ws + WS_MERGED), (const bf16_t*)(ws + WS_WOUT), 1024, 1024, 16};
        pg8::StaticOrder S; S.init(T, 1024, F.G, (int)blockIdx.x);
        pg8::EpiOutproj E{(bf16_t*)(ws + WS_MIX)};
        pg8::gemm_phase<pg8::PlainProb, pg8::StaticOrder, pg8::EpiOutproj, true>(F.lds + RING_OFF, pr, S, E);
        if (BOTH(5)) GRID_BAR(); PSTAMP(5);
    }
    if (IN(6)) {
        const int gw = F.vcu * NWAVES + F.wave, NGW = F.G * NWAVES;
        LAS f32x4* RG = (LAS f32x4*)(F.lds + RING_OFF);
        LAS unsigned* lcnt = (LAS unsigned*)(F.lds + RING_OFF + 81920);
        LAS unsigned* gbase = lcnt + 32;
        LAS f32x4* rowinfo = (LAS f32x4*)(F.lds + RING_OFF + 81920 + 256);
        LAS int* rowtok = (LAS int*)(F.lds + RING_OFF + 81920 + 256 + 512);
        const int tid6 = tid_now();
        ln1_stage_weights(p, RG, tid6);
        if (tid6 < 32) lcnt[tid6] = 0u;
        __syncthreads();
        const int lane6 = lane_now();
#pragma unroll 1
        for (int bt = F.vcu; bt < T / 32; bt += F.G) {
            ln1_router_rows<4>(p, bt * 32 + F.wave * 4, lane6, RG, (bf16_t*)(ws + WS_HB), lcnt, rowinfo, rowtok, F.wave * 4);
            ln1_commit(tid6, lcnt, gbase, rowinfo, rowtok, 32, F.ctl + CW_CNT, (int*)(ws + WS_PERM), (float*)(ws + WS_TOK));
        }
        if (BOTH(6)) GRID_BAR(); PSTAMP(6);
    }
    if (IN(7) || IN(8)) {
        LAS int* gt = (LAS int*)(F.lds + TAB_OFF);
        { const int tg = tid_now(); if (tg < NCLS) gt[32 + tg] = (int)__hip_atomic_load(F.ctl + CW_CNT + 64 * tg, RLX_AGENT);
          __syncthreads();
          if (tg == 0) { int acc = 0; for (int c = 0; c < NCLS; ++c) { gt[c] = acc; acc += (gt[32 + c] + 255) >> 8; } gt[24] = acc; } }
        __syncthreads();
    }
    if (IN(7)) {
        const LAS int* gt = (const LAS int*)(F.lds + TAB_OFF);
        LAS unsigned* rofft = (LAS unsigned*)(F.lds + TAB_OFF + 256); LAS int* tokt = (LAS int*)(F.lds + TAB_OFF + 256 + 6144);
        pg8::MoeGeo geo{gt}; pg8::MoeOrder S{geo.np() * 8, 8, F.G, F.vcu};
        const int* perm = (const int*)(ws + WS_PERM);
        { const int tid7 = tid_now(); pg8::Unit u; for (int i = 0; S.next(i, u); ++i) if (tid7 < 256) { const int c = geo.cls_of(u.pm); const int pos = (u.pm - gt[c]) * 256 + tid7; const int tok = pos < gt[32 + c] ? perm[(size_t)c * T + pos] : -1;
            rofft[i * 256 + tid7] = (unsigned)(tok < 0 ? 0 : tok) * 2048u; tokt[i * 256 + tid7] = tok; } }
        __syncthreads();
        pg8::Moe1Prob pr{(const bf16_t*)(ws + WS_HB), (const bf16_t*)(ws + WS_WGU), geo, rofft, 1024, 1024, 16};
        pg8::EpiMoe1 E{(bf16_t*)(ws + WS_ACT), (const float*)(ws + WS_TOK), tokt};
        pg8::gemm_phase<pg8::Moe1Prob, pg8::MoeOrder, pg8::EpiMoe1, true>(F.lds + RING_OFF, pr, S, E);
        if (BOTH(7)) GRID_BAR(); PSTAMP(7);
    }
    if (IN(8)) {
        const LAS int* gt = (const LAS int*)(F.lds + TAB_OFF);
        LAS int* tokt = (LAS int*)(F.lds + TAB_OFF + 256 + 6144);
        pg8::MoeGeo geo{gt}; pg8::MoeOrder S{geo.np() * 4, 4, F.G, F.vcu};
        const int* perm = (const int*)(ws + WS_PERM);
        __syncthreads();
        { const int tid8 = tid_now(); pg8::Unit u; for (int i = 0; S.next(i, u); ++i) if (tid8 < 256) { const int c = geo.cls_of(u.pm); const int pos = (u.pm - gt[c]) * 256 + tid8; tokt[i * 256 + tid8] = pos < gt[32 + c] ? perm[(size_t)c * T + pos] : -1; } }
        __syncthreads();
        pg8::Moe2Prob pr{(const bf16_t*)(ws + WS_ACT), (const bf16_t*)(ws + WS_WD), geo, 1024, 512, 16};
        pg8::EpiMoe2 E{(bf16_t*)(ws + WS_FFN), tokt};
        pg8::gemm_phase<pg8::Moe2Prob, pg8::MoeOrder, pg8::EpiMoe2, true>(F.lds + RING_OFF, pr, S, E);
        if (BOTH(8)) GRID_BAR(); PSTAMP(8);
    }
    if (IN(9)) {
        const int gw = F.vcu * NWAVES + F.wave, NGW = F.G * NWAVES;
        const int lane9 = lane_now();
#pragma unroll 1
        for (int m = gw; m < T; m += NGW) ln2_row(p, m, lane9);
    }
    PSTAMP(9);
#if PROBE_PH >= 0
    if (blockIdx.x == 0) { const unsigned long long t_end = __builtin_amdgcn_s_memrealtime(); while (__builtin_amdgcn_s_memrealtime() - t_end < 7ull * t_sel) __builtin_amdgcn_s_sleep(8); }
#endif
#undef IN
#undef BOTH
#undef GRID_BAR
}

static void launch_mega(const P& p, int lo, int hi, int li, hipStream_t stream) {
    Args a{}; a.p = p; a.ph_lo = lo; a.ph_hi = hi; a.li = li; a.pad = 0;
    hipLaunchKernelGGL(mega_fwd, dim3(256), dim3(NWAVES * 64), LDS_BYTES, stream, a);
}

extern "C" void kernel_launch(void* const* d_in, const int* in_sizes, int n_in, void* d_out, int out_size, void* d_ws, size_t ws_size, hipStream_t stream) {
    static int inited = 0;
    if (!inited) { (void)hipFuncSetAttribute((const void*)mega_fwd, hipFuncAttributeMaxDynamicSharedMemorySize, LDS_BYTES); inited = 1; }
    P p{};
    const float** ins = (const float**)&p;
    for (int i = 0; i < 20; ++i) ins[i] = (const float*)d_in[i];
    p.out = (float*)d_out; p.ws = (unsigned char*)d_ws;
    unsigned char* ws = p.ws;
    (void)hipMemsetAsync(ws + WS_CTL, 0, CTL_ZERO_BYTES, stream);
    unsigned* cnt = (unsigned*)(ws + WS_CTL) + CW_CNT;
    float* dt = (float*)(ws + WS_DT); float* F = (float*)(ws + WS_F);
    int* perm = (int*)(ws + WS_PERM); float* tokinfo = (float*)(ws + WS_TOK);
    float* yraw = (float*)(ws + WS_YRAW); bf16_t* z = (bf16_t*)(ws + WS_Z); bf16_t* xbc = (bf16_t*)(ws + WS_XBC); bf16_t* merged = (bf16_t*)(ws + WS_MERGED);
    bf16_t *q = (bf16_t*)(ws + WS_Q), *k = (bf16_t*)(ws + WS_K), *v = (bf16_t*)(ws + WS_V), *act = (bf16_t*)(ws + WS_ACT);
    float* xconv = (float*)(ws + WS_XCONV); bf16_t* hb = (bf16_t*)(ws + WS_HB);

    launch_mega(p, 0, 10, 0, stream);
}
```

```cpp
#include <hip/hip_runtime.h>
#include <hip/hip_bf16.h>
#include <stdint.h>
#include <cstdio>

typedef unsigned short bf16_t;
__device__ __forceinline__ float bf2f(bf16_t v) { return __uint_as_float(((unsigned)v) << 16); }
__device__ __forceinline__ bf16_t f2bf(float f) { unsigned u = __float_as_uint(f); return (bf16_t)((u + 0x7fffu + ((u >> 16) & 1u)) >> 16); }

constexpr int BATCH = 16, SEQ = 2048, T = BATCH * SEQ, D = 1024;
constexpr int NPROJ = 3088;
constexpr int NH = 8, HD = 64, NG = 2, NS = 128;
constexpr int NCLS = 24;
constexpr float ALPHA = 1.189207115002721f;
constexpr float LN_EPS = 1e-5f, RMS_EPS = 1e-5f;
constexpr float LOG2E = 1.4426950408889634f;
constexpr float C2 = 0.125f * LOG2E;

constexpr size_t MiB = 1u << 20;
constexpr size_t WS_CTL = 0, CTL_ZERO_BYTES = 1 * MiB;
constexpr size_t WS_WIN = 1 * MiB;
constexpr size_t WS_WOUT = 7 * MiB;
constexpr size_t WS_WGU = 9 * MiB;
constexpr size_t WS_WD = 41 * MiB;
constexpr size_t WS_DT = 58 * MiB;
constexpr size_t WS_LOGF = 59 * MiB;
constexpr size_t WS_F = 60 * MiB;
constexpr size_t WS_PERM = 61 * MiB;
constexpr size_t WS_TOK = 64 * MiB;
constexpr size_t WS_KX = 65 * MiB;
constexpr size_t WS_XB = 72 * MiB;
constexpr size_t WS_S = 72 * MiB;
constexpr size_t WS_CDEC = 69 * MiB;
constexpr size_t WS_MIX = 72 * MiB;
constexpr size_t WS_FFN = 408 * MiB;
constexpr size_t WS_XCB = 328 * MiB;
constexpr size_t WS_YRAW = 72 * MiB;
constexpr size_t WS_Z = 136 * MiB;
constexpr size_t WS_XBC = 168 * MiB;
constexpr size_t WS_HB = 136 * MiB;
constexpr size_t WS_Q = 232 * MiB, WS_K = 264 * MiB, WS_V = 296 * MiB;
constexpr size_t WS_ACT = 232 * MiB;
constexpr size_t WS_XCONV = 328 * MiB;
constexpr size_t WS_MERGED = 408 * MiB;
constexpr int CW_CNT = 1024;
constexpr int CW_TMO = 64, CW_CODE = 65;
constexpr int CW_BAR = 4096;

struct P {
    const float *x, *w_in, *b_in, *conv_w, *conv_b, *a_log, *d_skip, *ssd_norm_g, *w_out, *ln1_g, *ln1_b,
        *rg_w, *rg_b, *re_w, *re_b, *w_gate, *w_up, *w_down, *ln2_g, *ln2_b;
    float* out; unsigned char* ws;
};

__device__ __forceinline__ float softplus_f(float x) { return fmaxf(x, 0.f) + log1pf(expf(-fabsf(x))); }
__device__ __forceinline__ float silu_f(float x) { return x / (1.f + expf(-x)); }

template <int NB, class AL, class BL, class EP>
__global__ __launch_bounds__(256) void ngemm(AL al, BL bl, EP ep, int K) {
    __shared__ float As[16][68];
    __shared__ float Bs[NB][16][68];
    const int tm = blockIdx.y * 64, tn = blockIdx.x * 64;
    if (!al.tile_ok(tm)) return;
    const int tx = threadIdx.x & 15, ty = threadIdx.x >> 4;
    float acc[NB][4][4];
#pragma unroll
    for (int b = 0; b < NB; ++b)
#pragma unroll
        for (int i = 0; i < 4; ++i)
#pragma unroll
            for (int j = 0; j < 4; ++j) acc[b][i][j] = 0.f;
    for (int k0 = 0; k0 < K; k0 += 16) {
#pragma unroll
        for (int i = 0; i < 4; ++i) { const int idx = threadIdx.x + i * 256; const int r = idx >> 4, kk = idx & 15; As[kk][r] = al(tm + r, k0 + kk); }
#pragma unroll
        for (int b = 0; b < NB; ++b)
#pragma unroll
            for (int i = 0; i < 4; ++i) { const int idx = threadIdx.x + i * 256; const int kk = idx >> 6, n = idx & 63; Bs[b][kk][n] = bl(b, tm, k0 + kk, tn + n); }
        __syncthreads();
#pragma unroll
        for (int kk = 0; kk < 16; ++kk) {
            float a[4];
#pragma unroll
            for (int i = 0; i < 4; ++i) a[i] = As[kk][ty * 4 + i];
#pragma unroll
            for (int b = 0; b < NB; ++b) {
                float bb[4];
#pragma unroll
                for (int j = 0; j < 4; ++j) bb[j] = Bs[b][kk][tx * 4 + j];
#pragma unroll
                for (int i = 0; i < 4; ++i)
#pragma unroll
                    for (int j = 0; j < 4; ++j) acc[b][i][j] += a[i] * bb[j];
            }
        }
        __syncthreads();
    }
#pragma unroll
    for (int i = 0; i < 4; ++i)
#pragma unroll
        for (int j = 0; j < 4; ++j) {
            if (NB == 1) ep(tm + ty * 4 + i, tn + tx * 4 + j, acc[0][i][j], 0.f);
            else ep(tm + ty * 4 + i, tn + tx * 4 + j, acc[0][i][j], acc[NB - 1][i][j]);
        }
}

struct AL_x { const float* x; __device__ bool tile_ok(int) const { return true; } __device__ float operator()(int r, int k) const { return x[(size_t)r * D + k]; } };
struct BL_win { const float* w; __device__ float operator()(int, int, int k, int n) const { return n < NPROJ ? w[(size_t)k * NPROJ + n] : 0.f; } };
struct EP_inproj {
    const float* b_in; bf16_t *z, *xbc, *q, *k, *v; float *dt, *logf;
    __device__ void operator()(int r, int c, float v0, float) const {
        if (c >= NPROJ) return;
        const float val = v0 + b_in[c];
        if (c < 512) z[(size_t)r * 512 + c] = f2bf(val);
        else if (c < 1536) xbc[(size_t)r * 1024 + (c - 512)] = f2bf(val);
        else if (c < 1544) dt[(size_t)r * 8 + (c - 1536)] = softplus_f(val);
        else if (c < 2056) q[(size_t)r * 512 + (c - 1544)] = f2bf(val * C2);
        else if (c < 2568) k[(size_t)r * 512 + (c - 2056)] = f2bf(val);
        else if (c < 3080) v[(size_t)r * 512 + (c - 2568)] = f2bf(val);
        else logf[(size_t)r * 8 + (c - 3080)] = -softplus_f(-val);
    }
};

__global__ void k_conv(const bf16_t* xbc, const float* conv_w, const float* conv_b, float* xconv) {
    const size_t idx = (size_t)blockIdx.x * 256 + threadIdx.x;
    const int c = (int)(idx & 1023); const int t = (int)(idx >> 10); const int s = t & (SEQ - 1);
    float acc = conv_b[c];
#pragma unroll
    for (int k = 0; k < 4; ++k) { const int ss = s - 3 + k; if (ss >= 0) acc += conv_w[k * 1024 + c] * bf2f(xbc[(size_t)(t - 3 + k) * 1024 + c]); }
    xconv[idx] = silu_f(acc);
}

__global__ __launch_bounds__(64) void k_ssd(const float* xconv, const float* dt, const float* a_log, const float* d_skip, float* yraw) {
    __shared__ float Bs[16][128], Cs[16][128];
    const int b = blockIdx.x >> 3, h = blockIdx.x & 7, g = h >> 2, p = threadIdx.x;
    const float a = -expf(a_log[h]), dsk = d_skip[h];
    float st[128];
#pragma unroll
    for (int n = 0; n < 128; ++n) st[n] = 0.f;
    for (int t0 = 0; t0 < SEQ; t0 += 16) {
        __syncthreads();
        for (int i = p; i < 16 * 128; i += 64) { const int tt = i >> 7, n = i & 127; const size_t row = (size_t)(b * SEQ + t0 + tt) * 1024;
            Bs[tt][n] = xconv[row + 512 + g * 128 + n]; Cs[tt][n] = xconv[row + 768 + g * 128 + n]; }
        __syncthreads();
        for (int tt = 0; tt < 16; ++tt) {
            const size_t tok = (size_t)(b * SEQ + t0 + tt);
            const float xs = xconv[tok * 1024 + h * 64 + p], dtv = dt[tok * 8 + h];
            const float dA = expf(dtv * a), xdt = xs * dtv;
            float y = 0.f;
#pragma unroll
            for (int n = 0; n < 128; ++n) { st[n] = st[n] * dA + xdt * Bs[tt][n]; y += Cs[tt][n] * st[n]; }
            yraw[tok * 512 + h * 64 + p] = y + dsk * xs;
        }
    }
}

__global__ __launch_bounds__(256) void k_gatenorm(const float* yraw, const bf16_t* z, const float* norm_g, bf16_t* merged) {
    const int w = blockIdx.x * 4 + (threadIdx.x >> 6), lane = threadIdx.x & 63;
    const int t = w >> 1, g = w & 1;
    float v[4]; float ss = 0.f;
#pragma unroll
    for (int j = 0; j < 4; ++j) { const int c = g * 256 + lane * 4 + j; const float y = yraw[(size_t)t * 512 + c] * silu_f(bf2f(z[(size_t)t * 512 + c])); v[j] = y; ss += y * y; }
#pragma unroll
    for (int o = 1; o < 64; o <<= 1) ss += __shfl_xor(ss, o);
    const float r = rsqrtf(ss * (1.f / 256.f) + RMS_EPS);
#pragma unroll
    for (int j = 0; j < 4; ++j) { const int c = g * 256 + lane * 4 + j; merged[(size_t)t * 1024 + c] = f2bf(v[j] * r * norm_g[c]); }
}

__global__ void k_scanF(const float* logf, float* F) {
    const int i = blockIdx.x * 64 + threadIdx.x; if (i >= BATCH * NH) return;
    const int b = i >> 3, h = i & 7; float s = 0.f;
    for (int t = 0; t < SEQ; ++t) { const size_t o = (size_t)(b * SEQ + t) * 8 + h; s += logf[o]; F[o] = s; }
}

__global__ __launch_bounds__(64) void k_attn(const bf16_t* Q, const bf16_t* K, const bf16_t* V, const float* F, bf16_t* merged) {
    const int bh = blockIdx.y, b = bh >> 3, h = bh & 7; const int t = blockIdx.x * 64 + threadIdx.x;
    const size_t row = (size_t)(b * SEQ + t);
    float q[64], o[64];
#pragma unroll
    for (int d = 0; d < 64; ++d) { q[d] = bf2f(Q[row * 512 + h * 64 + d]); o[d] = 0.f; }
    const float Ft = F[row * 8 + h];
    float m = -INFINITY, l = 0.f;
    const int smax = blockIdx.x * 64 + 63;
    for (int s = 0; s <= smax; ++s) {
        const size_t kr = (size_t)(b * SEQ + s);
        const bf16_t* kp = K + kr * 512 + h * 64; const bf16_t* vp = V + kr * 512 + h * 64;
        float dot = 0.f;
#pragma unroll
        for (int d = 0; d < 64; ++d) dot += q[d] * bf2f(kp[d]);
        const float logit = dot + (Ft - F[kr * 8 + h]) * LOG2E;
        if (s <= t) {
            const float mn = fmaxf(m, logit), corr = exp2f(m - mn), pp = exp2f(logit - mn);
            l = l * corr + pp;
#pragma unroll
            for (int d = 0; d < 64; ++d) o[d] = o[d] * corr + pp * bf2f(vp[d]);
            m = mn;
        }
    }
    const float rl = 1.f / l;
#pragma unroll
    for (int d = 0; d < 64; ++d) merged[row * 1024 + 512 + h * 64 + d] = f2bf(o[d] * rl);
}

struct AL_bf { const bf16_t* a; int lda; int pad; __device__ bool tile_ok(int) const { return true; } __device__ float operator()(int r, int k) const { return bf2f(a[(size_t)r * lda + k]); } };
struct BL_plain { const float* w; int ldb; int pad; __device__ float operator()(int, int, int k, int n) const { return w[(size_t)k * ldb + n]; } };
struct EP_outproj { const float* x; float* out; __device__ void operator()(int r, int c, float v, float) const { out[(size_t)r * D + c] = ALPHA * x[(size_t)r * D + c] + v; } };

__device__ __forceinline__ float wsum(float v) {
#pragma unroll
    for (int o = 1; o < 64; o <<= 1) v += __shfl_xor(v, o);
    return v;
}
__global__ __launch_bounds__(256) void k_ln1_router(float* hio, const float* g1, const float* b1, const float* rg_w, const float* rg_b, const float* re_w, const float* re_b,
                                                    bf16_t* hb, unsigned* cnt, int* perm, float* tokinfo) {
    const int t = blockIdx.x * 4 + (threadIdx.x >> 6), lane = threadIdx.x & 63;
    float v[16]; float s = 0.f;
#pragma unroll
    for (int j = 0; j < 4; ++j) { const float4 u = *(const float4*)(hio + (size_t)t * D + j * 256 + lane * 4); v[4 * j] = u.x; v[4 * j + 1] = u.y; v[4 * j + 2] = u.z; v[4 * j + 3] = u.w; s += (u.x + u.y) + (u.z + u.w); }
    const float mu = wsum(s) * (1.f / D); float s2 = 0.f;
#pragma unroll
    for (int i = 0; i < 16; ++i) { v[i] -= mu; s2 += v[i] * v[i]; }
    const float rstd = rsqrtf(wsum(s2) * (1.f / D) + LN_EPS);
    float gl[4] = {0.f, 0.f, 0.f, 0.f};
#pragma unroll
    for (int j = 0; j < 4; ++j)
#pragma unroll
        for (int i = 0; i < 4; ++i) { const int c = j * 256 + lane * 4 + i; const float hv = v[4 * j + i] * rstd * g1[c] + b1[c]; v[4 * j + i] = hv;
            hio[(size_t)t * D + c] = hv; hb[(size_t)t * D + c] = f2bf(hv);
#pragma unroll
            for (int e = 0; e < 4; ++e) gl[e] += hv * rg_w[c * 4 + e]; }
#pragma unroll
    for (int e = 0; e < 4; ++e) gl[e] = wsum(gl[e]) + rg_b[e];
    int gi = 0; float gm = gl[0];
#pragma unroll
    for (int e = 1; e < 4; ++e) if (gl[e] > gm) { gm = gl[e]; gi = e; }
    float gden = 0.f;
#pragma unroll
    for (int e = 0; e < 4; ++e) gden += expf(gl[e] - gm);
    const float gval = 1.f / gden;
    float el[4] = {0.f, 0.f, 0.f, 0.f};
#pragma unroll
    for (int j = 0; j < 4; ++j)
#pragma unroll
        for (int i = 0; i < 4; ++i) { const int c = j * 256 + lane * 4 + i;
#pragma unroll
            for (int e = 0; e < 4; ++e) el[e] += v[4 * j + i] * re_w[((size_t)gi * D + c) * 4 + e]; }
#pragma unroll
    for (int e = 0; e < 4; ++e) el[e] = wsum(el[e]) + re_b[gi * 4 + e];
    int i1 = 0;
#pragma unroll
    for (int e = 1; e < 4; ++e) if (el[e] > el[i1]) i1 = e;
    int i2 = -1;
#pragma unroll
    for (int e = 0; e < 4; ++e) if (e != i1 && (i2 < 0 || el[e] > el[i2])) i2 = e;
    const float mx = el[i1]; const float p2 = expf(el[i2] - mx); const float w1 = gval / (1.f + p2), w2 = gval * p2 / (1.f + p2);
    const int lo = i1 < i2 ? i1 : i2, hi = i1 < i2 ? i2 : i1; const float wlo = i1 < i2 ? w1 : w2, whi = i1 < i2 ? w2 : w1;
    const int pairidx = lo == 0 ? (hi - 1) : (lo == 1 ? (hi + 1) : 5);
    const int cls = gi * 6 + pairidx;
    if (lane == 0) {
        const unsigned pos = atomicAdd(&cnt[cls], 1u);
        perm[(size_t)cls * T + pos] = t;
        tokinfo[(size_t)t * 4 + 0] = __int_as_float(cls); tokinfo[(size_t)t * 4 + 1] = __int_as_float((int)pos); tokinfo[(size_t)t * 4 + 2] = wlo; tokinfo[(size_t)t * 4 + 3] = whi;
    }
}

struct ClsGeo { const unsigned* cnt;
    __device__ bool find(int row, int& cls, int& pos, int& n) const {
        int off = 0;
        for (int c = 0; c < NCLS; ++c) { const int nc = (int)cnt[c], pc = (nc + 255) & ~255; if (row < off + pc) { cls = c; pos = row - off; n = nc; return true; } off += pc; }
        return false;
    }
};
__device__ __forceinline__ void cls_experts(int cls, int& ea, int& eb) { const int g = cls / 6, pi = cls % 6; const int lo = pi < 3 ? 0 : (pi < 5 ? 1 : 2); const int hi = pi < 3 ? pi + 1 : (pi < 5 ? pi - 1 : 3); ea = g * 4 + lo; eb = g * 4 + hi; }

struct AL_moe1 { const bf16_t* hb; const int* perm; ClsGeo geo;
    __device__ bool tile_ok(int tm) const { int c, p, n; if (!geo.find(tm, c, p, n)) return false; return p < n; }
    __device__ float operator()(int r, int k) const { int c, p, n; if (!geo.find(r, c, p, n) || p >= n) return 0.f; const int tok = perm[(size_t)c * T + p]; return bf2f(hb[(size_t)tok * D + k]); } };
struct BL_moe1 { const float *wg, *wu; ClsGeo geo;
    __device__ float operator()(int b, int tm, int k, int n) const { int c, p, nn; geo.find(tm, c, p, nn); int ea, eb; cls_experts(c, ea, eb); const int e = n < 512 ? ea : eb; const int col = n & 511;
        const float* w = b == 0 ? wg : wu; return w[((size_t)e * D + k) * 512 + col]; } };
struct EP_moe1 { bf16_t* act; const int* perm; const float* tokinfo; ClsGeo geo;
    __device__ void operator()(int r, int c, float g, float u) const { int cl, p, n; float w = 0.f; if (geo.find(r, cl, p, n) && p < n) { const int tok = perm[(size_t)cl * T + p]; w = tokinfo[(size_t)tok * 4 + (c < 512 ? 2 : 3)]; }
        act[(size_t)r * 1024 + c] = f2bf(silu_f(g) * u * w); } };
struct AL_moe2 { const bf16_t* act; ClsGeo geo;
    __device__ bool tile_ok(int tm) const { int c, p, n; if (!geo.find(tm, c, p, n)) return false; return p < n; }
    __device__ float operator()(int r, int k) const { return bf2f(act[(size_t)r * 1024 + k]); } };
struct BL_moe2 { const float* wd; ClsGeo geo;
    __device__ float operator()(int, int tm, int k, int n) const { int c, p, nn; geo.find(tm, c, p, nn); int ea, eb; cls_experts(c, ea, eb); const int e = k < 512 ? ea : eb; return wd[((size_t)e * 512 + (k & 511)) * D + n]; } };
struct EP_moe2 { float* out; const int* perm; ClsGeo geo;
    __device__ void operator()(int r, int c, float v, float) const { int cl, p, n; if (!geo.find(r, cl, p, n) || p >= n) return; const int tok = perm[(size_t)cl * T + p]; float* o = out + (size_t)tok * D + c; *o = ALPHA * (*o) + v; } };

__global__ __launch_bounds__(256) void k_ln2(float* io, const float* g2, const float* b2) {
    const int t = blockIdx.x * 4 + (threadIdx.x >> 6), lane = threadIdx.x & 63;
    float v[16]; float s = 0.f;
#pragma unroll
    for (int j = 0; j < 4; ++j) { const float4 u = *(const float4*)(io + (size_t)t * D + j * 256 + lane * 4); v[4 * j] = u.x; v[4 * j + 1] = u.y; v[4 * j + 2] = u.z; v[4 * j + 3] = u.w; s += (u.x + u.y) + (u.z + u.w); }
    const float mu = wsum(s) * (1.f / D); float s2 = 0.f;
#pragma unroll
    for (int i = 0; i < 16; ++i) { v[i] -= mu; s2 += v[i] * v[i]; }
    const float rstd = rsqrtf(wsum(s2) * (1.f / D) + LN_EPS);
#pragma unroll
    for (int j = 0; j < 4; ++j) { float4 o; const int c = j * 256 + lane * 4;
        o.x = v[4 * j] * rstd * g2[c] + b2[c]; o.y = v[4 * j + 1] * rstd * g2[c + 1] + b2[c + 1]; o.z = v[4 * j + 2] * rstd * g2[c + 2] + b2[c + 2]; o.w = v[4 * j + 3] * rstd * g2[c + 3] + b2[c + 3];
        *(float4*)(io + (size_t)t * D + c) = o; }
}

namespace pg8 {
#define PG8_LAS __attribute__((address_space(3)))
typedef short bf16x8 __attribute__((ext_vector_type(8)));
typedef float f32x4 __attribute__((ext_vector_type(4)));
typedef float f32x2 __attribute__((ext_vector_type(2)));
typedef unsigned u32x4 __attribute__((ext_vector_type(4)));
typedef unsigned u32x2 __attribute__((ext_vector_type(2)));
constexpr int BM = 256, BK = 64, HALF = 128, HTB = HALF * BK * 2, STAGE_BYTES = 8 * HTB, NXCD = 8, WGM = 8;
__host__ __device__ __forceinline__ int lds_byte(int r, int c) { const int st = (r >> 4) * 2 + (c >> 5), rr = r & 15, cc = c & 31, ob = rr * 64 + cc * 2; return st * 1024 + (ob ^ (((ob >> 9) & 1) << 5)); }
__host__ __device__ __forceinline__ void stage_rc(int b, int& R, int& C) { const int st = b / 1024, sb = b % 1024, swz = sb ^ (((sb >> 9) & 1) << 5); R = (st >> 1) * 16 + swz / 64; C = (st & 1) * 32 + (swz % 64) / 2; }
__host__ __device__ __forceinline__ int perm32(int rho) { const int n = rho >> 4, i = rho & 15; return 8 * (i >> 2) + 4 * n + (i & 3); }
typedef float f32x2c __attribute__((ext_vector_type(2))); typedef __bf16 bf16x2c __attribute__((ext_vector_type(2)));
__device__ __forceinline__ unsigned cvt_pk_bf16(float lo, float hi) { f32x2c v = {lo, hi}; bf16x2c b = __builtin_convertvector(v, bf16x2c); return __builtin_bit_cast(unsigned, b); }

struct Unit { int pm, pn; };
struct StaticOrder {
    int nM, nN, nwg, G, c;
    __device__ void init(int M, int N, int G_, int c_) { nM = M / BM; nN = N / BM; nwg = nM * nN; G = G_; c = c_; }
    __device__ bool next(int i, Unit& u) const {
        const long L = (long)i * G + c; if (L >= nwg) return false;
        int wgid = (int)L; { const int q = nwg / NXCD, r = nwg % NXCD, xcd = wgid % NXCD, off = wgid / NXCD; wgid = (xcd < r ? xcd * (q + 1) : r * (q + 1) + (xcd - r) * q) + off; }
        const int nig = WGM * nN, gid = wgid / nig, fm = gid * WGM, gsz = (nM - fm) < WGM ? (nM - fm) : WGM;
        u.pm = fm + ((wgid % nig) % gsz); u.pn = (wgid % nig) / gsz; return true;
    }
};
struct PlainProb {
    static constexpr bool GATHER = false;
    const bf16_t* A; const bf16_t* Bt; int lda, ldb, nt;
    __device__ __forceinline__ const char* a_base(const Unit& u) const { return (const char*)(A + (size_t)u.pm * BM * lda); }
    __device__ __forceinline__ void b_base(const Unit& u, const char*& b0, const char*& b1) const { b0 = (const char*)(Bt + (size_t)u.pn * BM * ldb); b1 = b0; }
    __device__ __forceinline__ int ksplit() const { return nt; }
    __device__ __forceinline__ unsigned rowoff(int, int) const { return 0u; }
};

template <class PR, class Sched, class Epi, bool ALIGN_EPI>
__device__ __forceinline__ void gemm_phase(PG8_LAS unsigned char* lds, const PR& pr, const Sched& S, const Epi& E) {
    const int tid = threadIdx.x, wid = __builtin_amdgcn_readfirstlane(tid >> 6), lane = tid & 63, wr = wid >> 2, wc = wid & 3, fr = lane & 15, fq = lane >> 4;
    const int nt = pr.nt, ksp = pr.ksplit();
    unsigned voffA[2][2], nvA[2][2], voffB[2]; int RA[2], CA[2];
#pragma unroll
    for (int i = 0; i < 2; ++i) { int R, C; stage_rc(tid * 16 + i * 8192, R, C); const int Rb = Epi::PERM ? ((R & ~31) + perm32(R & 31)) : R;
        RA[i] = R; CA[i] = C; voffB[i] = (unsigned)(Rb * pr.ldb + C) * 2u; }
    const size_t kstep = (size_t)(BK * 2);
    const size_t hstepB = (size_t)HALF * pr.ldb * 2;
    const unsigned ldsw = (unsigned)wid * 1024u;
    const int aoff = lds_byte(wr * 64 + fr, fq * 8), boff = lds_byte(wc * 32 + fr, fq * 8);
#define PG8_SA(b, h) (((b) * 2 + (h)) * HTB)
#define PG8_SB(b, h) ((4 + (b) * 2 + (h)) * HTB)
#define PG8_STAGE(bufoff, gbase, voff) do { _Pragma("unroll") for (int _i = 0; _i < 2; ++_i) \
        __builtin_amdgcn_global_load_lds((const unsigned*)((const char*)(gbase) + (voff)[_i]), (PG8_LAS unsigned*)(lds + (bufoff) + ldsw + _i * 8192), 16, 0, 0); } while (0)
#define PG8_LDA(dst, b, h) do { _Pragma("unroll") for (int m = 0; m < 4; ++m) _Pragma("unroll") for (int k = 0; k < 2; ++k) dst[m][k] = *(const PG8_LAS bf16x8*)(lds + PG8_SA(b, h) + aoff + m * 2048 + k * 1024); } while (0)
#define PG8_LDB(dst, b, h) do { _Pragma("unroll") for (int n = 0; n < 2; ++n) _Pragma("unroll") for (int k = 0; k < 2; ++k) dst[n][k] = *(const PG8_LAS bf16x8*)(lds + PG8_SB(b, h) + boff + n * 2048 + k * 1024); } while (0)
#define PG8_MMA(ai, bj, At, Bt) do { __builtin_amdgcn_s_setprio(1); _Pragma("unroll") for (int m = 0; m < 4; ++m) _Pragma("unroll") for (int n = 0; n < 2; ++n) _Pragma("unroll") for (int k = 0; k < 2; ++k) \
        acc[ai][bj][m][n] = __builtin_amdgcn_mfma_f32_16x16x32_bf16(Bt[n][k], At[m][k], acc[ai][bj][m][n], 0, 0, 0); __builtin_amdgcn_s_setprio(0); } while (0)
#define PG8_WAIT_V(n) asm volatile("s_waitcnt vmcnt(" #n ")" ::: "memory")
#define PG8_WAIT_L(n) asm volatile("s_waitcnt lgkmcnt(" #n ")" ::: "memory")
#define PG8_BAR __builtin_amdgcn_s_barrier()
#define PG8_SCHED __builtin_amdgcn_sched_barrier(0)
#define PG8_SETVA(dst, slot) do { _Pragma("unroll") for (int _h = 0; _h < 2; ++_h) _Pragma("unroll") for (int _i = 0; _i < 2; ++_i) \
        dst[_h][_i] = PR::GATHER ? (pr.rowoff((slot), _h * HALF + RA[_i]) + (unsigned)CA[_i] * 2u) : (unsigned)((_h * HALF + RA[_i]) * pr.lda + CA[_i]) * 2u; } while (0)
    Unit cur, nxt; int ui = 0;
    if (!S.next(0, cur)) return;
    f32x4 acc[2][2][4][2];
#pragma unroll
    for (int a = 0; a < 2; ++a)
#pragma unroll
        for (int b = 0; b < 2; ++b)
#pragma unroll
            for (int m = 0; m < 4; ++m)
#pragma unroll
                for (int n = 0; n < 2; ++n) acc[a][b][m][n] = (f32x4){0.f, 0.f, 0.f, 0.f};
    bf16x8 At[4][2], B0[2][2], B1[2][2];
    PG8_SETVA(voffA, 0);
    const char* cA = pr.a_base(cur); const char *cB0, *cB1; pr.b_base(cur, cB0, cB1);
    PG8_STAGE(PG8_SB(0, 0), cB0, voffB); PG8_STAGE(PG8_SB(0, 1), cB0 + hstepB, voffB); PG8_STAGE(PG8_SA(0, 0), cA, voffA[0]); PG8_STAGE(PG8_SA(0, 1), cA, voffA[1]);
    if (wr == 1) PG8_BAR;
    PG8_WAIT_V(2); PG8_BAR;
    PG8_STAGE(PG8_SB(1, 0), cB0 + kstep, voffB); PG8_STAGE(PG8_SA(1, 0), cA + kstep, voffA[0]); PG8_STAGE(PG8_SB(1, 1), cB0 + hstepB + kstep, voffB);
    PG8_WAIT_V(6); PG8_BAR;
    for (;;) {
        const bool has_next = S.next(ui + 1, nxt);
        const char *nA = cA, *nB0 = cB0, *nB1 = cB1;
        if (has_next) { nA = pr.a_base(nxt); pr.b_base(nxt, nB0, nB1); }
        if (PR::GATHER) { if (has_next) { PG8_SETVA(nvA, ui + 1); } else {
#pragma unroll
            for (int h = 0; h < 2; ++h)
#pragma unroll
                for (int i = 0; i < 2; ++i) nvA[h][i] = voffA[h][i]; } }
        for (int t = 0; t < nt; t += 2) {
            const bool last = (t == nt - 2);
            const char* a1 = cA + (size_t)(t + 1) * kstep;
            const char* a2 = last ? nA : cA + (size_t)(t + 2) * kstep;
            const char* b2 = last ? nB0 : ((t + 2 < ksp) ? cB0 + (size_t)(t + 2) * kstep : cB1 + (size_t)(t + 2 - ksp) * kstep);
            const char* a3 = a2 + kstep; const char* b3 = b2 + kstep;
            unsigned va2[2][2];
#pragma unroll
            for (int h = 0; h < 2; ++h)
#pragma unroll
                for (int i = 0; i < 2; ++i) va2[h][i] = (PR::GATHER && last) ? nvA[h][i] : voffA[h][i];
            PG8_LDB(B0, 0, 0); PG8_LDB(B1, 0, 1); PG8_SCHED; PG8_LDA(At, 0, 0); PG8_STAGE(PG8_SA(1, 1), a1, voffA[1]);
            PG8_WAIT_V(8); PG8_WAIT_L(0); PG8_BAR; PG8_MMA(0, 0, At, B0); PG8_MMA(0, 1, At, B1); PG8_BAR; PG8_SCHED;
            PG8_LDA(At, 0, 1); PG8_STAGE(PG8_SB(0, 0), b2, voffB); PG8_STAGE(PG8_SB(0, 1), b2 + hstepB, voffB); PG8_STAGE(PG8_SA(0, 0), a2, va2[0]);
            PG8_WAIT_V(8); PG8_WAIT_L(0); PG8_BAR; PG8_MMA(1, 0, At, B0); PG8_MMA(1, 1, At, B1); PG8_BAR; PG8_SCHED;
            PG8_LDB(B0, 1, 0); PG8_LDB(B1, 1, 1); PG8_SCHED; PG8_LDA(At, 1, 0); PG8_STAGE(PG8_SA(0, 1), a2, va2[1]);
            PG8_WAIT_V(8); PG8_WAIT_L(0); PG8_BAR; PG8_MMA(0, 0, At, B0); PG8_MMA(0, 1, At, B1); PG8_BAR; PG8_SCHED;
            PG8_LDA(At, 1, 1); PG8_STAGE(PG8_SB(1, 0), b3, voffB); PG8_STAGE(PG8_SB(1, 1), b3 + hstepB, voffB); PG8_STAGE(PG8_SA(1, 0), a3, va2[0]);
            PG8_WAIT_V(8); PG8_WAIT_L(0); PG8_BAR; PG8_MMA(1, 0, At, B0); PG8_MMA(1, 1, At, B1); PG8_BAR; PG8_SCHED;
        }
        if constexpr (ALIGN_EPI) { if (wr == 0) PG8_BAR; }
        if constexpr (!Epi::AFTER_DRAIN) { E(acc, cur, ui, wr, wc, fr, fq); }
        if (!has_next) break;
#pragma unroll
        for (int a = 0; a < 2; ++a)
#pragma unroll
            for (int b = 0; b < 2; ++b)
#pragma unroll
                for (int m = 0; m < 4; ++m)
#pragma unroll
                    for (int n = 0; n < 2; ++n) acc[a][b][m][n] = (f32x4){0.f, 0.f, 0.f, 0.f};
        cur = nxt; cA = nA; cB0 = nB0; cB1 = nB1; ++ui;
        if (PR::GATHER) {
#pragma unroll
            for (int h = 0; h < 2; ++h)
#pragma unroll
                for (int i = 0; i < 2; ++i) voffA[h][i] = nvA[h][i]; }
        if constexpr (ALIGN_EPI) { if (wr == 1) PG8_BAR; }
    }
    PG8_WAIT_V(0);
    if constexpr (!ALIGN_EPI) { if (wr == 0) PG8_BAR; }
    PG8_BAR;
    if constexpr (Epi::AFTER_DRAIN) { E.fused(acc, cur, ui, wr, wc, fr, fq, lds, wid, lane); }
#undef PG8_SA
#undef PG8_SB
#undef PG8_STAGE
#undef PG8_LDA
#undef PG8_LDB
#undef PG8_MMA
#undef PG8_WAIT_V
#undef PG8_WAIT_L
#undef PG8_BAR
#undef PG8_SCHED
#undef PG8_SETVA
}

struct EpiInproj {
    static constexpr bool PERM = true, AFTER_DRAIN = false;
    const float* b_in; bf16_t *z, *xbc, *q, *k, *v;
    __device__ __forceinline__ void operator()(const f32x4 (&acc)[2][2][4][2], const Unit& u, int, int wr, int wc, int fr, int fq) const {
        const int pn = u.pn; bf16_t* base; int ldc, colt; float sc = 1.f;
        if (pn < 2) { base = z; ldc = 512; colt = pn * 256; }
        else if (pn < 6) { base = xbc; ldc = 1024; colt = (pn - 2) * 256; }
        else if (pn < 8) { base = q; ldc = 512; colt = (pn - 6) * 256; sc = C2; }
        else if (pn < 10) { base = k; ldc = 512; colt = (pn - 8) * 256; }
        else { base = v; ldc = 512; colt = (pn - 10) * 256; }
        const int row0 = u.pm * BM + wr * 64 + fr;
        const int col0 = colt + wc * 32 + 8 * fq, bcol0 = pn * BM + (pn >= 6 ? 8 : 0) + wc * 32 + 8 * fq;
        f32x4 bv[2][2];
#pragma unroll
        for (int bj = 0; bj < 2; ++bj)
#pragma unroll
            for (int n = 0; n < 2; ++n) bv[bj][n] = *(const f32x4*)(b_in + bcol0 + bj * HALF + 4 * n);
#pragma unroll
        for (int ai = 0; ai < 2; ++ai)
#pragma unroll
            for (int m = 0; m < 4; ++m) { bf16_t* rowp = base + (size_t)(row0 + ai * HALF + m * 16) * ldc + col0;
#pragma unroll
                for (int bj = 0; bj < 2; ++bj) { f32x4 v0 = (acc[ai][bj][m][0] + bv[bj][0]) * sc, v1 = (acc[ai][bj][m][1] + bv[bj][1]) * sc;
                    u32x4 w; w.x = cvt_pk_bf16(v0[0], v0[1]); w.y = cvt_pk_bf16(v0[2], v0[3]); w.z = cvt_pk_bf16(v1[0], v1[1]); w.w = cvt_pk_bf16(v1[2], v1[3]);
                    *(u32x4*)(rowp + bj * HALF) = w; } }
    }
};

struct EpiOutproj {
    static constexpr bool PERM = true, AFTER_DRAIN = false;
    bf16_t* mix;
    __device__ __forceinline__ void operator()(const f32x4 (&acc)[2][2][4][2], const Unit& u, int, int wr, int wc, int fr, int fq) const {
        const int col0 = u.pn * BM + wc * 32 + 8 * fq;
#pragma unroll
        for (int ai = 0; ai < 2; ++ai)
#pragma unroll
            for (int m = 0; m < 4; ++m) { bf16_t* rowp = mix + (size_t)(u.pm * BM + ai * HALF + wr * 64 + m * 16 + fr) * D + col0;
#pragma unroll
                for (int bj = 0; bj < 2; ++bj) { const f32x4 v0 = acc[ai][bj][m][0], v1 = acc[ai][bj][m][1];
                    u32x4 w; w.x = cvt_pk_bf16(v0[0], v0[1]); w.y = cvt_pk_bf16(v0[2], v0[3]); w.z = cvt_pk_bf16(v1[0], v1[1]); w.w = cvt_pk_bf16(v1[2], v1[3]);
                    *(u32x4*)(rowp + bj * HALF) = w; } }
    }
};

struct MoeGeo {
    const PG8_LAS int* tab;
    __device__ __forceinline__ int np() const { return tab[24]; }
    __device__ __forceinline__ int cls_of(int panel) const { int c = 0;
#pragma unroll 1
        for (int j = 1; j < 24; ++j) if (panel >= tab[j]) c = j;
        return c; }
};
struct MoeOrder {
    int total, npn, G, c;
    __device__ __forceinline__ bool next(int i, Unit& u) const { const int L = i * G + c; if (L >= total) return false; u.pm = L / npn; u.pn = L % npn; return true; }
};
struct Moe1Prob {
    static constexpr bool GATHER = true;
    const bf16_t* A; const bf16_t* Wgu; MoeGeo geo; const PG8_LAS unsigned* rofftab; int lda, ldb, nt;
    __device__ __forceinline__ const char* a_base(const Unit&) const { return (const char*)A; }
    __device__ __forceinline__ void b_base(const Unit& u, const char*& b0, const char*& b1) const { int ea, eb; cls_experts(geo.cls_of(u.pm), ea, eb); const int e = u.pn < 4 ? ea : eb;
        b0 = (const char*)(Wgu + (size_t)((e * 4 + (u.pn & 3)) * 256) * 1024); b1 = b0; }
    __device__ __forceinline__ int ksplit() const { return nt; }
    __device__ __forceinline__ unsigned rowoff(int slot, int r) const { return rofftab[slot * 256 + r]; }
};
__device__ __forceinline__ float silu_fast(float g) { return g * __builtin_amdgcn_rcpf(1.f + __builtin_amdgcn_exp2f(-g * LOG2E)); }
struct EpiMoe1 {
    static constexpr bool PERM = true, AFTER_DRAIN = false;
    bf16_t* act; const float* tokinfo; const PG8_LAS int* toktab;
    __device__ __forceinline__ void operator()(const f32x4 (&acc)[2][2][4][2], const Unit& u, int slot, int wr, int wc, int fr, int fq) const {
        const int ex = u.pn >> 2; const int col0 = ex * 512 + (u.pn & 3) * 128 + wc * 32 + 8 * fq;
#pragma unroll
        for (int ai = 0; ai < 2; ++ai)
#pragma unroll
            for (int m = 0; m < 4; ++m) { const int r = ai * HALF + wr * 64 + m * 16 + fr; const int tok = toktab[slot * 256 + r];
                const float w = tok >= 0 ? tokinfo[(size_t)tok * 4 + 2 + ex] : 0.f;
                const f32x4 g0 = acc[ai][0][m][0], g1 = acc[ai][0][m][1], u0 = acc[ai][1][m][0], u1 = acc[ai][1][m][1];
                float o[8];
#pragma unroll
                for (int j = 0; j < 4; ++j) { o[j] = silu_fast(g0[j]) * u0[j] * w; o[4 + j] = silu_fast(g1[j]) * u1[j] * w; }
                u32x4 wv; wv.x = cvt_pk_bf16(o[0], o[1]); wv.y = cvt_pk_bf16(o[2], o[3]); wv.z = cvt_pk_bf16(o[4], o[5]); wv.w = cvt_pk_bf16(o[6], o[7]);
                *(u32x4*)(act + (size_t)(u.pm * BM + r) * 1024 + col0) = wv; }
    }
};
struct Moe2Prob {
    static constexpr bool GATHER = false;
    const bf16_t* A; const bf16_t* Wd; MoeGeo geo; int lda, ldb, nt;
    __device__ __forceinline__ const char* a_base(const Unit& u) const { return (const char*)(A + (size_t)u.pm * BM * lda); }
    __device__ __forceinline__ void b_base(const Unit& u, const char*& b0, const char*& b1) const { int ea, eb; cls_experts(geo.cls_of(u.pm), ea, eb);
        b0 = (const char*)(Wd + ((size_t)ea * 1024 + u.pn * 256) * 512); b1 = (const char*)(Wd + ((size_t)eb * 1024 + u.pn * 256) * 512); }
    __device__ __forceinline__ int ksplit() const { return 8; }
    __device__ __forceinline__ unsigned rowoff(int, int) const { return 0u; }
};
struct EpiMoe2 {
    static constexpr bool PERM = true, AFTER_DRAIN = false;
    bf16_t* ffn; const PG8_LAS int* toktab;
    __device__ __forceinline__ void operator()(const f32x4 (&acc)[2][2][4][2], const Unit& u, int slot, int wr, int wc, int fr, int fq) const {
        const int col0 = u.pn * BM + wc * 32 + 8 * fq;
#pragma unroll
        for (int ai = 0; ai < 2; ++ai)
#pragma unroll
            for (int m = 0; m < 4; ++m) { const int r = ai * HALF + wr * 64 + m * 16 + fr; const int tok = toktab[slot * 256 + r];
                if (tok >= 0) { bf16_t* rowp = ffn + (size_t)tok * D + col0;
#pragma unroll
                    for (int bj = 0; bj < 2; ++bj) { const f32x4 v0 = acc[ai][bj][m][0], v1 = acc[ai][bj][m][1];
                        u32x4 w; w.x = cvt_pk_bf16(v0[0], v0[1]); w.y = cvt_pk_bf16(v0[2], v0[3]); w.z = cvt_pk_bf16(v1[0], v1[1]); w.w = cvt_pk_bf16(v1[2], v1[3]);
                        *(u32x4*)(rowp + bj * HALF) = w; } } }
    }
};
}

#include <cmath>
namespace attn_body {

using bf16=__hip_bfloat16;
#define ALAS __attribute__((address_space(3)))
using bf16x8=__attribute__((ext_vector_type(8)))short;
using s16x4=__attribute__((ext_vector_type(4)))short;
using f32x16=__attribute__((ext_vector_type(16)))float;
using u32x4=__attribute__((ext_vector_type(4)))unsigned;
constexpr int BATCH=16,NHEAD=8,SEQ=2048,D=64,DM=NHEAD*D,ODM=1024,OCOL=512;
constexpr int NW=8,QBLK=32,QB=QBLK*NW,KVBLK=64,NQB=SEQ/QB;
constexpr int ATTN_PITCH=DM, ATTN_UNIT_ROWS=QB;
__device__ __forceinline__ int crow(int r,int hi){return (r&3)+8*(r>>2)+4*hi;}
#define SBAR() __builtin_amdgcn_sched_barrier(0)
__device__ __forceinline__ void cmask(f32x16&p0,f32x16&p1,int jb,int qrel,int hi){
  const float NEG=-INFINITY; int kb=64*jb+4*hi;
  #pragma unroll
  for(int r=0;r<16;++r){int kv=kb+(r&3)+8*(r>>2); if(kv>qrel)p0[r]=NEG; if(kv+32>qrel)p1[r]=NEG;}
}

constexpr int NSLOT=3, SLOTB=9216, KXOFF=8192;
constexpr int LDS_K=0, LDS_V=NSLOT*SLOTB, LDS_WS=2*NSLOT*SLOTB, LDS_OST=LDS_WS+NW*64*4, LDS_BYTES=LDS_OST+NW*4096;
constexpr float C2=0.125f*1.4426950408889634f;
__device__ __forceinline__ void glds16(const void*gsrc,unsigned lds_dst){unsigned keep;
  asm volatile("s_mov_b32 %0, m0\n\ts_mov_b32 m0, %2\n\ts_nop 0\n\tglobal_load_lds_dwordx4 %1, off\n\ts_mov_b32 m0, %0":"=&s"(keep):"v"(gsrc),"s"(lds_dst):"memory");}
__device__ __forceinline__ void glds16s(const void*sbase,unsigned voff,unsigned lds_dst){unsigned keep;
  asm volatile("s_nop 4\n\ts_mov_b32 %0, m0\n\ts_mov_b32 m0, %3\n\ts_nop 0\n\tglobal_load_lds_dwordx4 %1, %2\n\ts_mov_b32 m0, %0":"=&s"(keep):"v"(voff),"s"(sbase),"s"(lds_dst):"memory");}
__device__ __forceinline__ const char* sptr(const void*p){ const unsigned long long v=(unsigned long long)p; const unsigned lo=__builtin_amdgcn_readfirstlane((unsigned)v), hi=__builtin_amdgcn_readfirstlane((unsigned)(v>>32)); return (const char*)(((unsigned long long)hi<<32)|lo); }
__device__ __forceinline__ float max3f(float a,float b,float c){float r;asm("v_max3_f32 %0, %1, %2, %3":"=v"(r):"v"(a),"v"(b),"v"(c));return r;}
__device__ __forceinline__ float max2f(float a,float b){float r;asm("v_max_f32_e32 %0, %1, %2":"=v"(r):"v"(a),"v"(b));return r;}
__device__ __forceinline__ float fadd_s(float a,float b){float r;asm("v_add_f32_e32 %0, %1, %2":"=v"(r):"v"(a),"v"(b));return r;}
__device__ __forceinline__ float fsub_s(float a,float b){float r;asm("v_sub_f32_e32 %0, %1, %2":"=v"(r):"v"(a),"v"(b));return r;}
typedef float f32x2_t __attribute__((ext_vector_type(2))); typedef __bf16 bf16x2_t __attribute__((ext_vector_type(2)));
__device__ __forceinline__ unsigned cvtpk_s(float lo,float hi){f32x2_t v={lo,hi};bf16x2_t b=__builtin_convertvector(v,bf16x2_t);return __builtin_bit_cast(unsigned,b);}
#define WAIT_BAR(N) asm volatile("s_waitcnt vmcnt(" #N ") lgkmcnt(0)\n\ts_barrier":::"memory")
#define WAIT_BARK(N,N0) do{ if(wid==0){WAIT_BAR(N0);} else {WAIT_BAR(N);} }while(0)

__device__ __forceinline__ void qkt(f32x16&p0,f32x16&p1,const char*Kslot,const bf16x8*qr,const bf16x8 qr4,int r32,int hi){ const f32x16 zc=f32x16{};
  const char*kb=Kslot+hi*1024+r32*16;
  #pragma unroll
  for(int d0=0;d0<4;++d0){
    const bf16x8 b0=*reinterpret_cast<const bf16x8*>(kb+d0*2048);
    const bf16x8 b1=*reinterpret_cast<const bf16x8*>(kb+d0*2048+512);
    if(d0==0){p0=__builtin_amdgcn_mfma_f32_32x32x16_bf16(b0,qr[0],zc,0,0,0);p1=__builtin_amdgcn_mfma_f32_32x32x16_bf16(b1,qr[0],zc,0,0,0);}
    else{p0=__builtin_amdgcn_mfma_f32_32x32x16_bf16(b0,qr[d0],p0,0,0,0);p1=__builtin_amdgcn_mfma_f32_32x32x16_bf16(b1,qr[d0],p1,0,0,0);}}
  { const bf16x8 x0=*reinterpret_cast<const bf16x8*>(Kslot+KXOFF+r32*16); const bf16x8 x1=*reinterpret_cast<const bf16x8*>(Kslot+KXOFF+r32*16+512);
    p0=__builtin_amdgcn_mfma_f32_32x32x16_bf16(x0,qr4,p0,0,0,0);p1=__builtin_amdgcn_mfma_f32_32x32x16_bf16(x1,qr4,p1,0,0,0); }
}
typedef __attribute__((address_space(3))) const char* lds_cptr;
typedef short v4i16_t __attribute__((ext_vector_type(4)));
__device__ __forceinline__ void kload8(bf16x8*kf,lds_cptr kp){
  kf[0]=*(const __attribute__((address_space(3))) bf16x8*)(kp);      kf[1]=*(const __attribute__((address_space(3))) bf16x8*)(kp+512);
  kf[2]=*(const __attribute__((address_space(3))) bf16x8*)(kp+2048); kf[3]=*(const __attribute__((address_space(3))) bf16x8*)(kp+2560);
  kf[4]=*(const __attribute__((address_space(3))) bf16x8*)(kp+4096); kf[5]=*(const __attribute__((address_space(3))) bf16x8*)(kp+4608);
  kf[6]=*(const __attribute__((address_space(3))) bf16x8*)(kp+6144); kf[7]=*(const __attribute__((address_space(3))) bf16x8*)(kp+6656);
}
__device__ __forceinline__ void kload2(bf16x8*kf,lds_cptr kp,int j){ kf[2*j]=*(const __attribute__((address_space(3))) bf16x8*)(kp+j*2048); kf[2*j+1]=*(const __attribute__((address_space(3))) bf16x8*)(kp+j*2048+512); }
__device__ __forceinline__ s16x4 vtr(lds_cptr p){ return __builtin_bit_cast(s16x4,__builtin_amdgcn_ds_read_tr16_b64_v4i16((__attribute__((address_space(3))) v4i16_t*)p)); }
__device__ __forceinline__ float rowmax(const f32x16&p0,const f32x16&p1){
  float a=max3f(p0[0],p0[1],p1[0]),b=max3f(p0[2],p0[3],p1[1]);a=max3f(a,p1[2],p1[3]);
  #pragma unroll
  for(int r=4;r<16;r+=4){a=max3f(a,p0[r],p0[r+1]);b=max3f(b,p0[r+2],p0[r+3]);a=max3f(a,p1[r],p1[r+1]);b=max3f(b,p1[r+2],p1[r+3]);}
  const float m=max2f(a,b);
  auto rr=__builtin_amdgcn_permlane32_swap(__float_as_uint(m),__float_as_uint(m),false,false);
  return max2f(__uint_as_float(rr[0]),__uint_as_float(rr[1]));
}
__device__ __forceinline__ void pv(f32x16*o,int vb,bf16x8 pa0,bf16x8 pa1,bf16x8 pa2,bf16x8 pa3){
  #pragma unroll
  for(int d0=0;d0<2;++d0){s16x4 lo[4],hi[4];
    #pragma unroll
    for(int ks=0;ks<4;++ks){
      asm volatile("ds_read_b64_tr_b16 %0,%1 offset:%c2":"=&v"(lo[ks]):"v"(vb),"i"(d0*4096+ks*1024):"memory");
      asm volatile("ds_read_b64_tr_b16 %0,%1 offset:%c2":"=&v"(hi[ks]):"v"(vb),"i"(d0*4096+ks*1024+512):"memory");}
    asm volatile("s_waitcnt lgkmcnt(0)":::"memory");SBAR();
    #define PK(k) (bf16x8){lo[k][0],lo[k][1],lo[k][2],lo[k][3],hi[k][0],hi[k][1],hi[k][2],hi[k][3]}
    o[d0]=__builtin_amdgcn_mfma_f32_32x32x16_bf16(pa0,PK(0),o[d0],0,0,0);
    o[d0]=__builtin_amdgcn_mfma_f32_32x32x16_bf16(pa1,PK(1),o[d0],0,0,0);
    o[d0]=__builtin_amdgcn_mfma_f32_32x32x16_bf16(pa2,PK(2),o[d0],0,0,0);
    o[d0]=__builtin_amdgcn_mfma_f32_32x32x16_bf16(pa3,PK(3),o[d0],0,0,0);
    #undef PK
  }
}

#ifndef ATTN_STORE16
#define ATTN_STORE16(p,v) (*(u32x4*)(p)=(v))
#endif
template<int THRL> __device__ __forceinline__ void attn_unit(int b,int h,int qb,const bf16*Q,const bf16*__restrict__ K,const bf16*__restrict__ V,const bf16*__restrict__ KX,bf16*O,char*shm){
  const int tid=threadIdx.x; int lane_o=tid&63; asm volatile("":"+v"(lane_o));
  const int lane=lane_o,r32=lane&31,hi=lane>>5; const int wid=__builtin_amdgcn_readfirstlane(tid>>6);
  const long rowbase=(long)b*SEQ; const int q0=qb*QB;
  const bf16*Qw=Q+(rowbase+q0+wid*QBLK)*DM+h*D;
  const bf16*Kh=K+rowbase*DM+h*D,*Vh=V+rowbase*DM+h*D;
  const unsigned lds0=(unsigned)(uintptr_t)shm;
  float*wsf=(float*)(shm+LDS_WS)+wid*64;
  const unsigned koff=(unsigned)(lane*DM*2+wid*16), voff=(unsigned)((16*(wid&3)+(lane>>2))*DM*2+(wid>>2)*64+(lane&3)*16), kxoff=(unsigned)(lane*NHEAD*16);
  const unsigned kdst=lds0+LDS_K+wid*1024, vdst=lds0+LDS_V+wid*1024, kxdst=lds0+LDS_K+KXOFF;
  const char*Kb=sptr(Kh), *Vb=sptr(Vh), *KXb=sptr(KX+(rowbase*NHEAD+h)*8);
  #define TILE(p) ((p)==0?NT-4:((p)<=3?NT-(p):NT-1-(p)))
  #define DMA_K(t,slot) do{ const long tl_=TILE(t); glds16s(Kb+tl_*(KVBLK*DM*2),koff,(unsigned)__builtin_amdgcn_readfirstlane(kdst+(slot))); if(wid==0) glds16s(KXb+tl_*(KVBLK*NHEAD*16),kxoff,(unsigned)__builtin_amdgcn_readfirstlane(kxdst+(slot))); }while(0)
  #define DMA_V(t,slot) do{ const long tl_=TILE(t); glds16s(Vb+tl_*(KVBLK*DM*2),voff,(unsigned)__builtin_amdgcn_readfirstlane(vdst+(slot))); }while(0)
  const int vb0=(int)(lds0+LDS_V)+((lane>>4)&1)*32+(lane&3)*8+(4*hi+((lane&15)>>2))*64;
  const char*Kbase=shm+LDS_K; bf16x8 kf[8]; bf16x8 kx0,kx1;
  const lds_cptr shm3=(lds_cptr)shm; const lds_cptr kxp0=shm3+LDS_K+KXOFF+r32*16; const lds_cptr kp0=shm3+LDS_K+hi*1024+r32*16; const lds_cptr vp0=shm3+LDS_V+((lane>>4)&1)*32+(lane&3)*8+(4*hi+((lane&15)>>2))*64;
  const int NT=(q0+QB)/KVBLK;
  DMA_K(0,0);DMA_V(0,0);DMA_K(1,SLOTB);
  bf16x8 qr[4]; u32x4 qr4w={0u,0u,0u,0u}; if(hi==0){qr4w[0]=0x3F803F80u;qr4w[1]=0x00003F80u;}
  #define QR4 __builtin_bit_cast(bf16x8,qr4w)
  #define SETM() do{ const float nm_=-mhat; const unsigned b0_=__float_as_uint(nm_)&0xffff0000u; const float r1_=nm_-__uint_as_float(b0_); const unsigned b1_=__float_as_uint(r1_)&0xffff0000u; const float r2_=r1_-__uint_as_float(b1_); const unsigned b2_=__float_as_uint(r2_)&0xffff0000u; \
    if(hi==0){ qr4w[1]=0x00003F80u|b0_; qr4w[2]=(b1_>>16)|b2_; } asm volatile("":"+v"(qr4w)); }while(0)
  #pragma unroll
  for(int d0=0;d0<4;++d0)qr[d0]=*reinterpret_cast<const bf16x8*>(&Qw[(long)r32*DM+d0*16+hi*8]);
  float mhat=0.f,l_reg=0.f;f32x16 o[2];o[0]=f32x16{};o[1]=f32x16{};const f32x16 zc16=f32x16{};
  const int qrel=wid*QBLK+r32;
  #define CMASK(P0,P1,t) do{int jb_=(t)==0?0:((t)<=3?4-(t):-1); if(jb_>=0)cmask(P0,P1,jb_,qrel,hi);}while(0)
  bool resc=false;
  #define START(P0,P1) do{ const float rm=rowmax(P0,P1); resc=false; \
    { const float dl=rm; mhat=fadd_s(mhat,dl); \
      _Pragma("unroll") for(int r=0;r<16;++r){P0[r]=fsub_s(P0[r],dl);P1[r]=fsub_s(P1[r],dl);} \
      SETM(); } \
    _Pragma("unroll") for(int r=0;r<16;++r)P0[r]=__builtin_amdgcn_exp2f(P0[r]); }while(0)
  #define RESC() do{ if(resc){ asm volatile("s_waitcnt lgkmcnt(0)":::"memory"); \
      _Pragma("unroll") for(int d_=0;d_<2;++d_) _Pragma("unroll") for(int r=0;r<16;++r)o[d_][r]*=wsf[crow(r,hi)]; } }while(0)
  f32x16 pA0,pA1,pB0,pB1;
  int sl_prev=0,sl_cur=0,sl_next=SLOTB;
  #define ROT() do{sl_prev=sl_cur;sl_cur=sl_next;sl_next=(sl_next==(NSLOT-1)*SLOTB)?0:sl_next+SLOTB;}while(0)
  DMA_K(2,2*SLOTB);
  WAIT_BARK(3,5);
  qkt(pA0,pA1,Kbase,qr,QR4,r32,hi);asm volatile("s_nop 15\n\ts_nop 7":"+v"(pA0),"+v"(pA1));CMASK(pA0,pA1,0);
  START(pA0,pA1);
  _Pragma("unroll") for(int r=0;r<16;++r)pA1[r]=__builtin_amdgcn_exp2f(pA1[r]);
  WAIT_BAR(0);
  DMA_K(3,0);DMA_V(1,SLOTB);
  ROT();
  kload8(kf,kp0+sl_cur); kx0=*(const ALAS bf16x8*)(kxp0+sl_cur); kx1=*(const ALAS bf16x8*)(kxp0+sl_cur+512);
  WAIT_BARK(2,3);
  s16x4 vlo[8],vhi[8]; u32x4 pw0,pw1,pw2,pw3;
  #define PKW(P,B) cvtpk_s(P[B],P[B+1])
  #define PAF(k) __builtin_bit_cast(bf16x8,pw##k)
  #define VFR(i) (bf16x8){vlo[i][0],vlo[i][1],vlo[i][2],vlo[i][3],vhi[i][0],vhi[i][1],vhi[i][2],vhi[i][3]}
  #define PIN(x) asm volatile("":"+v"(x))
  #define MX3(a,b,c) __builtin_fmaxf(__builtin_fmaxf((a),(b)),(c))
  #define GAPA(MF,A0,A1,A2,A3,W0,W1,PW) do{ MF; sacc+=A0; sacc+=A1; sacc+=A2; sacc+=A3; PIN(sacc); W0; W1; PIN(PW); SBAR(); }while(0)
  #define EX(v) __builtin_amdgcn_exp2f(v)
  #define GAPB(MF,X,B) do{ MF; X[B]=EX(X[B]); X[B+1]=EX(X[B+1]); X[B+2]=EX(X[B+2]); X[B+3]=EX(X[B+3]); PIN(X); SBAR(); }while(0)
  #define VRD(i) do{ vlo[i]=vtr(vp_+(((i)>>2)*4096+((i)&3)*1024)); vhi[i]=vtr(vp_+(((i)>>2)*4096+((i)&3)*1024+512)); }while(0)
  #define KRD(G,j) do{ if(G){ kload2(kf,kp0+sl_next,j); SBAR(); } }while(0)
  #define STEP(C0,C1,P0,P1,t,GK,GV,GL) do{ SBAR(); \
    const lds_cptr vp_=vp0+sl_prev; \
    VRD(0); SBAR(); float sacc=(P0[0]+P0[1]); \
    GAPA(C0=__builtin_amdgcn_mfma_f32_32x32x16_bf16(kf[0],qr[0],zc16,0,0,0), P0[2],P0[3],P0[4],P0[5],     pw0[0]=PKW(P0,0), pw0[1]=PKW(P0,2), pw0); \
    VRD(4); SBAR(); GAPA(C1=__builtin_amdgcn_mfma_f32_32x32x16_bf16(kf[1],qr[0],zc16,0,0,0), P0[6],P0[7],P0[8],P0[9],     pw0[2]=PKW(P0,4), pw0[3]=PKW(P0,6), pw0); \
    VRD(1); SBAR(); GAPA(C0=__builtin_amdgcn_mfma_f32_32x32x16_bf16(kf[2],qr[1],C0,0,0,0),   P0[10],P0[11],P0[12],P0[13], pw1[0]=PKW(P0,8), pw1[1]=PKW(P0,10), pw1); \
    VRD(5); SBAR(); GAPA(C1=__builtin_amdgcn_mfma_f32_32x32x16_bf16(kf[3],qr[1],C1,0,0,0),   P0[14],P0[15],P1[0],P1[1],   pw1[2]=PKW(P0,12),pw1[3]=PKW(P0,14), pw1); \
    VRD(2); SBAR(); GAPA(C0=__builtin_amdgcn_mfma_f32_32x32x16_bf16(kf[4],qr[2],C0,0,0,0),   P1[2],P1[3],P1[4],P1[5],     pw2[0]=PKW(P1,0), pw2[1]=PKW(P1,2), pw2); \
    VRD(6); SBAR(); GAPA(C1=__builtin_amdgcn_mfma_f32_32x32x16_bf16(kf[5],qr[2],C1,0,0,0),   P1[6],P1[7],P1[8],P1[9],     pw2[2]=PKW(P1,4), pw2[3]=PKW(P1,6), pw2); \
    VRD(3); SBAR(); GAPA(C0=__builtin_amdgcn_mfma_f32_32x32x16_bf16(kf[6],qr[3],C0,0,0,0),   P1[10],P1[11],P1[12],P1[13], pw3[0]=PKW(P1,8), pw3[1]=PKW(P1,10), pw3); \
    VRD(7); SBAR(); GAPA(C1=__builtin_amdgcn_mfma_f32_32x32x16_bf16(kf[7],qr[3],C1,0,0,0),   P1[14],P1[15],0.f,0.f,       pw3[2]=PKW(P1,12),pw3[3]=PKW(P1,14), pw3); \
    C0=__builtin_amdgcn_mfma_f32_32x32x16_bf16(kx0,QR4,C0,0,0,0); C1=__builtin_amdgcn_mfma_f32_32x32x16_bf16(kx1,QR4,C1,0,0,0); SBAR(); \
    l_reg+=sacc; \
    if(GK){DMA_K((t)+3,sl_cur);} if(GV){DMA_V((t)+1,sl_next);} \
    CMASK(C0,C1,t); \
    { float a=MX3(C0[0],C0[1],C1[0]),b=MX3(C0[2],C0[3],C1[1]); a=MX3(a,C1[2],C1[3]); \
      _Pragma("unroll") for(int r=4;r<16;r+=4){a=MX3(a,C0[r],C0[r+1]);b=MX3(b,C0[r+2],C0[r+3]);a=MX3(a,C1[r],C1[r+1]);b=MX3(b,C1[r+2],C1[r+3]);} \
      float rm=__builtin_fmaxf(a,b); { auto rr=__builtin_amdgcn_permlane32_swap(__float_as_uint(rm),__float_as_uint(rm),false,false); rm=__builtin_fmaxf(__uint_as_float(rr[0]),__uint_as_float(rr[1])); } \
      resc=false; \
      if(__builtin_expect(__any(rm>(float)THRL),0)){ const float dl=__builtin_fmaxf(rm,0.f); mhat+=dl; \
        _Pragma("unroll") for(int r=0;r<16;++r){C0[r]-=dl;C1[r]-=dl;} \
        SETM(); \
        const float f=__builtin_amdgcn_exp2f(-dl); l_reg*=f; if(hi==0)wsf[r32]=f; resc=true; } } \
    SBAR(); \
    GAPB(o[0]=__builtin_amdgcn_mfma_f32_32x32x16_bf16(PAF(0),VFR(0),o[0],0,0,0), C0,0); \
    GAPB(o[1]=__builtin_amdgcn_mfma_f32_32x32x16_bf16(PAF(0),VFR(4),o[1],0,0,0), C0,4); \
    KRD(GL,0); GAPB(o[0]=__builtin_amdgcn_mfma_f32_32x32x16_bf16(PAF(1),VFR(1),o[0],0,0,0), C0,8); \
    KRD(GL,1); GAPB(o[1]=__builtin_amdgcn_mfma_f32_32x32x16_bf16(PAF(1),VFR(5),o[1],0,0,0), C0,12); \
    KRD(GL,2); GAPB(o[0]=__builtin_amdgcn_mfma_f32_32x32x16_bf16(PAF(2),VFR(2),o[0],0,0,0), C1,0); \
    KRD(GL,3); GAPB(o[1]=__builtin_amdgcn_mfma_f32_32x32x16_bf16(PAF(2),VFR(6),o[1],0,0,0), C1,4); \
    if(GL){ kx0=*(const ALAS bf16x8*)(kxp0+sl_next); kx1=*(const ALAS bf16x8*)(kxp0+sl_next+512); SBAR(); } \
    GAPB(o[0]=__builtin_amdgcn_mfma_f32_32x32x16_bf16(PAF(3),VFR(3),o[0],0,0,0), C1,8); \
    GAPB(o[1]=__builtin_amdgcn_mfma_f32_32x32x16_bf16(PAF(3),VFR(7),o[1],0,0,0), C1,12); \
    }while(0)
  #define ENDW(tt) do{ if((tt)+3<NT){WAIT_BARK(2,3);} else if((tt)+2<NT){WAIT_BAR(1);} else {WAIT_BAR(0);} }while(0)
  int t=1;
  for(;t<5&&t+1<NT;t+=2){
    STEP(pB0,pB1,pA0,pA1,t,(t+3<NT),(t+1<NT),(t+1<NT));       ENDW(t);   RESC(); ROT();
    STEP(pA0,pA1,pB0,pB1,t+1,(t+4<NT),(t+2<NT),(t+2<NT));     ENDW(t+1); RESC(); ROT();
  }
  #undef CMASK
  #define CMASK(P0,P1,t) do{}while(0)
  for(;t+5<NT;t+=2){
    STEP(pB0,pB1,pA0,pA1,t,true,true,true);     WAIT_BARK(2,3); RESC(); ROT();
    STEP(pA0,pA1,pB0,pB1,t+1,true,true,true);   WAIT_BARK(2,3); RESC(); ROT();
  }
  for(;t+1<NT;t+=2){
    STEP(pB0,pB1,pA0,pA1,t,(t+3<NT),(t+1<NT),(t+1<NT));       ENDW(t);   RESC(); ROT();
    STEP(pA0,pA1,pB0,pB1,t+1,(t+4<NT),(t+2<NT),(t+2<NT));     ENDW(t+1); RESC(); ROT();
  }
  #undef CMASK
  #define CMASK(P0,P1,t) do{int jb_=(t)==0?0:((t)<=3?4-(t):-1); if(jb_>=0)cmask(P0,P1,jb_,qrel,hi);}while(0)
  STEP(pB0,pB1,pA0,pA1,NT-1,false,false,false); RESC();
  { float sacc=pB0[0]+pB0[1]; _Pragma("unroll") for(int r=2;r<16;++r)sacc+=pB0[r]; _Pragma("unroll") for(int r=0;r<16;++r)sacc+=pB1[r]; l_reg+=sacc;
    pw0=(u32x4){PKW(pB0,0),PKW(pB0,2),PKW(pB0,4),PKW(pB0,6)};pw1=(u32x4){PKW(pB0,8),PKW(pB0,10),PKW(pB0,12),PKW(pB0,14)};pw2=(u32x4){PKW(pB1,0),PKW(pB1,2),PKW(pB1,4),PKW(pB1,6)};pw3=(u32x4){PKW(pB1,8),PKW(pB1,10),PKW(pB1,12),PKW(pB1,14)};
    SBAR(); pv(o,vb0+sl_cur,PAF(0),PAF(1),PAF(2),PAF(3)); }
  #undef PKW
  #undef PAF
  #undef VFR
  #undef PIN
  #undef MX3
  #undef GAPA
  #undef GAPB
  #undef EX
  #undef VRD
  #undef KRD
  #undef STEP
  #undef ENDW
  {auto rr=__builtin_amdgcn_permlane32_swap(__float_as_uint(l_reg),__float_as_uint(l_reg),false,false);l_reg=__uint_as_float(rr[0])+__uint_as_float(rr[1]);}
  if(hi==0)wsf[32+r32]=l_reg;asm volatile("s_waitcnt lgkmcnt(0)":::"memory");
  int hi_e=hi; asm volatile("":"+v"(hi_e));
  float rli[16];
  #pragma unroll
  for(int r=0;r<16;++r)rli[r]=__builtin_amdgcn_rcpf(wsf[32+crow(r,hi_e)]);
  bf16*Ow=O+(rowbase+q0+wid*QBLK)*ODM+OCOL+h*D;
  { bf16*stg=(bf16*)(shm+LDS_OST)+wid*2048;
    #pragma unroll
    for(int r=0;r<16;++r){const int orow=crow(r,hi_e);
      #pragma unroll
      for(int d0=0;d0<2;++d0)stg[orow*64+d0*32+r32]=__float2bfloat16(o[d0][r]*rli[r]);}
    asm volatile("s_waitcnt lgkmcnt(0)":::"memory");
    #pragma unroll
    for(int i=0;i<4;++i){const int row=i*8+(lane>>3),ch=lane&7; const u32x4 v=*(const u32x4*)(stg+row*64+ch*8); ATTN_STORE16(Ow+(long)row*ODM+ch*8,v);} }
  asm volatile("s_waitcnt lgkmcnt(0)\n\ts_barrier":::"memory");
  #undef DMA_K
  #undef TILE
  #undef DMA_V
  #undef CMASK
  #undef START
  #undef RESC
  #undef ROT
}
constexpr int ATTN_LDS_BYTES=LDS_BYTES;
struct AttnTensors { const bf16* Q; const bf16* K; const bf16* V; const bf16* KX; bf16* O; };
struct AttnUnit { int bh; int qb; };
struct StaticOrder {
  int vcu;
  __device__ __forceinline__ explicit StaticOrder(int grid,int block):vcu((block%8)*(grid/8)+block/8){}
  __device__ __forceinline__ bool next(int i,AttnUnit&u)const{ if(i>=4)return false; const int s=vcu&1; u.bh=vcu>>1; u.qb=(i==0)?(7-s):(i==1)?s:(i==2)?(5-s):(2+s); return true; }
  __device__ __forceinline__ void a_ready(const AttnUnit&)const{}
  __device__ __forceinline__ void done(const AttnUnit&)const{}
};
template<class Sched,int THRL=8> __device__ __forceinline__ void attn_phase(char*lds,const AttnTensors&T,const Sched&S){
  AttnUnit u;
  for(int i=0;S.next(i,u);++i){ S.a_ready(u); attn_unit<THRL>(u.bh/NHEAD,u.bh%NHEAD,u.qb,T.Q,T.K,T.V,T.KX,T.O,lds); S.done(u); }
}
#undef SBAR
#undef WAIT_BAR
}

namespace ssd {
typedef short bf16x8 __attribute__((ext_vector_type(8)));
typedef float f32x4 __attribute__((ext_vector_type(4)));
typedef unsigned u32x4 __attribute__((ext_vector_type(4)));
typedef unsigned u32x2 __attribute__((ext_vector_type(2)));
#define SLAS __attribute__((address_space(3)))
constexpr int LPB = 144;
constexpr int NPB = 272;
constexpr int NCH = SEQ / 64;
typedef float f32x2_t __attribute__((ext_vector_type(2))); typedef __bf16 bf16x2_t __attribute__((ext_vector_type(2)));
__device__ __forceinline__ unsigned pkbf(float lo, float hi) { f32x2_t v = {lo, hi}; bf16x2_t b = __builtin_convertvector(v, bf16x2_t); return __builtin_bit_cast(unsigned, b); }

__device__ __forceinline__ float chunk_acum(const float* dt, const float* a_log, int tok0, int h, int lane, float& dtv) {
    dtv = dt[(size_t)(tok0 + lane) * 8 + h];
    float A = dtv * (-expf(a_log[h]));
#pragma unroll
    for (int o = 1; o < 64; o <<= 1) { const float y = __shfl_up(A, o); if (lane >= o) A += y; }
    return A;
}


__device__ __forceinline__ void conv_chunk(const bf16_t* xbc, const float* cw, const float* cb, bf16_t* xcb, int b, int c) {
    const int tid = threadIdx.x, cg = tid & 127, rq = tid >> 7, ch0 = cg * 8, l0 = rq * 16;
    const size_t tok0 = (size_t)b * SEQ + c * 64;
    float w[4][8], bias[8];
#pragma unroll
    for (int k = 0; k < 4; ++k) { const f32x4 a = *(const f32x4*)(cw + k * 1024 + ch0), bq = *(const f32x4*)(cw + k * 1024 + ch0 + 4);
        w[k][0] = a[0]; w[k][1] = a[1]; w[k][2] = a[2]; w[k][3] = a[3]; w[k][4] = bq[0]; w[k][5] = bq[1]; w[k][6] = bq[2]; w[k][7] = bq[3]; }
    { const f32x4 a = *(const f32x4*)(cb + ch0), bq = *(const f32x4*)(cb + ch0 + 4); bias[0] = a[0]; bias[1] = a[1]; bias[2] = a[2]; bias[3] = a[3]; bias[4] = bq[0]; bias[5] = bq[1]; bias[6] = bq[2]; bias[7] = bq[3]; }
    float win[3][8];
#pragma unroll
    for (int k = 0; k < 3; ++k) { const int l = l0 - 3 + k; u32x4 v = (u32x4){0u, 0u, 0u, 0u};
        if (c * 64 + l >= 0) v = *(const u32x4*)(xbc + (tok0 + l) * 1024 + ch0);
#pragma unroll
        for (int j = 0; j < 4; ++j) { win[k][2 * j] = __uint_as_float(v[j] << 16); win[k][2 * j + 1] = __uint_as_float(v[j] & 0xffff0000u); } }
#pragma unroll
    for (int i = 0; i < 16; ++i) {
        const u32x4 v = *(const u32x4*)(xbc + (tok0 + l0 + i) * 1024 + ch0);
        float cur[8], o[8];
#pragma unroll
        for (int j = 0; j < 4; ++j) { cur[2 * j] = __uint_as_float(v[j] << 16); cur[2 * j + 1] = __uint_as_float(v[j] & 0xffff0000u); }
#pragma unroll
        for (int j = 0; j < 8; ++j) { const float a = bias[j] + w[0][j] * win[0][j] + w[1][j] * win[1][j] + w[2][j] * win[2][j] + w[3][j] * cur[j]; o[j] = a / (1.f + expf(-a)); }
        *(u32x4*)(xcb + (tok0 + l0 + i) * 1024 + ch0) = (u32x4){pkbf(o[0], o[1]), pkbf(o[2], o[3]), pkbf(o[4], o[5]), pkbf(o[6], o[7])};
#pragma unroll
        for (int j = 0; j < 8; ++j) { win[0][j] = win[1][j]; win[1][j] = win[2][j]; win[2][j] = cur[j]; }
    }
}


struct Conv8 {
    float w[4][8], bias[8]; u32x4 raw[11];
    __device__ __forceinline__ void load(const bf16_t* xbc, const float* cw, const float* cb, size_t tok0, int c, int col, int l0) {
#pragma unroll
        for (int k = 0; k < 4; ++k) { const f32x4 a = *(const f32x4*)(cw + k * 1024 + col), bq = *(const f32x4*)(cw + k * 1024 + col + 4);
            w[k][0] = a[0]; w[k][1] = a[1]; w[k][2] = a[2]; w[k][3] = a[3]; w[k][4] = bq[0]; w[k][5] = bq[1]; w[k][6] = bq[2]; w[k][7] = bq[3]; }
        { const f32x4 a = *(const f32x4*)(cb + col), bq = *(const f32x4*)(cb + col + 4); bias[0] = a[0]; bias[1] = a[1]; bias[2] = a[2]; bias[3] = a[3]; bias[4] = bq[0]; bias[5] = bq[1]; bias[6] = bq[2]; bias[7] = bq[3]; }
#pragma unroll
        for (int k = 0; k < 11; ++k) { const int l = l0 - 3 + k; raw[k] = (u32x4){0u, 0u, 0u, 0u}; if (c * 64 + l >= 0) raw[k] = *(const u32x4*)(xbc + (tok0 + l) * 1024 + col); }
    }
    __device__ __forceinline__ float val(int i, int j) const { float a = bias[j];
#pragma unroll
        for (int k = 0; k < 4; ++k) { const unsigned wv = raw[i + k][j >> 1]; a += w[k][j] * ((j & 1) ? __uint_as_float(wv & 0xffff0000u) : __uint_as_float(wv << 16)); }
        return a * __builtin_amdgcn_rcpf(1.f + __builtin_amdgcn_exp2f(-a * LOG2E)); }
};

__device__ __forceinline__ void states_unit(SLAS unsigned char* lds, const bf16_t* xbc, const float* cw, const float* cb, const float* dt, const float* a_log, bf16_t* S, float* cdec, int b, int c) {
    const int tid = threadIdx.x, lane = tid & 63, w = __builtin_amdgcn_readfirstlane(tid >> 6), r = lane & 15, q = lane >> 4;
    const int tok0 = b * SEQ + c * 64;
    SLAS float* warr = (SLAS float*)lds;
    SLAS unsigned char* BT = lds + 2048;
    SLAS unsigned char* XW = lds + 2048 + 128 * LPB;
    { float dtv; const float A = chunk_acum(dt, a_log, tok0, w, lane, dtv); const float A63 = __shfl(A, 63);
      warr[w * 64 + lane] = dtv * expf(A63 - A);
      if (lane == 63) cdec[(size_t)(b * NCH + c) * 8 + w] = expf(A63); }
    __syncthreads();
#pragma unroll 1
    for (int g = 0; g < 2; ++g) {
        if (lane < 48) {
            const bool isx = lane < 32; const int col = isx ? g * 256 + lane * 8 : 512 + g * 128 + (lane - 32) * 8; const int l0 = 8 * w;
            Conv8 cv; cv.load(xbc, cw, cb, (size_t)tok0, c, col, l0);
            float sc[8];
#pragma unroll
            for (int i = 0; i < 8; ++i) sc[i] = isx ? warr[(g * 4 + (lane >> 3)) * 64 + l0 + i] : 1.f;
            SLAS unsigned char* dstb = isx ? (XW + (lane * 8) * LPB) : (BT + ((lane - 32) * 8) * LPB);
#pragma unroll
            for (int j = 0; j < 8; ++j) { float o[8];
#pragma unroll
                for (int i = 0; i < 8; ++i) o[i] = cv.val(i, j) * sc[i];
                *(SLAS u32x4*)(dstb + j * LPB + l0 * 2) = (u32x4){pkbf(o[0], o[1]), pkbf(o[2], o[3]), pkbf(o[4], o[5]), pkbf(o[6], o[7])}; }
        }
        __syncthreads();
        f32x4 acc[8][2];
#pragma unroll
        for (int nt = 0; nt < 8; ++nt) { acc[nt][0] = (f32x4){0.f, 0.f, 0.f, 0.f}; acc[nt][1] = (f32x4){0.f, 0.f, 0.f, 0.f}; }
#pragma unroll
        for (int k = 0; k < 2; ++k) {
            bf16x8 xf[2];
#pragma unroll
            for (int ht = 0; ht < 2; ++ht) xf[ht] = *(const SLAS bf16x8*)(XW + (32 * w + 16 * ht + r) * LPB + (32 * k + 8 * q) * 2);
#pragma unroll
            for (int nt = 0; nt < 8; ++nt) { const bf16x8 bf = *(const SLAS bf16x8*)(BT + (16 * nt + r) * LPB + (32 * k + 8 * q) * 2);
#pragma unroll
                for (int ht = 0; ht < 2; ++ht) acc[nt][ht] = __builtin_amdgcn_mfma_f32_16x16x32_bf16(bf, xf[ht], acc[nt][ht], 0, 0, 0); }
        }
        const int h = g * 4 + (w >> 1);
#pragma unroll
        for (int ht = 0; ht < 2; ++ht) { const int p = (w & 1) * 32 + 16 * ht + r; bf16_t* dst = S + ((size_t)((b * NCH + c) * 8 + h) * 64 + p) * 128 + 4 * q;
#pragma unroll
            for (int nt = 0; nt < 8; ++nt) *(u32x2*)(dst + 16 * nt) = (u32x2){pkbf(acc[nt][ht][0], acc[nt][ht][1]), pkbf(acc[nt][ht][2], acc[nt][ht][3])}; }
        __syncthreads();
    }
}

__device__ __forceinline__ void scan_unit(bf16_t* S, const float* cdec, int bh, int half) {
    const int tid = threadIdx.x, b = bh >> 3, h = bh & 7;
    const size_t e0 = (size_t)(half * 512 + tid) * 8;
    float st[8];
#pragma unroll
    for (int i = 0; i < 8; ++i) st[i] = 0.f;
#pragma unroll 1
    for (int c0 = 0; c0 < NCH; c0 += 8) {
        u32x4 v[8];
#pragma unroll
        for (int j = 0; j < 8; ++j) v[j] = *(const u32x4*)(S + (size_t)((b * NCH + c0 + j) * 8 + h) * 8192 + e0);
#pragma unroll
        for (int j = 0; j < 8; ++j) {
            *(u32x4*)(S + (size_t)((b * NCH + c0 + j) * 8 + h) * 8192 + e0) = (u32x4){pkbf(st[0], st[1]), pkbf(st[2], st[3]), pkbf(st[4], st[5]), pkbf(st[6], st[7])};
            const float d = cdec[(size_t)(b * NCH + c0 + j) * 8 + h];
#pragma unroll
            for (int i = 0; i < 4; ++i) { const unsigned wv = v[j][i]; st[2 * i] = st[2 * i] * d + __uint_as_float(wv << 16); st[2 * i + 1] = st[2 * i + 1] * d + __uint_as_float(wv & 0xffff0000u); }
        }
    }
}

__device__ __forceinline__ void out_unit(SLAS unsigned char* lds, const bf16_t* xbc, const float* cw, const float* cb, const bf16_t* z, const float* dt, const float* a_log, const float* d_skip, const float* norm_g,
                                         const bf16_t* Sin, bf16_t* merged, int b, int c) {
    const int tid = threadIdx.x, lane = tid & 63, w = __builtin_amdgcn_readfirstlane(tid >> 6), r = lane & 15, q = lane >> 4;
    const int tok0 = b * SEQ + c * 64;
    SLAS float* Aarr = (SLAS float*)lds;
    SLAS float* dtarr = (SLAS float*)(lds + 2048);
    SLAS float* npart = (SLAS float*)(lds + 4096);
    SLAS unsigned char* Cg = lds + 6144;
    SLAS unsigned char* Bg = Cg + 64 * NPB;
    SLAS unsigned char* XT = Bg + 64 * NPB;
    SLAS unsigned char* Mm = XT + 256 * LPB;
    { float dtv; const float A = chunk_acum(dt, a_log, tok0, w, lane, dtv); Aarr[w * 64 + lane] = A; dtarr[w * 64 + lane] = dtv; }
    __syncthreads();
#pragma unroll 1
    for (int g = 0; g < 2; ++g) {
        if (w < 4) { const int cg = lane & 31, l0 = 8 * (2 * w + (lane >> 5));
            Conv8 cv; cv.load(xbc, cw, cb, (size_t)tok0, c, g * 256 + cg * 8, l0);
#pragma unroll
            for (int j = 0; j < 8; ++j) { float o[8];
#pragma unroll
                for (int i = 0; i < 8; ++i) o[i] = cv.val(i, j);
                *(SLAS u32x4*)(XT + (cg * 8 + j) * LPB + l0 * 2) = (u32x4){pkbf(o[0], o[1]), pkbf(o[2], o[3]), pkbf(o[4], o[5]), pkbf(o[6], o[7])}; }
        } else { const int cg = lane & 15, l0 = 8 * (4 * (w & 1) + (lane >> 4)); const bool isB = w < 6;
            Conv8 cv; cv.load(xbc, cw, cb, (size_t)tok0, c, (isB ? 512 : 768) + g * 128 + cg * 8, l0);
            SLAS unsigned char* dstb = (isB ? Bg : Cg) + cg * 16;
#pragma unroll
            for (int i = 0; i < 8; ++i) { float o[8];
#pragma unroll
                for (int j = 0; j < 8; ++j) o[j] = cv.val(i, j);
                *(SLAS u32x4*)(dstb + (l0 + i) * NPB) = (u32x4){pkbf(o[0], o[1]), pkbf(o[2], o[3]), pkbf(o[4], o[5]), pkbf(o[6], o[7])}; } }
        __syncthreads();
        {
            const int lt = w >> 1, st0 = 2 * (w & 1);
            f32x4 accG[2]; accG[0] = (f32x4){0.f, 0.f, 0.f, 0.f}; accG[1] = (f32x4){0.f, 0.f, 0.f, 0.f};
#pragma unroll
            for (int k = 0; k < 4; ++k) { const bf16x8 cf = *(const SLAS bf16x8*)(Cg + (16 * lt + r) * NPB + (32 * k + 8 * q) * 2);
#pragma unroll
                for (int j = 0; j < 2; ++j) { const bf16x8 bf = *(const SLAS bf16x8*)(Bg + (16 * (st0 + j) + r) * NPB + (32 * k + 8 * q) * 2); accG[j] = __builtin_amdgcn_mfma_f32_16x16x32_bf16(bf, cf, accG[j], 0, 0, 0); } }
            const int l = 16 * lt + r;
#pragma unroll
            for (int hh = 0; hh < 4; ++hh) { const int h = g * 4 + hh; const float Al = Aarr[h * 64 + l];
#pragma unroll
                for (int j = 0; j < 2; ++j) { const int s0 = 16 * (st0 + j) + 4 * q; float m[4];
#pragma unroll
                    for (int e = 0; e < 4; ++e) { const int s = s0 + e; m[e] = (s <= l) ? accG[j][e] * __builtin_amdgcn_exp2f((Al - Aarr[h * 64 + s]) * LOG2E) * dtarr[h * 64 + s] : 0.f; }
                    *(SLAS u32x2*)(Mm + hh * 64 * LPB + l * LPB + s0 * 2) = (u32x2){pkbf(m[0], m[1]), pkbf(m[2], m[3])}; } }
        }
        __syncthreads();
        {
            const int hh = w >> 1, h = g * 4 + hh;
            f32x4 acc[4][2];
#pragma unroll
            for (int lt = 0; lt < 4; ++lt) { acc[lt][0] = (f32x4){0.f, 0.f, 0.f, 0.f}; acc[lt][1] = (f32x4){0.f, 0.f, 0.f, 0.f}; }
            const bf16_t* sin = Sin + ((size_t)((b * NCH + c) * 8 + h) * 64 + (w & 1) * 32 + r) * 128 + 8 * q;
            bf16x8 sfr[4][2];
#pragma unroll
            for (int k = 0; k < 4; ++k)
#pragma unroll
                for (int ht = 0; ht < 2; ++ht) sfr[k][ht] = *(const bf16x8*)(sin + (size_t)(16 * ht) * 128 + 32 * k);
#pragma unroll
            for (int k = 0; k < 4; ++k) { bf16x8 sf[2]; sf[0] = sfr[k][0]; sf[1] = sfr[k][1];
#pragma unroll
                for (int lt = 0; lt < 4; ++lt) { const bf16x8 cf = *(const SLAS bf16x8*)(Cg + (16 * lt + r) * NPB + (32 * k + 8 * q) * 2);
#pragma unroll
                    for (int ht = 0; ht < 2; ++ht) acc[lt][ht] = __builtin_amdgcn_mfma_f32_16x16x32_bf16(sf[ht], cf, acc[lt][ht], 0, 0, 0); } }
#pragma unroll
            for (int lt = 0; lt < 4; ++lt) { const float e = __builtin_amdgcn_exp2f(Aarr[h * 64 + 16 * lt + r] * LOG2E); acc[lt][0] = acc[lt][0] * e; acc[lt][1] = acc[lt][1] * e; }
#pragma unroll
            for (int k = 0; k < 2; ++k) { bf16x8 xf[2];
#pragma unroll
                for (int ht = 0; ht < 2; ++ht) xf[ht] = *(const SLAS bf16x8*)(XT + (32 * w + 16 * ht + r) * LPB + (32 * k + 8 * q) * 2);
#pragma unroll
                for (int lt = 0; lt < 4; ++lt) { const bf16x8 mf = *(const SLAS bf16x8*)(Mm + hh * 64 * LPB + (16 * lt + r) * LPB + (32 * k + 8 * q) * 2);
#pragma unroll
                    for (int ht = 0; ht < 2; ++ht) acc[lt][ht] = __builtin_amdgcn_mfma_f32_16x16x32_bf16(xf[ht], mf, acc[lt][ht], 0, 0, 0); } }
            const float dsk = d_skip[h];
            float ss[4];
#pragma unroll
            for (int lt = 0; lt < 4; ++lt) { const int l = 16 * lt + r; float s2 = 0.f;
#pragma unroll
                for (int ht = 0; ht < 2; ++ht) { const int ch = g * 256 + 32 * w + 16 * ht + 4 * q;
                    const u32x2 zv = *(const u32x2*)(z + (size_t)(tok0 + l) * 512 + ch);
                    float xs4[4];
#pragma unroll
                    for (int e = 0; e < 4; ++e) xs4[e] = bf2f(*(const SLAS bf16_t*)(XT + (32 * w + 16 * ht + 4 * q + e) * LPB + l * 2));
                    const float z4[4] = {__uint_as_float(zv.x << 16), __uint_as_float(zv.x & 0xffff0000u), __uint_as_float(zv.y << 16), __uint_as_float(zv.y & 0xffff0000u)};
#pragma unroll
                    for (int e = 0; e < 4; ++e) { const float y = acc[lt][ht][e] + dsk * xs4[e]; const float yg = y * z4[e] * __builtin_amdgcn_rcpf(1.f + __builtin_amdgcn_exp2f(-z4[e] * LOG2E)); acc[lt][ht][e] = yg; s2 += yg * yg; } }
                s2 += __shfl_xor(s2, 16); s2 += __shfl_xor(s2, 32); ss[lt] = s2; }
            if (q == 0) {
#pragma unroll
                for (int lt = 0; lt < 4; ++lt) npart[w * 64 + 16 * lt + r] = ss[lt]; }
            __syncthreads();
#pragma unroll
            for (int lt = 0; lt < 4; ++lt) { const int l = 16 * lt + r; float tot = 0.f;
#pragma unroll
                for (int ww = 0; ww < 8; ++ww) tot += npart[ww * 64 + l];
                const float rs = rsqrtf(tot * (1.f / 256.f) + RMS_EPS);
#pragma unroll
                for (int ht = 0; ht < 2; ++ht) { const int ch = g * 256 + 32 * w + 16 * ht + 4 * q; const f32x4 gv = *(const f32x4*)(norm_g + ch);
                    *(u32x2*)(merged + (size_t)(tok0 + l) * 1024 + ch) = (u32x2){pkbf(acc[lt][ht][0] * rs * gv[0], acc[lt][ht][1] * rs * gv[1]), pkbf(acc[lt][ht][2] * rs * gv[2], acc[lt][ht][3] * rs * gv[3])}; } }
        }
        __syncthreads();
    }
}
#undef SLAS
}

__global__ void k_convb(const bf16_t* xbc, const float* conv_w, const float* conv_b, bf16_t* xc) {
    const size_t idx = (size_t)blockIdx.x * 256 + threadIdx.x;
    const int c = (int)(idx & 1023); const int t = (int)(idx >> 10); const int s = t & (SEQ - 1);
    float acc = conv_b[c];
#pragma unroll
    for (int k = 0; k < 4; ++k) { const int ss = s - 3 + k; if (ss >= 0) acc += conv_w[k * 1024 + c] * bf2f(xbc[(size_t)(t - 3 + k) * 1024 + c]); }
    xc[idx] = f2bf(acc / (1.f + expf(-acc)));
}


constexpr int NWAVES = 8;
constexpr int RING_OFF = 0, RING_BYTES = 131072;
constexpr int LDSCTL_OFF = RING_BYTES, MISC_OFF = LDSCTL_OFF + 320;
constexpr int TAB_OFF = RING_BYTES + 1024;
constexpr int LDS_BYTES = 147456;
#define GAS __attribute__((address_space(1)))
#define LAS __attribute__((address_space(3)))
typedef unsigned v4u __attribute__((ext_vector_type(4)));
typedef float f32x4 __attribute__((ext_vector_type(4)));
typedef GAS unsigned gu32;
#define RLX_AGENT __ATOMIC_RELAXED, __HIP_MEMORY_SCOPE_AGENT
#define LDS_WAIT() asm volatile("s_waitcnt lgkmcnt(0)" ::: "memory")
#define VM_WAIT() asm volatile("s_waitcnt vmcnt(0)" ::: "memory")
__device__ __forceinline__ unsigned pk2(float lo, float hi) { return (unsigned)f2bf(lo) | ((unsigned)f2bf(hi) << 16); }

#define XB_TMO      128
#define XB_XCNT(j)  (256  + 64 * (j))
#define XB_XSUB(j)  (1280 + 64 * (j))
#define XB_XGEN(j)  (2304 + 64 * (j))
#define XB_TOP      3328
#define XB_TOPGEN   3392
#define XCD_BAR_WORDS 3456
#define XB_SPIN_CAP (1u << 18)
__device__ __forceinline__ unsigned xb_ld(unsigned* p)              { return __hip_atomic_load(p, __ATOMIC_RELAXED, __HIP_MEMORY_SCOPE_AGENT); }
__device__ __forceinline__ unsigned xb_add(unsigned* p, unsigned v) { return __hip_atomic_fetch_add(p, v, __ATOMIC_RELAXED, __HIP_MEMORY_SCOPE_AGENT); }
__device__ __forceinline__ unsigned xb_xcc_id() { return (unsigned)__builtin_amdgcn_s_getreg((3 << 11) | 20) & 0xFu; }
#define XB_SPIN(cond, bar) do { unsigned _sp = 0; while (cond) { __builtin_amdgcn_s_sleep(1); \
    if ((++_sp & 255u) == 0u) { if (xb_ld(&(bar)[XB_TMO])) break; if (_sp > XB_SPIN_CAP) { atomicAdd(&(bar)[XB_TMO], 1u); break; } } } } while (0)
struct XcdBarrier { unsigned* bar; unsigned x; volatile LAS unsigned* st; };
__device__ __forceinline__ XcdBarrier xcd_barrier_post(unsigned* bar, volatile LAS unsigned* st) {
    XcdBarrier b; b.bar = bar; b.x = xb_xcc_id(); b.st = st;
    if (threadIdx.x == 0) (void)xb_add(&bar[XB_XCNT(b.x)], 1u);
    return b;
}
__device__ __forceinline__ void xcd_barrier_complete(unsigned* bar, unsigned x, unsigned& nloc, unsigned& nx) {
    const unsigned G = gridDim.x * gridDim.y * gridDim.z;
    unsigned sum, cnt, mine, sp = 0u;
    for (;;) {
        sum = 0u; cnt = 0u; mine = 0u;
#pragma unroll
        for (unsigned j = 0; j < 16; ++j) { const unsigned c = xb_ld(&bar[XB_XCNT(j)]); sum += c; cnt += (c > 0u) ? 1u : 0u; mine = (j == x) ? c : mine; }
        if (sum == G) break;
        __builtin_amdgcn_s_sleep(1);
        if ((++sp & 255u) == 0u) { if (xb_ld(&bar[XB_TMO])) break; if (sp > XB_SPIN_CAP) { atomicAdd(&bar[XB_TMO], 1u); break; } }
    }
    nloc = mine > 0u ? mine : 1u; nx = cnt > 0u ? cnt : 1u;
}
__device__ __forceinline__ void xcd_barrier(const XcdBarrier& b) {
    asm volatile("s_waitcnt vmcnt(0)" ::: "memory");
    __syncthreads();
    if (threadIdx.x == 0) {
        unsigned* bar = b.bar;
        __builtin_amdgcn_s_waitcnt(0);
        unsigned nloc = b.st[0], nx = b.st[1];
        if (nloc == 0u) { xcd_barrier_complete(bar, b.x, nloc, nx); b.st[0] = nloc; b.st[1] = nx; }
        const unsigned old = xb_add(&bar[XB_XSUB(b.x)], 1u);
        const unsigned gen = old / nloc;
        if (old + 1u == (gen + 1u) * nloc) {
            __builtin_amdgcn_fence(__ATOMIC_RELEASE, "agent");
            asm volatile("s_waitcnt vmcnt(0)" ::: "memory");
            const unsigned og = xb_add(&bar[XB_TOP], 1u);
            const unsigned tg = og / nx;
            if (og + 1u == (tg + 1u) * nx) xb_add(&bar[XB_TOPGEN], 1u);
            else XB_SPIN(xb_ld(&bar[XB_TOPGEN]) == tg, bar);
            __builtin_amdgcn_fence(__ATOMIC_ACQUIRE, "agent");
            xb_add(&bar[XB_XGEN(b.x)], 1u);
            asm volatile("s_waitcnt vmcnt(0)" ::: "memory");
        } else {
            XB_SPIN(xb_ld(&bar[XB_XGEN(b.x)]) == gen, bar);
            __builtin_amdgcn_fence(__ATOMIC_ACQUIRE, "agent");
            asm volatile("s_waitcnt vmcnt(0)" ::: "memory");
        }
    }
    __syncthreads();
}

struct Frame {
    LAS unsigned char* lds;
    volatile LAS unsigned* MISC;
    gu32* ctl;
    int tid, lane, wave, vcu, G;
};
__device__ __forceinline__ int tid_now() { int t; asm volatile("v_mov_b32 %0, %1" : "=v"(t) : "v"(threadIdx.x)); return t; }
__device__ __forceinline__ int lane_now() { int l; asm volatile("v_and_b32 %0, 63, %1" : "=v"(l) : "v"(threadIdx.x)); return l; }
__device__ __forceinline__ float wave_sum(float v) {
#pragma unroll
    for (int o = 1; o < 64; o <<= 1) v += __shfl_xor(v, o);
    return v;
}

__device__ __forceinline__ void p0_transpose_item(const float* W, int ldw, int k0, int n0, bf16_t* WT, int ldt, int drow0, LAS float* scr, int lane) {
    float tv[32];
#pragma unroll
    for (int i = 0; i < 32; ++i) { const int kk = 2 * i + (lane >> 5); tv[i] = W[(size_t)(k0 + kk) * ldw + n0 + (lane & 31)]; }
#pragma unroll
    for (int i = 0; i < 32; ++i) { const int kk = 2 * i + (lane >> 5); scr[kk * 33 + (lane & 31)] = tv[i]; }
    LDS_WAIT(); asm volatile("" ::: "memory");
    const int c = lane & 7;
#pragma unroll
    for (int j = 0; j < 4; ++j) { const int n = (lane >> 3) + 8 * j; const LAS float* s = scr + (8 * c) * 33 + n;
        v4u o; o.x = pk2(s[0 * 33], s[1 * 33]); o.y = pk2(s[2 * 33], s[3 * 33]); o.z = pk2(s[4 * 33], s[5 * 33]); o.w = pk2(s[6 * 33], s[7 * 33]);
        *(GAS v4u*)(WT + (size_t)(drow0 + n) * ldt + k0 + 8 * c) = o; }
    LDS_WAIT(); asm volatile("" ::: "memory");
}
__device__ __forceinline__ float softplus_d(float x) { return fmaxf(x, 0.f) + log1pf(expf(-fabsf(x))); }

__device__ __forceinline__ void p0_prologue(Frame& F, const P& p) {
    unsigned char* ws = p.ws;
    bf16_t* Win_t = (bf16_t*)(ws + WS_WIN); bf16_t* Wout_t = (bf16_t*)(ws + WS_WOUT); bf16_t* Wgu_t = (bf16_t*)(ws + WS_WGU);
    LAS float* scr = (LAS float*)(F.lds + RING_OFF + F.wave * 16384);
    const int gw = F.vcu * NWAVES + F.wave, NGW = F.G * NWAVES;
    constexpr int I_IN = 16 * 96, I_OUT = 16 * 32, I_GU = 16 * 2 * 256, NITEMS = I_IN + I_OUT + I_GU;
    for (int it = gw; it < NITEMS; it += NGW) {
        int r = it;
        if (r < I_IN) { const int kb = r / 96, nb = r % 96, n0 = 32 * nb; p0_transpose_item(p.w_in, NPROJ, 64 * kb, n0 + (n0 >= 1536 ? 8 : 0), Win_t, 1024, n0, scr, F.lane); continue; } r -= I_IN;
        if (r < I_OUT) { const int kb = r / 32, nb = r % 32; p0_transpose_item(p.w_out, 1024, 64 * kb, 32 * nb, Wout_t, 1024, 32 * nb, scr, F.lane); continue; } r -= I_OUT;
        { const int e = r / 512, rr = r % 512, mat = rr / 256, r2 = rr % 256, kb = r2 / 16, nb = r2 % 16, n0 = 32 * nb, q = n0 / 128;
            p0_transpose_item((mat ? p.w_up : p.w_gate) + (size_t)e * 1024 * 512, 512, 64 * kb, n0, Wgu_t, 1024, (e * 4 + q) * 256 + mat * 128 + (n0 % 128), scr, F.lane); }
    }
    __syncthreads();
    LAS float* w16 = (LAS float*)(F.lds + RING_OFF);
    { float wv[32];
#pragma unroll
      for (int i = 0; i < 32; ++i) { const int idx = F.tid + i * NWAVES * 64; const int k = idx >> 4, c = idx & 15; wv[i] = p.w_in[(size_t)k * NPROJ + (c < 8 ? 1536 + c : 3080 + c - 8)]; }
#pragma unroll
      for (int i = 0; i < 32; ++i) { const int idx = F.tid + i * NWAVES * 64; const int k = idx >> 4, c = idx & 15; w16[c * 1024 + k] = wv[i]; } }
    __syncthreads();
    bf16_t* xb = (bf16_t*)(ws + WS_XB); float* dt = (float*)(ws + WS_DT); float* logf = (float*)(ws + WS_LOGF);
#pragma unroll 1
    for (int grp = gw; grp < T / 2; grp += NGW) {
        float a[32];
#pragma unroll
        for (int r = 0; r < 2; ++r) {
            const int m = grp * 2 + r;
            const GAS f32x4* xr = (const GAS f32x4*)(p.x + (size_t)m * D) + F.lane;
            f32x4 v[4];
#pragma unroll
            for (int j = 0; j < 4; ++j) v[j] = xr[64 * j];
            GAS unsigned long long* o8 = (GAS unsigned long long*)(xb + (size_t)m * D) + F.lane;
#pragma unroll
            for (int j = 0; j < 4; ++j) o8[64 * j] = (unsigned long long)pk2(v[j].x, v[j].y) | ((unsigned long long)pk2(v[j].z, v[j].w) << 32);
#pragma unroll
            for (int c = 0; c < 16; ++c) {
                float s = 0.f;
#pragma unroll
                for (int j = 0; j < 4; ++j) { const f32x4 w = *(const LAS f32x4*)(w16 + c * 1024 + 256 * j + 4 * F.lane); s += (v[j].x * w.x + v[j].y * w.y) + (v[j].z * w.z + v[j].w * w.w); }
                a[r * 16 + c] = s; asm volatile("" ::: "memory");
            }
        }
#define TRSTEP(HALFN, SB) do { const bool up = (F.lane >> (SB)) & 1; _Pragma("unroll") for (int i = 0; i < (HALFN); ++i) { const float keep = up ? a[i + (HALFN)] : a[i]; const float send = up ? a[i] : a[i + (HALFN)]; a[i] = keep + __shfl_xor(send, 1 << (SB)); } } while (0)
        TRSTEP(16, 0); TRSTEP(8, 1); TRSTEP(4, 2); TRSTEP(2, 3); TRSTEP(1, 4);
#undef TRSTEP
        const float tot = a[0] + __shfl_xor(a[0], 32);
        const int L = F.lane & 31; const int idx = ((L & 1) << 4) | ((L & 2) << 2) | (L & 4) | ((L & 8) >> 2) | ((L & 16) >> 4);
        const int r = idx >> 4, c = idx & 15, m = grp * 2 + r;
        if (F.lane < 32) {
            if (c < 8) dt[(size_t)m * 8 + c] = softplus_d(tot + p.b_in[1536 + c]);
            else logf[(size_t)m * 8 + (c - 8)] = -softplus_d(-(tot + p.b_in[3080 + c - 8]));
        }
    }
}

__device__ __forceinline__ void scanF_unit(Frame& F, const P& p, int bh) {
    const int b = bh >> 3, h = bh & 7;
    const float* logf = (const float*)(p.ws + WS_LOGF); float* Fo = (float*)(p.ws + WS_F); bf16_t* kx = (bf16_t*)(p.ws + WS_KX);
    LAS float* wsum8 = (LAS float*)(F.lds + RING_OFF);
    float v[4]; float s = 0.f;
#pragma unroll
    for (int i = 0; i < 4; ++i) { v[i] = logf[(size_t)(b * SEQ + F.tid * 4 + i) * 8 + h]; s += v[i]; v[i] = s; }
    float inc = s;
#pragma unroll
    for (int o = 1; o < 64; o <<= 1) { const float y = __shfl_up(inc, o); if (F.lane >= o) inc += y; }
    if (F.lane == 63) wsum8[F.wave] = inc;
    __syncthreads();
    float base = inc - s;
    for (int w = 0; w < F.wave; ++w) base += wsum8[w];
#pragma unroll
    for (int i = 0; i < 4; ++i) { const size_t tok = (size_t)(b * SEQ + F.tid * 4 + i); const float f = base + v[i]; Fo[tok * 8 + h] = f;
        const float g = -f * LOG2E; const bf16_t g0 = f2bf(g); const float r1 = g - bf2f(g0); const bf16_t g1 = f2bf(r1); const float r2 = r1 - bf2f(g1); const bf16_t g2 = f2bf(r2);
        v4u o; o.x = (unsigned)g0 | ((unsigned)g1 << 16); o.y = (unsigned)g2 | 0x3F800000u; o.z = 0x3F803F80u; o.w = 0u;
        *(GAS v4u*)(kx + (tok * 8 + h) * 8) = o; }
    __syncthreads();
}


__device__ __forceinline__ void ln1_stage_weights(const P& p, LAS f32x4* RG, int tid) {
    f32x4 wv[10];
#pragma unroll
    for (int it = 0; it < 10; ++it) { const int idx = tid + it * NWAVES * 64; const int m = idx >> 10, cc = idx & 1023;
        wv[it] = m == 0 ? *(const GAS f32x4*)(p.rg_w + (size_t)cc * 4) : *(const GAS f32x4*)(p.re_w + ((size_t)(m - 1) * D + cc) * 4); }
#pragma unroll
    for (int it = 0; it < 10; ++it) { const int idx = tid + it * NWAVES * 64; const int m = idx >> 10, cc = idx & 1023, j = cc >> 8, ln = (cc & 255) >> 2, i = cc & 3;
        RG[m * 1024 + (j * 4 + i) * 64 + ln] = wv[it]; }
}
#define TRSTEP_(a, HALFN, SB, lane) do { const bool up_ = ((lane) >> (SB)) & 1; _Pragma("unroll") for (int i_ = 0; i_ < (HALFN); ++i_) { const float keep_ = up_ ? a[i_ + (HALFN)] : a[i_]; const float send_ = up_ ? a[i_] : a[i_ + (HALFN)]; a[i_] = keep_ + __shfl_xor(send_, 1 << (SB)); } } while (0)
__device__ __forceinline__ void wave_reduce8(float (&a)[8], int lane) { TRSTEP_(a, 4, 0, lane); TRSTEP_(a, 2, 1, lane); TRSTEP_(a, 1, 2, lane); a[0] += __shfl_xor(a[0], 8); a[0] += __shfl_xor(a[0], 16); a[0] += __shfl_xor(a[0], 32); }
__device__ __forceinline__ void wave_reduce16(float (&a)[16], int lane) { TRSTEP_(a, 8, 0, lane); TRSTEP_(a, 4, 1, lane); TRSTEP_(a, 2, 2, lane); TRSTEP_(a, 1, 3, lane); a[0] += __shfl_xor(a[0], 16); a[0] += __shfl_xor(a[0], 32); }
__device__ __forceinline__ constexpr int brev3(int k) { return ((k & 1) << 2) | (k & 2) | ((k & 4) >> 2); }
__device__ __forceinline__ constexpr int brev4(int k) { return ((k & 1) << 3) | ((k & 2) << 1) | ((k & 4) >> 1) | ((k & 8) >> 3); }
#define RDLANE(v, l) __int_as_float(__builtin_amdgcn_readlane(__float_as_int(v), (l)))
template <int R>
__device__ __forceinline__ void ln1_router_rows(const P& p, int t0, int lane, const LAS f32x4* RG, bf16_t* hb, LAS unsigned* lcnt, LAS f32x4* rowinfo, LAS int* rowtok, int slot0) {
    static_assert(R == 4, "4 rows per wave");
    const bf16_t* mix = (const bf16_t*)(p.ws + WS_MIX);
    f32x4 v[4][4];
#pragma unroll
    for (int r = 0; r < 4; ++r)
#pragma unroll
        for (int j = 0; j < 4; ++j) { const f32x4 xv = *(const GAS f32x4*)(p.x + (size_t)(t0 + r) * D + j * 256 + lane * 4);
            const unsigned long long mv = *(const GAS unsigned long long*)(mix + (size_t)(t0 + r) * D + j * 256 + lane * 4); const unsigned m0 = (unsigned)mv, m1 = (unsigned)(mv >> 32);
            v[r][j] = xv * ALPHA + (f32x4){__uint_as_float(m0 << 16), __uint_as_float(m0 & 0xffff0000u), __uint_as_float(m1 << 16), __uint_as_float(m1 & 0xffff0000u)}; }
    float st[8];
#pragma unroll
    for (int r = 0; r < 4; ++r) { float s = 0.f, q = 0.f;
#pragma unroll
        for (int j = 0; j < 4; ++j) { s += (v[r][j].x + v[r][j].y) + (v[r][j].z + v[r][j].w); q += (v[r][j].x * v[r][j].x + v[r][j].y * v[r][j].y) + (v[r][j].z * v[r][j].z + v[r][j].w * v[r][j].w); }
        st[2 * r] = s; st[2 * r + 1] = q; }
    wave_reduce8(st, lane);
    float mu[4], rstd[4];
#pragma unroll
    for (int r = 0; r < 4; ++r) { const float S = RDLANE(st[0], brev3(2 * r)), Q = RDLANE(st[0], brev3(2 * r + 1)); mu[r] = S * (1.f / D); const float var = fmaxf(Q * (1.f / D) - mu[r] * mu[r], 0.f); rstd[r] = rsqrtf(var + LN_EPS); }
    float gl[16];
    {
        f32x4 g1[4], b1[4];
#pragma unroll
        for (int j = 0; j < 4; ++j) { g1[j] = *(const GAS f32x4*)(p.ln1_g + j * 256 + lane * 4); b1[j] = *(const GAS f32x4*)(p.ln1_b + j * 256 + lane * 4); }
        f32x4 acc[4];
#pragma unroll
        for (int r = 0; r < 4; ++r) acc[r] = (f32x4){0.f, 0.f, 0.f, 0.f};
#pragma unroll
        for (int j = 0; j < 4; ++j) { const f32x4 w0 = RG[(j * 4 + 0) * 64 + lane], w1 = RG[(j * 4 + 1) * 64 + lane], w2 = RG[(j * 4 + 2) * 64 + lane], w3 = RG[(j * 4 + 3) * 64 + lane];
#pragma unroll
            for (int r = 0; r < 4; ++r) { const f32x4 hv = (v[r][j] - mu[r]) * rstd[r] * g1[j] + b1[j]; v[r][j] = hv;
                *(GAS unsigned long long*)(hb + (size_t)(t0 + r) * D + j * 256 + lane * 4) = (unsigned long long)pk2(hv.x, hv.y) | ((unsigned long long)pk2(hv.z, hv.w) << 32);
                acc[r] += w0 * hv.x; acc[r] += w1 * hv.y; acc[r] += w2 * hv.z; acc[r] += w3 * hv.w; } }
#pragma unroll
        for (int r = 0; r < 4; ++r)
#pragma unroll
            for (int e = 0; e < 4; ++e) gl[r * 4 + e] = acc[r][e];
    }
    wave_reduce16(gl, lane);
    int gi[4]; float gval[4];
#pragma unroll
    for (int r = 0; r < 4; ++r) { float glv[4];
#pragma unroll
        for (int e = 0; e < 4; ++e) glv[e] = RDLANE(gl[0], brev4(r * 4 + e)) + p.rg_b[e];
        int g = 0; float gm = glv[0];
#pragma unroll
        for (int e = 1; e < 4; ++e) if (glv[e] > gm) { gm = glv[e]; g = e; }
        float gden = 0.f;
#pragma unroll
        for (int e = 0; e < 4; ++e) gden += expf(glv[e] - gm);
        gi[r] = __builtin_amdgcn_readfirstlane(g); gval[r] = 1.f / gden; }
    float el16[16];
#pragma unroll
    for (int r = 0; r < 4; ++r) { const LAS f32x4* RE = RG + (1 + gi[r]) * 1024; f32x4 a = (f32x4){0.f, 0.f, 0.f, 0.f};
#pragma unroll
        for (int j = 0; j < 4; ++j) { a += RE[(j * 4 + 0) * 64 + lane] * v[r][j].x; a += RE[(j * 4 + 1) * 64 + lane] * v[r][j].y; a += RE[(j * 4 + 2) * 64 + lane] * v[r][j].z; a += RE[(j * 4 + 3) * 64 + lane] * v[r][j].w; }
#pragma unroll
        for (int e = 0; e < 4; ++e) el16[r * 4 + e] = a[e]; }
    wave_reduce16(el16, lane);
#pragma unroll
    for (int r = 0; r < 4; ++r) { float el[4];
#pragma unroll
        for (int e = 0; e < 4; ++e) el[e] = RDLANE(el16[0], brev4(r * 4 + e)) + p.re_b[gi[r] * 4 + e];
        int i1 = 0;
#pragma unroll
        for (int e = 1; e < 4; ++e) if (el[e] > el[i1]) i1 = e;
        int i2 = -1;
#pragma unroll
        for (int e = 0; e < 4; ++e) if (e != i1 && (i2 < 0 || el[e] > el[i2])) i2 = e;
        const float e1v = i1 == 0 ? el[0] : i1 == 1 ? el[1] : i1 == 2 ? el[2] : el[3];
        const float e2v = i2 == 0 ? el[0] : i2 == 1 ? el[1] : i2 == 2 ? el[2] : el[3];
        const float p2 = expf(e2v - e1v); const float w1 = gval[r] / (1.f + p2), w2 = gval[r] * p2 / (1.f + p2);
        const int lo = i1 < i2 ? i1 : i2, hi = i1 < i2 ? i2 : i1; const float wlo = i1 < i2 ? w1 : w2, whi = i1 < i2 ? w2 : w1;
        const int pairidx = lo == 0 ? (hi - 1) : (lo == 1 ? (hi + 1) : 5);
        const int cls = gi[r] * 6 + pairidx;
        if (lane == 0) {
            const unsigned lpos = __hip_atomic_fetch_add(lcnt + cls, 1u, __ATOMIC_RELAXED, __HIP_MEMORY_SCOPE_WORKGROUP);
            rowinfo[slot0 + r] = (f32x4){__int_as_float(cls), __int_as_float((int)lpos), wlo, whi}; rowtok[slot0 + r] = t0 + r;
        }
    }
}
__device__ __forceinline__ void ln1_commit(int tid, LAS unsigned* lcnt, LAS unsigned* gbase, const LAS f32x4* rowinfo, const LAS int* rowtok, int nrows, gu32* cnt, int* perm, float* tokinfo) {
    __syncthreads();
    if (tid < NCLS) { const unsigned n = lcnt[tid]; gbase[tid] = n ? __hip_atomic_fetch_add(cnt + 64 * tid, n, RLX_AGENT) : 0u; lcnt[tid] = 0u; }
    __syncthreads();
    if (tid < nrows) { const f32x4 ri = rowinfo[tid]; const int cls = __float_as_int(ri[0]); const int pos = __float_as_int(ri[1]) + (int)gbase[cls]; const int t = rowtok[tid];
        perm[(size_t)cls * T + pos] = t; *(GAS f32x4*)(tokinfo + (size_t)t * 4) = (f32x4){ri[0], __int_as_float(pos), ri[2], ri[3]}; }
}
__device__ __forceinline__ void ln2_row(const P& p, int t, int lane) {
    float* io = p.out;
    f32x4 v[4]; float s = 0.f;
#pragma unroll
    for (int j = 0; j < 4; ++j) { const unsigned long long hw = *(const GAS unsigned long long*)((const bf16_t*)(p.ws + WS_HB) + (size_t)t * D + j * 256 + lane * 4); const unsigned h0 = (unsigned)hw, h1 = (unsigned)(hw >> 32);
        const f32x4 hv = (f32x4){__uint_as_float(h0 << 16), __uint_as_float(h0 & 0xffff0000u), __uint_as_float(h1 << 16), __uint_as_float(h1 & 0xffff0000u)};
        const unsigned long long mv = *(const GAS unsigned long long*)((const bf16_t*)(p.ws + WS_FFN) + (size_t)t * D + j * 256 + lane * 4); const unsigned m0 = (unsigned)mv, m1 = (unsigned)(mv >> 32);
        v[j] = hv * ALPHA + (f32x4){__uint_as_float(m0 << 16), __uint_as_float(m0 & 0xffff0000u), __uint_as_float(m1 << 16), __uint_as_float(m1 & 0xffff0000u)};
        s += (v[j].x + v[j].y) + (v[j].z + v[j].w); }
    const float mu = wave_sum(s) * (1.f / D); float s2 = 0.f;
#pragma unroll
    for (int j = 0; j < 4; ++j) { v[j] = v[j] - mu; s2 += (v[j].x * v[j].x + v[j].y * v[j].y) + (v[j].z * v[j].z + v[j].w * v[j].w); }
    const float rstd = rsqrtf(wave_sum(s2) * (1.f / D) + LN_EPS);
#pragma unroll
    for (int j = 0; j < 4; ++j) { const int c = j * 256 + lane * 4; const f32x4 g2 = *(const GAS f32x4*)(p.ln2_g + c), b2 = *(const GAS f32x4*)(p.ln2_b + c);
        *(GAS f32x4*)(io + (size_t)t * D + c) = v[j] * rstd * g2 + b2; }
}

struct Args { P p; int ph_lo, ph_hi, li, pad; };
constexpr int N_PHASES = 2;
__global__ void __launch_bounds__(NWAVES * 64, 2) mega_fwd(Args args) {
    extern __shared__ __attribute__((aligned(16))) unsigned char lds[];
    Frame F;
    F.lds = (LAS unsigned char*)lds;
    F.MISC = (volatile LAS unsigned*)(F.lds + MISC_OFF);
    F.tid = threadIdx.x; F.lane = F.tid & 63; F.wave = __builtin_amdgcn_readfirstlane(F.tid >> 6);
    F.G = gridDim.x; { const int bx = blockIdx.x; F.vcu = (F.G % 8 == 0) ? (bx % 8) * (F.G / 8) + bx / 8 : bx; }
    const P& p = args.p;
    unsigned char* ws = p.ws;
    F.ctl = (gu32*)(ws + WS_CTL);
    for (int u = F.tid; u < (LDS_BYTES - LDSCTL_OFF) / 4; u += NWAVES * 64) ((LAS unsigned*)(F.lds + LDSCTL_OFF))[u] = 0u;
    __syncthreads();
    XcdBarrier bar = xcd_barrier_post((unsigned*)(F.ctl + CW_BAR) + args.li * XCD_BAR_WORDS, F.MISC + 8);
    const int lo = args.ph_lo, hi = args.ph_hi;
#ifndef PROBE_PH
#define PROBE_PH (-1)
#endif
#if PROBE_PH >= 0
    unsigned long long t_prev = __builtin_amdgcn_s_memrealtime(); unsigned long long t_sel = 0ull;
#define PSTAMP(k) do { const unsigned long long t_now = __builtin_amdgcn_s_memrealtime(); if ((k) == PROBE_PH) t_sel = t_now - t_prev; t_prev = t_now; } while (0)
#else
#define PSTAMP(k) do { } while (0)
#endif
#define IN(k) (lo <= (k) && (k) < hi)
#define BOTH(k) (IN(k) && IN((k) + 1))
#define GRID_BAR() xcd_barrier(bar)
    if (IN(0)) { p0_prologue(F, p); if (BOTH(0)) GRID_BAR(); PSTAMP(0); }
    if (IN(1)) {
        if (blockIdx.x < BATCH * NH) scanF_unit(F, p, blockIdx.x);
        pg8::PlainProb pr{(const bf16_t*)(ws + WS_XB), (const bf16_t*)(ws + WS_WIN), 1024, 1024, 16};
        pg8::StaticOrder S; S.init(T, 3072, F.G, (int)blockIdx.x);
        pg8::EpiInproj E{p.b_in, (bf16_t*)(ws + WS_Z), (bf16_t*)(ws + WS_XBC), (bf16_t*)(ws + WS_Q), (bf16_t*)(ws + WS_K), (bf16_t*)(ws + WS_V)};
        pg8::gemm_phase<pg8::PlainProb, pg8::StaticOrder, pg8::EpiInproj, true>(F.lds + RING_OFF, pr, S, E);
        if (BOTH(1)) GRID_BAR(); PSTAMP(1);
    }

    if (IN(2)) {
#pragma unroll 1
        for (int u = F.vcu; u < BATCH * ssd::NCH; u += F.G) { ssd::states_unit(F.lds + RING_OFF, (const bf16_t*)(ws + WS_XBC), p.conv_w, p.conv_b, (const float*)(ws + WS_DT), p.a_log, (bf16_t*)(ws + WS_S), (float*)(ws + WS_CDEC), u / ssd::NCH, u % ssd::NCH); }
        if (BOTH(2)) GRID_BAR(); PSTAMP(2);
    }
    if (IN(3)) {
#pragma unroll 1
        for (int u = F.vcu; u < BATCH * NH * 2; u += F.G) ssd::scan_unit((bf16_t*)(ws + WS_S), (const float*)(ws + WS_CDEC), u >> 1, u & 1);
        __syncthreads();
        const attn_body::AttnTensors AT{(const attn_body::bf16*)(ws + WS_Q), (const attn_body::bf16*)(ws + WS_K), (const attn_body::bf16*)(ws + WS_V), (const attn_body::bf16*)(ws + WS_KX), (attn_body::bf16*)(ws + WS_MERGED)};
        const attn_body::StaticOrder S((int)F.G, (int)blockIdx.x);
        attn_body::attn_phase<attn_body::StaticOrder>((char*)lds + RING_OFF, AT, S);
        if (BOTH(3)) GRID_BAR(); PSTAMP(3);
    }
    if (IN(4)) {
#pragma unroll 1
        for (int u = F.vcu; u < BATCH * ssd::NCH; u += F.G) ssd::out_unit(F.lds + RING_OFF, (const bf16_t*)(ws + WS_XBC), p.conv_w, p.conv_b, (const bf16_t*)(ws + WS_Z), (const float*)(ws + WS_DT), p.a_log, p.d_skip, p.ssd_norm_g,
                                                                          (const bf16_t*)(ws + WS_S), (bf16_t*)(ws + WS_MERGED), u / ssd::NCH, u % ssd::NCH);
        if (BOTH(4)) GRID_BAR(); PSTAMP(4);
    }
    if (IN(5)) {
        pg8::PlainProb pr{(const bf16_t*)(ws + WS_MERGED), (const bf16_t*)(ws + WS_WOUT), 1024, 1024, 16};
        pg8::StaticOrder S; S.init(T, 1024, F.G, (int)blockIdx.x);
        pg8::EpiOutproj E{(bf16_t*)(ws + WS_MIX)};
        pg8::gemm_phase<pg8::PlainProb, pg8::StaticOrder, pg8::EpiOutproj, true>(F.lds + RING_OFF, pr, S, E);
        if (BOTH(5)) GRID_BAR(); PSTAMP(5);
    }
    if (IN(6)) {
        const int gw = F.vcu * NWAVES + F.wave, NGW = F.G * NWAVES;
        LAS f32x4* RG = (LAS f32x4*)(F.lds + RING_OFF);
        LAS unsigned* lcnt = (LAS unsigned*)(F.lds + RING_OFF + 81920);
        LAS unsigned* gbase = lcnt + 32;
        LAS f32x4* rowinfo = (LAS f32x4*)(F.lds + RING_OFF + 81920 + 256);
        LAS int* rowtok = (LAS int*)(F.lds + RING_OFF + 81920 + 256 + 1024);
        const int tid6 = tid_now();
        ln1_stage_weights(p, RG, tid6);
        if (tid6 < 32) lcnt[tid6] = 0u;
        __syncthreads();
        const int lane6 = lane_now();
#pragma unroll 1
        for (int bt = F.vcu; bt < T / 32; bt += F.G) {
            const int par = (((bt - F.vcu) / F.G) & 1) * 32;
            ln1_router_rows<4>(p, bt * 32 + F.wave * 4, lane6, RG, (bf16_t*)(ws + WS_HB), lcnt, rowinfo + par, rowtok + par, F.wave * 4);
            ln1_commit(tid6, lcnt, gbase, rowinfo + par, rowtok + par, 32, F.ctl + CW_CNT, (int*)(ws + WS_PERM), (float*)(ws + WS_TOK));
        }
        if (BOTH(6)) GRID_BAR(); PSTAMP(6);
    }
    if (IN(7) || IN(8)) {
        LAS int* gt = (LAS int*)(F.lds + TAB_OFF);
        { const int tg = tid_now(); if (tg < NCLS) gt[32 + tg] = (int)__hip_atomic_load(F.ctl + CW_CNT + 64 * tg, RLX_AGENT);
          __syncthreads();
          if (tg == 0) { int acc = 0; for (int c = 0; c < NCLS; ++c) { gt[c] = acc; acc += (gt[32 + c] + 255) >> 8; } gt[24] = acc; } }
        __syncthreads();
    }
    if (IN(7)) {
        const LAS int* gt = (const LAS int*)(F.lds + TAB_OFF);
        LAS unsigned* rofft = (LAS unsigned*)(F.lds + TAB_OFF + 256); LAS int* tokt = (LAS int*)(F.lds + TAB_OFF + 256 + 6144);
        pg8::MoeGeo geo{gt}; pg8::MoeOrder S{geo.np() * 8, 8, F.G, F.vcu};
        const int* perm = (const int*)(ws + WS_PERM);
        { const int tid7 = tid_now(); pg8::Unit u; for (int i = 0; S.next(i, u); ++i) if (tid7 < 256) { const int c = geo.cls_of(u.pm); const int pos = (u.pm - gt[c]) * 256 + tid7; const int tok = pos < gt[32 + c] ? perm[(size_t)c * T + pos] : -1;
            rofft[i * 256 + tid7] = (unsigned)(tok < 0 ? 0 : tok) * 2048u; tokt[i * 256 + tid7] = tok; } }
        __syncthreads();
        pg8::Moe1Prob pr{(const bf16_t*)(ws + WS_HB), (const bf16_t*)(ws + WS_WGU), geo, rofft, 1024, 1024, 16};
        pg8::EpiMoe1 E{(bf16_t*)(ws + WS_ACT), (const float*)(ws + WS_TOK), tokt};
        pg8::gemm_phase<pg8::Moe1Prob, pg8::MoeOrder, pg8::EpiMoe1, true>(F.lds + RING_OFF, pr, S, E);
        {
            const int tot = geo.np() * 8, r1 = tot % F.G, NI = r1 ? F.G - r1 : F.G, ci = r1 ? F.vcu - r1 : F.vcu;
            if (ci >= 0) { LAS float* scr = (LAS float*)(F.lds + RING_OFF + F.wave * 16384); const int lane7 = lane_now(); bf16_t* Wd_t = (bf16_t*)(ws + WS_WD);
#pragma unroll 1
                for (int it = ci * NWAVES + F.wave; it < 16 * 256; it += NI * NWAVES) { const int e = it / 256, r2 = it % 256, kb = r2 / 32, nb = r2 % 32;
                    p0_transpose_item(p.w_down + (size_t)e * 512 * 1024, 1024, 64 * kb, 32 * nb, Wd_t + (size_t)e * 1024 * 512, 512, 32 * nb, scr, lane7); } }
        }
        if (BOTH(7)) GRID_BAR(); PSTAMP(7);
    }
    if (IN(8)) {
        const LAS int* gt = (const LAS int*)(F.lds + TAB_OFF);
        LAS int* tokt = (LAS int*)(F.lds + TAB_OFF + 256 + 6144);
        pg8::MoeGeo geo{gt}; pg8::MoeOrder S{geo.np() * 4, 4, F.G, F.vcu};
        const int* perm = (const int*)(ws + WS_PERM);
        __syncthreads();
        { const int tid8 = tid_now(); pg8::Unit u; for (int i = 0; S.next(i, u); ++i) if (tid8 < 256) { const int c = geo.cls_of(u.pm); const int pos = (u.pm - gt[c]) * 256 + tid8; tokt[i * 256 + tid8] = pos < gt[32 + c] ? perm[(size_t)c * T + pos] : -1; } }
        __syncthreads();
        pg8::Moe2Prob pr{(const bf16_t*)(ws + WS_ACT), (const bf16_t*)(ws + WS_WD), geo, 1024, 512, 16};
        pg8::EpiMoe2 E{(bf16_t*)(ws + WS_FFN), tokt};
        pg8::gemm_phase<pg8::Moe2Prob, pg8::MoeOrder, pg8::EpiMoe2, true>(F.lds + RING_OFF, pr, S, E);
        if (BOTH(8)) GRID_BAR(); PSTAMP(8);
    }
    if (IN(9)) {
        const int gw = F.vcu * NWAVES + F.wave, NGW = F.G * NWAVES;
        const int lane9 = lane_now();
#pragma unroll 1
        for (int m = gw; m < T; m += NGW) ln2_row(p, m, lane9);
    }
    PSTAMP(9);
#if PROBE_PH >= 0
    if (blockIdx.x == 0) { const unsigned long long t_end = __builtin_amdgcn_s_memrealtime(); while (__builtin_amdgcn_s_memrealtime() - t_end < 7ull * t_sel) __builtin_amdgcn_s_sleep(8); }
#endif
#undef IN
#undef BOTH
#undef GRID_BAR
}

static void launch_mega(const P& p, int lo, int hi, int li, hipStream_t stream) {
    Args a{}; a.p = p; a.ph_lo = lo; a.ph_hi = hi; a.li = li; a.pad = 0;
    hipLaunchKernelGGL(mega_fwd, dim3(256), dim3(NWAVES * 64), LDS_BYTES, stream, a);
}

extern "C" void kernel_launch(void* const* d_in, const int* in_sizes, int n_in, void* d_out, int out_size, void* d_ws, size_t ws_size, hipStream_t stream) {
    static int inited = 0;
    if (!inited) { (void)hipFuncSetAttribute((const void*)mega_fwd, hipFuncAttributeMaxDynamicSharedMemorySize, LDS_BYTES); inited = 1; }
    P p{};
    const float** ins = (const float**)&p;
    for (int i = 0; i < 20; ++i) ins[i] = (const float*)d_in[i];
    p.out = (float*)d_out; p.ws = (unsigned char*)d_ws;
    unsigned char* ws = p.ws;
    (void)hipMemsetAsync(ws + WS_CTL, 0, CTL_ZERO_BYTES, stream);
    unsigned* cnt = (unsigned*)(ws + WS_CTL) + CW_CNT;
    float* dt = (float*)(ws + WS_DT); float* F = (float*)(ws + WS_F);
    int* perm = (int*)(ws + WS_PERM); float* tokinfo = (float*)(ws + WS_TOK);
    float* yraw = (float*)(ws + WS_YRAW); bf16_t* z = (bf16_t*)(ws + WS_Z); bf16_t* xbc = (bf16_t*)(ws + WS_XBC); bf16_t* merged = (bf16_t*)(ws + WS_MERGED);
    bf16_t *q = (bf16_t*)(ws + WS_Q), *k = (bf16_t*)(ws + WS_K), *v = (bf16_t*)(ws + WS_V), *act = (bf16_t*)(ws + WS_ACT);
    float* xconv = (float*)(ws + WS_XCONV); bf16_t* hb = (bf16_t*)(ws + WS_HB);

    launch_mega(p, 0, 10, 0, stream);
}
```
